# Optimizing an MI355X kernel written in HIP

```python
import math
import jax
import jax.numpy as jnp
from jax import lax
import numpy as np

D_MODEL = 1024
BATCH = 1
SEQ = 16384
DEPTH = 4

CTX_LEN = 256
GRID_W = 64
N_MIXERS = 2
EPS = 1e-6
ADA_SCALE = 0.5

M_INNER = 2 * D_MODEL
M_HEADS = 4
M_DH_IN = M_INNER // M_HEADS
M_DQK = M_DH_IN // 2
M_DV = M_DH_IN
M_CONV = 3
M_CHUNK = 64

H_ORDER = 2
H_SCONV = 3
H_BANDS = 16
H_EMB = 2 * H_BANDS + 1
H_FH = 64
H_DECAY_MIN = -math.log(1e-2) / 1.5
H_DECAY_MAX = -math.log(1e-2) / 0.3

N_GROUPS = 4
EXP_PER_GROUP = 8
N_EXPERTS = N_GROUPS * EXP_PER_GROUP
TOP_K = 2
D_EXPERT = D_MODEL // 2
MOE_BLOCK = 128

kernel_name = 'hybrid_mlstm_hyena_hmoe_flow_backbone'


def rmsnorm(x, g):
    xf = x.astype(jnp.float32)
    y = xf * lax.rsqrt(jnp.mean(xf * xf, axis=-1, keepdims=True) + EPS)
    return (y * g.astype(jnp.float32)).astype(x.dtype)


def conv_centred(u, w, b):
    K = w.shape[0]
    L = u.shape[1]
    pad = K // 2
    up = jnp.pad(u, ((0, 0), (pad, pad), (0, 0)))
    out = b
    for kk in range(K):
        out = out + up[:, kk:kk + L] * w[kk]
    return out


def to_scan_order(x, col_major):
    if not col_major:
        return x
    B, L, D = x.shape
    rows = L // GRID_W
    return x.reshape(B, rows, GRID_W, D).transpose(0, 2, 1, 3).reshape(B, L, D)


def from_scan_order(x, col_major):
    if not col_major:
        return x
    B, L, D = x.shape
    rows = L // GRID_W
    return x.reshape(B, GRID_W, rows, D).transpose(0, 2, 1, 3).reshape(B, L, D)


def zero_state(B):
    f32 = jnp.float32
    return (jnp.zeros((B, M_HEADS, M_DV, M_DQK), f32),
            jnp.zeros((B, M_HEADS, M_DQK), f32),
            jnp.zeros((B, M_HEADS), f32))


def mlstm_scan(q, k, v, logi, logf, state):
    B, H, L, _ = q.shape
    nc = L // M_CHUNK

    def chunks(a):
        a = a.reshape(B, H, nc, M_CHUNK, *a.shape[3:])
        return jnp.moveaxis(a, 2, 0)

    mask = jnp.tril(jnp.ones((M_CHUNK, M_CHUNK), dtype=bool))

    def step(carry, xs):
        C, n, m = carry
        qc, kc, vc, ic, fc = xs
        b = jnp.cumsum(fc, axis=-1)
        log_d = b[..., :, None] - b[..., None, :] + ic[..., None, :]
        log_d = jnp.where(mask, log_d, -jnp.inf)
        inter = b + m[..., None]
        mj = jnp.maximum(inter, jnp.max(log_d, axis=-1))
        s = jnp.einsum('bhjd,bhsd->bhjs', qc, kc) * jnp.exp(log_d - mj[..., None])
        w_inter = jnp.exp(inter - mj)
        num = jnp.einsum('bhjs,bhsv->bhjv', s, vc) + w_inter[..., None] * jnp.einsum('bhjd,bhvd->bhjv', qc, C)
        den = jnp.sum(s, axis=-1) + w_inter * jnp.einsum('bhjd,bhd->bhj', qc, n)
        h = num / jnp.maximum(jnp.abs(den), jnp.exp(-mj))[..., None]
        b_last = b[..., -1]
        g = b_last[..., None] - b + ic
        m_new = jnp.maximum(b_last + m, jnp.max(g, axis=-1))
        decay = jnp.exp(b_last + m - m_new)
        wg = jnp.exp(g - m_new[..., None])
        C_new = decay[..., None, None] * C + jnp.einsum('bhsv,bhsd->bhvd', vc * wg[..., None], kc)
        n_new = decay[..., None] * n + jnp.einsum('bhs,bhsd->bhd', wg, kc)
        return (C_new, n_new, m_new), h

    state, h = lax.scan(step, state, (chunks(q), chunks(k), chunks(v), chunks(logi), chunks(logf)))
    h = jnp.moveaxis(h, 0, 2).reshape(B, H, L, -1)
    return h, state


def mlstm_mixer(u, in_w, conv_w, conv_b, q_w, k_w, v_w, gate_w, gate_b, norm_g, skip, out_w,
                init_f, init_b, need_out=True):
    f32 = jnp.float32
    B, L, _ = u.shape
    xm, o_pre = jnp.split(u @ in_w, 2, axis=-1)
    xc = jax.nn.silu(conv_centred(xm, conv_w, conv_b))
    xc_h = xc.reshape(B, L, M_HEADS, M_DH_IN)
    xm_h = xm.reshape(B, L, M_HEADS, M_DH_IN)
    q = jnp.einsum('blhi,hid->bhld', xc_h, q_w).astype(f32)
    k = (jnp.einsum('blhi,hid->bhld', xc_h, k_w) * (M_DQK ** -0.5)).astype(f32)
    v = jnp.einsum('blhi,hid->bhld', xm_h, v_w).astype(f32)
    gates = (jnp.concatenate([xc, xm], axis=-1) @ gate_w + gate_b).astype(f32)
    gates = gates.reshape(B, L, 4, M_HEADS).transpose(2, 0, 3, 1)
    h_f, st_f = mlstm_scan(q, k, v, gates[0], jax.nn.log_sigmoid(gates[1]), init_f)
    rev = lambda a: jnp.flip(a, axis=2)
    h_b, st_b = mlstm_scan(rev(q), rev(k), rev(v), rev(gates[2]), rev(jax.nn.log_sigmoid(gates[3])), init_b)
    if not need_out:
        return None, st_f, st_b
    h = h_f + rev(h_b)
    mu = jnp.mean(h, axis=-1, keepdims=True)
    var = jnp.mean(jnp.square(h - mu), axis=-1, keepdims=True)
    h = (h - mu) * lax.rsqrt(var + EPS)
    h = h.transpose(0, 2, 1, 3).reshape(B, L, M_INNER).astype(u.dtype)
    y = (h * norm_g + skip * xc) * jax.nn.sigmoid(o_pre)
    return y @ out_w, st_f, st_b


def hyena_filters(L, w1, b1, freq, w2, b2, w3, decay):
    f32 = jnp.float32
    pos = jnp.arange(L, dtype=f32)
    t = pos / max(L - 1, 1)
    bands = jnp.arange(1, H_BANDS + 1, dtype=f32)
    ang = (2.0 * math.pi / L) * pos[:, None] * bands[None, :]
    feat = jnp.concatenate([t[:, None], jnp.cos(ang), jnp.sin(ang)], axis=-1)
    fr = freq.astype(f32)
    z = jnp.sin(fr * (feat @ w1.astype(f32) + b1.astype(f32)))
    z = jnp.sin(fr * (z @ w2.astype(f32) + b2.astype(f32)))
    z = z @ w3.astype(f32)
    tau = jnp.abs(pos - L // 2) / (L / 2)
    filt = z * jnp.exp(-tau[:, None] * decay.astype(f32)[None, :])
    return filt * lax.rsqrt(jnp.sum(filt * filt, axis=0, keepdims=True) + EPS)


def fft_long_conv(u, filt, bias):
    f32 = jnp.float32
    L = u.shape[1]
    n = 2 * L
    uf = u.astype(f32)
    spec = jnp.fft.rfft(uf, n=n, axis=1) * jnp.fft.rfft(filt, n=n, axis=0)[None]
    y = jnp.fft.irfft(spec, n=n, axis=1)[:, L // 2:L // 2 + L]
    return (y + uf * bias.astype(f32)).astype(u.dtype)


def hyena_mixer(u, in_w, in_b, sc_w, sc_b, f_w1, f_b1, f_freq, f_w2, f_b2, f_w3, decay, fbias, out_w, out_b):
    B, L, D = u.shape
    z = conv_centred(u @ in_w + in_b, sc_w, sc_b)
    x1, x2, v = jnp.split(z, 3, axis=-1)
    filt = hyena_filters(L, f_w1, f_b1, f_freq, f_w2, f_b2, f_w3, decay)
    y = x1 * fft_long_conv(v, filt[:, :D], fbias[:D])
    y = x2 * fft_long_conv(y, filt[:, D:], fbias[D:])
    return y @ out_w + out_b


def moe_ffn(xt, rg_w, rg_b, re_w, re_b, w13, w2):
    f32 = jnp.float32
    T, D = xt.shape
    g_prob = jax.nn.softmax((xt @ rg_w + rg_b).astype(f32), axis=-1)
    g_w, g_idx = lax.top_k(g_prob, 1)
    e_logits = (xt @ re_w + re_b).astype(f32).reshape(T, N_GROUPS, EXP_PER_GROUP)
    e_logits = jnp.take_along_axis(e_logits, g_idx[:, :, None], axis=1)[:, 0]
    e_w, e_idx = lax.top_k(jax.nn.softmax(e_logits, axis=-1), TOP_K)
    e_w = e_w / jnp.sum(e_w, axis=-1, keepdims=True)
    weights = (g_w * e_w).reshape(-1)
    experts = (g_idx * EXP_PER_GROUP + e_idx).reshape(-1).astype(jnp.int32)
    A = T * TOP_K
    tok = jnp.arange(A, dtype=jnp.int32) // TOP_K
    order = jnp.argsort(experts)
    s_exp, s_tok, s_w = experts[order], tok[order], weights[order]
    counts = jnp.zeros((N_EXPERTS,), jnp.int32).at[experts].add(1)
    starts = jnp.cumsum(counts) - counts
    padded = (counts + MOE_BLOCK - 1) // MOE_BLOCK * MOE_BLOCK
    p_ends = jnp.cumsum(padded)
    p_starts = p_ends - padded
    dest = p_starts[s_exp] + jnp.arange(A, dtype=jnp.int32) - starts[s_exp]
    n_blocks = -(-A // MOE_BLOCK) + N_EXPERTS
    R = n_blocks * MOE_BLOCK
    row_tok = jnp.zeros((R,), jnp.int32).at[dest].set(s_tok)
    row_w = jnp.zeros((R,), f32).at[dest].set(s_w)
    blk_start = jnp.arange(n_blocks, dtype=jnp.int32) * MOE_BLOCK
    blk_exp = jnp.minimum(jnp.searchsorted(p_ends, blk_start, side='right'), N_EXPERTS - 1)
    xb = xt[row_tok].reshape(n_blocks, MOE_BLOCK, D)

    def expert_block(args):
        xblk, e = args
        gate, up = jnp.split(xblk @ w13[e], 2, axis=-1)
        return (jax.nn.silu(gate) * up) @ w2[e]

    yb = lax.map(expert_block, (xb, blk_exp)).reshape(R, D)
    return jax.ops.segment_sum(yb * row_w[:, None].astype(yb.dtype), row_tok, num_segments=T)


def setup_inputs(seed: int = 0) -> dict:
    key = jax.random.key(seed)
    ks = iter(jax.random.split(key, 64))
    f32 = jnp.float32

    def nrm(shape, scale):
        return scale * jax.random.normal(next(ks), shape, f32)

    D = D_MODEL
    n_a = len(range(0, DEPTH, N_MIXERS))
    n_b = len(range(1, DEPTH, N_MIXERS))
    fgate = jnp.linspace(3.0, 6.0, M_HEADS, dtype=f32)[None]
    decay = jnp.tile(jnp.linspace(H_DECAY_MIN, H_DECAY_MAX, D, dtype=f32), H_ORDER)[None]
    return {
        'x': nrm((BATCH, SEQ, D), 1.0),
        'c': nrm((BATCH, D), 1.0),
        'ctx': nrm((BATCH, CTX_LEN, D), 1.0),
        'c_ctx': nrm((D,), 1.0),
        'ada_w': nrm((DEPTH, D, 6 * D), ADA_SCALE * D ** -0.5),
        'ada_b': nrm((DEPTH, 6 * D), 0.01),
        'norm1_g': 1.0 + nrm((DEPTH, D), 0.02),
        'norm2_g': 1.0 + nrm((DEPTH, D), 0.02),
        'rg_w': nrm((DEPTH, D, N_GROUPS), D ** -0.5),
        'rg_b': nrm((DEPTH, N_GROUPS), 0.01),
        're_w': nrm((DEPTH, D, N_EXPERTS), D ** -0.5),
        're_b': nrm((DEPTH, N_EXPERTS), 0.01),
        'moe_w13': nrm((DEPTH, N_EXPERTS, D, 2 * D_EXPERT), D ** -0.5),
        'moe_w2': nrm((DEPTH, N_EXPERTS, D_EXPERT, D), D_EXPERT ** -0.5),
        'm_in_w': nrm((n_a, D, 2 * M_INNER), D ** -0.5),
        'm_conv_w': nrm((n_a, M_CONV, M_INNER), M_CONV ** -0.5),
        'm_conv_b': nrm((n_a, M_INNER), 0.01),
        'm_q_w': nrm((n_a, M_HEADS, M_DH_IN, M_DQK), M_DH_IN ** -0.5),
        'm_k_w': nrm((n_a, M_HEADS, M_DH_IN, M_DQK), M_DH_IN ** -0.5),
        'm_v_w': nrm((n_a, M_HEADS, M_DH_IN, M_DV), M_DH_IN ** -0.5),
        'm_gate_w': nrm((n_a, 2 * M_INNER, 4 * M_HEADS), 0.1 * (2 * M_INNER) ** -0.5),
        'm_gate_b': jnp.concatenate([nrm((n_a, M_HEADS), 0.1), fgate + nrm((n_a, M_HEADS), 0.1),
                                     nrm((n_a, M_HEADS), 0.1), fgate + nrm((n_a, M_HEADS), 0.1)], axis=-1),
        'm_norm_g': 1.0 + nrm((n_a, M_INNER), 0.02),
        'm_skip': 1.0 + nrm((n_a, M_INNER), 0.02),
        'm_out_w': nrm((n_a, M_INNER, D), M_INNER ** -0.5),
        'h_in_w': nrm((n_b, D, 3 * D), D ** -0.5),
        'h_in_b': nrm((n_b, 3 * D), 0.01),
        'h_sc_w': nrm((n_b, H_SCONV, 3 * D), H_SCONV ** -0.5),
        'h_sc_b': nrm((n_b, 3 * D), 0.01),
        'h_f_w1': nrm((n_b, H_EMB, H_FH), H_EMB ** -0.5),
        'h_f_b1': nrm((n_b, H_FH), 0.1),
        'h_f_freq': 1.0 + nrm((n_b, H_FH), 0.02),
        'h_f_w2': nrm((n_b, H_FH, H_FH), H_FH ** -0.5),
        'h_f_b2': nrm((n_b, H_FH), 0.1),
        'h_f_w3': nrm((n_b, H_FH, H_ORDER * D), H_FH ** -0.5),
        'h_decay': decay + nrm((n_b, H_ORDER * D), 0.05),
        'h_fbias': nrm((n_b, H_ORDER * D), 0.5),
        'h_out_w': nrm((n_b, D, D), D ** -0.5),
        'h_out_b': nrm((n_b, D), 0.01),
        'final_g': 1.0 + nrm((D,), 0.02),
    }


def reference(x, c, ctx, c_ctx, ada_w, ada_b, norm1_g, norm2_g, rg_w, rg_b, re_w, re_b, moe_w13, moe_w2,
              m_in_w, m_conv_w, m_conv_b, m_q_w, m_k_w, m_v_w, m_gate_w, m_gate_b, m_norm_g, m_skip, m_out_w,
              h_in_w, h_in_b, h_sc_w, h_sc_b, h_f_w1, h_f_b1, h_f_freq, h_f_w2, h_f_b2, h_f_w3, h_decay,
              h_fbias, h_out_w, h_out_b, final_g):
    B, S, D = x.shape
    n_ctx = ctx.shape[1]
    hl, hc = x, ctx
    for i in range(DEPTH):
        kind = i % N_MIXERS
        slot = i // N_MIXERS
        col_major = (slot % 2) == 1
        ctx_live = any(j % N_MIXERS == 0 for j in range(i + 1, DEPTH))
        ml = (jax.nn.silu(c) @ ada_w[i] + ada_b[i])[:, None, :]
        mc = (jax.nn.silu(c_ctx) @ ada_w[i] + ada_b[i])[None, None, :]
        sh1, sc1, g1, sh2, sc2, g2 = jnp.split(ml, 6, axis=-1)
        csh1, csc1, cg1, csh2, csc2, cg2 = jnp.split(mc, 6, axis=-1)

        ul = to_scan_order(rmsnorm(hl, norm1_g[i]) * (1.0 + sc1) + sh1, col_major)
        if kind == 0 or ctx_live:
            uc = rmsnorm(hc, norm1_g[i]) * (1.0 + csc1) + csh1
        if kind == 0:
            mp = (m_in_w[slot], m_conv_w[slot], m_conv_b[slot], m_q_w[slot], m_k_w[slot], m_v_w[slot],
                  m_gate_w[slot], m_gate_b[slot], m_norm_g[slot], m_skip[slot], m_out_w[slot])
            yc, st_f, st_b = mlstm_mixer(uc, *mp, zero_state(B), zero_state(B), need_out=ctx_live)
            yl, _, _ = mlstm_mixer(ul, *mp, st_f, st_b)
        else:
            hp = (h_in_w[slot], h_in_b[slot], h_sc_w[slot], h_sc_b[slot], h_f_w1[slot], h_f_b1[slot],
                  h_f_freq[slot], h_f_w2[slot], h_f_b2[slot], h_f_w3[slot], h_decay[slot], h_fbias[slot],
                  h_out_w[slot], h_out_b[slot])
            yl = hyena_mixer(ul, *hp)
            if ctx_live:
                yc = hyena_mixer(uc, *hp)
        hl = hl + g1 * from_scan_order(yl, col_major)
        if ctx_live:
            hc = hc + cg1 * yc

        mo = (rg_w[i], rg_b[i], re_w[i], re_b[i], moe_w13[i], moe_w2[i])
        vl = rmsnorm(hl, norm2_g[i]) * (1.0 + sc2) + sh2
        if ctx_live:
            vc = rmsnorm(hc, norm2_g[i]) * (1.0 + csc2) + csh2
            toks = jnp.concatenate([vc, vl], axis=1).reshape(-1, D)
            out = moe_ffn(toks, *mo).reshape(B, n_ctx + S, D)
            hc = hc + cg2 * out[:, :n_ctx]
            hl = hl + g2 * out[:, n_ctx:]
        else:
            hl = hl + g2 * moe_ffn(vl.reshape(-1, D), *mo).reshape(B, S, D)
    return rmsnorm(hl, final_g)
```

```cpp
#include <hip/hip_runtime.h>
#include <cstdio>
#include <cstdint>

#define LAS __attribute__((address_space(3)))
#define GAS __attribute__((address_space(1)))
#define RLX_AGENT __ATOMIC_RELAXED, __HIP_MEMORY_SCOPE_AGENT
typedef unsigned short bf16_t;
typedef short bf16x8 __attribute__((ext_vector_type(8)));
typedef float f32x4 __attribute__((ext_vector_type(4)));
typedef float f32x2 __attribute__((ext_vector_type(2)));
typedef unsigned u32x4 __attribute__((ext_vector_type(4)));
typedef unsigned u32x2 __attribute__((ext_vector_type(2)));

constexpr int D = 1024, SEQ = 16384, CTXN = 256, LT = SEQ + CTXN;
constexpr int MI = 2048, MH = 4, DQK = 256, DV = 512, CH = 64, NCH = LT / CH;
constexpr int NEXP = 32, DE = 512, NASG = 2 * LT;
constexpr int HB = 16, HEMB = 33, HFH = 64;
constexpr float EPS = 1e-6f;
constexpr int NT = 512, NWAVES = 8;
constexpr int LDS_BYTES = 147456;

constexpr size_t MiB = 1u << 20;
constexpr size_t WS_CTL = 0, CTL_BYTES = 1 * MiB;
constexpr size_t WS_MODS = 4 * MiB;
constexpr size_t WS_WC = 5 * MiB;
constexpr size_t WS_Z2 = 6 * MiB;
constexpr size_t WS_Z2C = 10 * MiB;
constexpr size_t WS_SCAL = 11 * MiB;
constexpr size_t WS_CHS = 14 * MiB;
constexpr size_t WS_DENI = 15 * MiB;
constexpr size_t WS_LIST = 16 * MiB;
constexpr size_t WS_AW = 21 * MiB;
constexpr size_t WS_GWT = 22 * MiB;
constexpr size_t WS_FILTC = 23 * MiB;
constexpr size_t WS_W3T = 25 * MiB;
constexpr size_t WS_WMIN = 32 * MiB;
constexpr size_t WS_WQ = 48 * MiB;
constexpr size_t WS_WK = 50 * MiB;
constexpr size_t WS_WV = 52 * MiB;
constexpr size_t WS_WMOUT = 56 * MiB;
constexpr size_t WS_WHIN = 64 * MiB;
constexpr size_t WS_WHOUT = 76 * MiB;
constexpr size_t WS_W13 = 96 * MiB;
constexpr size_t WS_W2 = 352 * MiB;
constexpr size_t WS_HL = 480 * MiB;
constexpr size_t WS_HC = 544 * MiB;
constexpr size_t WS_U = 546 * MiB;
constexpr size_t WS_VN = 580 * MiB;
constexpr size_t WS_YBUF = 614 * MiB;
constexpr size_t WS_H1 = 680 * MiB;
constexpr size_t WS_MIX = 722 * MiB;
constexpr size_t WS_XCM = WS_MIX;
constexpr size_t WS_OPRE = WS_MIX + 130 * MiB;
constexpr size_t WS_Q = WS_MIX + 195 * MiB;
constexpr size_t WS_KN = WS_MIX + 228 * MiB;
constexpr size_t WS_KT = WS_MIX + 261 * MiB;
constexpr size_t WS_VT = WS_MIX + 294 * MiB;
constexpr size_t WS_OINT = WS_MIX + 359 * MiB;
constexpr size_t WS_Y = WS_MIX + 495 * MiB;
constexpr size_t WS_ZT = WS_MIX;
constexpr size_t WS_FILT = WS_MIX + 98 * MiB;
constexpr size_t WS_Y2T = WS_MIX + 162 * MiB;
constexpr size_t WS_ZH = WS_MIX + 195 * MiB;
constexpr size_t WS_Y2 = WS_MIX + 259 * MiB;
constexpr size_t WS_END = WS_MIX + 560 * MiB;

constexpr int CW_BAR = 4096;
constexpr int CW_CNT = 16384;
constexpr int CW_ERR = 8;

__device__ __forceinline__ float bf2f(bf16_t b) { return __uint_as_float(((unsigned)b) << 16); }
__device__ __forceinline__ bf16_t f2bf(float f) { unsigned u = __float_as_uint(f); u += 0x7FFFu + ((u >> 16) & 1u); return (bf16_t)(u >> 16); }
__device__ __forceinline__ unsigned pk2(float lo, float hi) { return (unsigned)f2bf(lo) | ((unsigned)f2bf(hi) << 16); }
__device__ __forceinline__ float bflo(unsigned w) { return __uint_as_float(w << 16); }
__device__ __forceinline__ float bfhi(unsigned w) { return __uint_as_float(w & 0xffff0000u); }
__device__ __forceinline__ float siluf(float x) { return x / (1.0f + __expf(-x)); }
__device__ __forceinline__ float sigmf(float x) { return 1.0f / (1.0f + __expf(-x)); }
__device__ __forceinline__ int fresh_lane() { int l; asm volatile("v_mbcnt_lo_u32_b32 %0, -1, 0\n\tv_mbcnt_hi_u32_b32 %0, -1, %0" : "=v"(l)); return l; }
__device__ __forceinline__ float wave_sum(float v) {
#pragma unroll
    for (int o = 32; o > 0; o >>= 1) v += __shfl_xor(v, o);
    return v;
}
__device__ __forceinline__ float wave_max(float v) {
#pragma unroll
    for (int o = 32; o > 0; o >>= 1) v = fmaxf(v, __shfl_xor(v, o));
    return v;
}

#define XB_TMO      128
#define XB_XCNT(j)  (256  + 64 * (j))
#define XB_XSUB(j)  (1280 + 64 * (j))
#define XB_XGEN(j)  (2304 + 64 * (j))
#define XB_TOP      3328
#define XB_TOPGEN   3392
#define XCD_BAR_WORDS 3456
#define XB_SPIN_CAP (1u << 18)
__device__ __forceinline__ unsigned xb_ld(unsigned* p)              { return __hip_atomic_load(p, __ATOMIC_RELAXED, __HIP_MEMORY_SCOPE_AGENT); }
__device__ __forceinline__ unsigned xb_add(unsigned* p, unsigned v) { return __hip_atomic_fetch_add(p, v, __ATOMIC_RELAXED, __HIP_MEMORY_SCOPE_AGENT); }
__device__ __forceinline__ unsigned xb_xcc_id() { return (unsigned)__builtin_amdgcn_s_getreg((3 << 11) | 20) & 0xFu; }
#define XB_SPIN(cond, bar) do { unsigned _sp = 0; while (cond) { __builtin_amdgcn_s_sleep(1); \
    if ((++_sp & 255u) == 0u) { if (xb_ld(&(bar)[XB_TMO])) break; if (_sp > XB_SPIN_CAP) { atomicAdd(&(bar)[XB_TMO], 1u); break; } } } } while (0)
struct XcdBarrier { unsigned* bar; unsigned x; volatile LAS unsigned* st; };
__device__ __forceinline__ XcdBarrier xcd_barrier_post(unsigned* bar, volatile LAS unsigned* st, int tid) {
    XcdBarrier b; b.bar = bar; b.x = xb_xcc_id(); b.st = st;
    if (tid == 0) (void)xb_add(&bar[XB_XCNT(b.x)], 1u);
    return b;
}
__device__ __forceinline__ void xcd_barrier_complete(unsigned* bar, unsigned x, unsigned& nloc, unsigned& nx) {
    const unsigned G = gridDim.x * gridDim.y * gridDim.z;
    unsigned sum, cnt, mine, sp = 0u;
    for (;;) {
        sum = 0u; cnt = 0u; mine = 0u;
#pragma unroll
        for (unsigned j = 0; j < 16; ++j) { const unsigned c = xb_ld(&bar[XB_XCNT(j)]); sum += c; cnt += (c > 0u) ? 1u : 0u; mine = (j == x) ? c : mine; }
        if (sum == G) break;
        __builtin_amdgcn_s_sleep(1);
        if ((++sp & 255u) == 0u) { if (xb_ld(&bar[XB_TMO])) break; if (sp > XB_SPIN_CAP) { atomicAdd(&bar[XB_TMO], 1u); break; } }
    }
    nloc = mine > 0u ? mine : 1u; nx = cnt > 0u ? cnt : 1u;
}
__device__ __forceinline__ void xcd_barrier(const XcdBarrier& b, int tid) {
    asm volatile("s_waitcnt vmcnt(0)" ::: "memory");
    __syncthreads();
    if (tid == 0) {
        unsigned* bar = b.bar;
        __builtin_amdgcn_s_waitcnt(0);
        unsigned nloc = b.st[0], nx = b.st[1];
        if (nloc == 0u) { xcd_barrier_complete(bar, b.x, nloc, nx); b.st[0] = nloc; b.st[1] = nx; }
        const unsigned old = xb_add(&bar[XB_XSUB(b.x)], 1u);
        const unsigned gen = old / nloc;
        if (old + 1u == (gen + 1u) * nloc) {
            __builtin_amdgcn_fence(__ATOMIC_RELEASE, "agent");
            asm volatile("s_waitcnt vmcnt(0)" ::: "memory");
            const unsigned og = xb_add(&bar[XB_TOP], 1u);
            const unsigned tg = og / nx;
            if (og + 1u == (tg + 1u) * nx) xb_add(&bar[XB_TOPGEN], 1u);
            else XB_SPIN(xb_ld(&bar[XB_TOPGEN]) == tg, bar);
            __builtin_amdgcn_fence(__ATOMIC_ACQUIRE, "agent");
            xb_add(&bar[XB_XGEN(b.x)], 1u);
            asm volatile("s_waitcnt vmcnt(0)" ::: "memory");
        } else {
            XB_SPIN(xb_ld(&bar[XB_XGEN(b.x)]) == gen, bar);
            __builtin_amdgcn_fence(__ATOMIC_ACQUIRE, "agent");
            asm volatile("s_waitcnt vmcnt(0)" ::: "memory");
        }
    }
    __syncthreads();
}

namespace pg8 {
constexpr int BM = 256, BK = 64, HALF = 128, HTB = HALF * BK * 2, STAGE_BYTES = 8 * HTB;
__device__ __forceinline__ int lds_byte(int r, int c) { const int st = (r >> 4) * 2 + (c >> 5), rr = r & 15, cc = c & 31, ob = rr * 64 + cc * 2; return st * 1024 + (ob ^ (((ob >> 9) & 1) << 5)); }
__device__ __forceinline__ void stage_rc(int b, int& R, int& C) { const int st = b / 1024, sb = b % 1024, swz = sb ^ (((sb >> 9) & 1) << 5); R = (st >> 1) * 16 + swz / 64; C = (st & 1) * 32 + (swz % 64) / 2; }
__device__ __forceinline__ int perm32(int rho) { const int n = rho >> 4, i = rho & 15; return 8 * (i >> 2) + 4 * n + (i & 3); }

struct GUnit { const char* a; const char* b; char* o; int pm, pn, g, aux, lda, ldb, ldo, hsb; };

template <class Epi, class Sched, bool GATHER>
__device__ __forceinline__ void gemm_phase(LAS unsigned char* lds, const int K, const Sched& S, const Epi& E, int tid_in) {
    int tid_ = tid_in; asm volatile("" : "+v"(tid_));
    const int tid = tid_, wid = __builtin_amdgcn_readfirstlane(tid >> 6), lane = tid & 63, wr = wid >> 2, wc = wid & 3, fr = lane & 15, fq = lane >> 4;
    const int nt = K / BK;
    unsigned cvA0[2], cvA1[2], cvB[2];
#define PG8_OFFS(U, slot, vA0, vA1, vB) do { _Pragma("unroll") for (int i = 0; i < 2; ++i) { int R_, C_; stage_rc(tid * 16 + i * 8192, R_, C_); const int Rb_ = Epi::PERM ? ((R_ & ~31) + perm32(R_ & 31)) : R_; \
        if constexpr (GATHER) { vA0[i] = S.grow(slot, R_) + (unsigned)C_ * 2u; vA1[i] = S.grow(slot, R_ + HALF) + (unsigned)C_ * 2u; } \
        else { vA0[i] = (unsigned)(R_ * (U).lda + C_) * 2u; vA1[i] = (unsigned)((R_ + HALF) * (U).lda + C_) * 2u; } \
        vB[i] = (unsigned)(Rb_ * (U).ldb + C_) * 2u; } } while (0)
    const size_t kstep = (size_t)(BK * 2);
    const unsigned ldsw = (unsigned)wid * 1024u;
    const int aoff = lds_byte(wr * 64 + fr, fq * 8), boff = lds_byte(wc * 32 + fr, fq * 8);
#define PG8_SA(b, h) (((b) * 2 + (h)) * HTB)
#define PG8_SB(b, h) ((4 + (b) * 2 + (h)) * HTB)
#define PG8_STAGE(bufoff, gbase, voff) do { _Pragma("unroll") for (int _i = 0; _i < 2; ++_i) \
        __builtin_amdgcn_global_load_lds((const unsigned*)((const char*)(gbase) + (voff)[_i]), (LAS unsigned*)(lds + (bufoff) + ldsw + _i * 8192), 16, 0, 0); } while (0)
#define PG8_LDA(dst, b, h) do { _Pragma("unroll") for (int m = 0; m < 4; ++m) _Pragma("unroll") for (int k = 0; k < 2; ++k) dst[m][k] = *(const LAS bf16x8*)(lds + PG8_SA(b, h) + aoff + m * 2048 + k * 1024); } while (0)
#define PG8_LDB(dst, b, h) do { _Pragma("unroll") for (int n = 0; n < 2; ++n) _Pragma("unroll") for (int k = 0; k < 2; ++k) dst[n][k] = *(const LAS bf16x8*)(lds + PG8_SB(b, h) + boff + n * 2048 + k * 1024); } while (0)
#define PG8_MMA(ai, bj, At, Bt) do { __builtin_amdgcn_s_setprio(1); _Pragma("unroll") for (int m = 0; m < 4; ++m) _Pragma("unroll") for (int n = 0; n < 2; ++n) _Pragma("unroll") for (int k = 0; k < 2; ++k) \
        acc[ai][bj][m][n] = __builtin_amdgcn_mfma_f32_16x16x32_bf16(Bt[n][k], At[m][k], acc[ai][bj][m][n], 0, 0, 0); __builtin_amdgcn_s_setprio(0); } while (0)
#define PG8_WAIT_V(n) asm volatile("s_waitcnt vmcnt(" #n ")" ::: "memory")
#define PG8_WAIT_L(n) asm volatile("s_waitcnt lgkmcnt(" #n ")" ::: "memory")
#define PG8_BAR __builtin_amdgcn_s_barrier()
#define PG8_SCHED __builtin_amdgcn_sched_barrier(0)
    GUnit cur, nxt; int ui = 0;
    if (!S.next(0, cur)) return;
    PG8_OFFS(cur, 0, cvA0, cvA1, cvB);
    size_t chB = (size_t)cur.hsb * cur.ldb * 2;
    f32x4 acc[2][2][4][2];
#pragma unroll
    for (int a = 0; a < 2; ++a)
#pragma unroll
        for (int b = 0; b < 2; ++b)
#pragma unroll
            for (int m = 0; m < 4; ++m)
#pragma unroll
                for (int n = 0; n < 2; ++n) acc[a][b][m][n] = (f32x4){0.f, 0.f, 0.f, 0.f};
    bf16x8 At[4][2], B0[2][2], B1[2][2];
    const char* cA = cur.a; const char* cB = cur.b;
    PG8_STAGE(PG8_SB(0, 0), cB, cvB); PG8_STAGE(PG8_SA(0, 0), cA, cvA0); PG8_STAGE(PG8_SB(0, 1), cB + chB, cvB); PG8_STAGE(PG8_SA(0, 1), cA, cvA1);
    if (wr == 1) PG8_BAR;
    PG8_WAIT_V(4); PG8_BAR;
    PG8_STAGE(PG8_SB(1, 0), cB + kstep, cvB); PG8_STAGE(PG8_SA(1, 0), cA + kstep, cvA0); PG8_STAGE(PG8_SB(1, 1), cB + chB + kstep, cvB);
    PG8_WAIT_V(6); PG8_BAR;
    for (;;) {
        const bool has_next = S.next(ui + 1, nxt);
        const char* nA = has_next ? nxt.a : cA; const char* nB = has_next ? nxt.b : cB;
        for (int t = 0; t < nt; t += 2) {
            const bool last = (t == nt - 2);
            const char* a1 = cA + (size_t)(t + 1) * kstep;
            const char* a2 = last ? nA : cA + (size_t)(t + 2) * kstep; const char* b2 = last ? nB : cB + (size_t)(t + 2) * kstep;
            const char* a3 = a2 + kstep; const char* b3 = b2 + kstep;
            PG8_LDB(B0, 0, 0); PG8_SCHED; PG8_LDA(At, 0, 0); PG8_STAGE(PG8_SA(1, 1), a1, cvA1);
            PG8_WAIT_L(8); PG8_BAR; PG8_WAIT_L(0); PG8_MMA(0, 0, At, B0); PG8_BAR; PG8_SCHED;
            if (last && has_next) { PG8_OFFS(nxt, ui + 1, cvA0, cvA1, cvB); chB = (size_t)nxt.hsb * nxt.ldb * 2; }
            PG8_LDB(B1, 0, 1); PG8_STAGE(PG8_SB(0, 0), b2, cvB);
            PG8_BAR; PG8_WAIT_L(0); PG8_MMA(0, 1, At, B1); PG8_BAR;
            PG8_LDA(At, 0, 1); PG8_STAGE(PG8_SA(0, 0), a2, cvA0);
            PG8_BAR; PG8_WAIT_L(0); PG8_MMA(1, 0, At, B0); PG8_BAR; PG8_SCHED;
            PG8_STAGE(PG8_SB(0, 1), b2 + chB, cvB);
            PG8_WAIT_V(6); PG8_BAR; PG8_MMA(1, 1, At, B1); PG8_BAR;
            PG8_LDB(B0, 1, 0); PG8_SCHED; PG8_LDA(At, 1, 0); PG8_STAGE(PG8_SA(0, 1), a2, cvA1);
            PG8_WAIT_L(8); PG8_BAR; PG8_WAIT_L(0); PG8_MMA(0, 0, At, B0); PG8_BAR; PG8_SCHED;
            PG8_LDB(B1, 1, 1); PG8_STAGE(PG8_SB(1, 0), b3, cvB);
            PG8_BAR; PG8_WAIT_L(0); PG8_MMA(0, 1, At, B1); PG8_BAR;
            PG8_LDA(At, 1, 1); PG8_STAGE(PG8_SA(1, 0), a3, cvA0);
            PG8_BAR; PG8_WAIT_L(0); PG8_MMA(1, 0, At, B0); PG8_BAR; PG8_SCHED;
            PG8_STAGE(PG8_SB(1, 1), b3 + chB, cvB);
            PG8_WAIT_V(6); PG8_BAR; PG8_MMA(1, 1, At, B1); PG8_BAR;
        }
        E(acc, cur, wr, wc, fr, fq);
        if (!has_next) break;
#pragma unroll
        for (int a = 0; a < 2; ++a)
#pragma unroll
            for (int b = 0; b < 2; ++b)
#pragma unroll
                for (int m = 0; m < 4; ++m)
#pragma unroll
                    for (int n = 0; n < 2; ++n) acc[a][b][m][n] = (f32x4){0.f, 0.f, 0.f, 0.f};
        cur = nxt; cA = nA; cB = nB; ++ui;
    }
    PG8_WAIT_V(0);
    if (wr == 0) PG8_BAR;
    PG8_BAR;
#undef PG8_OFFS
#undef PG8_SA
#undef PG8_SB
#undef PG8_STAGE
#undef PG8_LDA
#undef PG8_LDB
#undef PG8_MMA
#undef PG8_WAIT_V
#undef PG8_WAIT_L
#undef PG8_BAR
#undef PG8_SCHED
}

__device__ __forceinline__ int xcd_remap(int wgid, int nwg) { const int q = nwg / 8, r = nwg % 8, xcd = wgid % 8, off = wgid / 8; return (xcd < r ? xcd * (q + 1) : r * (q + 1) + (xcd - r) * q) + off; }
}
using pg8::GUnit;

struct Args { const float* in[40]; float* out; unsigned char* ws; int ph_lo, ph_hi; };
struct Frame {
    LAS unsigned char* lds; unsigned char* ws; const float* const* in; float* out;
    int tid, lane, wave, G, bid;
};
struct Prob { const char* A; const char* B; char* O; long long sA, sB, sO;
              int nM, nN, nb, ustart; int lda, ldb, ldo; int osz; };
constexpr int SCHED_TAB = 131072 + 8192;
__device__ __forceinline__ int rfl(int v) { return __builtin_amdgcn_readfirstlane(v); }
__device__ __forceinline__ const char* rflp(const char* p) { const unsigned long long v = (unsigned long long)p; return (const char*)(((unsigned long long)(unsigned)rfl((int)(v >> 32)) << 32) | (unsigned)rfl((int)v)); }
template <int NP> struct MultiSched {
    LAS Prob* p; int total, G, c;
    __device__ __forceinline__ void init(const Frame& F, const Prob (&q)[NP], int total_) {
        p = (LAS Prob*)(F.lds + SCHED_TAB); total = total_; G = F.G; c = F.bid;
        __syncthreads();
        if (F.tid == 0) {
#pragma unroll
            for (int j = 0; j < NP; ++j) { p[j].A = q[j].A; p[j].B = q[j].B; p[j].O = q[j].O; p[j].sA = q[j].sA; p[j].sB = q[j].sB; p[j].sO = q[j].sO; p[j].nM = q[j].nM; p[j].nN = q[j].nN; p[j].nb = q[j].nb;
                p[j].ustart = q[j].ustart; p[j].lda = q[j].lda; p[j].ldb = q[j].ldb; p[j].ldo = q[j].ldo; p[j].osz = q[j].osz; } }
        __syncthreads();
    }
    __device__ __forceinline__ bool next(int i, GUnit& u) const {
        const long long Lq = (long long)i * G + c; if (Lq >= total) return false;
        int L = pg8::xcd_remap((int)Lq, total);
        int k = 0;
#pragma unroll
        for (int j = 1; j < NP; ++j) if (L >= p[j].ustart) k = j;
        k = rfl(k);
        const LAS Prob& q = p[k];
        const int nM = rfl(q.nM), nN = rfl(q.nN), lda = rfl(q.lda), ldb = rfl(q.ldb), ldo = rfl(q.ldo), osz = rfl(q.osz);
        L -= rfl(q.ustart);
        const int per = nM * nN, b = L / per, r = L - b * per, pm = r / nN, pn = r - pm * nN;
        u.pm = pm; u.pn = pn; u.g = b; u.aux = k; u.lda = lda; u.ldb = ldb; u.ldo = ldo; u.hsb = 128;
        u.a = rflp(q.A) + b * (long long)rfl((int)q.sA) + (size_t)pm * 256 * lda * 2;
        u.b = rflp(q.B) + b * (long long)rfl((int)q.sB) + (size_t)pn * 256 * ldb * 2;
        u.o = (char*)rflp(q.O) + b * (long long)rfl((int)q.sO) + ((size_t)pm * 256 * ldo + (size_t)pn * 256) * osz;
        return true;
    }
};

struct EpiStore {
    static constexpr bool PERM = true;
    const float* rowbias;
    __device__ __forceinline__ void operator()(const f32x4 (&acc)[2][2][4][2], const GUnit& u, int wr, int wc, int fr, int fq) const {
        bf16_t* base = (bf16_t*)u.o;
#pragma unroll
        for (int ai = 0; ai < 2; ++ai)
#pragma unroll
            for (int m = 0; m < 4; ++m) { const int r = ai * 128 + wr * 64 + m * 16 + fr; bf16_t* rowp = base + (size_t)r * u.ldo + wc * 32 + 8 * fq;
                const float rb = rowbias ? rowbias[u.pm * 256 + r] : 0.f;
#pragma unroll
                for (int bj = 0; bj < 2; ++bj) { const f32x4 v0 = acc[ai][bj][m][0] + rb, v1 = acc[ai][bj][m][1] + rb;
                    u32x4 w; w.x = pk2(v0[0], v0[1]); w.y = pk2(v0[2], v0[3]); w.z = pk2(v1[0], v1[1]); w.w = pk2(v1[2], v1[3]);
                    *(u32x4*)(rowp + bj * 128) = w; } }
    }
};

enum { I_X = 0, I_C, I_CTX, I_CCTX, I_ADAW, I_ADAB, I_N1G, I_N2G, I_RGW, I_RGB, I_REW, I_REB, I_W13, I_W2,
       I_MINW, I_MCONVW, I_MCONVB, I_MQW, I_MKW, I_MVW, I_MGATEW, I_MGATEB, I_MNORMG, I_MSKIP, I_MOUTW,
       I_HINW, I_HINB, I_HSCW, I_HSCB, I_HFW1, I_HFB1, I_HFFREQ, I_HFW2, I_HFB2, I_HFW3, I_HDECAY, I_HFBIAS, I_HOUTW, I_HOUTB, I_FINALG };

__device__ __forceinline__ void tconv(const Frame& F, const float* src, bf16_t* dst, int B, int R, int C, float scale) {
    LAS float* tile = (LAS float*)F.lds;
    const int tr = R / 64, tc = C / 64, ntile = B * tr * tc;
    for (int t = F.bid; t < ntile; t += F.G) {
        const int b = t / (tr * tc), rem = t - b * tr * tc, r0 = (rem / tc) * 64, c0 = (rem % tc) * 64;
        const float* s = src + ((size_t)b * R + r0) * C + c0;
        { const int r = F.tid >> 3, c8 = (F.tid & 7) * 8;
          const f32x4 v0 = *(const f32x4*)(s + (size_t)r * C + c8), v1 = *(const f32x4*)(s + (size_t)r * C + c8 + 4);
#pragma unroll
          for (int j = 0; j < 4; ++j) { tile[r * 65 + c8 + j] = v0[j]; tile[r * 65 + c8 + 4 + j] = v1[j]; } }
        __syncthreads();
        { const int n = F.tid >> 3, k8 = (F.tid & 7) * 8; float v[8];
#pragma unroll
          for (int j = 0; j < 8; ++j) v[j] = tile[(k8 + j) * 65 + n] * scale;
          u32x4 w; w.x = pk2(v[0], v[1]); w.y = pk2(v[2], v[3]); w.z = pk2(v[4], v[5]); w.w = pk2(v[6], v[7]);
          *(u32x4*)(dst + ((size_t)b * C + c0 + n) * R + r0 + k8) = w; }
        __syncthreads();
    }
}

__device__ __forceinline__ void p0_prologue(const Frame& F) {
    unsigned char* ws = F.ws;
    {
        LAS float* sv = (LAS float*)F.lds;
        __syncthreads();
        for (int i = F.tid; i < 2048; i += NT) sv[i] = siluf(i < 1024 ? F.in[I_C][i] : F.in[I_CCTX][i - 1024]);
        __syncthreads();
        for (int u = F.bid; u < 4 * 12; u += F.G) {
            const int l = u / 12, cb = u % 12;
            const int col = cb * 512 + F.tid;
            const float* w = F.in[I_ADAW] + (size_t)l * 1024 * 6144 + col;
            float a0 = F.in[I_ADAB][l * 6144 + col], a1 = a0;
#pragma unroll 16
            for (int k = 0; k < 1024; ++k) { const float wv = w[(size_t)k * 6144]; a0 += sv[k] * wv; a1 += sv[1024 + k] * wv; }
            float* mo = (float*)(ws + WS_MODS) + (size_t)(l * 2) * 6144;
            mo[col] = a0; mo[6144 + col] = a1;
        }
        __syncthreads();
    }
    tconv(F, F.in[I_MINW], (bf16_t*)(ws + WS_WMIN), 2, 1024, 4096, 1.f);
    tconv(F, F.in[I_MQW], (bf16_t*)(ws + WS_WQ), 8, 512, 256, 1.f);
    tconv(F, F.in[I_MKW], (bf16_t*)(ws + WS_WK), 8, 512, 256, 0.0625f);
    tconv(F, F.in[I_MVW], (bf16_t*)(ws + WS_WV), 8, 512, 512, 1.f);
    tconv(F, F.in[I_MOUTW], (bf16_t*)(ws + WS_WMOUT), 2, 2048, 1024, 1.f);
    tconv(F, F.in[I_HINW], (bf16_t*)(ws + WS_WHIN), 2, 1024, 3072, 1.f);
    tconv(F, F.in[I_HOUTW], (bf16_t*)(ws + WS_WHOUT), 2, 1024, 1024, 1.f);
    tconv(F, F.in[I_HFW3], (bf16_t*)(ws + WS_W3T), 2, 64, 2048, 1.f);
    tconv(F, F.in[I_W13], (bf16_t*)(ws + WS_W13), 128, 1024, 1024, 1.f);
    tconv(F, F.in[I_W2], (bf16_t*)(ws + WS_W2), 128, 512, 1024, 1.f);
    const int gt = F.bid * NT + F.tid, gs = F.G * NT;
    for (int i = gt; i < 2 * 16 * 4096; i += gs) { const int s = i / 65536, r = i % 65536, n = r / 4096, k = r % 4096;
        ((bf16_t*)(ws + WS_GWT))[i] = f2bf(F.in[I_MGATEW][((size_t)s * 4096 + k) * 16 + n]); }
    for (int i = gt; i < 4 * 1024 * 48; i += gs) { const int l = i / 49152, r = i % 49152, k = r / 48, n = r % 48;
        float v = 0.f; if (n < 4) v = F.in[I_RGW][((size_t)l * 1024 + k) * 4 + n]; else if (n < 36) v = F.in[I_REW][((size_t)l * 1024 + k) * 32 + (n - 4)];
        ((float*)(ws + WS_WC))[i] = v; }
    {
        LAS float* ft = (LAS float*)F.lds;
        LAS float* z1 = ft + 8 * 36;
        const int nrow = 2 * SEQ + CTXN;
        for (int r0 = F.bid * 8; r0 < nrow; r0 += F.G * 8) {
            const int rr = F.tid >> 6, j = F.tid & 63, row = r0 + rr;
            int slot, t, Ln; if (row < 2 * SEQ) { slot = row / SEQ; t = row % SEQ; Ln = SEQ; } else { slot = 0; t = row - 2 * SEQ; Ln = CTXN; }
            __syncthreads();
            if (j < 33) { float f;
                if (j == 0) f = (float)t / (float)(Ln - 1);
                else { const int b = (j - 1) % 16 + 1; const int ph = (t * b) % Ln; const float a = (float)ph / (float)Ln;
                       f = (j <= 16) ? cosf(6.283185307179586f * a) : sinf(6.283185307179586f * a); }
                ft[rr * 36 + j] = f; }
            __syncthreads();
            const float fr = F.in[I_HFFREQ][slot * 64 + j];
            { float a = F.in[I_HFB1][slot * 64 + j]; const float* w1 = F.in[I_HFW1] + (size_t)slot * 33 * 64 + j;
#pragma unroll
              for (int k = 0; k < 33; ++k) a += ft[rr * 36 + k] * w1[k * 64];
              z1[rr * 64 + j] = sinf(fr * a); }
            __syncthreads();
            { float a = F.in[I_HFB2][slot * 64 + j]; const float* w2 = F.in[I_HFW2] + (size_t)slot * 64 * 64 + j;
#pragma unroll 8
              for (int k = 0; k < 64; ++k) a += z1[rr * 64 + k] * w2[k * 64];
              const float z = sinf(fr * a);
              bf16_t* dst = (row < 2 * SEQ) ? (bf16_t*)(ws + WS_Z2) + (size_t)row * 64 : (bf16_t*)(ws + WS_Z2C) + (size_t)t * 64;
              dst[j] = f2bf(z); }
        }
        __syncthreads();
    }
}

__device__ __forceinline__ const float* modp(const Frame& F, int l, int s, int piece) { return (const float*)(F.ws + WS_MODS) + ((size_t)(l * 2 + s) * 6 + piece) * 1024; }
__device__ __forceinline__ int scan_pos(int t, bool colmajor) { return colmajor ? ((t & 63) * 256 + (t >> 6)) : t; }
__device__ __forceinline__ int scan_inv(int p, bool colmajor) { return colmajor ? ((p & 255) * 64 + (p >> 8)) : p; }

__device__ __forceinline__ void n1_phase(const Frame& F, int l, bool comb, bool ctx_rows, bool comb_ctx, bool first, bool colmajor) {
    float* HL = (float*)(F.ws + WS_HL); float* HC = (float*)(F.ws + WS_HC); bf16_t* U = (bf16_t*)(F.ws + WS_U);
    const bf16_t* YB = (const bf16_t*)(F.ws + WS_YBUF);
    const float* g1n = F.in[I_N1G] + l * 1024;
    const int nrows = SEQ + (ctx_rows ? CTXN : 0);
    for (int r = F.bid * NWAVES + F.wave; r < nrows; r += F.G * NWAVES) {
        const bool isctx = r >= SEQ; const int t = isctx ? r - SEQ : r; const int s = isctx ? 1 : 0;
        const float* src = first ? (isctx ? F.in[I_CTX] : F.in[I_X]) + (size_t)t * 1024 : (isctx ? HC : HL) + (size_t)t * 1024;
        float* dsth = (isctx ? HC : HL) + (size_t)t * 1024;
        const float* sh = modp(F, l, s, 0); const float* sc = modp(F, l, s, 1);
        const bool docomb = comb && (!isctx || comb_ctx);
        const float* g2 = docomb ? modp(F, l - 1, s, 5) : nullptr;
        const int tok = isctx ? t : CTXN + t;
        f32x4 v[4]; float ss = 0.f;
#pragma unroll
        for (int j = 0; j < 4; ++j) { const int c = j * 256 + F.lane * 4; v[j] = *(const f32x4*)(src + c);
            if (docomb) { const u32x2 y0 = *(const u32x2*)(YB + ((size_t)tok * 2 + 0) * 1024 + c), y1 = *(const u32x2*)(YB + ((size_t)tok * 2 + 1) * 1024 + c); const f32x4 g = *(const f32x4*)(g2 + c);
                v[j][0] += g[0] * (bflo(y0.x) + bflo(y1.x)); v[j][1] += g[1] * (bfhi(y0.x) + bfhi(y1.x)); v[j][2] += g[2] * (bflo(y0.y) + bflo(y1.y)); v[j][3] += g[3] * (bfhi(y0.y) + bfhi(y1.y)); }
            if (docomb || first) *(f32x4*)(dsth + c) = v[j];
            ss += v[j][0] * v[j][0] + v[j][1] * v[j][1] + v[j][2] * v[j][2] + v[j][3] * v[j][3]; }
        ss = wave_sum(ss);
        const float rstd = rsqrtf(ss * (1.0f / 1024.0f) + EPS);
        const int urow = isctx ? t : CTXN + scan_pos(t, colmajor);
#pragma unroll
        for (int j = 0; j < 4; ++j) { const int c = j * 256 + F.lane * 4; const f32x4 g = *(const f32x4*)(g1n + c), a = *(const f32x4*)(sc + c), b = *(const f32x4*)(sh + c);
            float o[4];
#pragma unroll
            for (int e = 0; e < 4; ++e) o[e] = v[j][e] * rstd * g[e] * (1.0f + a[e]) + b[e];
            u32x2 w; w.x = pk2(o[0], o[1]); w.y = pk2(o[2], o[3]); *(u32x2*)(U + (size_t)urow * 1024 + c) = w; }
    }
}

__device__ __forceinline__ void final_phase(const Frame& F, bool comb, int lprev, bool first) {
    const float* HL = (const float*)(F.ws + WS_HL); const bf16_t* YB = (const bf16_t*)(F.ws + WS_YBUF); const float* fg = F.in[I_FINALG];
    for (int t = F.bid * NWAVES + F.wave; t < SEQ; t += F.G * NWAVES) {
        const float* src = (first ? F.in[I_X] : HL) + (size_t)t * 1024; const float* g2 = comb ? modp(F, lprev, 0, 5) : nullptr; const int tok = CTXN + t;
        f32x4 v[4]; float ss = 0.f;
#pragma unroll
        for (int j = 0; j < 4; ++j) { const int c = j * 256 + F.lane * 4; v[j] = *(const f32x4*)(src + c);
            if (comb) { const u32x2 y0 = *(const u32x2*)(YB + ((size_t)tok * 2 + 0) * 1024 + c), y1 = *(const u32x2*)(YB + ((size_t)tok * 2 + 1) * 1024 + c); const f32x4 g = *(const f32x4*)(g2 + c);
                v[j][0] += g[0] * (bflo(y0.x) + bflo(y1.x)); v[j][1] += g[1] * (bfhi(y0.x) + bfhi(y1.x)); v[j][2] += g[2] * (bflo(y0.y) + bflo(y1.y)); v[j][3] += g[3] * (bfhi(y0.y) + bfhi(y1.y)); }
            ss += v[j][0] * v[j][0] + v[j][1] * v[j][1] + v[j][2] * v[j][2] + v[j][3] * v[j][3]; }
        ss = wave_sum(ss);
        const float rstd = rsqrtf(ss * (1.0f / 1024.0f) + EPS);
#pragma unroll
        for (int j = 0; j < 4; ++j) { const int c = j * 256 + F.lane * 4; const f32x4 g = *(const f32x4*)(fg + c);
            f32x4 o;
#pragma unroll
            for (int e = 0; e < 4; ++e) o[e] = v[j][e] * rstd * g[e];
            *(f32x4*)(F.out + (size_t)t * 1024 + c) = o; }
    }
}

__device__ __forceinline__ float* scal_arr(const Frame& F, int k, int ch) { return (float*)(F.ws + WS_SCAL) + ((size_t)k * 8 + ch) * LT; }
__device__ __forceinline__ float* chs_arr(const Frame& F, int k, int ch) { return (float*)(F.ws + WS_CHS) + ((size_t)k * 8 + ch) * NCH; }
__device__ __forceinline__ float logsigf(float x) { return fminf(x, 0.f) - log1pf(__expf(-fabsf(x))); }

__device__ __forceinline__ void mlstm_inproj(const Frame& F, int slot) {
    MultiSched<2> S; Prob pr[2];
    const char* W = (const char*)(F.ws + WS_WMIN) + (size_t)slot * 4096 * 1024 * 2;
    pr[0] = Prob{(const char*)(F.ws + WS_U), W, (char*)(F.ws + WS_XCM) + 2048 * 2, 0, 0, 0, NCH / 4, 8, 1, 0, 1024, 1024, 4096, 2};
    pr[1] = Prob{(const char*)(F.ws + WS_U), W + (size_t)2048 * 1024 * 2, (char*)(F.ws + WS_OPRE), 0, 0, 0, NCH / 4, 8, 1, 65 * 8, 1024, 1024, 2048, 2};
    S.init(F, pr, 65 * 16);
    EpiStore E{nullptr};
    pg8::gemm_phase<EpiStore, MultiSched<2>, false>(F.lds, 1024, S, E, F.tid);
}

__device__ __forceinline__ void mlstm_conv_gates(const Frame& F, int slot) {
    constexpr int TP = 4096 + 8;
    LAS bf16_t* tile = (LAS bf16_t*)F.lds;
    LAS float* part = (LAS float*)(F.lds + 16 * TP * 2);
    LAS float* gl = part + 8 * 256;
    bf16_t* XCM = (bf16_t*)(F.ws + WS_XCM);
    const bf16_t* GWT = (const bf16_t*)(F.ws + WS_GWT) + (size_t)slot * 16 * 4096;
    const int c4 = F.tid * 4;
    float cw[3][4], cb[4];
#pragma unroll
    for (int k = 0; k < 3; ++k) { const f32x4 w = *(const f32x4*)(F.in[I_MCONVW] + ((size_t)slot * 3 + k) * 2048 + c4); cw[k][0] = w[0]; cw[k][1] = w[1]; cw[k][2] = w[2]; cw[k][3] = w[3]; }
    { const f32x4 b = *(const f32x4*)(F.in[I_MCONVB] + (size_t)slot * 2048 + c4); cb[0] = b[0]; cb[1] = b[1]; cb[2] = b[2]; cb[3] = b[3]; }
    const int fr = F.lane & 15, fq = F.lane >> 4;
    for (int gc = F.bid; gc < NCH; gc += F.G) {
        const int seq_lo = gc < 4 ? 0 : CTXN, seq_hi = gc < 4 ? CTXN : LT;
        for (int sub = 0; sub < 4; ++sub) {
            const int r0 = gc * 64 + sub * 16;
            u32x2 prv, cur, nxt;
            { const int rp = r0 - 1; prv = (rp >= seq_lo) ? *(const u32x2*)(XCM + (size_t)rp * 4096 + 2048 + c4) : (u32x2){0u, 0u}; }
            cur = *(const u32x2*)(XCM + (size_t)r0 * 4096 + 2048 + c4);
#pragma unroll 4
            for (int rl = 0; rl < 16; ++rl) {
                const int row = r0 + rl, rn = row + 1;
                nxt = (rn < seq_hi) ? *(const u32x2*)(XCM + (size_t)rn * 4096 + 2048 + c4) : (u32x2){0u, 0u};
                const float p[4] = {bflo(prv.x), bfhi(prv.x), bflo(prv.y), bfhi(prv.y)}, c[4] = {bflo(cur.x), bfhi(cur.x), bflo(cur.y), bfhi(cur.y)}, n[4] = {bflo(nxt.x), bfhi(nxt.x), bflo(nxt.y), bfhi(nxt.y)};
                float o[4];
#pragma unroll
                for (int e = 0; e < 4; ++e) o[e] = siluf(cb[e] + cw[0][e] * p[e] + cw[1][e] * c[e] + cw[2][e] * n[e]);
                u32x2 w; w.x = pk2(o[0], o[1]); w.y = pk2(o[2], o[3]);
                *(u32x2*)(XCM + (size_t)row * 4096 + c4) = w;
                *(LAS u32x2*)(tile + rl * TP + c4) = w;
                *(LAS u32x2*)(tile + rl * TP + 2048 + c4) = cur;
                prv = cur; cur = nxt;
            }
            __syncthreads();
            {
                f32x4 acc = {0.f, 0.f, 0.f, 0.f};
#pragma unroll 4
                for (int kk = 0; kk < 16; ++kk) { const int k0 = F.wave * 512 + kk * 32 + fq * 8;
                    const bf16x8 a = *(const LAS bf16x8*)(tile + fr * TP + k0);
                    const bf16x8 b = *(const bf16x8*)(GWT + (size_t)fr * 4096 + k0);
                    acc = __builtin_amdgcn_mfma_f32_16x16x32_bf16(a, b, acc, 0, 0, 0); }
#pragma unroll
                for (int r = 0; r < 4; ++r) part[F.wave * 256 + (fq * 4 + r) * 16 + fr] = acc[r];
            }
            __syncthreads();
            if (F.tid < 256) { float a = F.in[I_MGATEB][slot * 16 + (F.tid & 15)];
#pragma unroll
                for (int w = 0; w < 8; ++w) a += part[w * 256 + F.tid];
                gl[(sub * 16 + (F.tid >> 4)) * 16 + (F.tid & 15)] = a; }
        }
        __syncthreads();
        {
            const int ch = F.wave, dir = ch >> 2, h = ch & 3, j = F.lane, rl = dir ? 63 - j : j, row = gc * 64 + rl;
            const float ig = gl[rl * 16 + (2 * dir) * 4 + h], lf = logsigf(gl[rl * 16 + (2 * dir + 1) * 4 + h]);
            float b = lf;
#pragma unroll
            for (int o = 1; o < 64; o <<= 1) { const float t = __shfl_up(b, o); if (j >= o) b += t; }
            const float cq = ig - b; float pm = cq;
#pragma unroll
            for (int o = 1; o < 64; o <<= 1) { const float t = __shfl_up(pm, o); if (j >= o) pm = fmaxf(pm, t); }
            const float bl = __shfl(b, 63), gq = bl - b + ig, gm = wave_max(gq);
            scal_arr(F, 0, ch)[row] = b; scal_arr(F, 1, ch)[row] = b + pm; scal_arr(F, 2, ch)[row] = gq; scal_arr(F, 3, ch)[row] = cq;
            if (j == 0) { chs_arr(F, 0, ch)[gc] = bl; chs_arr(F, 1, ch)[gc] = gm; }
        }
        __syncthreads();
    }
}

__device__ __forceinline__ void mlstm_qkv(const Frame& F, int slot) {
    MultiSched<4> S; Prob pr[4];
    const char* XCM = (const char*)(F.ws + WS_XCM);
    const char* WQ = (const char*)(F.ws + WS_WQ) + (size_t)slot * 4 * 256 * 512 * 2;
    const char* WK = (const char*)(F.ws + WS_WK) + (size_t)slot * 4 * 256 * 512 * 2;
    const char* WV = (const char*)(F.ws + WS_WV) + (size_t)slot * 4 * 512 * 512 * 2;
    pr[0] = Prob{XCM, WQ, (char*)(F.ws + WS_Q),  512 * 2, 256 * 512 * 2, (long long)LT * 256 * 2, 65, 1, 4, 0,    4096, 512,  256, 2};
    pr[1] = Prob{XCM, WK, (char*)(F.ws + WS_KN), 512 * 2, 256 * 512 * 2, (long long)LT * 256 * 2, 65, 1, 4, 260,  4096, 512,  256, 2};
    pr[2] = Prob{WK, XCM, (char*)(F.ws + WS_KT), 256 * 512 * 2, 512 * 2, (long long)256 * LT * 2, 1, 65, 4, 520,  512,  4096, LT,  2};
    pr[3] = Prob{WV, XCM + 2048 * 2, (char*)(F.ws + WS_VT), 512 * 512 * 2, 512 * 2, (long long)512 * LT * 2, 2, 65, 4, 780, 512, 4096, LT, 2};
    S.init(F, pr, 780 + 520);
    EpiStore E{nullptr};
    pg8::gemm_phase<EpiStore, MultiSched<4>, false>(F.lds, 512, S, E, F.tid);
}

struct ScanBuf { bf16x8 ld[10]; float sc[16]; };
__device__ __forceinline__ int scan_chunk(int dir, int st) { return dir == 0 ? st : (st < 4 ? 3 - st : 263 - st); }

__device__ __forceinline__ void mlstm_scan(const Frame& F) {
    constexpr int CP = 256 + 8;
    LAS bf16_t* Cs = (LAS bf16_t*)F.lds;
    const bf16_t* Q = (const bf16_t*)(F.ws + WS_Q); const bf16_t* KT = (const bf16_t*)(F.ws + WS_KT); const bf16_t* VT = (const bf16_t*)(F.ws + WS_VT);
    const int fr = F.lane & 15, fq = F.lane >> 4, w = F.wave;
    for (int job = F.bid; job < 256; job += F.G) {
        const int ch = job & 7, sl = job >> 3, dir = ch >> 2, h = ch & 3, ntile = (sl == 0) ? 2 : 1;
        const float* BQ = scal_arr(F, 0, ch); const float* AQ = scal_arr(F, 1, ch); const float* GQ = scal_arr(F, 2, ch);
        const float* BL = chs_arr(F, 0, ch); const float* GM = chs_arr(F, 1, ch); float* MS = chs_arr(F, 2, ch);
        const bf16_t* Qh = Q + (size_t)h * LT * 256; const bf16_t* KTh = KT + (size_t)h * 256 * LT; const bf16_t* VTh = VT + ((size_t)h * 512 + sl * 16) * LT;
        __syncthreads();
        for (int i = F.tid; i < 2 * 2 * 16 * CP / 2; i += NT) ((LAS unsigned*)Cs)[i] = 0u;
        __syncthreads();
        float m = 0.f;
        f32x4 acc[2][4];
#pragma unroll
        for (int t = 0; t < 2; ++t)
#pragma unroll
            for (int d = 0; d < 4; ++d) acc[t][d] = (f32x4){0.f, 0.f, 0.f, 0.f};
        ScanBuf sb[2];
#define SCAN_LOAD(B, st_) do { const int gc_ = scan_chunk(dir, st_), row0_ = gc_ * 64; \
        if (w < 4) { _Pragma("unroll") for (int kk = 0; kk < 8; ++kk) sb[B].ld[kk] = *(const bf16x8*)(Qh + (size_t)(row0_ + 16 * w + fr) * 256 + kk * 32 + fq * 8); \
            _Pragma("unroll") for (int r = 0; r < 4; ++r) { sb[B].sc[r] = BQ[row0_ + 16 * w + fq * 4 + r]; sb[B].sc[4 + r] = AQ[row0_ + 16 * w + fq * 4 + r]; } } \
        else { const int u_ = w - 4; \
            _Pragma("unroll") for (int d = 0; d < 4; ++d) _Pragma("unroll") for (int kk = 0; kk < 2; ++kk) sb[B].ld[2 * d + kk] = *(const bf16x8*)(KTh + (size_t)(16 * (4 * u_ + d) + fr) * LT + row0_ + kk * 32 + fq * 8); \
            _Pragma("unroll") for (int kk = 0; kk < 2; ++kk) { sb[B].ld[8 + kk] = *(const bf16x8*)(VTh + (size_t)fr * LT + row0_ + kk * 32 + fq * 8); \
                const f32x4 g0_ = *(const f32x4*)(GQ + row0_ + kk * 32 + fq * 8), g1_ = *(const f32x4*)(GQ + row0_ + kk * 32 + fq * 8 + 4); \
                _Pragma("unroll") for (int e = 0; e < 4; ++e) { sb[B].sc[8 * kk + e] = g0_[e]; sb[B].sc[8 * kk + 4 + e] = g1_[e]; } } } } while (0)
#define SCAN_STEP(B, st_) do { const int gc_ = scan_chunk(dir, st_), row0_ = gc_ * 64, cb_ = (st_) & 1; \
        const float bl_ = BL[gc_], gm_ = GM[gc_]; const float mn_ = fmaxf(bl_ + m, gm_), dec_ = __expf(bl_ + m - mn_); \
        if (w < 4) { \
            if (sl == 0 && w == 0 && F.lane == 0) MS[gc_] = m; \
            float wj_[4]; _Pragma("unroll") for (int r = 0; r < 4; ++r) { const float in_ = sb[B].sc[r] + m, mj_ = fmaxf(in_, sb[B].sc[4 + r]); wj_[r] = __expf(in_ - mj_); } \
            _Pragma("unroll") for (int t = 0; t < 2; ++t) if (t < ntile) { f32x4 o_ = {0.f, 0.f, 0.f, 0.f}; \
                _Pragma("unroll") for (int kk = 0; kk < 8; ++kk) { const bf16x8 b_ = *(const LAS bf16x8*)(Cs + ((cb_ * 2 + t) * 16 + fr) * CP + kk * 32 + fq * 8); o_ = __builtin_amdgcn_mfma_f32_16x16x32_bf16(sb[B].ld[kk], b_, o_, 0, 0, 0); } \
                if (t == 0) { u32x2 pw_; pw_.x = pk2(o_[0] * wj_[0], o_[1] * wj_[1]); pw_.y = pk2(o_[2] * wj_[2], o_[3] * wj_[3]); \
                    *(u32x2*)((bf16_t*)(F.ws + WS_OINT) + (((((size_t)ch * NCH + gc_) * 32 + sl) * 4 + w) * 64 + F.lane) * 4) = pw_; } \
                else if (fr == 0) { float* dn_ = (float*)(F.ws + WS_DENI) + (size_t)ch * LT + row0_ + 16 * w + fq * 4; \
                    _Pragma("unroll") for (int r = 0; r < 4; ++r) dn_[r] = o_[r] * wj_[r]; } } \
        } else { const int u_ = w - 4; \
            float wg_[2][8]; _Pragma("unroll") for (int kk = 0; kk < 2; ++kk) _Pragma("unroll") for (int e = 0; e < 8; ++e) wg_[kk][e] = __expf(sb[B].sc[8 * kk + e] - mn_); \
            _Pragma("unroll") for (int t = 0; t < 2; ++t) if (t < ntile) { bf16x8 bv_[2]; \
                _Pragma("unroll") for (int kk = 0; kk < 2; ++kk) _Pragma("unroll") for (int e = 0; e < 8; ++e) { \
                    const float x_ = (t == 0) ? bf2f((bf16_t)sb[B].ld[8 + kk][e]) * wg_[kk][e] : (fr == 0 ? wg_[kk][e] : 0.f); bv_[kk][e] = (short)f2bf(x_); } \
                _Pragma("unroll") for (int d = 0; d < 4; ++d) { f32x4 a_ = acc[t][d] * dec_; \
                    _Pragma("unroll") for (int kk = 0; kk < 2; ++kk) a_ = __builtin_amdgcn_mfma_f32_16x16x32_bf16(sb[B].ld[2 * d + kk], bv_[kk], a_, 0, 0, 0); \
                    acc[t][d] = a_; \
                    u32x2 pw_; pw_.x = pk2(a_[0], a_[1]); pw_.y = pk2(a_[2], a_[3]); \
                    *(LAS u32x2*)(Cs + (((cb_ ^ 1) * 2 + t) * 16 + fr) * CP + 16 * (4 * u_ + d) + fq * 4) = pw_; } } \
        } \
        m = mn_; __syncthreads(); } while (0)
        SCAN_LOAD(0, 0);
        for (int st = 0; st < NCH; st += 2) {
            SCAN_LOAD(1, st + 1);
            SCAN_STEP(0, st);
            if (st + 2 < NCH) SCAN_LOAD(0, st + 2);
            SCAN_STEP(1, st + 1);
        }
#undef SCAN_LOAD
#undef SCAN_STEP
    }
}

__device__ __forceinline__ void mlstm_intra(const Frame& F, int slot, int gc_lo) {
    constexpr int SP = 64 + 8;
    LAS float* sc = (LAS float*)F.lds;
    LAS bf16_t* Sb = (LAS bf16_t*)(F.lds + 2 * 6 * 64 * 4);
    LAS float* stt = (LAS float*)(F.lds + 2 * 6 * 64 * 4 + 2 * 64 * SP * 2);
    LAS float* mr = stt + 64 * 8 * 2;
    constexpr int HP = 512 + 8;
    LAS bf16_t* Hs = (LAS bf16_t*)(mr + 128);
    const bf16_t* Q = (const bf16_t*)(F.ws + WS_Q); const bf16_t* KN = (const bf16_t*)(F.ws + WS_KN); const bf16_t* VT = (const bf16_t*)(F.ws + WS_VT);
    const bf16_t* XCM = (const bf16_t*)(F.ws + WS_XCM); const bf16_t* OPRE = (const bf16_t*)(F.ws + WS_OPRE); bf16_t* Y = (bf16_t*)(F.ws + WS_Y);
    const float* NG = F.in[I_MNORMG] + (size_t)slot * 2048; const float* SK = F.in[I_MSKIP] + (size_t)slot * 2048;
    const int fr = F.lane & 15, fq = F.lane >> 4, w = F.wave;
    const int nunit = (NCH - gc_lo) * 4;
    for (int un = F.bid; un < nunit; un += F.G) {
        const int gc = gc_lo + un / 4, h = un & 3, row0 = gc * 64;
        __syncthreads();
        if (F.tid < 128) { const int dir = F.tid >> 6, i = F.tid & 63, ch = dir * 4 + h, row = row0 + i;
            const float bq = scal_arr(F, 0, ch)[row], aq = scal_arr(F, 1, ch)[row], cq = scal_arr(F, 3, ch)[row], m0 = chs_arr(F, 2, ch)[gc];
            const float mj = fmaxf(bq + m0, aq);
            LAS float* s = sc + dir * 6 * 64;
            s[i] = bq; s[64 + i] = cq; s[128 + i] = mj; s[192 + i] = __expf(-mj); s[256 + i] = ((const float*)(F.ws + WS_DENI))[(size_t)ch * LT + row]; }
        const int it = w >> 1, st0 = (w & 1) * 2;
        f32x4 sa[2] = {{0.f, 0.f, 0.f, 0.f}, {0.f, 0.f, 0.f, 0.f}};
        {
            const bf16_t* qp = Q + ((size_t)h * LT + row0 + 16 * it + fr) * 256 + fq * 8;
            const bf16_t* kp0 = KN + ((size_t)h * LT + row0 + 16 * st0 + fr) * 256 + fq * 8;
#pragma unroll
            for (int kk = 0; kk < 8; ++kk) { const bf16x8 a = *(const bf16x8*)(qp + kk * 32), b0 = *(const bf16x8*)(kp0 + kk * 32), b1 = *(const bf16x8*)(kp0 + 16 * 256 + kk * 32);
                sa[0] = __builtin_amdgcn_mfma_f32_16x16x32_bf16(a, b0, sa[0], 0, 0, 0); sa[1] = __builtin_amdgcn_mfma_f32_16x16x32_bf16(a, b1, sa[1], 0, 0, 0); }
        }
        __syncthreads();
#pragma unroll
        for (int t = 0; t < 2; ++t) { const int s = 16 * (st0 + t) + fr;
#pragma unroll
            for (int r = 0; r < 4; ++r) { const int i = 16 * it + fq * 4 + r;
                const float wf = (s <= i) ? __expf(sc[i] + sc[64 + s] - sc[128 + i]) : 0.f;
                const float wb = (s >= i) ? __expf(sc[384 + i] + sc[384 + 64 + s] - sc[384 + 128 + i]) : 0.f;
                Sb[(0 * 64 + i) * SP + s] = f2bf(sa[t][r] * wf); Sb[(1 * 64 + i) * SP + s] = f2bf(sa[t][r] * wb); } }
        __syncthreads();
        if (F.tid < 128) { const int dir = F.tid >> 6, i = F.tid & 63; float a = 0.f;
            for (int s = 0; s < 64; ++s) a += bf2f(Sb[(dir * 64 + i) * SP + s]);
            sc[dir * 384 + 320 + i] = a; }
        f32x4 oa[2][4][4];
#pragma unroll
        for (int d = 0; d < 2; ++d)
#pragma unroll
            for (int a = 0; a < 4; ++a)
#pragma unroll
                for (int b = 0; b < 4; ++b) oa[d][a][b] = (f32x4){0.f, 0.f, 0.f, 0.f};
        {
#pragma unroll
            for (int kk = 0; kk < 2; ++kk) {
                bf16x8 vb[4];
#pragma unroll
                for (int vt = 0; vt < 4; ++vt) vb[vt] = *(const bf16x8*)(VT + ((size_t)h * 512 + 16 * (4 * w + vt) + fr) * LT + row0 + kk * 32 + fq * 8);
#pragma unroll
                for (int d = 0; d < 2; ++d)
#pragma unroll
                    for (int a = 0; a < 4; ++a) { const bf16x8 sf = *(const LAS bf16x8*)(Sb + (d * 64 + 16 * a + fr) * SP + kk * 32 + fq * 8);
#pragma unroll
                        for (int vt = 0; vt < 4; ++vt) oa[d][a][vt] = __builtin_amdgcn_mfma_f32_16x16x32_bf16(sf, vb[vt], oa[d][a][vt], 0, 0, 0); }
            }
        }
        __syncthreads();
#pragma unroll
        for (int a = 0; a < 4; ++a) {
            float den[2][4], emj[2][4];
#pragma unroll
            for (int d = 0; d < 2; ++d)
#pragma unroll
                for (int r = 0; r < 4; ++r) { const int i = 16 * a + fq * 4 + r; den[d][r] = sc[d * 384 + 320 + i] + sc[d * 384 + 256 + i]; emj[d][r] = sc[d * 384 + 192 + i]; }
            float s1[4] = {0.f, 0.f, 0.f, 0.f}, s2[4] = {0.f, 0.f, 0.f, 0.f};
#pragma unroll
            for (int vt = 0; vt < 4; ++vt) {
                const u32x2 o0 = *(const u32x2*)((const bf16_t*)(F.ws + WS_OINT) + (((((size_t)(0 * 4 + h) * NCH + gc) * 32 + 4 * w + vt) * 4 + a) * 64 + F.lane) * 4);
                const u32x2 o1 = *(const u32x2*)((const bf16_t*)(F.ws + WS_OINT) + (((((size_t)(1 * 4 + h) * NCH + gc) * 32 + 4 * w + vt) * 4 + a) * 64 + F.lane) * 4);
                const float i0[4] = {bflo(o0.x), bfhi(o0.x), bflo(o0.y), bfhi(o0.y)}, i1[4] = {bflo(o1.x), bfhi(o1.x), bflo(o1.y), bfhi(o1.y)};
#pragma unroll
                for (int r = 0; r < 4; ++r) { const float hf = (oa[0][a][vt][r] + i0[r]) / fmaxf(fabsf(den[0][r]), emj[0][r]), hb = (oa[1][a][vt][r] + i1[r]) / fmaxf(fabsf(den[1][r]), emj[1][r]);
                    const float hs = hf + hb; s1[r] += hs; s2[r] += hs * hs; Hs[(16 * a + fq * 4 + r) * HP + 64 * w + 16 * vt + fr] = f2bf(hs); }
                __builtin_amdgcn_sched_barrier(0);
            }
#pragma unroll
            for (int r = 0; r < 4; ++r) {
#pragma unroll
                for (int o = 1; o < 16; o <<= 1) { s1[r] += __shfl_xor(s1[r], o); s2[r] += __shfl_xor(s2[r], o); }
                if (fr == 0) { const int i = 16 * a + fq * 4 + r; stt[(i * 8 + w) * 2] = s1[r]; stt[(i * 8 + w) * 2 + 1] = s2[r]; } }
        }
        __syncthreads();
        if (F.tid < 64) { float a = 0.f, b = 0.f;
#pragma unroll
            for (int ww = 0; ww < 8; ++ww) { a += stt[(F.tid * 8 + ww) * 2]; b += stt[(F.tid * 8 + ww) * 2 + 1]; }
            const float mu = a * (1.0f / 512.0f), var = fmaxf(b * (1.0f / 512.0f) - mu * mu, 0.f);
            mr[F.tid * 2] = mu; mr[F.tid * 2 + 1] = rsqrtf(var + EPS); }
        __syncthreads();
        {
            const int i = F.tid >> 3; const float mu = mr[i * 2], rs = mr[i * 2 + 1]; const size_t row = (size_t)(row0 + i);
#pragma unroll 2
            for (int q = 0; q < 8; ++q) { const int v8 = (F.tid & 7) * 8 + 64 * q, c = h * 512 + v8;
                const u32x4 hv = *(const LAS u32x4*)(Hs + i * HP + v8), xv = *(const u32x4*)(XCM + row * 4096 + c), ov = *(const u32x4*)(OPRE + row * 2048 + c);
                const f32x4 g0 = *(const f32x4*)(NG + c), g1 = *(const f32x4*)(NG + c + 4), k0 = *(const f32x4*)(SK + c), k1 = *(const f32x4*)(SK + c + 4);
                float o[8];
#pragma unroll
                for (int e = 0; e < 8; ++e) { const unsigned hw = hv[e >> 1], xw = xv[e >> 1], ow = ov[e >> 1];
                    const float hh = (e & 1) ? bfhi(hw) : bflo(hw), xc = (e & 1) ? bfhi(xw) : bflo(xw), op = (e & 1) ? bfhi(ow) : bflo(ow);
                    const float ng = e < 4 ? g0[e & 3] : g1[e & 3], sk = e < 4 ? k0[e & 3] : k1[e & 3];
                    o[e] = ((hh - mu) * rs * ng + sk * xc) * sigmf(op); }
                u32x4 wv; wv.x = pk2(o[0], o[1]); wv.y = pk2(o[2], o[3]); wv.z = pk2(o[4], o[5]); wv.w = pk2(o[6], o[7]);
                *(u32x4*)(Y + row * 2048 + c) = wv; }
        }
    }
}

struct EpiResid {
    static constexpr bool PERM = false;
    float* HL; float* HC; const float* g_lat; const float* g_ctx; const float* bias; int rowbase; bool colmajor;
    __device__ __forceinline__ void operator()(const f32x4 (&acc)[2][2][4][2], const GUnit& u, int wr, int wc, int fr, int fq) const {
        const int col0 = u.pn * 256 + wc * 32 + 4 * fq;
        const bool isctx = (rowbase + u.pm * 256) < CTXN;
        const float* g = isctx ? g_ctx : g_lat;
        f32x4 gv[2][2], bv[2][2];
#pragma unroll
        for (int bj = 0; bj < 2; ++bj)
#pragma unroll
            for (int n = 0; n < 2; ++n) { gv[bj][n] = *(const f32x4*)(g + col0 + bj * 128 + n * 16); bv[bj][n] = bias ? *(const f32x4*)(bias + col0 + bj * 128 + n * 16) : (f32x4){0.f, 0.f, 0.f, 0.f}; }
#pragma unroll
        for (int ai = 0; ai < 2; ++ai)
#pragma unroll
            for (int m = 0; m < 4; ++m) { const int R = rowbase + u.pm * 256 + ai * 128 + wr * 64 + m * 16 + fr;
                float* rowp = isctx ? HC + (size_t)R * 1024 : HL + (size_t)scan_inv(R - CTXN, colmajor) * 1024;
#pragma unroll
                for (int bj = 0; bj < 2; ++bj)
#pragma unroll
                    for (int n = 0; n < 2; ++n) { float* p = rowp + col0 + bj * 128 + n * 16; const f32x4 o = *(const f32x4*)p; *(f32x4*)p = o + gv[bj][n] * (acc[ai][bj][m][n] + bv[bj][n]); } }
    }
};

__device__ __forceinline__ void mlstm_outproj(const Frame& F, int l, int slot, bool with_ctx, bool colmajor) {
    MultiSched<1> S; Prob pr[1];
    const int rowbase = with_ctx ? 0 : CTXN, nM = with_ctx ? 65 : 64;
    pr[0] = Prob{(const char*)(F.ws + WS_Y) + (size_t)rowbase * 2048 * 2, (const char*)(F.ws + WS_WMOUT) + (size_t)slot * 1024 * 2048 * 2, nullptr, 0, 0, 0, nM, 4, 1, 0, 2048, 2048, 0, 0};
    S.init(F, pr, nM * 4);
    EpiResid E{(float*)(F.ws + WS_HL), (float*)(F.ws + WS_HC), modp(F, l, 0, 2), modp(F, l, 1, 2), nullptr, rowbase, colmajor};
    pg8::gemm_phase<EpiResid, MultiSched<1>, false>(F.lds, 2048, S, E, F.tid);
}
__device__ __forceinline__ void hyena_filtergen(const Frame& F, int slot, bool with_ctx) {
    const bf16_t* Z2 = (const bf16_t*)(F.ws + WS_Z2) + (size_t)slot * SEQ * 64;
    const bf16_t* W3T = (const bf16_t*)(F.ws + WS_W3T) + (size_t)slot * 2048 * 64;
    const float* dec = F.in[I_HDECAY] + (size_t)slot * 2048;
    bf16_t* FILT = (bf16_t*)(F.ws + WS_FILT);
    const int fr = F.lane & 15, fq = F.lane >> 4;
    for (int gw = F.bid * NWAVES + F.wave; gw < 128 * 16; gw += F.G * NWAVES) {
        const int oct = gw & 127, tg = gw >> 7, oc = oct * 16 + fr;
        bf16x8 b[2];
#pragma unroll
        for (int kk = 0; kk < 2; ++kk) b[kk] = *(const bf16x8*)(W3T + (size_t)oc * 64 + kk * 32 + fq * 8);
        const float dc = dec[oc];
        for (int tt = 0; tt < 64; ++tt) {
            const int t0 = (tg * 64 + tt) * 16;
            f32x4 acc = {0.f, 0.f, 0.f, 0.f};
#pragma unroll
            for (int kk = 0; kk < 2; ++kk) { const bf16x8 a = *(const bf16x8*)(Z2 + (size_t)(t0 + fr) * 64 + kk * 32 + fq * 8); acc = __builtin_amdgcn_mfma_f32_16x16x32_bf16(a, b[kk], acc, 0, 0, 0); }
            float o[4];
#pragma unroll
            for (int r = 0; r < 4; ++r) { const int t = t0 + fq * 4 + r; const float tau = fabsf((float)(t - SEQ / 2)) * (1.0f / (SEQ / 2)); o[r] = acc[r] * __expf(-tau * dc); }
            u32x2 w; w.x = pk2(o[0], o[1]); w.y = pk2(o[2], o[3]);
            *(u32x2*)(FILT + (size_t)oc * SEQ + t0 + fq * 4) = w;
        }
        if (with_ctx) {
            const bf16_t* Z2C = (const bf16_t*)(F.ws + WS_Z2C); float* FC = (float*)(F.ws + WS_FILTC);
            const int t0 = tg * 16;
            f32x4 acc = {0.f, 0.f, 0.f, 0.f};
#pragma unroll
            for (int kk = 0; kk < 2; ++kk) { const bf16x8 a = *(const bf16x8*)(Z2C + (size_t)(t0 + fr) * 64 + kk * 32 + fq * 8); acc = __builtin_amdgcn_mfma_f32_16x16x32_bf16(a, b[kk], acc, 0, 0, 0); }
#pragma unroll
            for (int r = 0; r < 4; ++r) { const int t = t0 + fq * 4 + r; const float tau = fabsf((float)(t - CTXN / 2)) * (1.0f / (CTXN / 2)); FC[(size_t)oc * CTXN + t] = acc[r] * __expf(-tau * dc); }
        }
    }
}

__device__ __forceinline__ void hyena_inproj(const Frame& F, int slot, bool with_ctx) {
    MultiSched<1> S; Prob pr[1];
    const int colbase = with_ctx ? 0 : CTXN, nN = with_ctx ? 65 : 64;
    pr[0] = Prob{(const char*)(F.ws + WS_WHIN) + (size_t)slot * 3072 * 1024 * 2, (const char*)(F.ws + WS_U) + (size_t)colbase * 1024 * 2, (char*)(F.ws + WS_ZT) + (size_t)colbase * 2, 0, 0, 0, 12, nN, 1, 0, 1024, 1024, LT, 2};
    S.init(F, pr, 12 * nN);
    EpiStore E{F.in[I_HINB] + (size_t)slot * 3072};
    pg8::gemm_phase<EpiStore, MultiSched<1>, false>(F.lds, 1024, S, E, F.tid);
}

__device__ __forceinline__ f32x2 cmul(f32x2 a, f32x2 b) { return (f32x2){a.x * b.x - a.y * b.y, a.x * b.y + a.y * b.x}; }
__device__ __forceinline__ f32x2 cmulc(f32x2 a, f32x2 b) { return (f32x2){a.x * b.x + a.y * b.y, a.y * b.x - a.x * b.y}; }
__device__ __forceinline__ f32x2 cconj(f32x2 a) { return (f32x2){a.x, -a.y}; }
template <int R> __device__ __forceinline__ constexpr int brevR(int x) { int r = 0; for (int b = 1; b < R; b <<= 1) { r = (r << 1) | (x & 1); x >>= 1; } return r; }
template <int R> __device__ __forceinline__ constexpr int log2R() { int l = 0; for (int b = 1; b < R; b <<= 1) ++l; return l; }
template <int R, int HALF_, bool INV> __device__ __forceinline__ void dft_stage(f32x2 (&v)[R]) {
    constexpr float C32[16] = {1.0f, 0.9807852804032304f, 0.9238795325112867f, 0.8314696123025452f, 0.7071067811865476f, 0.5555702330196022f, 0.3826834323650898f, 0.1950903220161283f,
                               0.0f, -0.1950903220161283f, -0.3826834323650898f, -0.5555702330196022f, -0.7071067811865476f, -0.8314696123025452f, -0.9238795325112867f, -0.9807852804032304f};
    constexpr float S32[16] = {0.0f, 0.1950903220161283f, 0.3826834323650898f, 0.5555702330196022f, 0.7071067811865476f, 0.8314696123025452f, 0.9238795325112867f, 0.9807852804032304f,
                               1.0f, 0.9807852804032304f, 0.9238795325112867f, 0.8314696123025452f, 0.7071067811865476f, 0.5555702330196022f, 0.3826834323650898f, 0.1950903220161283f};
#pragma unroll
    for (int blk = 0; blk < R; blk += 2 * HALF_) {
#pragma unroll
        for (int j = 0; j < HALF_; ++j) {
            const f32x2 a = v[blk + j], b = v[blk + j + HALF_];
            v[blk + j] = a + b; const f32x2 d = a - b;
            constexpr int TS = 16 / HALF_;
            const int ti = j * TS;
            if (ti == 0) v[blk + j + HALF_] = d;
            else if (ti == 8) v[blk + j + HALF_] = INV ? (f32x2){-d.y, d.x} : (f32x2){d.y, -d.x};
            else { const f32x2 w = {C32[ti], INV ? S32[ti] : -S32[ti]}; v[blk + j + HALF_] = cmul(d, w); }
        }
    }
    if constexpr (HALF_ > 1) dft_stage<R, HALF_ / 2, INV>(v);
}
template <int R, bool INV> __device__ __forceinline__ void dft_reg(f32x2 (&v)[R]) { dft_stage<R, R / 2, INV>(v); }
__device__ __forceinline__ int fpad(int i) { return i + (i >> 5); }
__device__ __forceinline__ f32x2 unit_root(int num, int den_log2) {
    asm volatile("" : "+v"(num));
    float s, c; sincospif((float)num * (2.0f / (float)(1 << den_log2)), &s, &c); return (f32x2){c, -s};
}
template <bool INV> __device__ __forceinline__ void fft_pass_a(LAS f32x2* buf, int tid) {
#pragma unroll 1
    for (int rr = 0; rr < 2; ++rr) { const int r = tid + rr * 512, pr = fpad(r); f32x2 v[16];
        const f32x2 w1 = unit_root(r, 14);
        if (!INV) {
#pragma unroll
            for (int a = 0; a < 16; ++a) v[a] = buf[pr + a * 1056];
            dft_reg<16, false>(v);
            f32x2 w = w1;
            buf[pr] = v[0];
#pragma unroll
            for (int p = 1; p < 16; ++p) { buf[pr + p * 1056] = cmul(v[brevR<16>(p)], w); w = cmul(w, w1); }
        } else {
            f32x2 w = w1;
            v[0] = buf[pr];
#pragma unroll
            for (int p = 1; p < 16; ++p) { v[p] = cmulc(buf[pr + p * 1056], w); w = cmul(w, w1); }
            dft_reg<16, true>(v);
#pragma unroll
            for (int a = 0; a < 16; ++a) buf[pr + a * 1056] = v[brevR<16>(a)];
        }
    }
}
template <bool INV> __device__ __forceinline__ void fft_pass_b(LAS f32x2* buf, int tid) {
    const int p1 = tid >> 5, r = tid & 31, pb = fpad(p1 * 1024 + r); f32x2 v[32];
    const f32x2 w1 = unit_root(r, 10);
    if (!INV) {
#pragma unroll
        for (int a = 0; a < 32; ++a) v[a] = buf[pb + a * 33];
        dft_reg<32, false>(v);
        f32x2 w = w1;
        buf[pb] = v[0];
#pragma unroll
        for (int p = 1; p < 32; ++p) { buf[pb + p * 33] = cmul(v[brevR<32>(p)], w); w = cmul(w, w1); }
    } else {
        f32x2 w = w1;
        v[0] = buf[pb];
#pragma unroll
        for (int p = 1; p < 32; ++p) { v[p] = cmulc(buf[pb + p * 33], w); w = cmul(w, w1); }
        dft_reg<32, true>(v);
#pragma unroll
        for (int a = 0; a < 32; ++a) buf[pb + a * 33] = v[brevR<32>(a)];
    }
}
template <bool INV> __device__ __forceinline__ void fft_pass_c(LAS f32x2* buf, int tid) {
    const int base = tid * 33; f32x2 v[32];
#pragma unroll
    for (int a = 0; a < 32; ++a) v[a] = buf[base + a];
    dft_reg<32, INV>(v);
#pragma unroll
    for (int a = 0; a < 32; ++a) buf[base + a] = v[brevR<32>(a)];
}
__device__ __forceinline__ void fft_fwd(LAS f32x2* buf, int tid) { fft_pass_a<false>(buf, tid); __syncthreads(); fft_pass_b<false>(buf, tid); __syncthreads(); fft_pass_c<false>(buf, tid); __syncthreads(); }
__device__ __forceinline__ void fft_inv(LAS f32x2* buf, int tid) { fft_pass_c<true>(buf, tid); __syncthreads(); fft_pass_b<true>(buf, tid); __syncthreads(); fft_pass_a<true>(buf, tid); __syncthreads(); }
__device__ __forceinline__ int fft_k_of_pos(int pos) { return (pos >> 10) + 16 * ((pos >> 5) & 31) + 512 * (pos & 31); }
__device__ __forceinline__ int fft_pos_of_k(int k) { return (k & 15) * 1024 + ((k >> 4) & 31) * 32 + (k >> 9); }

__device__ __forceinline__ void fft_save_pairs(const LAS f32x2* buf, f32x4* zh, int tid) {
    if ((tid & 31) < 16) {
#pragma unroll 4
        for (int it = 0; it < 32; ++it) { const int pos = it * 512 + tid, k = fft_k_of_pos(pos);
            const int pos2 = (k == 0) ? 16 : fft_pos_of_k(16384 - k);
            const f32x2 a = buf[fpad(pos)], b = buf[fpad(pos2)];
            zh[it * 256 + (tid >> 5) * 16 + (tid & 15)] = (f32x4){a.x, a.y, b.x, b.y}; }
    }
}
__device__ __forceinline__ void fft_pointwise(LAS f32x2* buf, const f32x4* zh, float scale, int tid) {
    if ((tid & 31) < 16) {
#pragma unroll 2
        for (int it = 0; it < 32; ++it) { const int pos = it * 512 + tid, k = fft_k_of_pos(pos);
            const f32x4 hq = zh[it * 256 + (tid >> 5) * 16 + (tid & 15)];
            const f32x2 h1 = {hq[0], hq[1]}, h2 = {hq[2], hq[3]};
            if (k == 0) {
                const f32x2 z0 = buf[0], zm = buf[16];
                const float x0 = z0.x + z0.y, xn = z0.x - z0.y, g0 = h1.x + h1.y, gn = h1.x - h1.y, y0 = x0 * g0 * scale, yn = xn * gn * scale;
                buf[0] = (f32x2){0.5f * (y0 + yn), 0.5f * (y0 - yn)};
                const f32x2 ym = cmul(cconj(zm), cconj(h2));
                buf[16] = (f32x2){ym.x * scale, -ym.y * scale};
            } else {
                const int pos2 = fft_pos_of_k(16384 - k);
                const f32x2 z1 = buf[fpad(pos)], z2 = buf[fpad(pos2)];
                const f32x2 wn = unit_root(k, 15);
                const f32x2 ex = {0.5f * (z1.x + z2.x), 0.5f * (z1.y - z2.y)}, dx = {0.5f * (z1.x - z2.x), 0.5f * (z1.y + z2.y)};
                const f32x2 tx = cmul(wn, (f32x2){dx.y, -dx.x});
                const f32x2 eh = {0.5f * (h1.x + h2.x), 0.5f * (h1.y - h2.y)}, dh = {0.5f * (h1.x - h2.x), 0.5f * (h1.y + h2.y)};
                const f32x2 th = cmul(wn, (f32x2){dh.y, -dh.x});
                const f32x2 xk = ex + tx, xk2 = cconj(ex - tx), hk = eh + th, hk2 = cconj(eh - th);
                const f32x2 yk = cmul(xk, hk) * scale, yk2 = cmul(xk2, hk2) * scale;
                const f32x2 e2 = {0.5f * (yk.x + yk2.x), 0.5f * (yk.y - yk2.y)}, d2 = {0.5f * (yk.x - yk2.x), 0.5f * (yk.y + yk2.y)};
                const f32x2 o2 = cmulc(d2, wn);
                buf[fpad(pos)] = (f32x2){e2.x - o2.y, e2.y + o2.x};
                buf[fpad(pos2)] = (f32x2){e2.x + o2.y, -(e2.y - o2.x)};
            }
        }
    }
}
__device__ __forceinline__ f32x2 sconv2(const bf16_t* row, int n, int Ln, float w0, float w1, float w2, float b) {
    const unsigned* r32 = (const unsigned*)row;
    const unsigned c = r32[n], p = (n > 0) ? r32[n - 1] : 0u, q = (2 * n + 2 < Ln) ? r32[n + 1] : 0u;
    const float xm1 = bfhi(p), x0 = bflo(c), x1 = bfhi(c), x2 = bflo(q);
    return (f32x2){b + w0 * xm1 + w1 * x0 + w2 * x1, b + w0 * x0 + w1 * x1 + w2 * x2};
}
__device__ __forceinline__ float block_sum(LAS float* red, float v, int tid) {
    v = wave_sum(v);
    __syncthreads();
    if ((tid & 63) == 0) red[tid >> 6] = v;
    __syncthreads();
    float s = 0.f;
#pragma unroll
    for (int i = 0; i < 8; ++i) s += red[i];
    return s;
}

__device__ __forceinline__ void hyena_fft(const Frame& F, int slot, bool with_ctx) {
    LAS f32x2* buf = (LAS f32x2*)F.lds;
    LAS float* red = (LAS float*)(F.lds + (16384 + 512) * 8);
    const bf16_t* ZT = (const bf16_t*)(F.ws + WS_ZT); const bf16_t* FILT = (const bf16_t*)(F.ws + WS_FILT); bf16_t* Y2T = (bf16_t*)(F.ws + WS_Y2T);
    f32x4* zh = (f32x4*)(F.ws + WS_ZH) + (size_t)F.bid * 2 * 8192;
    const float* scw = F.in[I_HSCW] + (size_t)slot * 3 * 3072; const float* scb = F.in[I_HSCB] + (size_t)slot * 3072; const float* fb = F.in[I_HFBIAS] + (size_t)slot * 2048;
    const int tid = F.tid, pt = fpad(F.tid);
    for (int c = F.bid; c < 1024; c += F.G) {
        float fs0 = 0.f, fs1 = 0.f;
        __syncthreads();
#pragma unroll 1
        for (int ord = 0; ord < 2; ++ord) {
            const unsigned* f32p = (const unsigned*)(FILT + (size_t)(ord * 1024 + c) * SEQ);
            float ss = 0.f;
#pragma unroll 4
            for (int j = 0; j < 16; ++j) { const int n = tid + 512 * j; const unsigned w = f32p[n]; const float a = bflo(w), b = bfhi(w); ss += a * a + b * b;
                buf[pt + 528 * j] = (f32x2){a, b}; buf[pt + 528 * j + 8448] = (f32x2){0.f, 0.f}; }
            const float tot = block_sum(red, ss, tid);
            { const float fsv = rsqrtf(tot + EPS) * (1.0f / 16384.0f); if (ord == 0) fs0 = fsv; else fs1 = fsv; }
            __syncthreads();
            fft_fwd(buf, tid);
            fft_save_pairs(buf, zh + ord * 8192, tid);
            __syncthreads();
        }
        f32x2 vv[16];
        {
            const int zc = 2048 + c; const float w0 = scw[zc], w1 = scw[3072 + zc], w2 = scw[2 * 3072 + zc], b = scb[zc];
            const bf16_t* row = ZT + (size_t)zc * LT + CTXN;
#pragma unroll
            for (int j = 0; j < 16; ++j) { const int n = tid + 512 * j; vv[j] = sconv2(row, n, SEQ, w0, w1, w2, b); buf[pt + 528 * j] = vv[j]; buf[pt + 528 * j + 8448] = (f32x2){0.f, 0.f}; if ((j & 3) == 3) __builtin_amdgcn_sched_barrier(0); }
        }
        __syncthreads();
        fft_fwd(buf, tid);
        fft_pointwise(buf, zh, fs0, tid);
        __syncthreads();
        fft_inv(buf, tid);
        {
            const int zc = c; const float w0 = scw[zc], w1 = scw[3072 + zc], w2 = scw[2 * 3072 + zc], b = scb[zc], fb0 = fb[c];
            const bf16_t* row = ZT + (size_t)zc * LT + CTXN;
#pragma unroll
            for (int j = 0; j < 16; ++j) { const int n = tid + 512 * j; const f32x2 y = buf[pt + 528 * j + 4224]; const f32x2 x1 = sconv2(row, n, SEQ, w0, w1, w2, b);
                vv[j] = (f32x2){x1.x * (y.x + vv[j].x * fb0), x1.y * (y.y + vv[j].y * fb0)}; if ((j & 3) == 3) __builtin_amdgcn_sched_barrier(0); }
        }
        __syncthreads();
#pragma unroll
        for (int j = 0; j < 16; ++j) { buf[pt + 528 * j] = vv[j]; buf[pt + 528 * j + 8448] = (f32x2){0.f, 0.f}; }
        __syncthreads();
        fft_fwd(buf, tid);
        fft_pointwise(buf, zh + 8192, fs1, tid);
        __syncthreads();
        fft_inv(buf, tid);
        {
            const int zc = 1024 + c; const float w0 = scw[zc], w1 = scw[3072 + zc], w2 = scw[2 * 3072 + zc], b = scb[zc], fb1 = fb[1024 + c];
            const bf16_t* row = ZT + (size_t)zc * LT + CTXN;
            unsigned* orow = (unsigned*)(Y2T + (size_t)c * LT + CTXN);
#pragma unroll
            for (int j = 0; j < 16; ++j) { const int n = tid + 512 * j; const f32x2 y = buf[pt + 528 * j + 4224]; const f32x2 x2 = sconv2(row, n, SEQ, w0, w1, w2, b);
                orow[n] = pk2(x2.x * (y.x + vv[j].x * fb1), x2.y * (y.y + vv[j].y * fb1)); if ((j & 3) == 3) __builtin_amdgcn_sched_barrier(0); }
        }
    }
    if (with_ctx) {
        LAS float* ub = (LAS float*)F.lds;
        LAS float* fbuf = ub + 512;
        const float* FC = (const float*)(F.ws + WS_FILTC);
        const int cc = tid >> 8, t = tid & 255;
        for (int c0 = F.bid * 2; c0 < 1024; c0 += F.G * 2) {
            const int c = c0 + cc;
            float cur, y1 = 0.f;
            { const int zc = 2048 + c; const bf16_t* row = ZT + (size_t)zc * LT;
              const float xm = t > 0 ? bf2f(row[t - 1]) : 0.f, x0 = bf2f(row[t]), xp = t < 255 ? bf2f(row[t + 1]) : 0.f;
              cur = scb[zc] + scw[zc] * xm + scw[3072 + zc] * x0 + scw[2 * 3072 + zc] * xp; }
#pragma unroll 1
            for (int ord = 0; ord < 2; ++ord) {
                __syncthreads();
                const float fv = FC[(size_t)(ord * 1024 + c) * CTXN + t];
                ub[cc * 256 + t] = cur; fbuf[cc * 256 + t] = fv;
                float ss = fv * fv;
                ss = wave_sum(ss);
                __syncthreads();
                if (F.lane == 0) red[F.wave] = ss;
                __syncthreads();
                const float tot = red[cc * 4] + red[cc * 4 + 1] + red[cc * 4 + 2] + red[cc * 4 + 3];
                const float fs = rsqrtf(tot + EPS);
                float acc = 0.f;
                const int jlo = max(0, t + 128 - 255), jhi = min(255, t + 128);
                for (int j = jlo; j <= jhi; ++j) acc += fbuf[cc * 256 + j] * ub[cc * 256 + t + 128 - j];
                const int zc = ord * 1024 + c; const bf16_t* row = ZT + (size_t)zc * LT;
                const float xm = t > 0 ? bf2f(row[t - 1]) : 0.f, x0 = bf2f(row[t]), xp = t < 255 ? bf2f(row[t + 1]) : 0.f;
                const float xg = scb[zc] + scw[zc] * xm + scw[3072 + zc] * x0 + scw[2 * 3072 + zc] * xp;
                const float yo = xg * (acc * fs + cur * fb[ord * 1024 + c]);
                if (ord == 0) { y1 = yo; cur = y1; } else Y2T[(size_t)c * LT + t] = f2bf(yo);
            }
        }
        __syncthreads();
    }
}

__device__ __forceinline__ void hyena_transpose(const Frame& F, bool with_ctx) {
    LAS bf16_t* tile = (LAS bf16_t*)F.lds;
    const bf16_t* Y2T = (const bf16_t*)(F.ws + WS_Y2T); bf16_t* Y2 = (bf16_t*)(F.ws + WS_Y2);
    const int tlo = with_ctx ? 0 : 4, ntt = NCH - tlo, ntile = 16 * ntt;
    for (int ti = F.bid; ti < ntile; ti += F.G) {
        const int c0 = (ti % 16) * 64, t0 = (tlo + ti / 16) * 64;
        __syncthreads();
        { const int c = F.tid >> 3, t8 = (F.tid & 7) * 8; const u32x4 v = *(const u32x4*)(Y2T + (size_t)(c0 + c) * LT + t0 + t8); *(LAS u32x4*)(tile + c * 72 + t8) = v; }
        __syncthreads();
        { const int t = F.tid >> 3, c8 = (F.tid & 7) * 8; bf16_t e[8];
#pragma unroll
          for (int j = 0; j < 8; ++j) e[j] = tile[(c8 + j) * 72 + t];
          u32x4 w; w.x = (unsigned)e[0] | ((unsigned)e[1] << 16); w.y = (unsigned)e[2] | ((unsigned)e[3] << 16); w.z = (unsigned)e[4] | ((unsigned)e[5] << 16); w.w = (unsigned)e[6] | ((unsigned)e[7] << 16);
          *(u32x4*)(Y2 + (size_t)(t0 + t) * 1024 + c0 + c8) = w; }
    }
}

__device__ __forceinline__ void hyena_outproj(const Frame& F, int l, int slot, bool with_ctx, bool colmajor) {
    MultiSched<1> S; Prob pr[1];
    const int rowbase = with_ctx ? 0 : CTXN, nM = with_ctx ? 65 : 64;
    pr[0] = Prob{(const char*)(F.ws + WS_Y2) + (size_t)rowbase * 1024 * 2, (const char*)(F.ws + WS_WHOUT) + (size_t)slot * 1024 * 1024 * 2, nullptr, 0, 0, 0, nM, 4, 1, 0, 1024, 1024, 0, 0};
    S.init(F, pr, nM * 4);
    EpiResid E{(float*)(F.ws + WS_HL), (float*)(F.ws + WS_HC), modp(F, l, 0, 2), modp(F, l, 1, 2), F.in[I_HOUTB] + (size_t)slot * 1024, rowbase, colmajor};
    pg8::gemm_phase<EpiResid, MultiSched<1>, false>(F.lds, 1024, S, E, F.tid);
}
constexpr int MOE_MAXG = 8;
constexpr int MOE_MAXU = 6;
constexpr int MOE_TAB = 131072;

__device__ __forceinline__ void moe_route(const Frame& F, int l, bool with_ctx) {
    constexpr int VP = 1028;
    LAS float* vs = (LAS float*)F.lds;
    LAS float* part = vs + 16 * VP;
    LAS float* lg = part + 8 * 16 * 48;
    LAS int* re = (LAS int*)(lg + 16 * 48);
    LAS float* rw = (LAS float*)(re + MOE_MAXG * 32);
    LAS int* rp = (LAS int*)(rw + MOE_MAXG * 32);
    LAS int* lc = rp + MOE_MAXG * 32;
    LAS int* lb = lc + 32;
    const float* HL = (const float*)(F.ws + WS_HL); const float* HC = (const float*)(F.ws + WS_HC); bf16_t* VN = (bf16_t*)(F.ws + WS_VN);
    const float* WC = (const float*)(F.ws + WS_WC) + (size_t)l * 1024 * 48;
    const float* g2n = F.in[I_N2G] + l * 1024;
    unsigned* cnt = (unsigned*)(F.ws + WS_CTL) + CW_CNT + l * 32 * 64;
    int* LIST = (int*)(F.ws + WS_LIST); float* AW = (float*)(F.ws + WS_AW);
    const int ntok = with_ctx ? LT : SEQ, tokbase = with_ctx ? 0 : CTXN, ngroups = ntok / 16;
    const int fr = F.lane & 15, fq = F.lane >> 4;
    int gi = 0;
    for (int grp = F.bid; grp < ngroups && gi < MOE_MAXG; grp += F.G, ++gi) {
        __syncthreads();
#pragma unroll 1
        for (int rr = 0; rr < 2; ++rr) { const int i = 2 * F.wave + rr, tok = tokbase + grp * 16 + i; const bool isctx = tok < CTXN; const int s = isctx ? 1 : 0;
            const float* src = isctx ? HC + (size_t)tok * 1024 : HL + (size_t)(tok - CTXN) * 1024;
            const float* sh = modp(F, l, s, 3); const float* sc = modp(F, l, s, 4);
            f32x4 v[4]; float ss = 0.f;
#pragma unroll
            for (int j = 0; j < 4; ++j) { v[j] = *(const f32x4*)(src + j * 256 + F.lane * 4); ss += v[j][0] * v[j][0] + v[j][1] * v[j][1] + v[j][2] * v[j][2] + v[j][3] * v[j][3]; }
            ss = wave_sum(ss);
            const float rstd = rsqrtf(ss * (1.0f / 1024.0f) + EPS);
#pragma unroll
            for (int j = 0; j < 4; ++j) { const int c = j * 256 + F.lane * 4; const f32x4 g = *(const f32x4*)(g2n + c), a = *(const f32x4*)(sc + c), b = *(const f32x4*)(sh + c);
                f32x4 o;
#pragma unroll
                for (int e = 0; e < 4; ++e) o[e] = v[j][e] * rstd * g[e] * (1.0f + a[e]) + b[e];
                *(LAS f32x4*)(vs + i * VP + c) = o;
                u32x2 w; w.x = pk2(o[0], o[1]); w.y = pk2(o[2], o[3]); *(u32x2*)(VN + (size_t)tok * 1024 + c) = w; }
        }
        __syncthreads();
        {
            f32x4 acc[3] = {{0.f, 0.f, 0.f, 0.f}, {0.f, 0.f, 0.f, 0.f}, {0.f, 0.f, 0.f, 0.f}};
#pragma unroll 4
            for (int st = 0; st < 32; ++st) { const int k = F.wave * 128 + st * 4 + fq; const float a = vs[fr * VP + k];
#pragma unroll
                for (int nt = 0; nt < 3; ++nt) { const float b = WC[(size_t)k * 48 + nt * 16 + fr]; acc[nt] = __builtin_amdgcn_mfma_f32_16x16x4f32(a, b, acc[nt], 0, 0, 0); } }
#pragma unroll
            for (int nt = 0; nt < 3; ++nt)
#pragma unroll
                for (int r = 0; r < 4; ++r) part[(F.wave * 16 + fq * 4 + r) * 48 + nt * 16 + fr] = acc[nt][r];
        }
        __syncthreads();
        for (int idx = F.tid; idx < 16 * 48; idx += NT) { const int n = idx % 48; float a = (n < 4) ? F.in[I_RGB][l * 4 + n] : (n < 36 ? F.in[I_REB][l * 32 + n - 4] : 0.f);
#pragma unroll
            for (int w = 0; w < 8; ++w) a += part[w * 16 * 48 + idx];
            lg[idx] = a; }
        __syncthreads();
        if (F.tid < 16) { const LAS float* q = lg + F.tid * 48;
            int gx = 0; float gm = q[0];
            for (int j = 1; j < 4; ++j) if (q[j] > gm) { gm = q[j]; gx = j; }
            float gs = 0.f; for (int j = 0; j < 4; ++j) gs += __expf(q[j] - gm);
            const float gw = 1.0f / gs;
            const LAS float* e = q + 4 + gx * 8;
            int i1 = 0; float m1 = e[0];
            for (int j = 1; j < 8; ++j) if (e[j] > m1) { m1 = e[j]; i1 = j; }
            int i2 = -1; float m2 = 0.f;
            for (int j = 0; j < 8; ++j) if (j != i1 && (i2 < 0 || e[j] > m2)) { m2 = e[j]; i2 = j; }
            const float x = __expf(m2 - m1), w1 = 1.0f / (1.0f + x), w2 = x / (1.0f + x);
            const int a0 = gi * 32 + F.tid * 2;
            re[a0] = gx * 8 + i1; rw[a0] = gw * w1; re[a0 + 1] = gx * 8 + i2; rw[a0 + 1] = gw * w2; }
    }
    __syncthreads();
    if (F.tid < 32) lc[F.tid] = 0;
    __syncthreads();
    const int na = gi * 32;
    if (F.tid < na) rp[F.tid] = __hip_atomic_fetch_add(&lc[re[F.tid]], 1, __ATOMIC_RELAXED, __HIP_MEMORY_SCOPE_WORKGROUP);
    __syncthreads();
    if (F.tid < 32) lb[F.tid] = lc[F.tid] > 0 ? (int)__hip_atomic_fetch_add(cnt + F.tid * 64, (unsigned)lc[F.tid], RLX_AGENT) : 0;
    __syncthreads();
    if (F.tid < na) { const int a = F.tid, g = a >> 5, i = (a >> 1) & 15, slot = a & 1, e = re[a];
        const int tok = tokbase + (F.bid + g * F.G) * 16 + i, gidx = tok * 2 + slot;
        LIST[(size_t)e * NASG + lb[e] + rp[a]] = gidx; AW[gidx] = rw[a]; }
}

struct MoeSched {
    LAS int* cnt; LAS int* tstart; LAS unsigned* rowtab;
    const char* A; const char* B; char* O; int total, G, c, mode;
    __device__ __forceinline__ void locate(int L, int& e, int& mt, int& pn) const {
        const int mtg = L >> 2; pn = L & 3; e = 0;
        for (int j = 1; j < 32; ++j) if (tstart[j] <= mtg) e = j;
        mt = mtg - tstart[e];
    }
    __device__ __forceinline__ bool next(int i, GUnit& u) const {
        const int L = i * G + c; if (L >= total) return false;
        int e, mt, pn; locate(L, e, mt, pn);
        u.g = e; u.aux = mt; u.pm = tstart[e] + mt; u.pn = pn;
        if (mode == 0) { u.a = A; u.lda = 1024; u.b = B + ((size_t)e * 1024 + pn * 128) * 1024 * 2; u.ldb = 1024; u.hsb = 512; u.o = O + ((size_t)u.pm * 256 * 512 + pn * 128) * 2; u.ldo = 512; }
        else { u.a = A + (size_t)u.pm * 256 * 512 * 2; u.lda = 512; u.b = B + ((size_t)e * 1024 + pn * 256) * 512 * 2; u.ldb = 512; u.hsb = 128; u.o = O; u.ldo = 1024; }
        return true;
    }
    __device__ __forceinline__ unsigned grow(int slot, int r) const { return rowtab[slot * 256 + r]; }
};
__device__ __forceinline__ void moe_tables(const Frame& F, int l, MoeSched& S, int mode) {
    S.cnt = (LAS int*)(F.lds + MOE_TAB); S.tstart = S.cnt + 32; S.rowtab = (LAS unsigned*)(F.lds + MOE_TAB + 512);
    const unsigned* cnt = (const unsigned*)(F.ws + WS_CTL) + CW_CNT + l * 32 * 64;
    __syncthreads();
    if (F.tid < 32) S.cnt[F.tid] = (int)__hip_atomic_load(cnt + F.tid * 64, RLX_AGENT);
    __syncthreads();
    if (F.tid == 0) { int a = 0; for (int e = 0; e < 32; ++e) { S.tstart[e] = a; a += (S.cnt[e] + 255) >> 8; } S.tstart[32] = a; }
    __syncthreads();
    S.total = S.tstart[32] * 4; S.G = F.G; S.c = F.bid; S.mode = mode;
    if (mode == 0 && F.tid < 256) {
        const int* LIST = (const int*)(F.ws + WS_LIST);
        for (int slot = 0; slot < MOE_MAXU; ++slot) { const int L = slot * S.G + S.c; if (L >= S.total) break;
            int e, mt, pn; S.locate(L, e, mt, pn);
            const int idx = mt * 256 + F.tid; const int tok = idx < S.cnt[e] ? (LIST[(size_t)e * NASG + idx] >> 1) : 0;
            S.rowtab[slot * 256 + F.tid] = (unsigned)tok * 2048u; }
    }
    __syncthreads();
}
struct EpiSwiGLU {
    static constexpr bool PERM = true;
    __device__ __forceinline__ void operator()(const f32x4 (&acc)[2][2][4][2], const GUnit& u, int wr, int wc, int fr, int fq) const {
        bf16_t* base = (bf16_t*)u.o;
#pragma unroll
        for (int ai = 0; ai < 2; ++ai)
#pragma unroll
            for (int m = 0; m < 4; ++m) { const int r = ai * 128 + wr * 64 + m * 16 + fr; float o[8];
#pragma unroll
                for (int n = 0; n < 2; ++n)
#pragma unroll
                    for (int j = 0; j < 4; ++j) o[n * 4 + j] = siluf(acc[ai][0][m][n][j]) * acc[ai][1][m][n][j];
                u32x4 w; w.x = pk2(o[0], o[1]); w.y = pk2(o[2], o[3]); w.z = pk2(o[4], o[5]); w.w = pk2(o[6], o[7]);
                *(u32x4*)(base + (size_t)r * 512 + wc * 32 + 8 * fq) = w; }
    }
};
struct EpiScatter {
    static constexpr bool PERM = true;
    const int* LIST; const float* AW; bf16_t* YB; LAS int* cnt;
    __device__ __forceinline__ void operator()(const f32x4 (&acc)[2][2][4][2], const GUnit& u, int wr, int wc, int fr, int fq) const {
        const int ce = cnt[u.g];
#pragma unroll
        for (int ai = 0; ai < 2; ++ai)
#pragma unroll
            for (int m = 0; m < 4; ++m) { const int r = ai * 128 + wr * 64 + m * 16 + fr, idx = u.aux * 256 + r;
                if (idx < ce) { const int a = LIST[(size_t)u.g * NASG + idx]; const float w = AW[a];
                    bf16_t* rowp = YB + (size_t)a * 1024 + u.pn * 256 + wc * 32 + 8 * fq;
#pragma unroll
                    for (int bj = 0; bj < 2; ++bj) { const f32x4 v0 = acc[ai][bj][m][0] * w, v1 = acc[ai][bj][m][1] * w;
                        u32x4 q; q.x = pk2(v0[0], v0[1]); q.y = pk2(v0[2], v0[3]); q.z = pk2(v1[0], v1[1]); q.w = pk2(v1[2], v1[3]);
                        *(u32x4*)(rowp + bj * 128) = q; } } }
    }
};
__device__ __forceinline__ void moe_e1(const Frame& F, int l) {
    MoeSched S; moe_tables(F, l, S, 0);
    S.A = (const char*)(F.ws + WS_VN); S.B = (const char*)(F.ws + WS_W13) + (size_t)l * 32 * 1024 * 1024 * 2; S.O = (char*)(F.ws + WS_H1);
    EpiSwiGLU E;
    pg8::gemm_phase<EpiSwiGLU, MoeSched, true>(F.lds, 1024, S, E, F.tid);
}
__device__ __forceinline__ void moe_e2(const Frame& F, int l) {
    MoeSched S; moe_tables(F, l, S, 1);
    S.A = (const char*)(F.ws + WS_H1); S.B = (const char*)(F.ws + WS_W2) + (size_t)l * 32 * 1024 * 512 * 2; S.O = nullptr;
    EpiScatter E{(const int*)(F.ws + WS_LIST), (const float*)(F.ws + WS_AW), (bf16_t*)(F.ws + WS_YBUF), S.cnt};
    pg8::gemm_phase<EpiScatter, MoeSched, false>(F.lds, 512, S, E, F.tid);
}
#ifndef MK_LAYERS
#define MK_LAYERS 4
#endif
__global__ void __launch_bounds__(NT, 2) mk_fwd(Args args) {
    extern __shared__ __attribute__((aligned(16))) unsigned char lds_raw[];
    Frame F0;
    { Frame& F = F0;
    F.lds = (LAS unsigned char*)lds_raw; F.ws = args.ws; F.in = args.in; F.out = args.out;
    F.wave = __builtin_amdgcn_readfirstlane((int)threadIdx.x >> 6); F.lane = fresh_lane(); F.tid = F.wave * 64 + F.lane; F.G = gridDim.x; F.bid = blockIdx.x; }
    const Frame& F = F0;
    volatile LAS unsigned* xbw = (volatile LAS unsigned*)(F.lds + LDS_BYTES - 16);
    if (F.tid < 4) xbw[F.tid] = 0u;
    __syncthreads();
    unsigned* ctl = (unsigned*)(F.ws + WS_CTL);
    const int lo = args.ph_lo, hi = args.ph_hi;
    XcdBarrier bar; bar.bar = ctl + CW_BAR; bar.x = 0; bar.st = xbw;
    if (hi - lo > 1) bar = xcd_barrier_post(ctl + CW_BAR, xbw, F.tid);
    int ph = 0;
#define PHASE_BEGIN if (lo <= ph && ph < hi) { Frame F = F0; { const int t_ = F0.wave * 64 + fresh_lane(); F.tid = t_; F.lane = t_ & 63; }
#define PHASE_END   if (ph + 1 < hi) xcd_barrier(bar, F0.wave * 64 + fresh_lane()); } ++ph;

    PHASE_BEGIN p0_prologue(F); PHASE_END
    int lprev = -1;
#define LAYER_PAIR(IT) { constexpr int it = IT; \
        const int lm = 2 * it, lh = 2 * it + 1; const bool colmajor = (it == 1), ctxl = (it == 0); \
        if (lm < MK_LAYERS) { \
         \
        PHASE_BEGIN n1_phase(F, lm, it > 0, true, it > 0, it == 0, colmajor); PHASE_END \
        PHASE_BEGIN mlstm_inproj(F, it); PHASE_END \
        PHASE_BEGIN mlstm_conv_gates(F, it); PHASE_END \
        PHASE_BEGIN mlstm_qkv(F, it); PHASE_END \
        PHASE_BEGIN mlstm_scan(F); PHASE_END \
        PHASE_BEGIN mlstm_intra(F, it, ctxl ? 0 : 4); PHASE_END \
        PHASE_BEGIN mlstm_outproj(F, lm, it, ctxl, colmajor); PHASE_END \
        PHASE_BEGIN moe_route(F, lm, ctxl); PHASE_END \
        PHASE_BEGIN moe_e1(F, lm); PHASE_END \
        PHASE_BEGIN moe_e2(F, lm); PHASE_END \
        lprev = lm; \
        if (lh < MK_LAYERS) { \
         \
        PHASE_BEGIN n1_phase(F, lh, true, ctxl, ctxl, false, colmajor); hyena_filtergen(F, it, ctxl); PHASE_END \
        PHASE_BEGIN hyena_inproj(F, it, ctxl); PHASE_END \
        PHASE_BEGIN hyena_fft(F, it, ctxl); PHASE_END \
        PHASE_BEGIN hyena_transpose(F, ctxl); PHASE_END \
        PHASE_BEGIN hyena_outproj(F, lh, it, ctxl, colmajor); PHASE_END \
        PHASE_BEGIN moe_route(F, lh, ctxl); PHASE_END \
        PHASE_BEGIN moe_e1(F, lh); PHASE_END \
        PHASE_BEGIN moe_e2(F, lh); PHASE_END \
        lprev = lh; \
        } } }
    LAYER_PAIR(0)
    LAYER_PAIR(1)
    PHASE_BEGIN final_phase(F, lprev >= 0, lprev, lprev < 0); PHASE_END
}

extern "C" void kernel_launch(void* const* d_in, const int* in_sizes, int n_in, void* d_out, int out_size, void* d_ws, size_t ws_size, hipStream_t stream) {
    static int grid = 0;
    if (grid == 0) {
        if (n_in != 40 || out_size != SEQ * D || ws_size < WS_END) { fprintf(stderr, "kernel_launch: unexpected shapes (n_in %d out %d ws %zu)\n", n_in, out_size, ws_size); grid = -1; return; }
        int dev = 0, cus = 0, per_cu = 0;
        if (hipGetDevice(&dev) != hipSuccess || hipDeviceGetAttribute(&cus, hipDeviceAttributeMultiprocessorCount, dev) != hipSuccess) { grid = -1; return; }
        if (hipFuncSetAttribute((const void*)mk_fwd, hipFuncAttributeMaxDynamicSharedMemorySize, LDS_BYTES) != hipSuccess) { fprintf(stderr, "kernel_launch: hipFuncSetAttribute failed\n"); grid = -1; return; }
        if (hipOccupancyMaxActiveBlocksPerMultiprocessor(&per_cu, (const void*)mk_fwd, NT, LDS_BYTES) != hipSuccess || per_cu < 1) { fprintf(stderr, "kernel_launch: occupancy query says %d\n", per_cu); }
        (void)hipGetLastError();
        grid = cus;
        if (grid > 256) grid = 256;
    }
    if (grid < 0) return;
    (void)hipMemsetAsync((char*)d_ws + WS_CTL, 0, CTL_BYTES, stream);
    Args a{};
    for (int i = 0; i < 40; ++i) a.in[i] = (const float*)d_in[i];
    a.out = (float*)d_out; a.ws = (unsigned char*)d_ws;
#ifdef MK_SPLIT
    for (int p = 0; p < MK_SPLIT; ++p) { a.ph_lo = p; a.ph_hi = p + 1; hipLaunchKernelGGL(mk_fwd, dim3(grid), dim3(NT), LDS_BYTES, stream, a); }
#else
    a.ph_lo = 0; a.ph_hi = 1000;
    hipLaunchKernelGGL(mk_fwd, dim3(grid), dim3(NT), LDS_BYTES, stream, a);
#endif
}
```

```cpp
#include <hip/hip_runtime.h>
#include <cstdio>
#include <cstdint>

#define LAS __attribute__((address_space(3)))
#define GAS __attribute__((address_space(1)))
#define RLX_AGENT __ATOMIC_RELAXED, __HIP_MEMORY_SCOPE_AGENT
typedef unsigned short bf16_t;
typedef short bf16x8 __attribute__((ext_vector_type(8)));
typedef float f32x4 __attribute__((ext_vector_type(4)));
typedef float f32x2 __attribute__((ext_vector_type(2)));
typedef unsigned u32x4 __attribute__((ext_vector_type(4)));
typedef unsigned u32x2 __attribute__((ext_vector_type(2)));

constexpr int D = 1024, SEQ = 16384, CTXN = 256, LT = SEQ + CTXN;
constexpr int MI = 2048, MH = 4, DQK = 256, DV = 512, CH = 64, NCH = LT / CH;
constexpr int NEXP = 32, DE = 512, NASG = 2 * LT;
constexpr int HB = 16, HEMB = 33, HFH = 64;
constexpr float EPS = 1e-6f;
constexpr int NT = 512, NWAVES = 8;
constexpr int LDS_BYTES = 147456;

constexpr size_t MiB = 1u << 20;
constexpr size_t WS_CTL = 0, CTL_BYTES = 1 * MiB;
constexpr size_t WS_MODS = 4 * MiB;
constexpr size_t WS_WC = 5 * MiB;
constexpr size_t WS_Z2 = 6 * MiB;
constexpr size_t WS_Z2C = 10 * MiB;
constexpr size_t WS_SCAL = 11 * MiB;
constexpr size_t WS_CHS = 14 * MiB;
constexpr size_t WS_DENI = 15 * MiB;
constexpr size_t WS_LIST = 16 * MiB;
constexpr size_t WS_AW = 21 * MiB;
constexpr size_t WS_WGP = 26 * MiB;
constexpr size_t WS_FSC = 27 * MiB;
constexpr size_t WS_TWP = 28 * MiB;
constexpr size_t WS_GWT = 22 * MiB;
constexpr size_t WS_FILTC = 23 * MiB;
constexpr size_t WS_W3T = 25 * MiB;
constexpr size_t WS_WMIN = 32 * MiB;
constexpr size_t WS_WQ = 48 * MiB;
constexpr size_t WS_WK = 50 * MiB;
constexpr size_t WS_WV = 52 * MiB;
constexpr size_t WS_WMOUT = 56 * MiB;
constexpr size_t WS_WHIN = 64 * MiB;
constexpr size_t WS_WHOUT = 76 * MiB;
constexpr size_t WS_W13 = 96 * MiB;
constexpr size_t WS_W2 = 352 * MiB;
constexpr size_t WS_HL = 480 * MiB;
constexpr size_t WS_HC = 544 * MiB;
constexpr size_t WS_U = 546 * MiB;
constexpr size_t WS_VN = 580 * MiB;
constexpr size_t WS_YBUF = 614 * MiB;
constexpr size_t WS_H1 = 680 * MiB;
constexpr size_t WS_MIX = 722 * MiB;
constexpr size_t WS_XCM = WS_MIX;
constexpr size_t WS_OPRE = WS_MIX + 130 * MiB;
constexpr size_t WS_Q = WS_MIX + 195 * MiB;
constexpr size_t WS_KN = WS_MIX + 228 * MiB;
constexpr size_t WS_KT = WS_MIX + 261 * MiB;
constexpr size_t WS_VT = WS_MIX + 294 * MiB;
constexpr size_t WS_OINT = WS_MIX + 359 * MiB;
constexpr size_t WS_Y = WS_MIX + 495 * MiB;
constexpr size_t WS_ZT = WS_MIX;
constexpr size_t WS_FILT = WS_MIX + 98 * MiB;
constexpr size_t WS_Y2T = WS_MIX + 162 * MiB;
constexpr size_t WS_ZH = WS_MIX + 195 * MiB;
constexpr size_t WS_Y2 = WS_MIX + 259 * MiB;
constexpr size_t WS_VTS = WS_MIX + 560 * MiB;
constexpr size_t WS_FILT2 = WS_MIX + 696 * MiB;
constexpr size_t WS_ZHALL = WS_MIX + 760 * MiB;
constexpr size_t WS_END = WS_MIX + 1016 * MiB;

constexpr int CW_BAR = 4096;
constexpr int CW_CNT = 16384;
constexpr int CW_ERR = 8;

__device__ __forceinline__ float bf2f(bf16_t b) { return __uint_as_float(((unsigned)b) << 16); }
__device__ __forceinline__ unsigned pk2(float lo, float hi) { unsigned r; asm("v_cvt_pk_bf16_f32 %0, %1, %2" : "=v"(r) : "v"(lo), "v"(hi)); return r; }
__device__ __forceinline__ bf16_t f2bf(float f) { return (bf16_t)pk2(f, 0.f); }
__device__ __forceinline__ float bflo(unsigned w) { return __uint_as_float(w << 16); }
__device__ __forceinline__ float bfhi(unsigned w) { return __uint_as_float(w & 0xffff0000u); }
__device__ __forceinline__ float sigmf(float x) { return __builtin_amdgcn_rcpf(1.0f + __expf(-x)); }
__device__ __forceinline__ float siluf(float x) { return x * sigmf(x); }
#define LDS_BAR() do { asm volatile("s_waitcnt lgkmcnt(0)" ::: "memory"); __builtin_amdgcn_s_barrier(); asm volatile("" ::: "memory"); } while (0)
__device__ __forceinline__ int fresh_lane() { int l; asm volatile("v_mbcnt_lo_u32_b32 %0, -1, 0\n\tv_mbcnt_hi_u32_b32 %0, -1, %0" : "=v"(l)); return l; }
__device__ __forceinline__ float wave_sum(float v) {
#pragma unroll
    for (int o = 32; o > 0; o >>= 1) v += __shfl_xor(v, o);
    return v;
}
__device__ __forceinline__ float wave_max(float v) {
#pragma unroll
    for (int o = 32; o > 0; o >>= 1) v = fmaxf(v, __shfl_xor(v, o));
    return v;
}

#define XB_TMO      128
#define XB_XCNT(j)  (256  + 64 * (j))
#define XB_XSUB(j)  (1280 + 64 * (j))
#define XB_XGEN(j)  (2304 + 64 * (j))
#define XB_TOP      3328
#define XB_TOPGEN   3392
#define XCD_BAR_WORDS 3456
#define XB_SPIN_CAP (1u << 18)
__device__ __forceinline__ unsigned xb_ld(unsigned* p)              { return __hip_atomic_load(p, __ATOMIC_RELAXED, __HIP_MEMORY_SCOPE_AGENT); }
__device__ __forceinline__ unsigned xb_add(unsigned* p, unsigned v) { return __hip_atomic_fetch_add(p, v, __ATOMIC_RELAXED, __HIP_MEMORY_SCOPE_AGENT); }
__device__ __forceinline__ unsigned xb_xcc_id() { return (unsigned)__builtin_amdgcn_s_getreg((3 << 11) | 20) & 0xFu; }
#define XB_SPIN(cond, bar) do { unsigned _sp = 0; while (cond) { __builtin_amdgcn_s_sleep(1); \
    if ((++_sp & 255u) == 0u) { if (xb_ld(&(bar)[XB_TMO])) break; if (_sp > XB_SPIN_CAP) { atomicAdd(&(bar)[XB_TMO], 1u); break; } } } } while (0)
struct XcdBarrier { unsigned* bar; unsigned x; volatile LAS unsigned* st; };
__device__ __forceinline__ XcdBarrier xcd_barrier_post(unsigned* bar, volatile LAS unsigned* st, int tid) {
    XcdBarrier b; b.bar = bar; b.x = xb_xcc_id(); b.st = st;
    if (tid == 0) (void)xb_add(&bar[XB_XCNT(b.x)], 1u);
    return b;
}
__device__ __forceinline__ void xcd_barrier_complete(unsigned* bar, unsigned x, unsigned& nloc, unsigned& nx) {
    const unsigned G = gridDim.x * gridDim.y * gridDim.z;
    unsigned sum, cnt, mine, sp = 0u;
    for (;;) {
        sum = 0u; cnt = 0u; mine = 0u;
#pragma unroll
        for (unsigned j = 0; j < 16; ++j) { const unsigned c = xb_ld(&bar[XB_XCNT(j)]); sum += c; cnt += (c > 0u) ? 1u : 0u; mine = (j == x) ? c : mine; }
        if (sum == G) break;
        __builtin_amdgcn_s_sleep(1);
        if ((++sp & 255u) == 0u) { if (xb_ld(&bar[XB_TMO])) break; if (sp > XB_SPIN_CAP) { atomicAdd(&bar[XB_TMO], 1u); break; } }
    }
    nloc = mine > 0u ? mine : 1u; nx = cnt > 0u ? cnt : 1u;
}
__device__ __forceinline__ void xcd_barrier(const XcdBarrier& b, int tid) {
    asm volatile("s_waitcnt vmcnt(0)" ::: "memory");
    __syncthreads();
    if (tid == 0) {
        unsigned* bar = b.bar;
        __builtin_amdgcn_s_waitcnt(0);
        unsigned nloc = b.st[0], nx = b.st[1];
        if (nloc == 0u) { xcd_barrier_complete(bar, b.x, nloc, nx); b.st[0] = nloc; b.st[1] = nx; }
        const unsigned old = xb_add(&bar[XB_XSUB(b.x)], 1u);
        const unsigned gen = old / nloc;
        if (old + 1u == (gen + 1u) * nloc) {
            __builtin_amdgcn_fence(__ATOMIC_RELEASE, "agent");
            asm volatile("s_waitcnt vmcnt(0)" ::: "memory");
            const unsigned og = xb_add(&bar[XB_TOP], 1u);
            const unsigned tg = og / nx;
            if (og + 1u == (tg + 1u) * nx) xb_add(&bar[XB_TOPGEN], 1u);
            else XB_SPIN(xb_ld(&bar[XB_TOPGEN]) == tg, bar);
            __builtin_amdgcn_fence(__ATOMIC_ACQUIRE, "agent");
            xb_add(&bar[XB_XGEN(b.x)], 1u);
            asm volatile("s_waitcnt vmcnt(0)" ::: "memory");
        } else {
            XB_SPIN(xb_ld(&bar[XB_XGEN(b.x)]) == gen, bar);
            __builtin_amdgcn_fence(__ATOMIC_ACQUIRE, "agent");
            asm volatile("s_waitcnt vmcnt(0)" ::: "memory");
        }
    }
    __syncthreads();
}

namespace pg8 {
constexpr int BM = 256, BK = 64, HALF = 128, HTB = HALF * BK * 2, STAGE_BYTES = 8 * HTB;
__device__ __forceinline__ int lds_byte(int r, int c) { const int st = (r >> 4) * 2 + (c >> 5), rr = r & 15, cc = c & 31, ob = rr * 64 + cc * 2; return st * 1024 + (ob ^ (((ob >> 9) & 1) << 5)); }
__device__ __forceinline__ void stage_rc(int b, int& R, int& C) { const int st = b / 1024, sb = b % 1024, swz = sb ^ (((sb >> 9) & 1) << 5); R = (st >> 1) * 16 + swz / 64; C = (st & 1) * 32 + (swz % 64) / 2; }
__device__ __forceinline__ int perm32(int rho) { const int n = rho >> 4, i = rho & 15; return 8 * (i >> 2) + 4 * n + (i & 3); }

struct GUnit { const char* a; const char* b; char* o; int pm, pn, g, aux, lda, ldb, ldo, hsb, half; };

template <class Epi, class Sched, bool GATHER>
__device__ __forceinline__ void gemm_phase(LAS unsigned char* lds, const int K, const Sched& S, const Epi& E, int tid_in) {
    int tid_ = tid_in; asm volatile("" : "+v"(tid_));
    const int tid = tid_, wid = __builtin_amdgcn_readfirstlane(tid >> 6), lane = tid & 63, wr = wid >> 2, wc = wid & 3, fr = lane & 15, fq = lane >> 4;
    const int nt = K / BK;
    unsigned cvA0[2], cvA1[2], cvB[2];
#define PG8_OFFS(U, slot, vA0, vA1, vB) do { _Pragma("unroll") for (int i = 0; i < 2; ++i) { int R_, C_; stage_rc(tid * 16 + i * 8192, R_, C_); const int Rb_ = Epi::PERM ? ((R_ & ~31) + perm32(R_ & 31)) : R_; \
        if constexpr (GATHER) { vA0[i] = S.grow(slot, R_) + (unsigned)C_ * 2u; vA1[i] = S.grow(slot, R_ + HALF) + (unsigned)C_ * 2u; } \
        else { vA0[i] = (unsigned)(R_ * (U).lda + C_) * 2u; vA1[i] = (unsigned)((R_ + HALF) * (U).lda + C_) * 2u; } \
        vB[i] = (unsigned)(Rb_ * (U).ldb + C_) * 2u; } } while (0)
    const size_t kstep = (size_t)(BK * 2);
    const unsigned ldsw = (unsigned)wid * 1024u;
    const int aoff = lds_byte(wr * 64 + fr, fq * 8), boff = lds_byte(wc * 32 + fr, fq * 8);
#define PG8_SA(b, h) (((b) * 2 + (h)) * HTB)
#define PG8_SB(b, h) ((4 + (b) * 2 + (h)) * HTB)
#define PG8_STAGE(bufoff, gbase, voff) do { _Pragma("unroll") for (int _i = 0; _i < 2; ++_i) \
        __builtin_amdgcn_global_load_lds((const unsigned*)((const char*)(gbase) + (voff)[_i]), (LAS unsigned*)(lds + (bufoff) + ldsw + _i * 8192), 16, 0, 0); } while (0)
#define PG8_LDA(dst, b, h) do { _Pragma("unroll") for (int m = 0; m < 4; ++m) _Pragma("unroll") for (int k = 0; k < 2; ++k) dst[m][k] = *(const LAS bf16x8*)(lds + PG8_SA(b, h) + aoff + m * 2048 + k * 1024); } while (0)
#define PG8_LDB(dst, b, h) do { _Pragma("unroll") for (int n = 0; n < 2; ++n) _Pragma("unroll") for (int k = 0; k < 2; ++k) dst[n][k] = *(const LAS bf16x8*)(lds + PG8_SB(b, h) + boff + n * 2048 + k * 1024); } while (0)
#define PG8_MMA(ai, bj, At, Bt) do { __builtin_amdgcn_s_setprio(1); _Pragma("unroll") for (int m = 0; m < 4; ++m) _Pragma("unroll") for (int n = 0; n < 2; ++n) _Pragma("unroll") for (int k = 0; k < 2; ++k) \
        acc[ai][bj][m][n] = __builtin_amdgcn_mfma_f32_16x16x32_bf16(Bt[n][k], At[m][k], acc[ai][bj][m][n], 0, 0, 0); __builtin_amdgcn_s_setprio(0); } while (0)
#define PG8_WAIT_V(n) asm volatile("s_waitcnt vmcnt(" #n ")" ::: "memory")
#define PG8_WAIT_L(n) asm volatile("s_waitcnt lgkmcnt(" #n ")" ::: "memory")
#define PG8_BAR __builtin_amdgcn_s_barrier()
#define PG8_SCHED __builtin_amdgcn_sched_barrier(0)
    GUnit cur, nxt; int ui = 0;
    if (!S.next(0, cur)) return;
    PG8_OFFS(cur, 0, cvA0, cvA1, cvB);
    size_t chB = (size_t)cur.hsb * cur.ldb * 2;
    f32x4 acc[2][2][4][2];
#pragma unroll
    for (int a = 0; a < 2; ++a)
#pragma unroll
        for (int b = 0; b < 2; ++b)
#pragma unroll
            for (int m = 0; m < 4; ++m)
#pragma unroll
                for (int n = 0; n < 2; ++n) acc[a][b][m][n] = (f32x4){0.f, 0.f, 0.f, 0.f};
    bf16x8 At[4][2], B0[2][2], B1[2][2];
    const char* cA = cur.a; const char* cB = cur.b;
    PG8_STAGE(PG8_SB(0, 0), cB, cvB); PG8_STAGE(PG8_SA(0, 0), cA, cvA0); PG8_STAGE(PG8_SB(0, 1), cB + chB, cvB); PG8_STAGE(PG8_SA(0, 1), cA, cvA1);
    if (wr == 1) PG8_BAR;
    PG8_WAIT_V(4); PG8_BAR;
    PG8_STAGE(PG8_SB(1, 0), cB + kstep, cvB); PG8_STAGE(PG8_SA(1, 0), cA + kstep, cvA0); PG8_STAGE(PG8_SB(1, 1), cB + chB + kstep, cvB);
    PG8_WAIT_V(6); PG8_BAR;
    for (;;) {
        const bool has_next = S.next(ui + 1, nxt);
        const char* nA = has_next ? nxt.a : cA; const char* nB = has_next ? nxt.b : cB;
        for (int t = 0; t < nt; t += 2) {
            const bool last = (t == nt - 2);
            const char* a1 = cA + (size_t)(t + 1) * kstep;
            const char* a2 = last ? nA : cA + (size_t)(t + 2) * kstep; const char* b2 = last ? nB : cB + (size_t)(t + 2) * kstep;
            const char* a3 = a2 + kstep; const char* b3 = b2 + kstep;
            PG8_LDB(B0, 0, 0); PG8_SCHED; PG8_LDA(At, 0, 0); PG8_STAGE(PG8_SA(1, 1), a1, cvA1);
            PG8_WAIT_L(8); PG8_BAR; PG8_WAIT_L(0); PG8_MMA(0, 0, At, B0); PG8_BAR; PG8_SCHED;
            if (last && has_next) { PG8_OFFS(nxt, ui + 1, cvA0, cvA1, cvB); chB = (size_t)nxt.hsb * nxt.ldb * 2; }
            PG8_LDB(B1, 0, 1); PG8_STAGE(PG8_SB(0, 0), b2, cvB);
            PG8_BAR; PG8_WAIT_L(0); PG8_MMA(0, 1, At, B1); PG8_BAR;
            PG8_LDA(At, 0, 1); PG8_STAGE(PG8_SA(0, 0), a2, cvA0);
            PG8_BAR; PG8_WAIT_L(0); PG8_MMA(1, 0, At, B0); PG8_BAR; PG8_SCHED;
            PG8_STAGE(PG8_SB(0, 1), b2 + chB, cvB);
            PG8_WAIT_V(6); PG8_BAR; PG8_MMA(1, 1, At, B1); PG8_BAR;
            PG8_LDB(B0, 1, 0); PG8_SCHED; PG8_LDA(At, 1, 0); PG8_STAGE(PG8_SA(0, 1), a2, cvA1);
            PG8_WAIT_L(8); PG8_BAR; PG8_WAIT_L(0); PG8_MMA(0, 0, At, B0); PG8_BAR; PG8_SCHED;
            PG8_LDB(B1, 1, 1); PG8_STAGE(PG8_SB(1, 0), b3, cvB);
            PG8_BAR; PG8_WAIT_L(0); PG8_MMA(0, 1, At, B1); PG8_BAR;
            PG8_LDA(At, 1, 1); PG8_STAGE(PG8_SA(1, 0), a3, cvA0);
            PG8_BAR; PG8_WAIT_L(0); PG8_MMA(1, 0, At, B0); PG8_BAR; PG8_SCHED;
            PG8_STAGE(PG8_SB(1, 1), b3 + chB, cvB);
            PG8_WAIT_V(6); PG8_BAR; PG8_MMA(1, 1, At, B1); PG8_BAR;
        }
        E(acc, cur, wr, wc, fr, fq);
        if (!has_next) break;
#pragma unroll
        for (int a = 0; a < 2; ++a)
#pragma unroll
            for (int b = 0; b < 2; ++b)
#pragma unroll
                for (int m = 0; m < 4; ++m)
#pragma unroll
                    for (int n = 0; n < 2; ++n) acc[a][b][m][n] = (f32x4){0.f, 0.f, 0.f, 0.f};
        cur = nxt; cA = nA; cB = nB; ++ui;
    }
    PG8_WAIT_V(0);
    if (wr == 0) PG8_BAR;
    PG8_BAR;
#undef PG8_OFFS
#undef PG8_SA
#undef PG8_SB
#undef PG8_STAGE
#undef PG8_LDA
#undef PG8_LDB
#undef PG8_MMA
#undef PG8_WAIT_V
#undef PG8_WAIT_L
#undef PG8_BAR
#undef PG8_SCHED
}

__device__ __forceinline__ int xcd_remap(int wgid, int nwg) { const int q = nwg / 8, r = nwg % 8, xcd = wgid % 8, off = wgid / 8; return (xcd < r ? xcd * (q + 1) : r * (q + 1) + (xcd - r) * q) + off; }
}
using pg8::GUnit;

struct Args { const float* in[40]; float* out; unsigned char* ws; int ph_lo, ph_hi; };
struct Frame {
    LAS unsigned char* lds; unsigned char* ws; const float* const* in; float* out;
    int tid, lane, wave, G, bid;
};
struct Prob { const char* A; const char* B; char* O; long long sA, sB, sO;
              int nM, nN, nb, ustart; int lda, ldb, ldo; int osz; };
constexpr int SCHED_TAB = 131072 + 8192;
__device__ __forceinline__ int rfl(int v) { return __builtin_amdgcn_readfirstlane(v); }
__device__ __forceinline__ const char* rflp(const char* p) { const unsigned long long v = (unsigned long long)p; return (const char*)(((unsigned long long)(unsigned)rfl((int)(v >> 32)) << 32) | (unsigned)rfl((int)v)); }
template <int NP> struct MultiSched {
    LAS Prob* p; int total, G, c;
    __device__ __forceinline__ void init(const Frame& F, const Prob (&q)[NP], int total_) {
        p = (LAS Prob*)(F.lds + SCHED_TAB); total = total_; G = F.G; c = F.bid;
        __syncthreads();
        if (F.tid == 0) {
#pragma unroll
            for (int j = 0; j < NP; ++j) { p[j].A = q[j].A; p[j].B = q[j].B; p[j].O = q[j].O; p[j].sA = q[j].sA; p[j].sB = q[j].sB; p[j].sO = q[j].sO; p[j].nM = q[j].nM; p[j].nN = q[j].nN; p[j].nb = q[j].nb;
                p[j].ustart = q[j].ustart; p[j].lda = q[j].lda; p[j].ldb = q[j].ldb; p[j].ldo = q[j].ldo; p[j].osz = q[j].osz; } }
        __syncthreads();
    }
    __device__ __forceinline__ bool next(int i, GUnit& u) const {
        const long long Lq = (long long)i * G + c; if (Lq >= total) return false;
        int L = pg8::xcd_remap((int)Lq, total);
        int k = 0;
#pragma unroll
        for (int j = 1; j < NP; ++j) if (L >= p[j].ustart) k = j;
        k = rfl(k);
        const LAS Prob& q = p[k];
        const int nM = rfl(q.nM), nN = rfl(q.nN), lda = rfl(q.lda), ldb = rfl(q.ldb), ldo = rfl(q.ldo), osz = rfl(q.osz);
        L -= rfl(q.ustart);
        const int per = nM * nN, b = L / per, r = L - b * per, pm = r / nN, pn = r - pm * nN;
        u.pm = pm; u.pn = pn; u.g = b; u.aux = k; u.lda = lda; u.ldb = ldb; u.ldo = ldo; u.hsb = 128; u.half = 0;
        u.a = rflp(q.A) + b * (long long)rfl((int)q.sA) + (size_t)pm * 256 * lda * 2;
        u.b = rflp(q.B) + b * (long long)rfl((int)q.sB) + (size_t)pn * 256 * ldb * 2;
        u.o = (char*)rflp(q.O) + b * (long long)rfl((int)q.sO) + ((size_t)pm * 256 * ldo + (size_t)pn * 256) * osz;
        return true;
    }
};

struct EpiStore {
    static constexpr bool PERM = true;
    const float* rowbias;
    const float* wgp; bf16_t* vts;
    int fragmode;
    __device__ __forceinline__ void operator()(const f32x4 (&acc)[2][2][4][2], const GUnit& u, int wr, int wc, int fr, int fq) const {
        bf16_t* base = (bf16_t*)u.o;
#pragma unroll
        for (int ai = 0; ai < 2; ++ai)
#pragma unroll
            for (int m = 0; m < 4; ++m) { const int r = ai * 128 + wr * 64 + m * 16 + fr;
                const float rb = rowbias ? rowbias[u.pm * 256 + r] : 0.f;
#pragma unroll
                for (int bj = 0; bj < 2; ++bj) { const f32x4 v0 = acc[ai][bj][m][0] + rb, v1 = acc[ai][bj][m][1] + rb;
                    u32x4 w; w.x = pk2(v0[0], v0[1]); w.y = pk2(v0[2], v0[3]); w.z = pk2(v1[0], v1[1]); w.w = pk2(v1[2], v1[3]);
                    const int c = bj * 128 + wc * 32 + 8 * fq;
                    unsigned off;
                    if (fragmode == 0) off = (unsigned)(r * u.ldo + c);
                    else if (u.aux < 2) { const int R = u.pm * 256 + r; off = (unsigned)((((R >> 4) * 8 + (c >> 5)) * 64 + (R & 15) + 16 * fq) * 8); }
                    else { const int R = u.pm * 256 + r, s = u.pn * 256 + c, nrt = (u.aux == 2) ? 16 : 32;
                           off = (unsigned)(((((s >> 6) * nrt + (R >> 4)) * 2 + ((s >> 5) & 1)) * 64 + (R & 15) + 16 * fq) * 8); }
                    *(u32x4*)(base + off) = w; } }
        if (vts != nullptr && u.aux == 3) {
#pragma unroll 1
            for (int dir = 0; dir < 2; ++dir) { const int ch = dir * 4 + u.g;
                bf16_t* ob = vts + (size_t)ch * NCH * 33 * 1024;
#pragma unroll
                for (int bj = 0; bj < 2; ++bj) { const int c = bj * 128 + wc * 32 + 8 * fq, s = u.pn * 256 + c;
                    const f32x4 g0 = *(const f32x4*)(wgp + (size_t)ch * LT + s), g1 = *(const f32x4*)(wgp + (size_t)ch * LT + s + 4);
#pragma unroll
                    for (int ai = 0; ai < 2; ++ai)
#pragma unroll
                        for (int m = 0; m < 4; ++m) { const int R = u.pm * 256 + ai * 128 + wr * 64 + m * 16 + fr; const f32x4 v0 = acc[ai][bj][m][0] * g0, v1 = acc[ai][bj][m][1] * g1;
                            u32x4 w; w.x = pk2(v0[0], v0[1]); w.y = pk2(v0[2], v0[3]); w.z = pk2(v1[0], v1[1]); w.w = pk2(v1[2], v1[3]);
                            *(u32x4*)(ob + (unsigned)(((((s >> 6) * 33 + (R >> 4)) * 2 + ((s >> 5) & 1)) * 64 + (R & 15) + 16 * fq) * 8)) = w; }
                    asm volatile("" ::: "memory"); } }
        }
    }
};

enum { I_X = 0, I_C, I_CTX, I_CCTX, I_ADAW, I_ADAB, I_N1G, I_N2G, I_RGW, I_RGB, I_REW, I_REB, I_W13, I_W2,
       I_MINW, I_MCONVW, I_MCONVB, I_MQW, I_MKW, I_MVW, I_MGATEW, I_MGATEB, I_MNORMG, I_MSKIP, I_MOUTW,
       I_HINW, I_HINB, I_HSCW, I_HSCB, I_HFW1, I_HFB1, I_HFFREQ, I_HFW2, I_HFB2, I_HFW3, I_HDECAY, I_HFBIAS, I_HOUTW, I_HOUTB, I_FINALG };

__device__ __forceinline__ void tconv(const Frame& F, const float* src, bf16_t* dst, int B, int R, int C, float scale, int vbid, int vG) {
    LAS float* tile = (LAS float*)F.lds;
    const int tr = R / 64, tc = C / 64, ntile = B * tr * tc;
    for (int t = vbid; t < ntile; t += vG) {
        const int b = t / (tr * tc), rem = t - b * tr * tc, r0 = (rem / tc) * 64, c0 = (rem % tc) * 64;
        const float* s = src + ((size_t)b * R + r0) * C + c0;
        { const int r = F.tid >> 3, c8 = (F.tid & 7) * 8;
          const f32x4 v0 = *(const f32x4*)(s + (size_t)r * C + c8), v1 = *(const f32x4*)(s + (size_t)r * C + c8 + 4);
#pragma unroll
          for (int j = 0; j < 4; ++j) { tile[r * 65 + c8 + j] = v0[j]; tile[r * 65 + c8 + 4 + j] = v1[j]; } }
        LDS_BAR();
        { const int n = F.tid >> 3, k8 = (F.tid & 7) * 8; float v[8];
#pragma unroll
          for (int j = 0; j < 8; ++j) v[j] = tile[(k8 + j) * 65 + n] * scale;
          u32x4 w; w.x = pk2(v[0], v[1]); w.y = pk2(v[2], v[3]); w.z = pk2(v[4], v[5]); w.w = pk2(v[6], v[7]);
          *(u32x4*)(dst + ((size_t)b * C + c0 + n) * R + r0 + k8) = w; }
        LDS_BAR();
    }
}

__device__ __forceinline__ void p0_prologue(const Frame& F) {
    unsigned char* ws = F.ws;
    {
        LAS float* sv = (LAS float*)F.lds;
        LAS float* pr = sv + 2048;
        __syncthreads();
        for (int i = F.tid; i < 2048; i += NT) sv[i] = siluf(i < 1024 ? F.in[I_C][i] : F.in[I_CCTX][i - 1024]);
        __syncthreads();
        const int cl = F.tid & 63, kg = F.tid >> 6;
        for (int u = F.bid; u < 4 * 96; u += F.G) {
            const int l = u / 96, col = (u % 96) * 64 + cl;
            const float* w = F.in[I_ADAW] + ((size_t)l * 1024 + kg * 128) * 6144 + col;
            float a0 = 0.f, a1 = 0.f;
#pragma unroll 16
            for (int k = 0; k < 128; ++k) { const float wv = w[(size_t)k * 6144]; a0 += sv[kg * 128 + k] * wv; a1 += sv[1024 + kg * 128 + k] * wv; }
            pr[(kg * 2 + 0) * 64 + cl] = a0; pr[(kg * 2 + 1) * 64 + cl] = a1;
            __syncthreads();
            if (F.tid < 128) { const int s2 = F.tid >> 6; float a = F.in[I_ADAB][l * 6144 + col];
#pragma unroll
                for (int g = 0; g < 8; ++g) a += pr[(g * 2 + s2) * 64 + cl];
                ((float*)(ws + WS_MODS))[(size_t)(l * 2 + s2) * 6144 + col] = a; }
            __syncthreads();
        }
    }
    tconv(F, F.in[I_MINW], (bf16_t*)(ws + WS_WMIN), 2, 1024, 4096, 1.f, F.bid, F.G);
    tconv(F, F.in[I_MQW], (bf16_t*)(ws + WS_WQ), 8, 512, 256, 1.f, F.bid, F.G);
    tconv(F, F.in[I_MKW], (bf16_t*)(ws + WS_WK), 8, 512, 256, 0.0625f, F.bid, F.G);
    tconv(F, F.in[I_MVW], (bf16_t*)(ws + WS_WV), 8, 512, 512, 1.f, F.bid, F.G);
    tconv(F, F.in[I_MOUTW], (bf16_t*)(ws + WS_WMOUT), 2, 2048, 1024, 1.f, F.bid, F.G);
    tconv(F, F.in[I_HFW3], (bf16_t*)(ws + WS_W3T), 2, 64, 2048, 1.f, F.bid, F.G);
    for (int ci = F.bid * NT + F.tid; ci < 8192; ci += F.G * NT) { const int k = (ci >> 9) + 16 * ((ci >> 4) & 31) + 512 * (ci & 15);
        float sn, cs; sincospif((float)k * (1.0f / 16384.0f), &sn, &cs); ((f32x2*)(ws + WS_TWP))[ci] = (f32x2){cs, -sn}; }
    const int gt = F.bid * NT + F.tid, gs = F.G * NT;
    for (int i = gt; i < 2 * 16 * 4096; i += gs) { const int s = i / 65536, r = i % 65536, n = r / 4096, k = r % 4096;
        ((bf16_t*)(ws + WS_GWT))[i] = f2bf(F.in[I_MGATEW][((size_t)s * 4096 + k) * 16 + n]); }
    for (int i = gt; i < 4 * 1024 * 48; i += gs) { const int l = i / 49152, r = i % 49152, k = r / 48, n = r % 48;
        float v = 0.f; if (n < 4) v = F.in[I_RGW][((size_t)l * 1024 + k) * 4 + n]; else if (n < 36) v = F.in[I_REW][((size_t)l * 1024 + k) * 32 + (n - 4)];
        ((float*)(ws + WS_WC))[i] = v; }
    {
        LAS float* ft = (LAS float*)F.lds;
        LAS float* z1 = ft + 8 * 36;
        const int nrow = 2 * SEQ + CTXN;
        for (int r0 = F.bid * 8; r0 < nrow; r0 += F.G * 8) {
            const int rr = F.tid >> 6, j = F.tid & 63, row = r0 + rr;
            int slot, t, Ln; if (row < 2 * SEQ) { slot = row / SEQ; t = row % SEQ; Ln = SEQ; } else { slot = 0; t = row - 2 * SEQ; Ln = CTXN; }
            __syncthreads();
            if (j < 33) { float f;
                if (j == 0) f = (float)t / (float)(Ln - 1);
                else { const int b = (j - 1) % 16 + 1; const int ph = (t * b) % Ln; const float a = (float)ph / (float)Ln;
                       f = (j <= 16) ? cosf(6.283185307179586f * a) : sinf(6.283185307179586f * a); }
                ft[rr * 36 + j] = f; }
            __syncthreads();
            const float fr = F.in[I_HFFREQ][slot * 64 + j];
            { float a = F.in[I_HFB1][slot * 64 + j]; const float* w1 = F.in[I_HFW1] + (size_t)slot * 33 * 64 + j;
#pragma unroll
              for (int k = 0; k < 33; ++k) a += ft[rr * 36 + k] * w1[k * 64];
              z1[rr * 64 + j] = sinf(fr * a); }
            __syncthreads();
            { float a = F.in[I_HFB2][slot * 64 + j]; const float* w2 = F.in[I_HFW2] + (size_t)slot * 64 * 64 + j;
#pragma unroll 8
              for (int k = 0; k < 64; ++k) a += z1[rr * 64 + k] * w2[k * 64];
              const float z = sinf(fr * a);
              bf16_t* dst = (row < 2 * SEQ) ? (bf16_t*)(ws + WS_Z2) + (size_t)row * 64 : (bf16_t*)(ws + WS_Z2C) + (size_t)t * 64;
              dst[j] = f2bf(z); }
        }
        __syncthreads();
    }
}

__device__ __forceinline__ void deferred_convert(const Frame& F, int part, int vbid, int vG) {
    unsigned char* ws = F.ws;
    if (part == 0) {
        tconv(F, F.in[I_HINW], (bf16_t*)(ws + WS_WHIN), 2, 1024, 3072, 1.f, vbid, vG);
        tconv(F, F.in[I_HOUTW], (bf16_t*)(ws + WS_WHOUT), 2, 1024, 1024, 1.f, vbid, vG);
    }
    tconv(F, F.in[I_W13] + (size_t)part * 64 * 1024 * 1024, (bf16_t*)(ws + WS_W13) + (size_t)part * 64 * 1024 * 1024, 64, 1024, 1024, 1.f, vbid, vG);
    tconv(F, F.in[I_W2] + (size_t)part * 64 * 512 * 1024, (bf16_t*)(ws + WS_W2) + (size_t)part * 64 * 512 * 1024, 64, 512, 1024, 1.f, vbid, vG);
}

__device__ __forceinline__ const float* modp(const Frame& F, int l, int s, int piece) { return (const float*)(F.ws + WS_MODS) + ((size_t)(l * 2 + s) * 6 + piece) * 1024; }
__device__ __forceinline__ int scan_pos(int t, bool colmajor) { return colmajor ? ((t & 63) * 256 + (t >> 6)) : t; }
__device__ __forceinline__ int scan_inv(int p, bool colmajor) { return colmajor ? ((p & 255) * 64 + (p >> 8)) : p; }

__device__ __forceinline__ void n1_phase(const Frame& F, int l, bool comb, bool ctx_rows, bool comb_ctx, bool first, bool colmajor) {
    float* HL = (float*)(F.ws + WS_HL); float* HC = (float*)(F.ws + WS_HC); bf16_t* U = (bf16_t*)(F.ws + WS_U);
    const bf16_t* YB = (const bf16_t*)(F.ws + WS_YBUF);
    const float* g1n = F.in[I_N1G] + l * 1024;
    const int nrows = SEQ + (ctx_rows ? CTXN : 0);
    f32x4 hg2[4], hga[4], hsh[4];
#pragma unroll
    for (int j = 0; j < 4; ++j) { const int c = j * 256 + F.lane * 4; const f32x4 g = *(const f32x4*)(g1n + c), a = *(const f32x4*)(modp(F, l, 0, 1) + c);
        hga[j] = g * (a + 1.0f); hsh[j] = *(const f32x4*)(modp(F, l, 0, 0) + c); hg2[j] = comb ? *(const f32x4*)(modp(F, l - 1, 0, 5) + c) : (f32x4){0.f, 0.f, 0.f, 0.f}; }
    for (int r0 = (F.bid * NWAVES + F.wave) * 2; r0 < nrows; r0 += F.G * NWAVES * 2) {
        f32x4 v[2][4]; float ss[2] = {0.f, 0.f};
        u32x2 y0[2][4], y1[2][4];
#pragma unroll
        for (int q = 0; q < 2; ++q) { const int r = r0 + q; const bool isctx = r >= SEQ; const int t = isctx ? r - SEQ : r;
            const float* src = first ? (isctx ? F.in[I_CTX] : F.in[I_X]) + (size_t)t * 1024 : (isctx ? HC : HL) + (size_t)t * 1024;
            const bool docomb = comb && (!isctx || comb_ctx); const int tok = isctx ? t : CTXN + t;
#pragma unroll
            for (int j = 0; j < 4; ++j) { const int c = j * 256 + F.lane * 4; v[q][j] = *(const f32x4*)(src + c);
                if (docomb) { y0[q][j] = *(const u32x2*)(YB + ((size_t)tok * 2 + 0) * 1024 + c); y1[q][j] = *(const u32x2*)(YB + ((size_t)tok * 2 + 1) * 1024 + c); } } }
#pragma unroll
        for (int q = 0; q < 2; ++q) { const int r = r0 + q; const bool isctx = r >= SEQ; const int t = isctx ? r - SEQ : r; const int s = isctx ? 1 : 0;
            float* dsth = (isctx ? HC : HL) + (size_t)t * 1024;
            const bool docomb = comb && (!isctx || comb_ctx);
            const float* g2 = docomb ? modp(F, l - 1, s, 5) : nullptr;
#pragma unroll
            for (int j = 0; j < 4; ++j) { const int c = j * 256 + F.lane * 4;
                if (docomb) { const f32x4 g = isctx ? *(const f32x4*)(g2 + c) : hg2[j];
                    v[q][j][0] += g[0] * (bflo(y0[q][j].x) + bflo(y1[q][j].x)); v[q][j][1] += g[1] * (bfhi(y0[q][j].x) + bfhi(y1[q][j].x)); v[q][j][2] += g[2] * (bflo(y0[q][j].y) + bflo(y1[q][j].y)); v[q][j][3] += g[3] * (bfhi(y0[q][j].y) + bfhi(y1[q][j].y)); }
                if (docomb || first) *(f32x4*)(dsth + c) = v[q][j];
                ss[q] += v[q][j][0] * v[q][j][0] + v[q][j][1] * v[q][j][1] + v[q][j][2] * v[q][j][2] + v[q][j][3] * v[q][j][3]; }
            ss[q] = wave_sum(ss[q]); }
#pragma unroll
        for (int q = 0; q < 2; ++q) { const int r = r0 + q; const bool isctx = r >= SEQ; const int t = isctx ? r - SEQ : r; const int s = isctx ? 1 : 0;
            const float* sh = modp(F, l, s, 0); const float* sc = modp(F, l, s, 1);
            const float rstd = rsqrtf(ss[q] * (1.0f / 1024.0f) + EPS);
            const int urow = isctx ? t : CTXN + scan_pos(t, colmajor);
#pragma unroll
            for (int j = 0; j < 4; ++j) { const int c = j * 256 + F.lane * 4;
                f32x4 ga, b;
                if (isctx) { const f32x4 g = *(const f32x4*)(g1n + c), a = *(const f32x4*)(sc + c); ga = g * (a + 1.0f); b = *(const f32x4*)(sh + c); } else { ga = hga[j]; b = hsh[j]; }
                float o[4];
#pragma unroll
                for (int e = 0; e < 4; ++e) o[e] = v[q][j][e] * rstd * ga[e] + b[e];
                u32x2 w; w.x = pk2(o[0], o[1]); w.y = pk2(o[2], o[3]); *(u32x2*)(U + (size_t)urow * 1024 + c) = w; } }
    }
}

__device__ __forceinline__ void final_phase(const Frame& F, bool comb, int lprev, bool first) {
    const float* HL = (const float*)(F.ws + WS_HL); const bf16_t* YB = (const bf16_t*)(F.ws + WS_YBUF); const float* fg = F.in[I_FINALG];
    const float* g2 = comb ? modp(F, lprev, 0, 5) : nullptr;
    for (int t0 = (F.bid * NWAVES + F.wave) * 2; t0 < SEQ; t0 += F.G * NWAVES * 2) {
        f32x4 v[2][4]; u32x2 y0[2][4], y1[2][4]; float ss[2] = {0.f, 0.f};
#pragma unroll
        for (int q = 0; q < 2; ++q) { const int t = t0 + q; const float* src = (first ? F.in[I_X] : HL) + (size_t)t * 1024; const int tok = CTXN + t;
#pragma unroll
            for (int j = 0; j < 4; ++j) { const int c = j * 256 + F.lane * 4; v[q][j] = *(const f32x4*)(src + c);
                if (comb) { y0[q][j] = *(const u32x2*)(YB + ((size_t)tok * 2 + 0) * 1024 + c); y1[q][j] = *(const u32x2*)(YB + ((size_t)tok * 2 + 1) * 1024 + c); } } }
#pragma unroll
        for (int q = 0; q < 2; ++q) {
#pragma unroll
            for (int j = 0; j < 4; ++j) { const int c = j * 256 + F.lane * 4;
                if (comb) { const f32x4 g = *(const f32x4*)(g2 + c);
                    v[q][j][0] += g[0] * (bflo(y0[q][j].x) + bflo(y1[q][j].x)); v[q][j][1] += g[1] * (bfhi(y0[q][j].x) + bfhi(y1[q][j].x)); v[q][j][2] += g[2] * (bflo(y0[q][j].y) + bflo(y1[q][j].y)); v[q][j][3] += g[3] * (bfhi(y0[q][j].y) + bfhi(y1[q][j].y)); }
                ss[q] += v[q][j][0] * v[q][j][0] + v[q][j][1] * v[q][j][1] + v[q][j][2] * v[q][j][2] + v[q][j][3] * v[q][j][3]; }
            ss[q] = wave_sum(ss[q]); }
#pragma unroll
        for (int q = 0; q < 2; ++q) { const int t = t0 + q; const float rstd = rsqrtf(ss[q] * (1.0f / 1024.0f) + EPS);
#pragma unroll
            for (int j = 0; j < 4; ++j) { const int c = j * 256 + F.lane * 4; const f32x4 g = *(const f32x4*)(fg + c);
                f32x4 o;
#pragma unroll
                for (int e = 0; e < 4; ++e) o[e] = v[q][j][e] * rstd * g[e];
                *(f32x4*)(F.out + (size_t)t * 1024 + c) = o; } }
    }
}

__device__ __forceinline__ void hyena_filter_fft(const Frame& F, int vbid, int vG);
__device__ __forceinline__ float* scal_arr(const Frame& F, int k, int ch) { return (float*)(F.ws + WS_SCAL) + ((size_t)k * 8 + ch) * LT; }
__device__ __forceinline__ float* chs_arr(const Frame& F, int k, int ch) { return (float*)(F.ws + WS_CHS) + ((size_t)k * 8 + ch) * NCH; }
__device__ __forceinline__ bf16x8 bload16(__amdgpu_buffer_rsrc_t r, unsigned voff, unsigned soff) { const u32x4 x = __builtin_amdgcn_raw_buffer_load_b128(r, voff, soff, 0); return __builtin_bit_cast(bf16x8, x); }
__device__ __forceinline__ float logsigf(float x) { return fminf(x, 0.f) - log1pf(__expf(-fabsf(x))); }

__device__ __forceinline__ void mlstm_inproj(const Frame& F, int slot) {
    MultiSched<2> S; Prob pr[2];
    const char* W = (const char*)(F.ws + WS_WMIN) + (size_t)slot * 4096 * 1024 * 2;
    pr[0] = Prob{(const char*)(F.ws + WS_U), W, (char*)(F.ws + WS_XCM) + (size_t)4 * LT * 512 * 2, 0, 512 * 1024 * 2, (long long)LT * 512 * 2, NCH / 4, 2, 4, 0, 1024, 1024, 512, 2};
    pr[1] = Prob{(const char*)(F.ws + WS_U), W + (size_t)2048 * 1024 * 2, (char*)(F.ws + WS_OPRE), 0, 0, 0, NCH / 4, 8, 1, 65 * 8, 1024, 1024, 2048, 2};
    S.init(F, pr, 65 * 16);
    EpiStore E{nullptr, nullptr, nullptr, 0};
    pg8::gemm_phase<EpiStore, MultiSched<2>, false>(F.lds, 1024, S, E, F.tid);
}

__device__ __forceinline__ void mlstm_conv_gates(const Frame& F, int slot) {
    constexpr int TP = 4096 + 8;
    LAS bf16_t* tile = (LAS bf16_t*)F.lds;
    LAS float* part = (LAS float*)(F.lds + 16 * TP * 2);
    LAS float* gl = part + 8 * 256;
    bf16_t* XCp = (bf16_t*)(F.ws + WS_XCM) + (size_t)(F.tid >> 7) * LT * 512 + (F.tid & 127) * 4;
    const bf16_t* XMp = XCp + (size_t)4 * LT * 512;
    const bf16_t* GWT = (const bf16_t*)(F.ws + WS_GWT) + (size_t)slot * 16 * 4096;
    const int c4 = F.tid * 4;
    float cw[3][4], cb[4];
#pragma unroll
    for (int k = 0; k < 3; ++k) { const f32x4 w = *(const f32x4*)(F.in[I_MCONVW] + ((size_t)slot * 3 + k) * 2048 + c4); cw[k][0] = w[0]; cw[k][1] = w[1]; cw[k][2] = w[2]; cw[k][3] = w[3]; }
    { const f32x4 b = *(const f32x4*)(F.in[I_MCONVB] + (size_t)slot * 2048 + c4); cb[0] = b[0]; cb[1] = b[1]; cb[2] = b[2]; cb[3] = b[3]; }
    const int fr = F.lane & 15, fq = F.lane >> 4;
    bf16x8 gw[16];
#pragma unroll
    for (int kk = 0; kk < 16; ++kk) gw[kk] = *(const bf16x8*)(GWT + (size_t)fr * 4096 + F.wave * 512 + kk * 32 + fq * 8);
    for (int gc = F.bid; gc < NCH; gc += F.G) {
        const int seq_lo = gc < 4 ? 0 : CTXN, seq_hi = gc < 4 ? CTXN : LT;
        for (int sub = 0; sub < 4; ++sub) {
            const int r0 = gc * 64 + sub * 16;
            u32x2 xr[18];
#pragma unroll
            for (int i = 0; i < 18; ++i) { const int rr = r0 - 1 + i; xr[i] = (rr >= seq_lo && rr < seq_hi) ? *(const u32x2*)(XMp + (size_t)rr * 512) : (u32x2){0u, 0u}; }
#pragma unroll
            for (int rl = 0; rl < 16; ++rl) {
                const int row = r0 + rl; const u32x2 prv = xr[rl], cur = xr[rl + 1], nxt = xr[rl + 2];
                const float p[4] = {bflo(prv.x), bfhi(prv.x), bflo(prv.y), bfhi(prv.y)}, c[4] = {bflo(cur.x), bfhi(cur.x), bflo(cur.y), bfhi(cur.y)}, n[4] = {bflo(nxt.x), bfhi(nxt.x), bflo(nxt.y), bfhi(nxt.y)};
                float o[4];
#pragma unroll
                for (int e = 0; e < 4; ++e) o[e] = siluf(cb[e] + cw[0][e] * p[e] + cw[1][e] * c[e] + cw[2][e] * n[e]);
                u32x2 w; w.x = pk2(o[0], o[1]); w.y = pk2(o[2], o[3]);
                *(u32x2*)(XCp + (size_t)row * 512) = w;
                *(LAS u32x2*)(tile + rl * TP + c4) = w;
                *(LAS u32x2*)(tile + rl * TP + 2048 + c4) = cur;
            }
            LDS_BAR();
            {
                f32x4 acc = {0.f, 0.f, 0.f, 0.f};
#pragma unroll
                for (int kk = 0; kk < 16; ++kk) { const int k0 = F.wave * 512 + kk * 32 + fq * 8;
                    const bf16x8 a = *(const LAS bf16x8*)(tile + fr * TP + k0);
                    acc = __builtin_amdgcn_mfma_f32_16x16x32_bf16(a, gw[kk], acc, 0, 0, 0); }
#pragma unroll
                for (int r = 0; r < 4; ++r) part[F.wave * 256 + (fq * 4 + r) * 16 + fr] = acc[r];
            }
            LDS_BAR();
            if (F.tid < 256) { float a = F.in[I_MGATEB][slot * 16 + (F.tid & 15)];
#pragma unroll
                for (int w = 0; w < 8; ++w) a += part[w * 256 + F.tid];
                gl[(sub * 16 + (F.tid >> 4)) * 16 + (F.tid & 15)] = a; }
        }
        LDS_BAR();
        {
            const int ch = F.wave, dir = ch >> 2, h = ch & 3, j = F.lane, rl = dir ? 63 - j : j, row = gc * 64 + rl;
            const float ig = gl[rl * 16 + (2 * dir) * 4 + h], lf = logsigf(gl[rl * 16 + (2 * dir + 1) * 4 + h]);
            float b = lf;
#pragma unroll
            for (int o = 1; o < 64; o <<= 1) { const float t = __shfl_up(b, o); if (j >= o) b += t; }
            const float cq = ig - b; float pm = cq;
#pragma unroll
            for (int o = 1; o < 64; o <<= 1) { const float t = __shfl_up(pm, o); if (j >= o) pm = fmaxf(pm, t); }
            const float bl = __shfl(b, 63), gq = bl - b + ig, gm = wave_max(gq);
            scal_arr(F, 0, ch)[row] = b; scal_arr(F, 1, ch)[row] = b + pm; scal_arr(F, 2, ch)[row] = gq; scal_arr(F, 3, ch)[row] = cq;
            if (j == 0) { chs_arr(F, 0, ch)[gc] = bl; chs_arr(F, 1, ch)[gc] = gm; }
            const float wp = __expf(gq - gm);
            ((float*)(F.ws + WS_WGP))[(size_t)ch * LT + row] = wp;
            bf16_t* vx = (bf16_t*)(F.ws + WS_VTS) + (((((size_t)ch * NCH + gc) * 33 + 32) * 2 + (rl >> 5)) * 64 + 16 * ((rl & 31) >> 3)) * 8 + (rl & 7);
            vx[0] = f2bf(wp);
#pragma unroll
            for (int z = 1; z < 16; ++z) vx[z * 8] = 0;
        }
        LDS_BAR();
    }
}

__device__ __forceinline__ void mlstm_qkv(const Frame& F, int slot) {
    MultiSched<4> S; Prob pr[4];
    const char* WQ = (const char*)(F.ws + WS_WQ) + (size_t)slot * 4 * 256 * 512 * 2;
    const char* WK = (const char*)(F.ws + WS_WK) + (size_t)slot * 4 * 256 * 512 * 2;
    const char* WV = (const char*)(F.ws + WS_WV) + (size_t)slot * 4 * 512 * 512 * 2;
    const char* XC = (const char*)(F.ws + WS_XCM); const char* XM = XC + (size_t)4 * LT * 512 * 2; const long long HS = (long long)LT * 512 * 2;
    pr[0] = Prob{XC, WQ, (char*)(F.ws + WS_Q),  HS, 256 * 512 * 2, (long long)LT * 256 * 2, 65, 1, 4, 0,    512, 512,  0, 0};
    pr[1] = Prob{XC, WK, (char*)(F.ws + WS_KN), HS, 256 * 512 * 2, (long long)LT * 256 * 2, 65, 1, 4, 260,  512, 512,  0, 0};
    pr[2] = Prob{WK, XC, (char*)(F.ws + WS_KT), 256 * 512 * 2, HS, (long long)256 * LT * 2, 1, 65, 4, 520,  512,  512, 0,  0};
    pr[3] = Prob{WV, XM, (char*)(F.ws + WS_VT), 512 * 512 * 2, HS, (long long)512 * LT * 2, 2, 65, 4, 780, 512, 512, 0, 0};
    S.init(F, pr, 780 + 520);
    EpiStore E{nullptr, (const float*)(F.ws + WS_WGP), (bf16_t*)(F.ws + WS_VTS), 1};
    pg8::gemm_phase<EpiStore, MultiSched<4>, false>(F.lds, 512, S, E, F.tid);
}

constexpr int SCAN_NV = 4;
struct ScanBufR { bf16x8 q[8]; bf16x8 v[2]; float bq[4], aq[4]; float bl, gm; };
struct ScanBufU { bf16x8 k[8]; float bl, gm; };
__device__ __forceinline__ int scan_chunk(int dir, int st) { return dir == 0 ? st : (st < 4 ? 3 - st : 263 - st); }
#define SCAN_BAR() do { asm volatile("s_waitcnt lgkmcnt(0)" ::: "memory"); __builtin_amdgcn_s_barrier(); asm volatile("" ::: "memory"); } while (0)

template <bool DEN> __device__ __forceinline__ void scan_job(const Frame& F, const int ch, const int sl) {
    constexpr int CP = 256 + 16, NV = SCAN_NV;
    LAS bf16_t* Cs = (LAS bf16_t*)F.lds;
    LAS bf16x8* VS = (LAS bf16x8*)(F.lds + 2 * NV * 16 * CP * 2);
    const bf16_t* Q = (const bf16_t*)(F.ws + WS_Q); const bf16_t* KT = (const bf16_t*)(F.ws + WS_KT); const bf16_t* VTS = (const bf16_t*)(F.ws + WS_VTS);
    const int w = F.wave;
    {
        const int dir = ch >> 2, h = ch & 3; constexpr bool denjob = DEN; constexpr int ntile = DEN ? 1 : NV;
        const float* BL = chs_arr(F, 0, ch); const float* GM = chs_arr(F, 1, ch);
        __syncthreads();
        for (int i = F.tid; i < 2 * NV * 16 * CP / 2; i += NT) ((LAS unsigned*)Cs)[i] = 0u;
        float m = 0.f;
        if (w < 4) {
            const float* BQ = scal_arr(F, 0, ch); const float* AQ = scal_arr(F, 1, ch); float* MS = chs_arr(F, 2, ch);
            const int fr = F.lane & 15, fq = F.lane >> 4;
            const __amdgpu_buffer_rsrc_t rsQ = __builtin_amdgcn_make_buffer_rsrc((void*)(Q + (size_t)h * LT * 256), 0, LT * 256 * 2, 0x00020000);
            const __amdgpu_buffer_rsrc_t rsV = __builtin_amdgcn_make_buffer_rsrc((void*)(VTS + (size_t)ch * NCH * 33 * 1024), 0, NCH * 33 * 1024 * 2, 0x00020000);
            const unsigned loQ = (unsigned)F.lane * 16u + (unsigned)w * 8192u, loV = (unsigned)F.lane * 16u + (unsigned)(denjob ? 32 : sl * NV + w) * 2048u, loS = (unsigned)(16 * w + fq * 4) * 4u;
            char* ubO = (char*)(F.ws + WS_OINT) + ((((size_t)ch * NCH) * 32 + sl * NV) * 4 + w) * 512;
            {
                const unsigned g0 = (unsigned)scan_chunk(dir, 0);
#pragma unroll
                for (int kk = 0; kk < 2; ++kk) VS[((0 * NV + w) * 2 + kk) * 64 + F.lane] = bload16(rsV, loV, g0 * (33u * 2048u) + kk * 1024u);
            }
            __syncthreads();
            ScanBufR sb[3];
#define SCAN_LOAD_R(B, st_) do { const unsigned gc_ = (unsigned)scan_chunk(dir, st_), gn_ = (unsigned)scan_chunk(dir, ((st_) + 1 < NCH) ? (st_) + 1 : (st_)); sb[B].bl = BL[gc_]; sb[B].gm = GM[gc_]; \
            _Pragma("unroll") for (int i = 0; i < 8; ++i) sb[B].q[i] = bload16(rsQ, loQ, gc_ * 32768u + i * 1024u); \
            _Pragma("unroll") for (int kk = 0; kk < 2; ++kk) sb[B].v[kk] = bload16(rsV, loV, gn_ * (33u * 2048u) + kk * 1024u); \
            { const f32x4 a0_ = *(const f32x4*)((const char*)BQ + (size_t)gc_ * 256 + loS), a1_ = *(const f32x4*)((const char*)AQ + (size_t)gc_ * 256 + loS); \
              _Pragma("unroll") for (int e = 0; e < 4; ++e) { sb[B].bq[e] = a0_[e]; sb[B].aq[e] = a1_[e]; } } } while (0)
#define SCAN_LPART_R(LB, lst_, part) do { { const int lc_ = ((lst_) < NCH) ? (lst_) : NCH - 1;     \
            const unsigned gc2_ = (unsigned)scan_chunk(dir, lc_), gn2_ = (unsigned)scan_chunk(dir, (lc_ + 1 < NCH) ? lc_ + 1 : lc_); \
            __builtin_amdgcn_sched_barrier(0x38F); \
            sb[LB].q[2 * (part)] = bload16(rsQ, loQ, gc2_ * 32768u + (2 * (part)) * 1024u); sb[LB].q[2 * (part) + 1] = bload16(rsQ, loQ, gc2_ * 32768u + (2 * (part) + 1) * 1024u); \
            if ((part) == 0) { sb[LB].bl = BL[gc2_]; sb[LB].gm = GM[gc2_]; } \
            if ((part) == 1) { const f32x4 a0_ = *(const f32x4*)((const char*)BQ + (size_t)gc2_ * 256 + loS), a1_ = *(const f32x4*)((const char*)AQ + (size_t)gc2_ * 256 + loS); \
                _Pragma("unroll") for (int e = 0; e < 4; ++e) { sb[LB].bq[e] = a0_[e]; sb[LB].aq[e] = a1_[e]; } } \
            if ((part) >= 2) sb[LB].v[(part) - 2] = bload16(rsV, loV, gn2_ * (33u * 2048u) + ((part) - 2) * 1024u); \
            __builtin_amdgcn_sched_barrier(0); } } while (0)
#define SCAN_STEP_R(B, st_, CB, LB, lst_) do { const int gc_ = scan_chunk(dir, st_), row0_ = gc_ * 64; constexpr int cb_ = CB; \
            int ln_ = F.lane; asm volatile("" : "+v"(ln_)); const int fr_ = ln_ & 15, fq_ = ln_ >> 4;     \
            const float mn_ = fmaxf(sb[B].bl + m, sb[B].gm); \
            if (sl == 0 && w == 0 && ln_ == 0) MS[gc_] = m; \
            _Pragma("unroll") for (int kk = 0; kk < 2; ++kk) VS[(((cb_ ^ 1) * NV + w) * 2 + kk) * 64 + ln_] = sb[B].v[kk]; \
            float wj_[4]; _Pragma("unroll") for (int r = 0; r < 4; ++r) { const float in_ = sb[B].bq[r] + m, mj_ = fmaxf(in_, sb[B].aq[r]); wj_[r] = __expf(in_ - mj_); } \
            _Pragma("unroll") for (int t = 0; t < NV; ++t) { if (t < ntile) { f32x4 o_ = {0.f, 0.f, 0.f, 0.f}; \
                _Pragma("unroll") for (int kk = 0; kk < 8; ++kk) { const bf16x8 b_ = *(const LAS bf16x8*)(Cs + ((cb_ * NV + t) * 16 + fr_) * CP + kk * 32 + fq_ * 8); o_ = __builtin_amdgcn_mfma_f32_16x16x32_bf16(sb[B].q[kk], b_, o_, 0, 0, 0); } \
                if (!denjob) { u32x2 pw_; pw_.x = pk2(o_[0] * wj_[0], o_[1] * wj_[1]); pw_.y = pk2(o_[2] * wj_[2], o_[3] * wj_[3]); \
                    *(u32x2*)(ubO + ((size_t)gc_ * 32 + t) * 2048 + (unsigned)ln_ * 8u) = pw_; } \
                else if (fr_ == 0) { float* dn_ = (float*)(F.ws + WS_DENI) + (size_t)ch * LT + row0_ + 16 * w + fq_ * 4; \
                    _Pragma("unroll") for (int r = 0; r < 4; ++r) dn_[r] = o_[r] * wj_[r]; } } \
                SCAN_LPART_R(LB, lst_, t); }     \
            m = mn_; SCAN_BAR(); } while (0)
            SCAN_LOAD_R(0, 0); SCAN_LOAD_R(1, 1);
            static_assert((NCH - 2) % 6 == 0, "two peeled steps + whole groups of six (3 register buffers x 2 LDS state buffers): no guards inside the loop");
            SCAN_STEP_R(0, 0, 0, 2, 2);
            SCAN_STEP_R(1, 1, 1, 0, 3);
            for (int st = 2; st < NCH; st += 6) {
                SCAN_STEP_R(2, st, 0, 1, st + 2);
                SCAN_STEP_R(0, st + 1, 1, 2, st + 3);
                SCAN_STEP_R(1, st + 2, 0, 0, st + 4);
                SCAN_STEP_R(2, st + 3, 1, 1, st + 5);
                SCAN_STEP_R(0, st + 4, 0, 2, st + 6);
                SCAN_STEP_R(1, st + 5, 1, 0, st + 7);
            }
#undef SCAN_LPART_R
#undef SCAN_LOAD_R
#undef SCAN_STEP_R
        } else {
            const int u = w - 4; const int fr = F.lane & 15, fq = F.lane >> 4;
            const __amdgpu_buffer_rsrc_t rsK = __builtin_amdgcn_make_buffer_rsrc((void*)(KT + (size_t)h * 256 * LT), 0, 256 * LT * 2, 0x00020000);
            const unsigned loK = (unsigned)F.lane * 16u + (unsigned)u * 8192u;
            f32x4 acc[NV][4];
#pragma unroll
            for (int t = 0; t < NV; ++t)
#pragma unroll
                for (int d = 0; d < 4; ++d) acc[t][d] = (f32x4){0.f, 0.f, 0.f, 0.f};
            __syncthreads();
            ScanBufU sb[3];
#define SCAN_LOAD_U(B, st_) do { const unsigned gc_ = (unsigned)scan_chunk(dir, st_); sb[B].bl = BL[gc_]; sb[B].gm = GM[gc_]; \
            _Pragma("unroll") for (int i = 0; i < 8; ++i) sb[B].k[i] = bload16(rsK, loK, gc_ * 32768u + (unsigned)i * 1024u); } while (0)
#define SCAN_LPART_U(LB, lst_, part) do { { const unsigned gc2_ = (unsigned)scan_chunk(dir, ((lst_) < NCH) ? (lst_) : NCH - 1); \
            __builtin_amdgcn_sched_barrier(0x38F); \
            sb[LB].k[2 * (part)] = bload16(rsK, loK, gc2_ * 32768u + (unsigned)(2 * (part)) * 1024u); sb[LB].k[2 * (part) + 1] = bload16(rsK, loK, gc2_ * 32768u + (unsigned)(2 * (part) + 1) * 1024u); \
            if ((part) == 0) { sb[LB].bl = BL[gc2_]; sb[LB].gm = GM[gc2_]; } \
            __builtin_amdgcn_sched_barrier(0); } } while (0)
#define SCAN_STEP_U(B, st_, CB, LB, lst_) do { constexpr int cb_ = CB; \
            int ln_ = F.lane; asm volatile("" : "+v"(ln_)); const int fr_ = ln_ & 15, fq_ = ln_ >> 4; \
            const float bl_ = sb[B].bl, gm_ = sb[B].gm; const float mn_ = fmaxf(bl_ + m, gm_), dec_ = __expf(bl_ + m - mn_), sf_ = __expf(gm_ - mn_); \
            _Pragma("unroll") for (int t = 0; t < NV; ++t) { if (t < ntile) { \
                const bf16x8 v0_ = VS[((cb_ * NV + t) * 2 + 0) * 64 + ln_], v1_ = VS[((cb_ * NV + t) * 2 + 1) * 64 + ln_]; \
                _Pragma("unroll") for (int d = 0; d < 4; ++d) { f32x4 n_ = {0.f, 0.f, 0.f, 0.f}; \
                    n_ = __builtin_amdgcn_mfma_f32_16x16x32_bf16(sb[B].k[2 * d], v0_, n_, 0, 0, 0); n_ = __builtin_amdgcn_mfma_f32_16x16x32_bf16(sb[B].k[2 * d + 1], v1_, n_, 0, 0, 0); \
                    const f32x4 a_ = acc[t][d] * dec_ + n_ * sf_; acc[t][d] = a_; \
                    u32x2 pw_; pw_.x = pk2(a_[0], a_[1]); pw_.y = pk2(a_[2], a_[3]); \
                    *(LAS u32x2*)(Cs + (((cb_ ^ 1) * NV + t) * 16 + fr_) * CP + 16 * (4 * u + d) + fq_ * 4) = pw_; } } \
                SCAN_LPART_U(LB, lst_, t); } \
            m = mn_; SCAN_BAR(); } while (0)
            SCAN_LOAD_U(0, 0); SCAN_LOAD_U(1, 1);
            SCAN_STEP_U(0, 0, 0, 2, 2);
            SCAN_STEP_U(1, 1, 1, 0, 3);
            for (int st = 2; st < NCH; st += 6) {
                SCAN_STEP_U(2, st, 0, 1, st + 2);
                SCAN_STEP_U(0, st + 1, 1, 2, st + 3);
                SCAN_STEP_U(1, st + 2, 0, 0, st + 4);
                SCAN_STEP_U(2, st + 3, 1, 1, st + 5);
                SCAN_STEP_U(0, st + 4, 0, 2, st + 6);
                SCAN_STEP_U(1, st + 5, 1, 0, st + 7);
            }
#undef SCAN_LPART_U
#undef SCAN_LOAD_U
#undef SCAN_STEP_U
        }
    }
}

__device__ __forceinline__ void mlstm_scan(const Frame& F, int cvt_part) {
    constexpr int CP = 256 + 16, NV = SCAN_NV, NSL = 32 / NV;
    static_assert(NV == 4, "one reader wave per v-tile");
    LAS bf16_t* Cs = (LAS bf16_t*)F.lds;
    LAS bf16x8* VS = (LAS bf16x8*)(F.lds + 2 * NV * 16 * CP * 2);
    const bf16_t* Q = (const bf16_t*)(F.ws + WS_Q); const bf16_t* KT = (const bf16_t*)(F.ws + WS_KT); const bf16_t* VTS = (const bf16_t*)(F.ws + WS_VTS);
    const int w = F.wave;
    const int job = F.bid;
    if (job >= 8 * (NSL + 1)) { deferred_convert(F, cvt_part, job - 8 * (NSL + 1), F.G - 8 * (NSL + 1)); hyena_filter_fft(F, job - 8 * (NSL + 1), F.G - 8 * (NSL + 1)); return; }
    { const int ch = job & 7, sl = job >> 3;
      if (sl == NSL) scan_job<true>(F, ch, sl); else scan_job<false>(F, ch, sl); }
}

__device__ __forceinline__ void mlstm_intra(const Frame& F, int slot, int gc_lo) {
    constexpr int SP = 64 + 8;
    LAS float* sc = (LAS float*)F.lds;
    LAS bf16_t* Sb = (LAS bf16_t*)(F.lds + 2 * 6 * 64 * 4);
    LAS float* stt = (LAS float*)(F.lds + 2 * 6 * 64 * 4 + 2 * 64 * SP * 2);
    LAS float* mr = stt + 64 * 8 * 2;
    constexpr int HP = 512 + 8;
    LAS bf16_t* Hs = (LAS bf16_t*)(mr + 128);
    const bf16_t* Q = (const bf16_t*)(F.ws + WS_Q); const bf16_t* KN = (const bf16_t*)(F.ws + WS_KN); const bf16_t* VT = (const bf16_t*)(F.ws + WS_VT);
    const bf16_t* XCM = (const bf16_t*)(F.ws + WS_XCM); const bf16_t* OPRE = (const bf16_t*)(F.ws + WS_OPRE); bf16_t* Y = (bf16_t*)(F.ws + WS_Y);
    const float* NG = F.in[I_MNORMG] + (size_t)slot * 2048; const float* SK = F.in[I_MSKIP] + (size_t)slot * 2048;
    const int w = F.wave;
    const int nunit = (NCH - gc_lo) * 4;
    for (int un = F.bid; un < nunit; un += F.G) {
        int ln_ = F.lane; asm volatile("" : "+v"(ln_)); const int fr = ln_ & 15, fq = ln_ >> 4;
        const int tid_ = w * 64 + ln_;
        const int gc = gc_lo + un / 4, h = un & 3, row0 = gc * 64;
        LDS_BAR();
        if (tid_ < 128) { const int dir = tid_ >> 6, i = tid_ & 63, ch = dir * 4 + h, row = row0 + i;
            const float bq = scal_arr(F, 0, ch)[row], aq = scal_arr(F, 1, ch)[row], cq = scal_arr(F, 3, ch)[row], m0 = chs_arr(F, 2, ch)[gc];
            const float mj = fmaxf(bq + m0, aq);
            LAS float* s = sc + dir * 6 * 64;
            s[i] = bq; s[64 + i] = cq; s[128 + i] = mj; s[192 + i] = __expf(-mj); s[256 + i] = ((const float*)(F.ws + WS_DENI))[(size_t)ch * LT + row]; }
        const int it = w >> 1, st0 = (w & 1) * 2;
        f32x4 sa[2] = {{0.f, 0.f, 0.f, 0.f}, {0.f, 0.f, 0.f, 0.f}};
        {
            const __amdgpu_buffer_rsrc_t rsQi = __builtin_amdgcn_make_buffer_rsrc((void*)(Q + ((size_t)h * 1040 + gc * 4) * 4096), 0, 4 * 4096 * 2, 0x00020000);
            const __amdgpu_buffer_rsrc_t rsKi = __builtin_amdgcn_make_buffer_rsrc((void*)(KN + ((size_t)h * 1040 + gc * 4) * 4096), 0, 4 * 4096 * 2, 0x00020000);
            const unsigned lo = (unsigned)ln_ * 16u;
#pragma unroll
            for (int kk = 0; kk < 8; ++kk) { const bf16x8 a = bload16(rsQi, lo, (unsigned)((it * 8 + kk) * 1024)), b0 = bload16(rsKi, lo, (unsigned)((st0 * 8 + kk) * 1024)), b1 = bload16(rsKi, lo, (unsigned)(((st0 + 1) * 8 + kk) * 1024));
                sa[0] = __builtin_amdgcn_mfma_f32_16x16x32_bf16(a, b0, sa[0], 0, 0, 0); sa[1] = __builtin_amdgcn_mfma_f32_16x16x32_bf16(a, b1, sa[1], 0, 0, 0); }
        }
        LDS_BAR();
#pragma unroll
        for (int t = 0; t < 2; ++t) { const int s = 16 * (st0 + t) + fr;
#pragma unroll
            for (int r = 0; r < 4; ++r) { const int i = 16 * it + fq * 4 + r;
                const float wf = (s <= i) ? __expf(sc[i] + sc[64 + s] - sc[128 + i]) : 0.f;
                const float wb = (s >= i) ? __expf(sc[384 + i] + sc[384 + 64 + s] - sc[384 + 128 + i]) : 0.f;
                Sb[(0 * 64 + i) * SP + s] = f2bf(sa[t][r] * wf); Sb[(1 * 64 + i) * SP + s] = f2bf(sa[t][r] * wb); } }
        LDS_BAR();
        if (tid_ < 128) { const int dir = tid_ >> 6, i = tid_ & 63; float a = 0.f;
            for (int s = 0; s < 64; ++s) a += bf2f(Sb[(dir * 64 + i) * SP + s]);
            sc[dir * 384 + 320 + i] = a; }
        const __amdgpu_buffer_rsrc_t rsO0 = __builtin_amdgcn_make_buffer_rsrc((void*)(F.ws + WS_OINT + ((size_t)h * NCH + gc) * 65536), 0, 65536, 0x00020000);
        const __amdgpu_buffer_rsrc_t rsO1 = __builtin_amdgcn_make_buffer_rsrc((void*)(F.ws + WS_OINT + ((size_t)(4 + h) * NCH + gc) * 65536), 0, 65536, 0x00020000);
        const __amdgpu_buffer_rsrc_t rsVT = __builtin_amdgcn_make_buffer_rsrc((void*)(VT + ((size_t)h * NCH + gc) * 512 * 64), 0, 512 * 64 * 2, 0x00020000);
        f32x4 oa[2][4][4];
#pragma unroll
        for (int d = 0; d < 2; ++d)
#pragma unroll
            for (int a = 0; a < 4; ++a)
#pragma unroll
                for (int b = 0; b < 4; ++b) oa[d][a][b] = (f32x4){0.f, 0.f, 0.f, 0.f};
        {
#pragma unroll
            for (int kk = 0; kk < 2; ++kk) {
                bf16x8 vb[4];
#pragma unroll
                for (int vt = 0; vt < 4; ++vt) vb[vt] = bload16(rsVT, (unsigned)ln_ * 16u, (unsigned)(((4 * w + vt) * 2 + kk) * 1024));
#pragma unroll
                for (int d = 0; d < 2; ++d)
#pragma unroll
                    for (int a = 0; a < 4; ++a) { const bf16x8 sf = *(const LAS bf16x8*)(Sb + (d * 64 + 16 * a + fr) * SP + kk * 32 + fq * 8);
#pragma unroll
                        for (int vt = 0; vt < 4; ++vt) oa[d][a][vt] = __builtin_amdgcn_mfma_f32_16x16x32_bf16(sf, vb[vt], oa[d][a][vt], 0, 0, 0); }
            }
        }
        LDS_BAR();
        u32x2 oi[2][2][4];
#define OI_LOAD(buf, a_) do { _Pragma("unroll") for (int vt = 0; vt < 4; ++vt) { \
            oi[buf][0][vt] = __builtin_bit_cast(u32x2, __builtin_amdgcn_raw_buffer_load_b64(rsO0, (unsigned)ln_ * 8u, (unsigned)(((4 * w + vt) * 4 + (a_)) * 512), 0)); \
            oi[buf][1][vt] = __builtin_bit_cast(u32x2, __builtin_amdgcn_raw_buffer_load_b64(rsO1, (unsigned)ln_ * 8u, (unsigned)(((4 * w + vt) * 4 + (a_)) * 512), 0)); } } while (0)
        OI_LOAD(0, 0);
#pragma unroll
        for (int a = 0; a < 4; ++a) {
            if (a < 3) OI_LOAD((a + 1) & 1, a + 1);
            float den[2][4], emj[2][4];
#pragma unroll
            for (int d = 0; d < 2; ++d)
#pragma unroll
                for (int r = 0; r < 4; ++r) { const int i = 16 * a + fq * 4 + r; emj[d][r] = sc[d * 384 + 192 + i]; den[d][r] = __builtin_amdgcn_rcpf(fmaxf(fabsf(sc[d * 384 + 320 + i] + sc[d * 384 + 256 + i]), emj[d][r])); }
            float s1[4] = {0.f, 0.f, 0.f, 0.f}, s2[4] = {0.f, 0.f, 0.f, 0.f};
#pragma unroll
            for (int vt = 0; vt < 4; ++vt) {
                const u32x2 o0 = oi[a & 1][0][vt], o1 = oi[a & 1][1][vt];
                const float i0[4] = {bflo(o0.x), bfhi(o0.x), bflo(o0.y), bfhi(o0.y)}, i1[4] = {bflo(o1.x), bfhi(o1.x), bflo(o1.y), bfhi(o1.y)};
#pragma unroll
                for (int r = 0; r < 4; ++r) { const float hf = (oa[0][a][vt][r] + i0[r]) * den[0][r], hb = (oa[1][a][vt][r] + i1[r]) * den[1][r];
                    const float hs = hf + hb; s1[r] += hs; s2[r] += hs * hs; Hs[(16 * a + fq * 4 + r) * HP + 64 * w + 16 * vt + fr] = f2bf(hs); }
            }
#pragma unroll
            for (int r = 0; r < 4; ++r) {
#pragma unroll
                for (int o = 1; o < 16; o <<= 1) { s1[r] += __shfl_xor(s1[r], o); s2[r] += __shfl_xor(s2[r], o); }
                if (fr == 0) { const int i = 16 * a + fq * 4 + r; stt[(i * 8 + w) * 2] = s1[r]; stt[(i * 8 + w) * 2 + 1] = s2[r]; } }
            __builtin_amdgcn_sched_barrier(0);
        }
#undef OI_LOAD
        LDS_BAR();
        if (tid_ < 64) { float a = 0.f, b = 0.f;
#pragma unroll
            for (int ww = 0; ww < 8; ++ww) { a += stt[(tid_ * 8 + ww) * 2]; b += stt[(tid_ * 8 + ww) * 2 + 1]; }
            const float mu = a * (1.0f / 512.0f), var = fmaxf(b * (1.0f / 512.0f) - mu * mu, 0.f);
            mr[tid_ * 2] = mu; mr[tid_ * 2 + 1] = rsqrtf(var + EPS); }
        LDS_BAR();
        {
            const int i = tid_ >> 3; const float mu = mr[i * 2], rs = mr[i * 2 + 1]; const size_t row = (size_t)(row0 + i);
#pragma unroll 2
            for (int q = 0; q < 8; ++q) { const int v8 = (tid_ & 7) * 8 + 64 * q, c = h * 512 + v8;
                const u32x4 hv = *(const LAS u32x4*)(Hs + i * HP + v8), xv = *(const u32x4*)(XCM + ((size_t)h * LT + row) * 512 + v8), ov = *(const u32x4*)(OPRE + row * 2048 + c);
                const f32x4 g0 = *(const f32x4*)(NG + c), g1 = *(const f32x4*)(NG + c + 4), k0 = *(const f32x4*)(SK + c), k1 = *(const f32x4*)(SK + c + 4);
                float o[8];
#pragma unroll
                for (int e = 0; e < 8; ++e) { const unsigned hw = hv[e >> 1], xw = xv[e >> 1], ow = ov[e >> 1];
                    const float hh = (e & 1) ? bfhi(hw) : bflo(hw), xc = (e & 1) ? bfhi(xw) : bflo(xw), op = (e & 1) ? bfhi(ow) : bflo(ow);
                    const float ng = e < 4 ? g0[e & 3] : g1[e & 3], sk = e < 4 ? k0[e & 3] : k1[e & 3];
                    o[e] = ((hh - mu) * rs * ng + sk * xc) * sigmf(op); }
                u32x4 wv; wv.x = pk2(o[0], o[1]); wv.y = pk2(o[2], o[3]); wv.z = pk2(o[4], o[5]); wv.w = pk2(o[6], o[7]);
                *(u32x4*)(Y + row * 2048 + c) = wv; }
        }
    }
}

struct EpiResid {
    static constexpr bool PERM = false;
    float* HL; float* HC; const float* g_lat; const float* g_ctx; const float* bias; int rowbase; bool colmajor;
    __device__ __forceinline__ void operator()(const f32x4 (&acc)[2][2][4][2], const GUnit& u, int wr, int wc, int fr, int fq) const {
        const int col0 = u.pn * 256 + wc * 32 + 4 * fq;
        const bool isctx = (rowbase + u.pm * 256) < CTXN;
        const float* g = isctx ? g_ctx : g_lat;
        f32x4 gv[2][2], bv[2][2];
#pragma unroll
        for (int bj = 0; bj < 2; ++bj)
#pragma unroll
            for (int n = 0; n < 2; ++n) { gv[bj][n] = *(const f32x4*)(g + col0 + bj * 128 + n * 16); bv[bj][n] = bias ? *(const f32x4*)(bias + col0 + bj * 128 + n * 16) : (f32x4){0.f, 0.f, 0.f, 0.f}; }
#pragma unroll
        for (int ai = 0; ai < 2; ++ai)
#pragma unroll
            for (int m = 0; m < 4; ++m) { const int R = rowbase + u.pm * 256 + ai * 128 + wr * 64 + m * 16 + fr;
                float* rowp = isctx ? HC + (size_t)R * 1024 : HL + (size_t)scan_inv(R - CTXN, colmajor) * 1024;
#pragma unroll
                for (int bj = 0; bj < 2; ++bj)
#pragma unroll
                    for (int n = 0; n < 2; ++n) { float* p = rowp + col0 + bj * 128 + n * 16; const f32x4 o = *(const f32x4*)p; *(f32x4*)p = o + gv[bj][n] * (acc[ai][bj][m][n] + bv[bj][n]); } }
    }
};

__device__ __forceinline__ void mlstm_outproj(const Frame& F, int l, int slot, bool with_ctx, bool colmajor) {
    MultiSched<1> S; Prob pr[1];
    const int rowbase = with_ctx ? 0 : CTXN, nM = with_ctx ? 65 : 64;
    pr[0] = Prob{(const char*)(F.ws + WS_Y) + (size_t)rowbase * 2048 * 2, (const char*)(F.ws + WS_WMOUT) + (size_t)slot * 1024 * 2048 * 2, nullptr, 0, 0, 0, nM, 4, 1, 0, 2048, 2048, 0, 0};
    S.init(F, pr, nM * 4);
    EpiResid E{(float*)(F.ws + WS_HL), (float*)(F.ws + WS_HC), modp(F, l, 0, 2), modp(F, l, 1, 2), nullptr, rowbase, colmajor};
    pg8::gemm_phase<EpiResid, MultiSched<1>, false>(F.lds, 2048, S, E, F.tid);
}
__device__ __forceinline__ void hyena_filtergen(const Frame& F, int slot, bool with_ctx) {
    const bf16_t* Z2 = (const bf16_t*)(F.ws + WS_Z2) + (size_t)slot * SEQ * 64;
    const bf16_t* W3T = (const bf16_t*)(F.ws + WS_W3T) + (size_t)slot * 2048 * 64;
    const float* dec = F.in[I_HDECAY] + (size_t)slot * 2048;
    bf16_t* FILT = (bf16_t*)(F.ws + WS_FILT2);
    const int fr = F.lane & 15, fq = F.lane >> 4;
    for (int gw = F.bid * NWAVES + F.wave; gw < 128 * 16; gw += F.G * NWAVES) {
        const int oct = gw & 127, tg = gw >> 7, oc = oct * 16 + fr;
        bf16x8 b[2];
#pragma unroll
        for (int kk = 0; kk < 2; ++kk) b[kk] = *(const bf16x8*)(W3T + (size_t)oc * 64 + kk * 32 + fq * 8);
        const float dc = dec[oc];
        for (int tt = 0; tt < 64; ++tt) {
            const int t0 = (tg * 64 + tt) * 16;
            f32x4 acc = {0.f, 0.f, 0.f, 0.f};
#pragma unroll
            for (int kk = 0; kk < 2; ++kk) { const bf16x8 a = *(const bf16x8*)(Z2 + (size_t)(t0 + fr) * 64 + kk * 32 + fq * 8); acc = __builtin_amdgcn_mfma_f32_16x16x32_bf16(a, b[kk], acc, 0, 0, 0); }
            float o[4];
#pragma unroll
            for (int r = 0; r < 4; ++r) { const int t = t0 + fq * 4 + r; const float tau = fabsf((float)(t - SEQ / 2)) * (1.0f / (SEQ / 2)); o[r] = acc[r] * __expf(-tau * dc); }
            u32x2 w; w.x = pk2(o[0], o[1]); w.y = pk2(o[2], o[3]);
            *(u32x2*)(FILT + (size_t)oc * SEQ + t0 + fq * 4) = w;
        }
        if (with_ctx) {
            const bf16_t* Z2C = (const bf16_t*)(F.ws + WS_Z2C); float* FC = (float*)(F.ws + WS_FILTC);
            const int t0 = tg * 16;
            f32x4 acc = {0.f, 0.f, 0.f, 0.f};
#pragma unroll
            for (int kk = 0; kk < 2; ++kk) { const bf16x8 a = *(const bf16x8*)(Z2C + (size_t)(t0 + fr) * 64 + kk * 32 + fq * 8); acc = __builtin_amdgcn_mfma_f32_16x16x32_bf16(a, b[kk], acc, 0, 0, 0); }
#pragma unroll
            for (int r = 0; r < 4; ++r) { const int t = t0 + fq * 4 + r; const float tau = fabsf((float)(t - CTXN / 2)) * (1.0f / (CTXN / 2)); FC[(size_t)oc * CTXN + t] = acc[r] * __expf(-tau * dc); }
        }
    }
}

__device__ __forceinline__ void hyena_inproj(const Frame& F, int slot, bool with_ctx) {
    MultiSched<1> S; Prob pr[1];
    const int colbase = with_ctx ? 0 : CTXN, nN = with_ctx ? 65 : 64;
    pr[0] = Prob{(const char*)(F.ws + WS_WHIN) + (size_t)slot * 3072 * 1024 * 2, (const char*)(F.ws + WS_U) + (size_t)colbase * 1024 * 2, (char*)(F.ws + WS_ZT) + (size_t)colbase * 2, 0, 0, 0, 12, nN, 1, 0, 1024, 1024, LT, 2};
    S.init(F, pr, 12 * nN);
    EpiStore E{F.in[I_HINB] + (size_t)slot * 3072, nullptr, nullptr, 0};
    pg8::gemm_phase<EpiStore, MultiSched<1>, false>(F.lds, 1024, S, E, F.tid);
}

__device__ __forceinline__ f32x2 cmul(f32x2 a, f32x2 b) { return (f32x2){a.x * b.x - a.y * b.y, a.x * b.y + a.y * b.x}; }
__device__ __forceinline__ f32x2 cmulc(f32x2 a, f32x2 b) { return (f32x2){a.x * b.x + a.y * b.y, a.y * b.x - a.x * b.y}; }
__device__ __forceinline__ f32x2 cconj(f32x2 a) { return (f32x2){a.x, -a.y}; }
template <int R> __device__ __forceinline__ constexpr int brevR(int x) { int r = 0; for (int b = 1; b < R; b <<= 1) { r = (r << 1) | (x & 1); x >>= 1; } return r; }
template <int R> __device__ __forceinline__ constexpr int log2R() { int l = 0; for (int b = 1; b < R; b <<= 1) ++l; return l; }
template <int R, int HALF_, bool INV> __device__ __forceinline__ void dft_stage(f32x2 (&v)[R]) {
    constexpr float C32[16] = {1.0f, 0.9807852804032304f, 0.9238795325112867f, 0.8314696123025452f, 0.7071067811865476f, 0.5555702330196022f, 0.3826834323650898f, 0.1950903220161283f,
                               0.0f, -0.1950903220161283f, -0.3826834323650898f, -0.5555702330196022f, -0.7071067811865476f, -0.8314696123025452f, -0.9238795325112867f, -0.9807852804032304f};
    constexpr float S32[16] = {0.0f, 0.1950903220161283f, 0.3826834323650898f, 0.5555702330196022f, 0.7071067811865476f, 0.8314696123025452f, 0.9238795325112867f, 0.9807852804032304f,
                               1.0f, 0.9807852804032304f, 0.9238795325112867f, 0.8314696123025452f, 0.7071067811865476f, 0.5555702330196022f, 0.3826834323650898f, 0.1950903220161283f};
#pragma unroll
    for (int blk = 0; blk < R; blk += 2 * HALF_) {
#pragma unroll
        for (int j = 0; j < HALF_; ++j) {
            const f32x2 a = v[blk + j], b = v[blk + j + HALF_];
            v[blk + j] = a + b; const f32x2 d = a - b;
            constexpr int TS = 16 / HALF_;
            const int ti = j * TS;
            if (ti == 0) v[blk + j + HALF_] = d;
            else if (ti == 8) v[blk + j + HALF_] = INV ? (f32x2){-d.y, d.x} : (f32x2){d.y, -d.x};
            else { const f32x2 w = {C32[ti], INV ? S32[ti] : -S32[ti]}; v[blk + j + HALF_] = cmul(d, w); }
        }
    }
    if constexpr (HALF_ > 1) dft_stage<R, HALF_ / 2, INV>(v);
}
template <int R, bool INV> __device__ __forceinline__ void dft_reg(f32x2 (&v)[R]) { dft_stage<R, R / 2, INV>(v); }
__device__ __forceinline__ int fpad(int i) { return i + (i >> 5); }
__device__ __forceinline__ f32x2 unit_root(int num, int den_log2) {
    asm volatile("" : "+v"(num));
    float s, c; sincospif((float)num * (2.0f / (float)(1 << den_log2)), &s, &c); return (f32x2){c, -s};
}
template <bool INV> __device__ __forceinline__ void fft_pass_a(LAS f32x2* buf, int tid) {
#pragma unroll 1
    for (int rr = 0; rr < 2; ++rr) { const int r = tid + rr * 512, pr = fpad(r); f32x2 v[16];
        const f32x2 w1 = unit_root(r, 14);
        if (!INV) {
#pragma unroll
            for (int a = 0; a < 16; ++a) v[a] = buf[pr + a * 1056];
            dft_reg<16, false>(v);
            f32x2 w = w1;
            buf[pr] = v[0];
#pragma unroll
            for (int p = 1; p < 16; ++p) { buf[pr + p * 1056] = cmul(v[brevR<16>(p)], w); w = cmul(w, w1); }
        } else {
            f32x2 w = w1;
            v[0] = buf[pr];
#pragma unroll
            for (int p = 1; p < 16; ++p) { v[p] = cmulc(buf[pr + p * 1056], w); w = cmul(w, w1); }
            dft_reg<16, true>(v);
#pragma unroll
            for (int a = 0; a < 16; ++a) buf[pr + a * 1056] = v[brevR<16>(a)];
        }
    }
}
__device__ __forceinline__ void fft_pass_a_fwd_regs(LAS f32x2* buf, const f32x2 (&z)[16], int tid) {
#pragma unroll
    for (int rr = 0; rr < 2; ++rr) { const int r = tid + rr * 512, pr = fpad(r); f32x2 v[16];
        const f32x2 w1 = unit_root(r, 14);
#pragma unroll
        for (int a = 0; a < 16; ++a) v[a] = (a < 8) ? z[2 * a + rr] : (f32x2){0.f, 0.f};
        dft_reg<16, false>(v);
        f32x2 w = w1;
        buf[pr] = v[0];
#pragma unroll
        for (int p = 1; p < 16; ++p) { buf[pr + p * 1056] = cmul(v[brevR<16>(p)], w); w = cmul(w, w1); }
    }
}
__device__ __forceinline__ void fft_pass_a_inv_regs(const LAS f32x2* buf, f32x2 (&y)[16], int tid) {
#pragma unroll
    for (int rr = 0; rr < 2; ++rr) { const int r = tid + rr * 512, pr = fpad(r); f32x2 v[16];
        const f32x2 w1 = unit_root(r, 14);
        f32x2 w = w1;
        v[0] = buf[pr];
#pragma unroll
        for (int p = 1; p < 16; ++p) { v[p] = cmulc(buf[pr + p * 1056], w); w = cmul(w, w1); }
        dft_reg<16, true>(v);
#pragma unroll
        for (int a = 4; a < 12; ++a) y[2 * (a - 4) + rr] = v[brevR<16>(a)];
    }
}
template <bool INV> __device__ __forceinline__ void fft_pass_b(LAS f32x2* buf, int tid) {
    const int p1 = tid >> 5, r = tid & 31, pb = fpad(p1 * 1024 + r); f32x2 v[32];
    const f32x2 w1 = unit_root(r, 10);
    if (!INV) {
#pragma unroll
        for (int a = 0; a < 32; ++a) v[a] = buf[pb + a * 33];
        dft_reg<32, false>(v);
        f32x2 w = w1;
        buf[pb] = v[0];
#pragma unroll
        for (int p = 1; p < 32; ++p) { buf[pb + p * 33] = cmul(v[brevR<32>(p)], w); w = cmul(w, w1); }
    } else {
        f32x2 w = w1;
        v[0] = buf[pb];
#pragma unroll
        for (int p = 1; p < 32; ++p) { v[p] = cmulc(buf[pb + p * 33], w); w = cmul(w, w1); }
        dft_reg<32, true>(v);
#pragma unroll
        for (int a = 0; a < 32; ++a) buf[pb + a * 33] = v[brevR<32>(a)];
    }
}
template <bool INV> __device__ __forceinline__ void fft_pass_c(LAS f32x2* buf, int tid) {
    const int base = tid * 33; f32x2 v[32];
#pragma unroll
    for (int a = 0; a < 32; ++a) v[a] = buf[base + a];
    dft_reg<32, INV>(v);
#pragma unroll
    for (int a = 0; a < 32; ++a) buf[base + a] = v[brevR<32>(a)];
}
__device__ __forceinline__ void fft_fwd(LAS f32x2* buf, int tid) { fft_pass_a<false>(buf, tid); __syncthreads(); fft_pass_b<false>(buf, tid); __syncthreads(); fft_pass_c<false>(buf, tid); __syncthreads(); }
__device__ __forceinline__ void fft_inv(LAS f32x2* buf, int tid) { fft_pass_c<true>(buf, tid); __syncthreads(); fft_pass_b<true>(buf, tid); __syncthreads(); fft_pass_a<true>(buf, tid); __syncthreads(); }
__device__ __forceinline__ int fft_k_of_pos(int pos) { return (pos >> 10) + 16 * ((pos >> 5) & 31) + 512 * (pos & 31); }
__device__ __forceinline__ int fft_pos_of_k(int k) { return (k & 15) * 1024 + ((k >> 4) & 31) * 32 + (k >> 9); }

__device__ __forceinline__ int fft_pos_of_ci(int ci) { return (ci >> 9) * 1024 + ((ci >> 4) & 31) * 32 + (ci & 15); }
__device__ __forceinline__ void fft_save_pairs(const LAS f32x2* buf, f32x4* zh, const f32x2* twp, float scale, int tid) {
#pragma unroll 4
    for (int it = 0; it < 16; ++it) { const int ci = it * 512 + tid, pos = fft_pos_of_ci(ci), k = fft_k_of_pos(pos);
        const int pos2 = (k == 0) ? 16 : fft_pos_of_k(16384 - k);
        const f32x2 h1 = buf[fpad(pos)], h2 = buf[fpad(pos2)];
        if (k == 0) zh[ci] = (f32x4){(h1.x + h1.y) * scale, (h1.x - h1.y) * scale, h2.x * scale, -h2.y * scale};
        else { const f32x2 wn = twp[ci];
            const f32x2 eh = {0.5f * (h1.x + h2.x), 0.5f * (h1.y - h2.y)}, dh = {0.5f * (h1.x - h2.x), 0.5f * (h1.y + h2.y)};
            const f32x2 th = cmul(wn, (f32x2){dh.y, -dh.x});
            const f32x2 hk = (eh + th) * scale, hk2 = cconj(eh - th) * scale;
            zh[ci] = (f32x4){hk.x, hk.y, hk2.x, hk2.y}; } }
}
__device__ __forceinline__ void fft_pointwise(LAS f32x2* buf, const f32x4* zh, const f32x2* twp, int tid) {
#pragma unroll 2
    for (int it = 0; it < 16; ++it) { const int ci = it * 512 + tid, pos = fft_pos_of_ci(ci), k = fft_k_of_pos(pos);
        const f32x4 hq = zh[ci];
        if (k == 0) {
            const f32x2 z0 = buf[0], zm = buf[16];
            const float y0 = (z0.x + z0.y) * hq[0], yn = (z0.x - z0.y) * hq[1];
            buf[0] = (f32x2){0.5f * (y0 + yn), 0.5f * (y0 - yn)};
            const f32x2 ym = cmul(cconj(zm), (f32x2){hq[2], hq[3]});
            buf[16] = (f32x2){ym.x, -ym.y};
        } else {
            const int pp = fpad(pos), pp2 = fpad(fft_pos_of_k(16384 - k));
            const f32x2 z1 = buf[pp], z2 = buf[pp2];
            const f32x2 wn = twp[ci];
            const f32x2 ex = {0.5f * (z1.x + z2.x), 0.5f * (z1.y - z2.y)}, dx = {0.5f * (z1.x - z2.x), 0.5f * (z1.y + z2.y)};
            const f32x2 tx = cmul(wn, (f32x2){dx.y, -dx.x});
            const f32x2 xk = ex + tx, xk2 = cconj(ex - tx);
            const f32x2 yk = cmul(xk, (f32x2){hq[0], hq[1]}), yk2 = cmul(xk2, (f32x2){hq[2], hq[3]});
            const f32x2 e2 = {0.5f * (yk.x + yk2.x), 0.5f * (yk.y - yk2.y)}, d2 = {0.5f * (yk.x - yk2.x), 0.5f * (yk.y + yk2.y)};
            const f32x2 o2 = cmulc(d2, wn);
            buf[pp] = (f32x2){e2.x - o2.y, e2.y + o2.x};
            buf[pp2] = (f32x2){e2.x + o2.y, -(e2.y - o2.x)};
        }
    }
}
__device__ __forceinline__ f32x2 sconv2(const bf16_t* row, int n, int Ln, float w0, float w1, float w2, float b) {
    struct W3 { unsigned p, c, q; } t;
    __builtin_memcpy(&t, (const unsigned*)row + (n - 1), 12);
    const unsigned p = (n > 0) ? t.p : 0u, q = (2 * n + 2 < Ln) ? t.q : 0u, c = t.c;
    const float xm1 = bfhi(p), x0 = bflo(c), x1 = bfhi(c), x2 = bflo(q);
    return (f32x2){b + w0 * xm1 + w1 * x0 + w2 * x1, b + w0 * x0 + w1 * x1 + w2 * x2};
}
__device__ __forceinline__ float block_sum(LAS float* red, float v, int tid) {
    v = wave_sum(v);
    __syncthreads();
    if ((tid & 63) == 0) red[tid >> 6] = v;
    __syncthreads();
    float s = 0.f;
#pragma unroll
    for (int i = 0; i < 8; ++i) s += red[i];
    return s;
}

__device__ __forceinline__ void hyena_filter_fft(const Frame& F, int vbid, int vG) {
    LAS f32x2* buf = (LAS f32x2*)F.lds;
    LAS float* red = (LAS float*)(F.lds + (16384 + 512) * 8);
    const bf16_t* FILT = (const bf16_t*)(F.ws + WS_FILT2);
    const int tid = F.tid, pt = fpad(F.tid);
    for (int job = vbid; job < 2048; job += vG) {
        const int c = job >> 1, ord = job & 1;
        const unsigned* f32p = (const unsigned*)(FILT + (size_t)(ord * 1024 + c) * SEQ);
        float ss = 0.f; f32x2 fz[16];
        __syncthreads();
#pragma unroll
        for (int j = 0; j < 16; ++j) { const int n = tid + 512 * j; const unsigned w = f32p[n]; const float a = bflo(w), b = bfhi(w); ss += a * a + b * b; fz[j] = (f32x2){a, b}; }
        const float tot = block_sum(red, ss, tid);
        const float fsv = rsqrtf(tot + EPS) * (1.0f / 16384.0f);
        fft_pass_a_fwd_regs(buf, fz, tid); __syncthreads(); fft_pass_b<false>(buf, tid); __syncthreads(); fft_pass_c<false>(buf, tid); __syncthreads();
        fft_save_pairs(buf, (f32x4*)(F.ws + WS_ZHALL) + (size_t)job * 8192, (const f32x2*)(F.ws + WS_TWP), fsv, tid);
    }
    __syncthreads();
}

__device__ __forceinline__ void hyena_fft(const Frame& F, int slot, bool with_ctx) {
    LAS f32x2* buf = (LAS f32x2*)F.lds;
    LAS float* red = (LAS float*)(F.lds + (16384 + 512) * 8);
    const bf16_t* ZT = (const bf16_t*)(F.ws + WS_ZT); bf16_t* Y2T = (bf16_t*)(F.ws + WS_Y2T);
    const f32x2* twp = (const f32x2*)(F.ws + WS_TWP);
    const float* scw = F.in[I_HSCW] + (size_t)slot * 3 * 3072; const float* scb = F.in[I_HSCB] + (size_t)slot * 3072; const float* fb = F.in[I_HFBIAS] + (size_t)slot * 2048;
    const int tid = F.tid, pt = fpad(F.tid);
    for (int c = F.bid; c < 1024; c += F.G) {
        const f32x4* zh = (const f32x4*)(F.ws + WS_ZHALL) + (size_t)c * 2 * 8192;
        __syncthreads();
        f32x2 vv[16], yy[16];
        {
            const int zc = 2048 + c; const float w0 = scw[zc], w1 = scw[3072 + zc], w2 = scw[2 * 3072 + zc], b = scb[zc];
            const bf16_t* row = ZT + (size_t)zc * LT + CTXN;
#pragma unroll
            for (int j = 0; j < 16; ++j) { const int n = tid + 512 * j; vv[j] = sconv2(row, n, SEQ, w0, w1, w2, b); if ((j & 3) == 3) __builtin_amdgcn_sched_barrier(0); }
        }
        fft_pass_a_fwd_regs(buf, vv, tid); __syncthreads(); fft_pass_b<false>(buf, tid); __syncthreads(); fft_pass_c<false>(buf, tid); __syncthreads();
        fft_pointwise(buf, zh, twp, tid);
        __syncthreads();
        fft_pass_c<true>(buf, tid); __syncthreads(); fft_pass_b<true>(buf, tid); __syncthreads(); fft_pass_a_inv_regs(buf, yy, tid);
        {
            const int zc = c; const float w0 = scw[zc], w1 = scw[3072 + zc], w2 = scw[2 * 3072 + zc], b = scb[zc], fb0 = fb[c];
            const bf16_t* row = ZT + (size_t)zc * LT + CTXN;
#pragma unroll
            for (int j = 0; j < 16; ++j) { const int n = tid + 512 * j; const f32x2 x1 = sconv2(row, n, SEQ, w0, w1, w2, b);
                vv[j] = (f32x2){x1.x * (yy[j].x + vv[j].x * fb0), x1.y * (yy[j].y + vv[j].y * fb0)}; if ((j & 3) == 3) __builtin_amdgcn_sched_barrier(0); }
        }
        fft_pass_a_fwd_regs(buf, vv, tid); __syncthreads(); fft_pass_b<false>(buf, tid); __syncthreads(); fft_pass_c<false>(buf, tid); __syncthreads();
        fft_pointwise(buf, zh + 8192, twp, tid);
        __syncthreads();
        fft_pass_c<true>(buf, tid); __syncthreads(); fft_pass_b<true>(buf, tid); __syncthreads(); fft_pass_a_inv_regs(buf, yy, tid);
        {
            const int zc = 1024 + c; const float w0 = scw[zc], w1 = scw[3072 + zc], w2 = scw[2 * 3072 + zc], b = scb[zc], fb1 = fb[1024 + c];
            const bf16_t* row = ZT + (size_t)zc * LT + CTXN;
            unsigned* orow = (unsigned*)(Y2T + (size_t)c * LT + CTXN);
#pragma unroll
            for (int j = 0; j < 16; ++j) { const int n = tid + 512 * j; const f32x2 x2 = sconv2(row, n, SEQ, w0, w1, w2, b);
                orow[n] = pk2(x2.x * (yy[j].x + vv[j].x * fb1), x2.y * (yy[j].y + vv[j].y * fb1)); if ((j & 3) == 3) __builtin_amdgcn_sched_barrier(0); }
        }
        __syncthreads();
    }
    if (with_ctx) {
        LAS float* ub = (LAS float*)F.lds;
        LAS float* fbuf = ub + 512;
        const float* FC = (const float*)(F.ws + WS_FILTC);
        const int cc = tid >> 8, t = tid & 255;
        for (int c0 = F.bid * 2; c0 < 1024; c0 += F.G * 2) {
            const int c = c0 + cc;
            float cur, y1 = 0.f;
            { const int zc = 2048 + c; const bf16_t* row = ZT + (size_t)zc * LT;
              const float xm = t > 0 ? bf2f(row[t - 1]) : 0.f, x0 = bf2f(row[t]), xp = t < 255 ? bf2f(row[t + 1]) : 0.f;
              cur = scb[zc] + scw[zc] * xm + scw[3072 + zc] * x0 + scw[2 * 3072 + zc] * xp; }
#pragma unroll 1
            for (int ord = 0; ord < 2; ++ord) {
                __syncthreads();
                const float fv = FC[(size_t)(ord * 1024 + c) * CTXN + t];
                ub[cc * 256 + t] = cur; fbuf[cc * 256 + t] = fv;
                float ss = fv * fv;
                ss = wave_sum(ss);
                __syncthreads();
                if (F.lane == 0) red[F.wave] = ss;
                __syncthreads();
                const float tot = red[cc * 4] + red[cc * 4 + 1] + red[cc * 4 + 2] + red[cc * 4 + 3];
                const float fs = rsqrtf(tot + EPS);
                float acc = 0.f;
                const int jlo = max(0, t + 128 - 255), jhi = min(255, t + 128);
                for (int j = jlo; j <= jhi; ++j) acc += fbuf[cc * 256 + j] * ub[cc * 256 + t + 128 - j];
                const int zc = ord * 1024 + c; const bf16_t* row = ZT + (size_t)zc * LT;
                const float xm = t > 0 ? bf2f(row[t - 1]) : 0.f, x0 = bf2f(row[t]), xp = t < 255 ? bf2f(row[t + 1]) : 0.f;
                const float xg = scb[zc] + scw[zc] * xm + scw[3072 + zc] * x0 + scw[2 * 3072 + zc] * xp;
                const float yo = xg * (acc * fs + cur * fb[ord * 1024 + c]);
                if (ord == 0) { y1 = yo; cur = y1; } else Y2T[(size_t)c * LT + t] = f2bf(yo);
            }
        }
        __syncthreads();
    }
}

__device__ __forceinline__ void hyena_transpose(const Frame& F, bool with_ctx) {
    LAS bf16_t* tile = (LAS bf16_t*)F.lds;
    const bf16_t* Y2T = (const bf16_t*)(F.ws + WS_Y2T); bf16_t* Y2 = (bf16_t*)(F.ws + WS_Y2);
    const int tlo = with_ctx ? 0 : 4, ntt = NCH - tlo, ntile = 16 * ntt;
    for (int ti = F.bid; ti < ntile; ti += F.G) {
        const int c0 = (ti % 16) * 64, t0 = (tlo + ti / 16) * 64;
        LDS_BAR();
        { const int c = F.tid >> 3, t8 = (F.tid & 7) * 8; const u32x4 v = *(const u32x4*)(Y2T + (size_t)(c0 + c) * LT + t0 + t8); *(LAS u32x4*)(tile + c * 72 + t8) = v; }
        LDS_BAR();
        { const int t = F.tid >> 3, c8 = (F.tid & 7) * 8; bf16_t e[8];
#pragma unroll
          for (int j = 0; j < 8; ++j) e[j] = tile[(c8 + j) * 72 + t];
          u32x4 w; w.x = (unsigned)e[0] | ((unsigned)e[1] << 16); w.y = (unsigned)e[2] | ((unsigned)e[3] << 16); w.z = (unsigned)e[4] | ((unsigned)e[5] << 16); w.w = (unsigned)e[6] | ((unsigned)e[7] << 16);
          *(u32x4*)(Y2 + (size_t)(t0 + t) * 1024 + c0 + c8) = w; }
    }
}

__device__ __forceinline__ void hyena_outproj(const Frame& F, int l, int slot, bool with_ctx, bool colmajor) {
    MultiSched<1> S; Prob pr[1];
    const int rowbase = with_ctx ? 0 : CTXN, nM = with_ctx ? 65 : 64;
    pr[0] = Prob{(const char*)(F.ws + WS_Y2) + (size_t)rowbase * 1024 * 2, (const char*)(F.ws + WS_WHOUT) + (size_t)slot * 1024 * 1024 * 2, nullptr, 0, 0, 0, nM, 4, 1, 0, 1024, 1024, 0, 0};
    S.init(F, pr, nM * 4);
    EpiResid E{(float*)(F.ws + WS_HL), (float*)(F.ws + WS_HC), modp(F, l, 0, 2), modp(F, l, 1, 2), F.in[I_HOUTB] + (size_t)slot * 1024, rowbase, colmajor};
    pg8::gemm_phase<EpiResid, MultiSched<1>, false>(F.lds, 1024, S, E, F.tid);
}
constexpr int MOE_MAXG = 8;
constexpr int MOE_MAXU = 6;
constexpr int MOE_TAB = 131072;

__device__ __forceinline__ void moe_route(const Frame& F, int l, bool with_ctx) {
    constexpr int VP = 1028;
    LAS float* vs = (LAS float*)F.lds;
    LAS float* part = vs + 16 * VP;
    LAS float* lg = part + 8 * 16 * 48;
    LAS int* re = (LAS int*)(lg + 16 * 48);
    LAS float* rw = (LAS float*)(re + MOE_MAXG * 32);
    LAS int* rp = (LAS int*)(rw + MOE_MAXG * 32);
    LAS int* lc = rp + MOE_MAXG * 32;
    LAS int* lb = lc + 32;
    const float* HL = (const float*)(F.ws + WS_HL); const float* HC = (const float*)(F.ws + WS_HC); bf16_t* VN = (bf16_t*)(F.ws + WS_VN);
    const float* WC = (const float*)(F.ws + WS_WC) + (size_t)l * 1024 * 48;
    const float* g2n = F.in[I_N2G] + l * 1024;
    unsigned* cnt = (unsigned*)(F.ws + WS_CTL) + CW_CNT + l * 32 * 64;
    int* LIST = (int*)(F.ws + WS_LIST); float* AW = (float*)(F.ws + WS_AW);
    const int ntok = with_ctx ? LT : SEQ, tokbase = with_ctx ? 0 : CTXN, ngroups = ntok / 16;
    const int fr = F.lane & 15, fq = F.lane >> 4;
    float wcr[32][3];
#pragma unroll
    for (int st = 0; st < 32; ++st)
#pragma unroll
        for (int nt = 0; nt < 3; ++nt) wcr[st][nt] = WC[(size_t)(F.wave * 128 + st * 4 + fq) * 48 + nt * 16 + fr];
    int gi = 0;
    for (int grp = F.bid; grp < ngroups && gi < MOE_MAXG; grp += F.G, ++gi) {
        LDS_BAR();
#pragma unroll
        for (int rr = 0; rr < 2; ++rr) { const int i = 2 * F.wave + rr, tok = tokbase + grp * 16 + i; const bool isctx = tok < CTXN; const int s = isctx ? 1 : 0;
            const float* src = isctx ? HC + (size_t)tok * 1024 : HL + (size_t)(tok - CTXN) * 1024;
            const float* sh = modp(F, l, s, 3); const float* sc = modp(F, l, s, 4);
            f32x4 v[4]; float ss = 0.f;
#pragma unroll
            for (int j = 0; j < 4; ++j) { v[j] = *(const f32x4*)(src + j * 256 + F.lane * 4); ss += v[j][0] * v[j][0] + v[j][1] * v[j][1] + v[j][2] * v[j][2] + v[j][3] * v[j][3]; }
            ss = wave_sum(ss);
            const float rstd = rsqrtf(ss * (1.0f / 1024.0f) + EPS);
#pragma unroll
            for (int j = 0; j < 4; ++j) { const int c = j * 256 + F.lane * 4; const f32x4 g = *(const f32x4*)(g2n + c), a = *(const f32x4*)(sc + c), b = *(const f32x4*)(sh + c);
                f32x4 o;
#pragma unroll
                for (int e = 0; e < 4; ++e) o[e] = v[j][e] * rstd * g[e] * (1.0f + a[e]) + b[e];
                *(LAS f32x4*)(vs + i * VP + c) = o;
                u32x2 w; w.x = pk2(o[0], o[1]); w.y = pk2(o[2], o[3]); *(u32x2*)(VN + (size_t)tok * 1024 + c) = w; }
        }
        LDS_BAR();
        {
            f32x4 acc[3] = {{0.f, 0.f, 0.f, 0.f}, {0.f, 0.f, 0.f, 0.f}, {0.f, 0.f, 0.f, 0.f}};
#pragma unroll
            for (int st = 0; st < 32; ++st) { const int k = F.wave * 128 + st * 4 + fq; const float a = vs[fr * VP + k];
#pragma unroll
                for (int nt = 0; nt < 3; ++nt) acc[nt] = __builtin_amdgcn_mfma_f32_16x16x4f32(a, wcr[st][nt], acc[nt], 0, 0, 0); }
#pragma unroll
            for (int nt = 0; nt < 3; ++nt)
#pragma unroll
                for (int r = 0; r < 4; ++r) part[(F.wave * 16 + fq * 4 + r) * 48 + nt * 16 + fr] = acc[nt][r];
        }
        LDS_BAR();
        for (int idx = F.tid; idx < 16 * 48; idx += NT) { const int n = idx % 48; float a = (n < 4) ? F.in[I_RGB][l * 4 + n] : (n < 36 ? F.in[I_REB][l * 32 + n - 4] : 0.f);
#pragma unroll
            for (int w = 0; w < 8; ++w) a += part[w * 16 * 48 + idx];
            lg[idx] = a; }
        LDS_BAR();
        if (F.tid < 16) { const LAS float* q = lg + F.tid * 48;
            int gx = 0; float gm = q[0];
            for (int j = 1; j < 4; ++j) if (q[j] > gm) { gm = q[j]; gx = j; }
            float gs = 0.f; for (int j = 0; j < 4; ++j) gs += __expf(q[j] - gm);
            const float gw = 1.0f / gs;
            const LAS float* e = q + 4 + gx * 8;
            int i1 = 0; float m1 = e[0];
            for (int j = 1; j < 8; ++j) if (e[j] > m1) { m1 = e[j]; i1 = j; }
            int i2 = -1; float m2 = 0.f;
            for (int j = 0; j < 8; ++j) if (j != i1 && (i2 < 0 || e[j] > m2)) { m2 = e[j]; i2 = j; }
            const float x = __expf(m2 - m1), w1 = 1.0f / (1.0f + x), w2 = x / (1.0f + x);
            const int a0 = gi * 32 + F.tid * 2;
            re[a0] = gx * 8 + i1; rw[a0] = gw * w1; re[a0 + 1] = gx * 8 + i2; rw[a0 + 1] = gw * w2; }
    }
    LDS_BAR();
    if (F.tid < 32) lc[F.tid] = 0;
    LDS_BAR();
    const int na = gi * 32;
    if (F.tid < na) rp[F.tid] = __hip_atomic_fetch_add(&lc[re[F.tid]], 1, __ATOMIC_RELAXED, __HIP_MEMORY_SCOPE_WORKGROUP);
    LDS_BAR();
    if (F.tid < 32) lb[F.tid] = lc[F.tid] > 0 ? (int)__hip_atomic_fetch_add(cnt + F.tid * 64, (unsigned)lc[F.tid], RLX_AGENT) : 0;
    LDS_BAR();
    if (F.tid < na) { const int a = F.tid, g = a >> 5, i = (a >> 1) & 15, slot = a & 1, e = re[a];
        const int tok = tokbase + (F.bid + g * F.G) * 16 + i, gidx = tok * 2 + slot;
        LIST[(size_t)e * NASG + lb[e] + rp[a]] = gidx; AW[gidx] = rw[a]; }
}

struct MoeSched {
    LAS int* cnt; LAS int* tstart; LAS unsigned* rowtab;
    const char* A; const char* B; char* O; int total, G, c, mode;
    __device__ __forceinline__ void locate(int Lq, int& e, int& mt, int& pn) const {
        const int L = pg8::xcd_remap(Lq, total);
        const int mtg = L >> 2; pn = L & 3; e = 0;
        for (int j = 1; j < 32; ++j) if (tstart[j] <= mtg) e = j;
        mt = mtg - tstart[e];
    }
    __device__ __forceinline__ bool next(int i, GUnit& u) const {
        const int L = i * G + c; if (L >= total) return false;
        int e, mt, pn; locate(L, e, mt, pn);
        u.g = e; u.aux = mt; u.pm = tstart[e] + mt; u.pn = pn;
        if (mode == 0) { u.a = A; u.lda = 1024; u.b = B + ((size_t)e * 1024 + pn * 128) * 1024 * 2; u.ldb = 1024; u.hsb = 512; u.o = O + ((size_t)u.pm * 256 * 512 + pn * 128) * 2; u.ldo = 512; }
        else { u.a = A + (size_t)u.pm * 256 * 512 * 2; u.lda = 512; u.b = B + ((size_t)e * 1024 + pn * 256) * 512 * 2; u.ldb = 512; u.hsb = 128; u.o = O; u.ldo = 1024; }
        return true;
    }
    __device__ __forceinline__ unsigned grow(int slot, int r) const { return rowtab[slot * 256 + r]; }
};
__device__ __forceinline__ void moe_tables(const Frame& F, int l, MoeSched& S, int mode) {
    S.cnt = (LAS int*)(F.lds + MOE_TAB); S.tstart = S.cnt + 32; S.rowtab = (LAS unsigned*)(F.lds + MOE_TAB + 512);
    const unsigned* cnt = (const unsigned*)(F.ws + WS_CTL) + CW_CNT + l * 32 * 64;
    __syncthreads();
    if (F.tid < 32) S.cnt[F.tid] = (int)__hip_atomic_load(cnt + F.tid * 64, RLX_AGENT);
    __syncthreads();
    if (F.tid == 0) { int a = 0; for (int e = 0; e < 32; ++e) { S.tstart[e] = a; a += (S.cnt[e] + 255) >> 8; } S.tstart[32] = a; }
    __syncthreads();
    S.total = S.tstart[32] * 4; S.G = F.G; S.c = F.bid; S.mode = mode;
    if (mode == 0 && F.tid < 256) {
        const int* LIST = (const int*)(F.ws + WS_LIST);
        for (int slot = 0; slot < MOE_MAXU; ++slot) { const int L = slot * S.G + S.c; if (L >= S.total) break;
            int e, mt, pn; S.locate(L, e, mt, pn);
            const int idx = mt * 256 + F.tid; const int tok = idx < S.cnt[e] ? (LIST[(size_t)e * NASG + idx] >> 1) : 0;
            S.rowtab[slot * 256 + F.tid] = (unsigned)tok * 2048u; }
    }
    __syncthreads();
}
struct EpiSwiGLU {
    static constexpr bool PERM = true;
    __device__ __forceinline__ void operator()(const f32x4 (&acc)[2][2][4][2], const GUnit& u, int wr, int wc, int fr, int fq) const {
        bf16_t* base = (bf16_t*)u.o;
#pragma unroll
        for (int ai = 0; ai < 2; ++ai)
#pragma unroll
            for (int m = 0; m < 4; ++m) { const int r = ai * 128 + wr * 64 + m * 16 + fr; float o[8];
#pragma unroll
                for (int n = 0; n < 2; ++n)
#pragma unroll
                    for (int j = 0; j < 4; ++j) o[n * 4 + j] = siluf(acc[ai][0][m][n][j]) * acc[ai][1][m][n][j];
                u32x4 w; w.x = pk2(o[0], o[1]); w.y = pk2(o[2], o[3]); w.z = pk2(o[4], o[5]); w.w = pk2(o[6], o[7]);
                *(u32x4*)(base + (size_t)r * 512 + wc * 32 + 8 * fq) = w; }
    }
};
struct EpiScatter {
    static constexpr bool PERM = true;
    const int* LIST; const float* AW; bf16_t* YB; LAS int* cnt;
    __device__ __forceinline__ void operator()(const f32x4 (&acc)[2][2][4][2], const GUnit& u, int wr, int wc, int fr, int fq) const {
        const int ce = cnt[u.g];
#pragma unroll
        for (int ai = 0; ai < 2; ++ai)
#pragma unroll
            for (int m = 0; m < 4; ++m) { const int r = ai * 128 + wr * 64 + m * 16 + fr, idx = u.aux * 256 + r;
                if (idx < ce) { const int a = LIST[(size_t)u.g * NASG + idx]; const float w = AW[a];
                    bf16_t* rowp = YB + (size_t)a * 1024 + u.pn * 256 + wc * 32 + 8 * fq;
#pragma unroll
                    for (int bj = 0; bj < 2; ++bj) { const f32x4 v0 = acc[ai][bj][m][0] * w, v1 = acc[ai][bj][m][1] * w;
                        u32x4 q; q.x = pk2(v0[0], v0[1]); q.y = pk2(v0[2], v0[3]); q.z = pk2(v1[0], v1[1]); q.w = pk2(v1[2], v1[3]);
                        *(u32x4*)(rowp + bj * 128) = q; } } }
    }
};
__device__ __forceinline__ void moe_e1(const Frame& F, int l) {
    MoeSched S; moe_tables(F, l, S, 0);
    S.A = (const char*)(F.ws + WS_VN); S.B = (const char*)(F.ws + WS_W13) + (size_t)l * 32 * 1024 * 1024 * 2; S.O = (char*)(F.ws + WS_H1);
    EpiSwiGLU E;
    pg8::gemm_phase<EpiSwiGLU, MoeSched, true>(F.lds, 1024, S, E, F.tid);
}
__device__ __forceinline__ void moe_e2(const Frame& F, int l) {
    MoeSched S; moe_tables(F, l, S, 1);
    S.A = (const char*)(F.ws + WS_H1); S.B = (const char*)(F.ws + WS_W2) + (size_t)l * 32 * 1024 * 512 * 2; S.O = nullptr;
    EpiScatter E{(const int*)(F.ws + WS_LIST), (const float*)(F.ws + WS_AW), (bf16_t*)(F.ws + WS_YBUF), S.cnt};
    pg8::gemm_phase<EpiScatter, MoeSched, false>(F.lds, 512, S, E, F.tid);
}
#ifndef MK_LAYERS
#define MK_LAYERS 4
#endif
__global__ void __launch_bounds__(NT, 2) mk_fwd(Args args) {
    extern __shared__ __attribute__((aligned(16))) unsigned char lds_raw[];
    Frame F0;
    { Frame& F = F0;
    F.lds = (LAS unsigned char*)lds_raw; F.ws = args.ws; F.in = args.in; F.out = args.out;
    F.wave = __builtin_amdgcn_readfirstlane((int)threadIdx.x >> 6); F.lane = fresh_lane(); F.tid = F.wave * 64 + F.lane; F.G = gridDim.x; F.bid = blockIdx.x; }
    const Frame& F = F0;
    volatile LAS unsigned* xbw = (volatile LAS unsigned*)(F.lds + LDS_BYTES - 16);
    if (F.tid < 4) xbw[F.tid] = 0u;
    __syncthreads();
    unsigned* ctl = (unsigned*)(F.ws + WS_CTL);
    const int lo = args.ph_lo, hi = args.ph_hi;
    XcdBarrier bar; bar.bar = ctl + CW_BAR; bar.x = 0; bar.st = xbw;
    if (hi - lo > 1) bar = xcd_barrier_post(ctl + CW_BAR, xbw, F.tid);
    int ph = 0;
#ifdef MK_PROBE
    unsigned long long tacc = 0ull, tp0 = 0ull;
#define PROBE_T0(g) tp0 = __builtin_amdgcn_s_memrealtime();
#ifdef MK_PROBE_WG
#define PROBE_TMID(g) if (((MK_PROBE >> (g)) & 1) && F0.bid == MK_PROBE_WG) tacc += __builtin_amdgcn_s_memrealtime() - tp0;
#define PROBE_T1(g)
#else
#define PROBE_TMID(g)
#define PROBE_T1(g) if ((MK_PROBE >> (g)) & 1) tacc += __builtin_amdgcn_s_memrealtime() - tp0;
#endif
#else
#define PROBE_T0(g)
#define PROBE_T1(g)
#define PROBE_TMID(g)
#endif
#define PHASE_BEGIN(g) if (lo <= ph && ph < hi) { PROBE_T0(g) Frame F = F0; { const int t_ = F0.wave * 64 + fresh_lane(); F.tid = t_; F.lane = t_ & 63; }
#define PHASE_END(g)   PROBE_TMID(g) if (ph + 1 < hi) xcd_barrier(bar, F0.wave * 64 + fresh_lane()); PROBE_T1(g) } ++ph;

    PHASE_BEGIN(0) p0_prologue(F); PHASE_END(0)
    int lprev = -1;
#define LAYER_PAIR(IT) { constexpr int it = IT; \
        const int lm = 2 * it, lh = 2 * it + 1; const bool colmajor = (it == 1), ctxl = (it == 0); \
        if (lm < MK_LAYERS) { \
         \
        PHASE_BEGIN(1) n1_phase(F, lm, it > 0, true, it > 0, it == 0, colmajor); hyena_filtergen(F, it, ctxl); PHASE_END(1) \
        PHASE_BEGIN(2) mlstm_inproj(F, it); PHASE_END(2) \
        PHASE_BEGIN(3) mlstm_conv_gates(F, it); PHASE_END(3) \
        PHASE_BEGIN(4) mlstm_qkv(F, it); PHASE_END(4) \
        PHASE_BEGIN(5) mlstm_scan(F, it); PHASE_END(5) \
        PHASE_BEGIN(6) mlstm_intra(F, it, ctxl ? 0 : 4); PHASE_END(6) \
        PHASE_BEGIN(7) mlstm_outproj(F, lm, it, ctxl, colmajor); PHASE_END(7) \
        PHASE_BEGIN(8) moe_route(F, lm, ctxl); PHASE_END(8) \
        PHASE_BEGIN(9) moe_e1(F, lm); PHASE_END(9) \
        PHASE_BEGIN(10) moe_e2(F, lm); PHASE_END(10) \
        lprev = lm; \
        if (lh < MK_LAYERS) { \
         \
        PHASE_BEGIN(1) n1_phase(F, lh, true, ctxl, ctxl, false, colmajor); PHASE_END(1) \
        PHASE_BEGIN(11) hyena_inproj(F, it, ctxl); PHASE_END(11) \
        PHASE_BEGIN(12) hyena_fft(F, it, ctxl); PHASE_END(12) \
        PHASE_BEGIN(13) hyena_transpose(F, ctxl); PHASE_END(13) \
        PHASE_BEGIN(14) hyena_outproj(F, lh, it, ctxl, colmajor); PHASE_END(14) \
        PHASE_BEGIN(8) moe_route(F, lh, ctxl); PHASE_END(8) \
        PHASE_BEGIN(9) moe_e1(F, lh); PHASE_END(9) \
        PHASE_BEGIN(10) moe_e2(F, lh); PHASE_END(10) \
        lprev = lh; \
        } } }
    LAYER_PAIR(0)
    LAYER_PAIR(1)
    PHASE_BEGIN(15) final_phase(F, lprev >= 0, lprev, lprev < 0); PHASE_END(15)
#ifdef MK_PROBE_WG
    { unsigned long long* slot = (unsigned long long*)(F0.ws + WS_CTL) + 16;
      if (F0.bid == MK_PROBE_WG && F0.tid == 0) __hip_atomic_store(slot, tacc, __ATOMIC_RELAXED, __HIP_MEMORY_SCOPE_AGENT);
      xcd_barrier(bar, F0.wave * 64 + fresh_lane());
      { const unsigned long long tv = __hip_atomic_load(slot, __ATOMIC_RELAXED, __HIP_MEMORY_SCOPE_AGENT); tacc = ((unsigned long long)(unsigned)__builtin_amdgcn_readfirstlane((int)(tv >> 32)) << 32) | (unsigned)__builtin_amdgcn_readfirstlane((int)tv); } }
#endif
#ifdef MK_PROBE
    { const unsigned long long te = __builtin_amdgcn_s_memrealtime() + tacc * MK_PROBE_MULT; while (__builtin_amdgcn_s_memrealtime() < te) __builtin_amdgcn_s_sleep(8); }
#endif
}

extern "C" void kernel_launch(void* const* d_in, const int* in_sizes, int n_in, void* d_out, int out_size, void* d_ws, size_t ws_size, hipStream_t stream) {
    static int grid = 0;
    if (grid == 0) {
        if (n_in != 40 || out_size != SEQ * D || ws_size < WS_END) { fprintf(stderr, "kernel_launch: unexpected shapes (n_in %d out %d ws %zu)\n", n_in, out_size, ws_size); grid = -1; return; }
        int dev = 0, cus = 0, per_cu = 0;
        if (hipGetDevice(&dev) != hipSuccess || hipDeviceGetAttribute(&cus, hipDeviceAttributeMultiprocessorCount, dev) != hipSuccess) { grid = -1; return; }
        if (hipFuncSetAttribute((const void*)mk_fwd, hipFuncAttributeMaxDynamicSharedMemorySize, LDS_BYTES) != hipSuccess) { fprintf(stderr, "kernel_launch: hipFuncSetAttribute failed\n"); grid = -1; return; }
        if (hipOccupancyMaxActiveBlocksPerMultiprocessor(&per_cu, (const void*)mk_fwd, NT, LDS_BYTES) != hipSuccess || per_cu < 1) { fprintf(stderr, "kernel_launch: occupancy query says %d\n", per_cu); }
        (void)hipGetLastError();
        grid = cus;
        if (grid > 256) grid = 256;
        if (grid < 128) { fprintf(stderr, "kernel_launch: needs >= 128 CUs (got %d)\n", grid); grid = -1; return; }
    }
    if (grid < 0) return;
    (void)hipMemsetAsync((char*)d_ws + WS_CTL, 0, CTL_BYTES, stream);
    Args a{};
    for (int i = 0; i < 40; ++i) a.in[i] = (const float*)d_in[i];
    a.out = (float*)d_out; a.ws = (unsigned char*)d_ws;
#ifdef MK_SPLIT
    for (int p = 0; p < MK_SPLIT; ++p) { a.ph_lo = p; a.ph_hi = p + 1; hipLaunchKernelGGL(mk_fwd, dim3(grid), dim3(NT), LDS_BYTES, stream, a); }
#else
    a.ph_lo = 0; a.ph_hi = 1000;
    hipLaunchKernelGGL(mk_fwd, dim3(grid), dim3(NT), LDS_BYTES, stream, a);
#endif
}
```

```cpp
#include <hip/hip_runtime.h>
#include <cstdio>
#include <cstdint>

#define LAS __attribute__((address_space(3)))
#define GAS __attribute__((address_space(1)))
#define RLX_AGENT __ATOMIC_RELAXED, __HIP_MEMORY_SCOPE_AGENT
typedef unsigned short bf16_t;
typedef short bf16x8 __attribute__((ext_vector_type(8)));
typedef float f32x4 __attribute__((ext_vector_type(4)));
typedef float f32x2 __attribute__((ext_vector_type(2)));
typedef unsigned u32x4 __attribute__((ext_vector_type(4)));
typedef unsigned u32x2 __attribute__((ext_vector_type(2)));

constexpr int D = 1024, SEQ = 16384, CTXN = 256, LT = SEQ + CTXN;
constexpr int MI = 2048, MH = 4, DQK = 256, DV = 512, CH = 64, NCH = LT / CH;
constexpr int NEXP = 32, DE = 512, NASG = 2 * LT;
constexpr int HB = 16, HEMB = 33, HFH = 64;
constexpr float EPS = 1e-6f;
constexpr int NT = 512, NWAVES = 8;
constexpr int LDS_BYTES = 147456;

constexpr size_t MiB = 1u << 20;
constexpr size_t WS_CTL = 0, CTL_BYTES = 1 * MiB;
constexpr size_t WS_MODS = 4 * MiB;
constexpr size_t WS_WC = 5 * MiB;
constexpr size_t WS_Z2 = 6 * MiB;
constexpr size_t WS_Z2C = 10 * MiB;
constexpr size_t WS_SCAL = 11 * MiB;
constexpr size_t WS_CHS = 14 * MiB;
constexpr size_t WS_DENI = 15 * MiB;
constexpr size_t WS_LIST = 16 * MiB;
constexpr size_t WS_AW = 21 * MiB;
constexpr size_t WS_WGP = 26 * MiB;
constexpr size_t WS_FSC = 27 * MiB;
constexpr size_t WS_TWP = 28 * MiB;
constexpr size_t WS_GWT = 22 * MiB;
constexpr size_t WS_FILTC = 23 * MiB;
constexpr size_t WS_W3T = 25 * MiB;
constexpr size_t WS_WMIN = 32 * MiB;
constexpr size_t WS_WQ = 48 * MiB;
constexpr size_t WS_WK = 50 * MiB;
constexpr size_t WS_WV = 52 * MiB;
constexpr size_t WS_WMOUT = 56 * MiB;
constexpr size_t WS_WHIN = 64 * MiB;
constexpr size_t WS_WHOUT = 76 * MiB;
constexpr size_t WS_W13 = 96 * MiB;
constexpr size_t WS_W2 = 352 * MiB;
constexpr size_t WS_HL = 480 * MiB;
constexpr size_t WS_HC = 544 * MiB;
constexpr size_t WS_U = 546 * MiB;
constexpr size_t WS_VN = 580 * MiB;
constexpr size_t WS_YBUF = 614 * MiB;
constexpr size_t WS_H1 = 680 * MiB;
constexpr size_t WS_MIX = 722 * MiB;
constexpr size_t WS_XCM = WS_MIX;
constexpr size_t WS_OPRE = WS_MIX + 130 * MiB;
constexpr size_t WS_Q = WS_MIX + 195 * MiB;
constexpr size_t WS_KN = WS_MIX + 228 * MiB;
constexpr size_t WS_KT = WS_MIX + 261 * MiB;
constexpr size_t WS_VT = WS_MIX + 294 * MiB;
constexpr size_t WS_OINT = WS_MIX + 359 * MiB;
constexpr size_t WS_Y = WS_MIX + 495 * MiB;
constexpr size_t WS_ZT = WS_MIX;
constexpr size_t WS_FILT = WS_MIX + 98 * MiB;
constexpr size_t WS_Y2T = WS_MIX + 162 * MiB;
constexpr size_t WS_ZH = WS_MIX + 195 * MiB;
constexpr size_t WS_Y2 = WS_MIX + 259 * MiB;
constexpr size_t WS_VTS = WS_MIX + 560 * MiB;
constexpr size_t WS_FILT2 = WS_MIX + 696 * MiB;
constexpr size_t WS_ZHALL = WS_MIX + 760 * MiB;
constexpr size_t WS_END = WS_MIX + 1016 * MiB;

constexpr int CW_BAR = 4096;
constexpr int CW_CNT = 16384;
constexpr int CW_ERR = 8;

__device__ __forceinline__ float bf2f(bf16_t b) { return __uint_as_float(((unsigned)b) << 16); }
__device__ __forceinline__ unsigned pk2(float lo, float hi) { unsigned r; asm("v_cvt_pk_bf16_f32 %0, %1, %2" : "=v"(r) : "v"(lo), "v"(hi)); return r; }
__device__ __forceinline__ bf16_t f2bf(float f) { return (bf16_t)pk2(f, 0.f); }
__device__ __forceinline__ float bflo(unsigned w) { return __uint_as_float(w << 16); }
__device__ __forceinline__ float bfhi(unsigned w) { return __uint_as_float(w & 0xffff0000u); }
__device__ __forceinline__ float sigmf(float x) { return __builtin_amdgcn_rcpf(1.0f + __expf(-x)); }
__device__ __forceinline__ float siluf(float x) { return x * sigmf(x); }
#define LDS_BAR() do { asm volatile("s_waitcnt lgkmcnt(0)" ::: "memory"); __builtin_amdgcn_s_barrier(); asm volatile("" ::: "memory"); } while (0)
__device__ __forceinline__ int fresh_lane() { int l; asm volatile("v_mbcnt_lo_u32_b32 %0, -1, 0\n\tv_mbcnt_hi_u32_b32 %0, -1, %0" : "=v"(l)); return l; }
__device__ __forceinline__ float wave_sum(float v) {
#pragma unroll
    for (int o = 32; o > 0; o >>= 1) v += __shfl_xor(v, o);
    return v;
}
__device__ __forceinline__ float wave_max(float v) {
#pragma unroll
    for (int o = 32; o > 0; o >>= 1) v = fmaxf(v, __shfl_xor(v, o));
    return v;
}

#define XB_TMO      128
#define XB_XCNT(j)  (256  + 64 * (j))
#define XB_XSUB(j)  (1280 + 64 * (j))
#define XB_XGEN(j)  (2304 + 64 * (j))
#define XB_TOP      3328
#define XB_TOPGEN   3392
#define XCD_BAR_WORDS 3456
#define XB_SPIN_CAP (1u << 18)
__device__ __forceinline__ unsigned xb_ld(unsigned* p)              { return __hip_atomic_load(p, __ATOMIC_RELAXED, __HIP_MEMORY_SCOPE_AGENT); }
__device__ __forceinline__ unsigned xb_add(unsigned* p, unsigned v) { return __hip_atomic_fetch_add(p, v, __ATOMIC_RELAXED, __HIP_MEMORY_SCOPE_AGENT); }
__device__ __forceinline__ unsigned xb_xcc_id() { return (unsigned)__builtin_amdgcn_s_getreg((3 << 11) | 20) & 0xFu; }
#define XB_SPIN(cond, bar) do { unsigned _sp = 0; while (cond) { __builtin_amdgcn_s_sleep(1); \
    if ((++_sp & 255u) == 0u) { if (xb_ld(&(bar)[XB_TMO])) break; if (_sp > XB_SPIN_CAP) { atomicAdd(&(bar)[XB_TMO], 1u); break; } } } } while (0)
struct XcdBarrier { unsigned* bar; unsigned x; volatile LAS unsigned* st; };
__device__ __forceinline__ XcdBarrier xcd_barrier_post(unsigned* bar, volatile LAS unsigned* st, int tid) {
    XcdBarrier b; b.bar = bar; b.x = xb_xcc_id(); b.st = st;
    if (tid == 0) (void)xb_add(&bar[XB_XCNT(b.x)], 1u);
    return b;
}
__device__ __forceinline__ void xcd_barrier_complete(unsigned* bar, unsigned x, unsigned& nloc, unsigned& nx) {
    const unsigned G = gridDim.x * gridDim.y * gridDim.z;
    unsigned sum, cnt, mine, sp = 0u;
    for (;;) {
        sum = 0u; cnt = 0u; mine = 0u;
#pragma unroll
        for (unsigned j = 0; j < 16; ++j) { const unsigned c = xb_ld(&bar[XB_XCNT(j)]); sum += c; cnt += (c > 0u) ? 1u : 0u; mine = (j == x) ? c : mine; }
        if (sum == G) break;
        __builtin_amdgcn_s_sleep(1);
        if ((++sp & 255u) == 0u) { if (xb_ld(&bar[XB_TMO])) break; if (sp > XB_SPIN_CAP) { atomicAdd(&bar[XB_TMO], 1u); break; } }
    }
    nloc = mine > 0u ? mine : 1u; nx = cnt > 0u ? cnt : 1u;
}
__device__ __forceinline__ void xcd_barrier(const XcdBarrier& b, int tid) {
    asm volatile("s_waitcnt vmcnt(0)" ::: "memory");
    __syncthreads();
    if (tid == 0) {
        unsigned* bar = b.bar;
        __builtin_amdgcn_s_waitcnt(0);
        unsigned nloc = b.st[0], nx = b.st[1];
        if (nloc == 0u) { xcd_barrier_complete(bar, b.x, nloc, nx); b.st[0] = nloc; b.st[1] = nx; }
        const unsigned old = xb_add(&bar[XB_XSUB(b.x)], 1u);
        const unsigned gen = old / nloc;
        if (old + 1u == (gen + 1u) * nloc) {
            __builtin_amdgcn_fence(__ATOMIC_RELEASE, "agent");
            asm volatile("s_waitcnt vmcnt(0)" ::: "memory");
            const unsigned og = xb_add(&bar[XB_TOP], 1u);
            const unsigned tg = og / nx;
            if (og + 1u == (tg + 1u) * nx) xb_add(&bar[XB_TOPGEN], 1u);
            else XB_SPIN(xb_ld(&bar[XB_TOPGEN]) == tg, bar);
            __builtin_amdgcn_fence(__ATOMIC_ACQUIRE, "agent");
            xb_add(&bar[XB_XGEN(b.x)], 1u);
            asm volatile("s_waitcnt vmcnt(0)" ::: "memory");
        } else {
            XB_SPIN(xb_ld(&bar[XB_XGEN(b.x)]) == gen, bar);
            __builtin_amdgcn_fence(__ATOMIC_ACQUIRE, "agent");
            asm volatile("s_waitcnt vmcnt(0)" ::: "memory");
        }
    }
    __syncthreads();
}

namespace pg8 {
constexpr int BM = 256, BK = 64, HALF = 128, HTB = HALF * BK * 2, STAGE_BYTES = 8 * HTB;
__device__ __forceinline__ int lds_byte(int r, int c) { const int st = (r >> 4) * 2 + (c >> 5), rr = r & 15, cc = c & 31, ob = rr * 64 + cc * 2; return st * 1024 + (ob ^ (((ob >> 9) & 1) << 5)); }
__device__ __forceinline__ void stage_rc(int b, int& R, int& C) { const int st = b / 1024, sb = b % 1024, swz = sb ^ (((sb >> 9) & 1) << 5); R = (st >> 1) * 16 + swz / 64; C = (st & 1) * 32 + (swz % 64) / 2; }
__device__ __forceinline__ int perm32(int rho) { const int n = rho >> 4, i = rho & 15; return 8 * (i >> 2) + 4 * n + (i & 3); }

struct GUnit { const char* a; const char* b; char* o; int pm, pn, g, aux, lda, ldb, ldo, hsb, half; };

template <class Epi, class Sched, bool GATHER>
__device__ __forceinline__ void gemm_phase(LAS unsigned char* lds, const int K, const Sched& S, const Epi& E, int tid_in) {
    int tid_ = tid_in; asm volatile("" : "+v"(tid_));
    const int tid = tid_, wid = __builtin_amdgcn_readfirstlane(tid >> 6), lane = tid & 63, wr = wid >> 2, wc = wid & 3, fr = lane & 15, fq = lane >> 4;
    const int nt = K / BK;
    unsigned cvA0[2], cvA1[2], cvB[2];
#define PG8_OFFS(U, slot, vA0, vA1, vB) do { _Pragma("unroll") for (int i = 0; i < 2; ++i) { int R_, C_; stage_rc(tid * 16 + i * 8192, R_, C_); const int Rb_ = Epi::PERM ? ((R_ & ~31) + perm32(R_ & 31)) : R_; \
        if constexpr (GATHER) { vA0[i] = S.grow(slot, R_) + (unsigned)C_ * 2u; vA1[i] = S.grow(slot, R_ + HALF) + (unsigned)C_ * 2u; } \
        else { vA0[i] = (unsigned)(R_ * (U).lda + C_) * 2u; vA1[i] = (unsigned)((R_ + HALF) * (U).lda + C_) * 2u; } \
        vB[i] = (unsigned)(Rb_ * (U).ldb + C_) * 2u; } } while (0)
    const size_t kstep = (size_t)(BK * 2);
    const unsigned ldsw = (unsigned)wid * 1024u;
    const int aoff = lds_byte(wr * 64 + fr, fq * 8), boff = lds_byte(wc * 32 + fr, fq * 8);
#define PG8_SA(b, h) (((b) * 2 + (h)) * HTB)
#define PG8_SB(b, h) ((4 + (b) * 2 + (h)) * HTB)
#define PG8_STAGE(bufoff, gbase, voff) do { _Pragma("unroll") for (int _i = 0; _i < 2; ++_i) \
        __builtin_amdgcn_global_load_lds((const unsigned*)((const char*)(gbase) + (voff)[_i]), (LAS unsigned*)(lds + (bufoff) + ldsw + _i * 8192), 16, 0, 0); } while (0)
#define PG8_LDA(dst, b, h) do { _Pragma("unroll") for (int m = 0; m < 4; ++m) _Pragma("unroll") for (int k = 0; k < 2; ++k) dst[m][k] = *(const LAS bf16x8*)(lds + PG8_SA(b, h) + aoff + m * 2048 + k * 1024); } while (0)
#define PG8_LDB(dst, b, h) do { _Pragma("unroll") for (int n = 0; n < 2; ++n) _Pragma("unroll") for (int k = 0; k < 2; ++k) dst[n][k] = *(const LAS bf16x8*)(lds + PG8_SB(b, h) + boff + n * 2048 + k * 1024); } while (0)
#define PG8_MMA(ai, bj, At, Bt) do { __builtin_amdgcn_s_setprio(1); _Pragma("unroll") for (int m = 0; m < 4; ++m) _Pragma("unroll") for (int n = 0; n < 2; ++n) _Pragma("unroll") for (int k = 0; k < 2; ++k) \
        acc[ai][bj][m][n] = __builtin_amdgcn_mfma_f32_16x16x32_bf16(Bt[n][k], At[m][k], acc[ai][bj][m][n], 0, 0, 0); __builtin_amdgcn_s_setprio(0); } while (0)
#define PG8_WAIT_V(n) asm volatile("s_waitcnt vmcnt(" #n ")" ::: "memory")
#define PG8_WAIT_L(n) asm volatile("s_waitcnt lgkmcnt(" #n ")" ::: "memory")
#define PG8_BAR __builtin_amdgcn_s_barrier()
#define PG8_SCHED __builtin_amdgcn_sched_barrier(0)
    GUnit cur, nxt; int ui = 0;
    if (!S.next(0, cur)) return;
    PG8_OFFS(cur, 0, cvA0, cvA1, cvB);
    size_t chB = (size_t)cur.hsb * cur.ldb * 2;
    f32x4 acc[2][2][4][2];
#pragma unroll
    for (int a = 0; a < 2; ++a)
#pragma unroll
        for (int b = 0; b < 2; ++b)
#pragma unroll
            for (int m = 0; m < 4; ++m)
#pragma unroll
                for (int n = 0; n < 2; ++n) acc[a][b][m][n] = (f32x4){0.f, 0.f, 0.f, 0.f};
    bf16x8 At[4][2], B0[2][2], B1[2][2];
    const char* cA = cur.a; const char* cB = cur.b;
    PG8_STAGE(PG8_SB(0, 0), cB, cvB); PG8_STAGE(PG8_SA(0, 0), cA, cvA0); PG8_STAGE(PG8_SB(0, 1), cB + chB, cvB); PG8_STAGE(PG8_SA(0, 1), cA, cvA1);
    if (wr == 1) PG8_BAR;
    PG8_WAIT_V(4); PG8_BAR;
    PG8_STAGE(PG8_SB(1, 0), cB + kstep, cvB); PG8_STAGE(PG8_SA(1, 0), cA + kstep, cvA0); PG8_STAGE(PG8_SB(1, 1), cB + chB + kstep, cvB);
    PG8_WAIT_V(6); PG8_BAR;
    for (;;) {
        const bool has_next = S.next(ui + 1, nxt);
        const char* nA = has_next ? nxt.a : cA; const char* nB = has_next ? nxt.b : cB;
        for (int t = 0; t < nt; t += 2) {
            const bool last = (t == nt - 2);
            const char* a1 = cA + (size_t)(t + 1) * kstep;
            const char* a2 = last ? nA : cA + (size_t)(t + 2) * kstep; const char* b2 = last ? nB : cB + (size_t)(t + 2) * kstep;
            const char* a3 = a2 + kstep; const char* b3 = b2 + kstep;
            PG8_LDB(B0, 0, 0); PG8_SCHED; PG8_LDA(At, 0, 0); PG8_STAGE(PG8_SA(1, 1), a1, cvA1);
            PG8_WAIT_L(8); PG8_BAR; PG8_WAIT_L(0); PG8_MMA(0, 0, At, B0); PG8_BAR; PG8_SCHED;
            if (last && has_next) { PG8_OFFS(nxt, ui + 1, cvA0, cvA1, cvB); chB = (size_t)nxt.hsb * nxt.ldb * 2; }
            PG8_LDB(B1, 0, 1); PG8_STAGE(PG8_SB(0, 0), b2, cvB);
            PG8_BAR; PG8_WAIT_L(0); PG8_MMA(0, 1, At, B1); PG8_BAR;
            PG8_LDA(At, 0, 1); PG8_STAGE(PG8_SA(0, 0), a2, cvA0);
            PG8_BAR; PG8_WAIT_L(0); PG8_MMA(1, 0, At, B0); PG8_BAR; PG8_SCHED;
            PG8_STAGE(PG8_SB(0, 1), b2 + chB, cvB);
            PG8_WAIT_V(6); PG8_BAR; PG8_MMA(1, 1, At, B1); PG8_BAR;
            PG8_LDB(B0, 1, 0); PG8_SCHED; PG8_LDA(At, 1, 0); PG8_STAGE(PG8_SA(0, 1), a2, cvA1);
            PG8_WAIT_L(8); PG8_BAR; PG8_WAIT_L(0); PG8_MMA(0, 0, At, B0); PG8_BAR; PG8_SCHED;
            PG8_LDB(B1, 1, 1); PG8_STAGE(PG8_SB(1, 0), b3, cvB);
            PG8_BAR; PG8_WAIT_L(0); PG8_MMA(0, 1, At, B1); PG8_BAR;
            PG8_LDA(At, 1, 1); PG8_STAGE(PG8_SA(1, 0), a3, cvA0);
            PG8_BAR; PG8_WAIT_L(0); PG8_MMA(1, 0, At, B0); PG8_BAR; PG8_SCHED;
            PG8_STAGE(PG8_SB(1, 1), b3 + chB, cvB);
            PG8_WAIT_V(6); PG8_BAR; PG8_MMA(1, 1, At, B1); PG8_BAR;
        }
        E(acc, cur, wr, wc, fr, fq);
        if (!has_next) break;
#pragma unroll
        for (int a = 0; a < 2; ++a)
#pragma unroll
            for (int b = 0; b < 2; ++b)
#pragma unroll
                for (int m = 0; m < 4; ++m)
#pragma unroll
                    for (int n = 0; n < 2; ++n) acc[a][b][m][n] = (f32x4){0.f, 0.f, 0.f, 0.f};
        cur = nxt; cA = nA; cB = nB; ++ui;
    }
    PG8_WAIT_V(0);
    if (wr == 0) PG8_BAR;
    PG8_BAR;
#undef PG8_OFFS
#undef PG8_SA
#undef PG8_SB
#undef PG8_STAGE
#undef PG8_LDA
#undef PG8_LDB
#undef PG8_MMA
#undef PG8_WAIT_V
#undef PG8_WAIT_L
#undef PG8_BAR
#undef PG8_SCHED
}

__device__ __forceinline__ int xcd_remap(int wgid, int nwg) { const int q = nwg / 8, r = nwg % 8, xcd = wgid % 8, off = wgid / 8; return (xcd < r ? xcd * (q + 1) : r * (q + 1) + (xcd - r) * q) + off; }
}
using pg8::GUnit;

struct Args { const float* in[40]; float* out; unsigned char* ws; int ph_lo, ph_hi; };
struct Frame {
    LAS unsigned char* lds; unsigned char* ws; const float* const* in; float* out;
    int tid, lane, wave, G, bid;
};
struct Prob { const char* A; const char* B; char* O; long long sA, sB, sO;
              int nM, nN, nb, ustart; int lda, ldb, ldo; int osz; };
constexpr int SCHED_TAB = 131072 + 8192;
__device__ __forceinline__ int rfl(int v) { return __builtin_amdgcn_readfirstlane(v); }
__device__ __forceinline__ const char* rflp(const char* p) { const unsigned long long v = (unsigned long long)p; return (const char*)(((unsigned long long)(unsigned)rfl((int)(v >> 32)) << 32) | (unsigned)rfl((int)v)); }
template <int NP> struct MultiSched {
    LAS Prob* p; int total, G, c;
    __device__ __forceinline__ void init(const Frame& F, const Prob (&q)[NP], int total_) {
        p = (LAS Prob*)(F.lds + SCHED_TAB); total = total_; G = F.G; c = F.bid;
        __syncthreads();
        if (F.tid == 0) {
#pragma unroll
            for (int j = 0; j < NP; ++j) { p[j].A = q[j].A; p[j].B = q[j].B; p[j].O = q[j].O; p[j].sA = q[j].sA; p[j].sB = q[j].sB; p[j].sO = q[j].sO; p[j].nM = q[j].nM; p[j].nN = q[j].nN; p[j].nb = q[j].nb;
                p[j].ustart = q[j].ustart; p[j].lda = q[j].lda; p[j].ldb = q[j].ldb; p[j].ldo = q[j].ldo; p[j].osz = q[j].osz; } }
        __syncthreads();
    }
    __device__ __forceinline__ bool next(int i, GUnit& u) const {
        const long long Lq = (long long)i * G + c; if (Lq >= total) return false;
        int L = pg8::xcd_remap((int)Lq, total);
        int k = 0;
#pragma unroll
        for (int j = 1; j < NP; ++j) if (L >= p[j].ustart) k = j;
        k = rfl(k);
        const LAS Prob& q = p[k];
        const int nM = rfl(q.nM), nN = rfl(q.nN), lda = rfl(q.lda), ldb = rfl(q.ldb), ldo = rfl(q.ldo), osz = rfl(q.osz);
        L -= rfl(q.ustart);
        const int per = nM * nN, b = L / per, r = L - b * per, pm = r / nN, pn = r - pm * nN;
        u.pm = pm; u.pn = pn; u.g = b; u.aux = k; u.lda = lda; u.ldb = ldb; u.ldo = ldo; u.hsb = 128; u.half = 0;
        u.a = rflp(q.A) + b * (long long)rfl((int)q.sA) + (size_t)pm * 256 * lda * 2;
        u.b = rflp(q.B) + b * (long long)rfl((int)q.sB) + (size_t)pn * 256 * ldb * 2;
        u.o = (char*)rflp(q.O) + b * (long long)rfl((int)q.sO) + ((size_t)pm * 256 * ldo + (size_t)pn * 256) * osz;
        return true;
    }
};

struct EpiStore {
    static constexpr bool PERM = true;
    const float* rowbias;
    const float* wgp; bf16_t* vts;
    int fragmode;
    __device__ __forceinline__ void operator()(const f32x4 (&acc)[2][2][4][2], const GUnit& u, int wr, int wc, int fr, int fq) const {
        bf16_t* base = (bf16_t*)u.o;
#pragma unroll
        for (int ai = 0; ai < 2; ++ai)
#pragma unroll
            for (int m = 0; m < 4; ++m) { const int r = ai * 128 + wr * 64 + m * 16 + fr;
                const float rb = rowbias ? rowbias[u.pm * 256 + r] : 0.f;
#pragma unroll
                for (int bj = 0; bj < 2; ++bj) { const f32x4 v0 = acc[ai][bj][m][0] + rb, v1 = acc[ai][bj][m][1] + rb;
                    u32x4 w; w.x = pk2(v0[0], v0[1]); w.y = pk2(v0[2], v0[3]); w.z = pk2(v1[0], v1[1]); w.w = pk2(v1[2], v1[3]);
                    const int c = bj * 128 + wc * 32 + 8 * fq;
                    unsigned off;
                    if (fragmode == 0) off = (unsigned)(r * u.ldo + c);
                    else if (u.aux < 2) { const int R = u.pm * 256 + r; off = (unsigned)((((R >> 4) * 8 + (c >> 5)) * 64 + (R & 15) + 16 * fq) * 8); }
                    else { const int R = u.pm * 256 + r, s = u.pn * 256 + c, nrt = (u.aux == 2) ? 16 : 32;
                           off = (unsigned)(((((s >> 6) * nrt + (R >> 4)) * 2 + ((s >> 5) & 1)) * 64 + (R & 15) + 16 * fq) * 8); }
                    *(u32x4*)(base + off) = w; } }
        if (vts != nullptr && u.aux == 3) {
#pragma unroll 1
            for (int dir = 0; dir < 2; ++dir) { const int ch = dir * 4 + u.g;
                bf16_t* ob = vts + (size_t)ch * NCH * 33 * 1024;
#pragma unroll
                for (int bj = 0; bj < 2; ++bj) { const int c = bj * 128 + wc * 32 + 8 * fq, s = u.pn * 256 + c;
                    const f32x4 g0 = *(const f32x4*)(wgp + (size_t)ch * LT + s), g1 = *(const f32x4*)(wgp + (size_t)ch * LT + s + 4);
#pragma unroll
                    for (int ai = 0; ai < 2; ++ai)
#pragma unroll
                        for (int m = 0; m < 4; ++m) { const int R = u.pm * 256 + ai * 128 + wr * 64 + m * 16 + fr; const f32x4 v0 = acc[ai][bj][m][0] * g0, v1 = acc[ai][bj][m][1] * g1;
                            u32x4 w; w.x = pk2(v0[0], v0[1]); w.y = pk2(v0[2], v0[3]); w.z = pk2(v1[0], v1[1]); w.w = pk2(v1[2], v1[3]);
                            *(u32x4*)(ob + (unsigned)(((((s >> 6) * 33 + (R >> 4)) * 2 + ((s >> 5) & 1)) * 64 + (R & 15) + 16 * fq) * 8)) = w; }
                    asm volatile("" ::: "memory"); } }
        }
    }
};

enum { I_X = 0, I_C, I_CTX, I_CCTX, I_ADAW, I_ADAB, I_N1G, I_N2G, I_RGW, I_RGB, I_REW, I_REB, I_W13, I_W2,
       I_MINW, I_MCONVW, I_MCONVB, I_MQW, I_MKW, I_MVW, I_MGATEW, I_MGATEB, I_MNORMG, I_MSKIP, I_MOUTW,
       I_HINW, I_HINB, I_HSCW, I_HSCB, I_HFW1, I_HFB1, I_HFFREQ, I_HFW2, I_HFB2, I_HFW3, I_HDECAY, I_HFBIAS, I_HOUTW, I_HOUTB, I_FINALG };

__device__ __forceinline__ void tconv(const Frame& F, const float* src, bf16_t* dst, int B, int R, int C, float scale, int vbid, int vG) {
    LAS float* tile = (LAS float*)F.lds;
    const int tr = R / 64, tc = C / 64, ntile = B * tr * tc;
    for (int t = vbid; t < ntile; t += vG) {
        const int b = t / (tr * tc), rem = t - b * tr * tc, r0 = (rem / tc) * 64, c0 = (rem % tc) * 64;
        const float* s = src + ((size_t)b * R + r0) * C + c0;
        { const int r = F.tid >> 3, c8 = (F.tid & 7) * 8;
          const f32x4 v0 = *(const f32x4*)(s + (size_t)r * C + c8), v1 = *(const f32x4*)(s + (size_t)r * C + c8 + 4);
#pragma unroll
          for (int j = 0; j < 4; ++j) { tile[r * 65 + c8 + j] = v0[j]; tile[r * 65 + c8 + 4 + j] = v1[j]; } }
        LDS_BAR();
        { const int n = F.tid >> 3, k8 = (F.tid & 7) * 8; float v[8];
#pragma unroll
          for (int j = 0; j < 8; ++j) v[j] = tile[(k8 + j) * 65 + n] * scale;
          u32x4 w; w.x = pk2(v[0], v[1]); w.y = pk2(v[2], v[3]); w.z = pk2(v[4], v[5]); w.w = pk2(v[6], v[7]);
          *(u32x4*)(dst + ((size_t)b * C + c0 + n) * R + r0 + k8) = w; }
        LDS_BAR();
    }
}

__device__ __forceinline__ void adaln_units(const Frame& F, int u_lo, int u_hi, int vbid, int vG) {
    unsigned char* ws = F.ws;
    {
        LAS float* sv = (LAS float*)F.lds;
        LAS float* pr = sv + 2048;
        __syncthreads();
        for (int i = F.tid; i < 2048; i += NT) sv[i] = siluf(i < 1024 ? F.in[I_C][i] : F.in[I_CCTX][i - 1024]);
        __syncthreads();
        const int cl = F.tid & 63, kg = F.tid >> 6;
        for (int u = u_lo + vbid; u < u_hi; u += vG) {
            const int l = u / 96, col = (u % 96) * 64 + cl;
            const float* w = F.in[I_ADAW] + ((size_t)l * 1024 + kg * 128) * 6144 + col;
            float a0 = 0.f, a1 = 0.f;
#pragma unroll 16
            for (int k = 0; k < 128; ++k) { const float wv = w[(size_t)k * 6144]; a0 += sv[kg * 128 + k] * wv; a1 += sv[1024 + kg * 128 + k] * wv; }
            pr[(kg * 2 + 0) * 64 + cl] = a0; pr[(kg * 2 + 1) * 64 + cl] = a1;
            __syncthreads();
            if (F.tid < 128) { const int s2 = F.tid >> 6; float a = F.in[I_ADAB][l * 6144 + col];
#pragma unroll
                for (int g = 0; g < 8; ++g) a += pr[(g * 2 + s2) * 64 + cl];
                ((float*)(ws + WS_MODS))[(size_t)(l * 2 + s2) * 6144 + col] = a; }
            __syncthreads();
        }
    }
}
__device__ __forceinline__ void mlstm_wconv(const Frame& F, int slot, int vbid, int vG) {
    unsigned char* ws = F.ws;
    tconv(F, F.in[I_MINW] + (size_t)slot * 1024 * 4096, (bf16_t*)(ws + WS_WMIN) + (size_t)slot * 1024 * 4096, 1, 1024, 4096, 1.f, vbid, vG);
    tconv(F, F.in[I_MQW] + (size_t)slot * 4 * 512 * 256, (bf16_t*)(ws + WS_WQ) + (size_t)slot * 4 * 512 * 256, 4, 512, 256, 1.f, vbid, vG);
    tconv(F, F.in[I_MKW] + (size_t)slot * 4 * 512 * 256, (bf16_t*)(ws + WS_WK) + (size_t)slot * 4 * 512 * 256, 4, 512, 256, 0.0625f, vbid, vG);
    tconv(F, F.in[I_MVW] + (size_t)slot * 4 * 512 * 512, (bf16_t*)(ws + WS_WV) + (size_t)slot * 4 * 512 * 512, 4, 512, 512, 1.f, vbid, vG);
}
__device__ __forceinline__ void z2_rows(const Frame& F, int row_lo, int row_hi, int vbid, int vG);

__device__ __forceinline__ void p0_prologue(const Frame& F) {
    unsigned char* ws = F.ws;
    adaln_units(F, 0, 96, F.bid, F.G);
    mlstm_wconv(F, 0, F.bid, F.G);
    tconv(F, F.in[I_HFW3], (bf16_t*)(ws + WS_W3T), 1, 64, 2048, 1.f, F.bid, F.G);
    for (int ci = F.bid * NT + F.tid; ci < 8192; ci += F.G * NT) { const int k = (ci >> 9) + 16 * ((ci >> 4) & 31) + 512 * (ci & 15);
        float sn, cs; sincospif((float)k * (1.0f / 16384.0f), &sn, &cs); ((f32x2*)(ws + WS_TWP))[ci] = (f32x2){cs, -sn}; }
    const int gt = F.bid * NT + F.tid, gs = F.G * NT;
    for (int i = gt; i < 2 * 16 * 4096; i += gs) { const int s = i / 65536, r = i % 65536, n = r / 4096, k = r % 4096;
        ((bf16_t*)(ws + WS_GWT))[i] = f2bf(F.in[I_MGATEW][((size_t)s * 4096 + k) * 16 + n]); }
    for (int i = gt; i < 4 * 1024 * 48; i += gs) { const int l = i / 49152, r = i % 49152, k = r / 48, n = r % 48;
        float v = 0.f; if (n < 4) v = F.in[I_RGW][((size_t)l * 1024 + k) * 4 + n]; else if (n < 36) v = F.in[I_REW][((size_t)l * 1024 + k) * 32 + (n - 4)];
        ((float*)(ws + WS_WC))[i] = v; }
    z2_rows(F, 0, SEQ, F.bid, F.G);
    z2_rows(F, 2 * SEQ, 2 * SEQ + CTXN, F.bid, F.G);
}
__device__ __forceinline__ void z2_rows(const Frame& F, int row_lo, int row_hi, int vbid, int vG) {
    unsigned char* ws = F.ws;
    {
        LAS float* ft = (LAS float*)F.lds;
        LAS float* z1 = ft + 8 * 36;
        for (int r0 = row_lo + vbid * 8; r0 < row_hi; r0 += vG * 8) {
            const int rr = F.tid >> 6, j = F.tid & 63, row = r0 + rr;
            int slot, t, Ln; if (row < 2 * SEQ) { slot = row / SEQ; t = row % SEQ; Ln = SEQ; } else { slot = 0; t = row - 2 * SEQ; Ln = CTXN; }
            __syncthreads();
            if (j < 33) { float f;
                if (j == 0) f = (float)t / (float)(Ln - 1);
                else { const int b = (j - 1) % 16 + 1; const int ph = (t * b) % Ln; const float a = (float)ph / (float)Ln;
                       f = (j <= 16) ? cosf(6.283185307179586f * a) : sinf(6.283185307179586f * a); }
                ft[rr * 36 + j] = f; }
            __syncthreads();
            const float fr = F.in[I_HFFREQ][slot * 64 + j];
            { float a = F.in[I_HFB1][slot * 64 + j]; const float* w1 = F.in[I_HFW1] + (size_t)slot * 33 * 64 + j;
#pragma unroll
              for (int k = 0; k < 33; ++k) a += ft[rr * 36 + k] * w1[k * 64];
              z1[rr * 64 + j] = sinf(fr * a); }
            __syncthreads();
            { float a = F.in[I_HFB2][slot * 64 + j]; const float* w2 = F.in[I_HFW2] + (size_t)slot * 64 * 64 + j;
#pragma unroll 8
              for (int k = 0; k < 64; ++k) a += z1[rr * 64 + k] * w2[k * 64];
              const float z = sinf(fr * a);
              bf16_t* dst = (row < 2 * SEQ) ? (bf16_t*)(ws + WS_Z2) + (size_t)row * 64 : (bf16_t*)(ws + WS_Z2C) + (size_t)t * 64;
              dst[j] = f2bf(z); }
        }
        __syncthreads();
    }
}

__device__ __forceinline__ void deferred_convert(const Frame& F, int part, int vbid, int vG) {
    unsigned char* ws = F.ws;
    if (part == 0) {
        tconv(F, F.in[I_MOUTW], (bf16_t*)(ws + WS_WMOUT), 2, 2048, 1024, 1.f, vbid, vG);
        adaln_units(F, 96, 4 * 96, vbid, vG);
        mlstm_wconv(F, 1, vbid, vG);
        tconv(F, F.in[I_HFW3] + (size_t)64 * 2048, (bf16_t*)(ws + WS_W3T) + (size_t)64 * 2048, 1, 64, 2048, 1.f, vbid, vG);
        z2_rows(F, SEQ, 2 * SEQ, vbid, vG);
        tconv(F, F.in[I_HINW], (bf16_t*)(ws + WS_WHIN), 2, 1024, 3072, 1.f, vbid, vG);
        tconv(F, F.in[I_HOUTW], (bf16_t*)(ws + WS_WHOUT), 2, 1024, 1024, 1.f, vbid, vG);
    }
    tconv(F, F.in[I_W13] + (size_t)part * 64 * 1024 * 1024, (bf16_t*)(ws + WS_W13) + (size_t)part * 64 * 1024 * 1024, 64, 1024, 1024, 1.f, vbid, vG);
    tconv(F, F.in[I_W2] + (size_t)part * 64 * 512 * 1024, (bf16_t*)(ws + WS_W2) + (size_t)part * 64 * 512 * 1024, 64, 512, 1024, 1.f, vbid, vG);
}

__device__ __forceinline__ const float* modp(const Frame& F, int l, int s, int piece) { return (const float*)(F.ws + WS_MODS) + ((size_t)(l * 2 + s) * 6 + piece) * 1024; }
__device__ __forceinline__ int scan_pos(int t, bool colmajor) { return colmajor ? ((t & 63) * 256 + (t >> 6)) : t; }
__device__ __forceinline__ int scan_inv(int p, bool colmajor) { return colmajor ? ((p & 255) * 64 + (p >> 8)) : p; }

__device__ __forceinline__ void n1_phase(const Frame& F, int l, bool comb, bool ctx_rows, bool comb_ctx, bool first, bool colmajor) {
    float* HL = (float*)(F.ws + WS_HL); float* HC = (float*)(F.ws + WS_HC); bf16_t* U = (bf16_t*)(F.ws + WS_U);
    const bf16_t* YB = (const bf16_t*)(F.ws + WS_YBUF);
    const float* g1n = F.in[I_N1G] + l * 1024;
    const int nrows = SEQ + (ctx_rows ? CTXN : 0);
    f32x4 hg2[4], hga[4], hsh[4];
#pragma unroll
    for (int j = 0; j < 4; ++j) { const int c = j * 256 + F.lane * 4; const f32x4 g = *(const f32x4*)(g1n + c), a = *(const f32x4*)(modp(F, l, 0, 1) + c);
        hga[j] = g * (a + 1.0f); hsh[j] = *(const f32x4*)(modp(F, l, 0, 0) + c); hg2[j] = comb ? *(const f32x4*)(modp(F, l - 1, 0, 5) + c) : (f32x4){0.f, 0.f, 0.f, 0.f}; }
    for (int r0 = (F.bid * NWAVES + F.wave) * 2; r0 < nrows; r0 += F.G * NWAVES * 2) {
        f32x4 v[2][4]; float ss[2] = {0.f, 0.f};
        u32x2 y0[2][4], y1[2][4];
#pragma unroll
        for (int q = 0; q < 2; ++q) { const int r = r0 + q; const bool isctx = r >= SEQ; const int t = isctx ? r - SEQ : r;
            const float* src = first ? (isctx ? F.in[I_CTX] : F.in[I_X]) + (size_t)t * 1024 : (isctx ? HC : HL) + (size_t)t * 1024;
            const bool docomb = comb && (!isctx || comb_ctx); const int tok = isctx ? t : CTXN + t;
#pragma unroll
            for (int j = 0; j < 4; ++j) { const int c = j * 256 + F.lane * 4; v[q][j] = *(const f32x4*)(src + c);
                if (docomb) { y0[q][j] = *(const u32x2*)(YB + ((size_t)tok * 2 + 0) * 1024 + c); y1[q][j] = *(const u32x2*)(YB + ((size_t)tok * 2 + 1) * 1024 + c); } } }
#pragma unroll
        for (int q = 0; q < 2; ++q) { const int r = r0 + q; const bool isctx = r >= SEQ; const int t = isctx ? r - SEQ : r; const int s = isctx ? 1 : 0;
            float* dsth = (isctx ? HC : HL) + (size_t)t * 1024;
            const bool docomb = comb && (!isctx || comb_ctx);
            const float* g2 = docomb ? modp(F, l - 1, s, 5) : nullptr;
#pragma unroll
            for (int j = 0; j < 4; ++j) { const int c = j * 256 + F.lane * 4;
                if (docomb) { const f32x4 g = isctx ? *(const f32x4*)(g2 + c) : hg2[j];
                    v[q][j][0] += g[0] * (bflo(y0[q][j].x) + bflo(y1[q][j].x)); v[q][j][1] += g[1] * (bfhi(y0[q][j].x) + bfhi(y1[q][j].x)); v[q][j][2] += g[2] * (bflo(y0[q][j].y) + bflo(y1[q][j].y)); v[q][j][3] += g[3] * (bfhi(y0[q][j].y) + bfhi(y1[q][j].y)); }
                if (docomb || first) *(f32x4*)(dsth + c) = v[q][j];
                ss[q] += v[q][j][0] * v[q][j][0] + v[q][j][1] * v[q][j][1] + v[q][j][2] * v[q][j][2] + v[q][j][3] * v[q][j][3]; }
            ss[q] = wave_sum(ss[q]); }
#pragma unroll
        for (int q = 0; q < 2; ++q) { const int r = r0 + q; const bool isctx = r >= SEQ; const int t = isctx ? r - SEQ : r; const int s = isctx ? 1 : 0;
            const float* sh = modp(F, l, s, 0); const float* sc = modp(F, l, s, 1);
            const float rstd = rsqrtf(ss[q] * (1.0f / 1024.0f) + EPS);
            const int urow = isctx ? t : CTXN + scan_pos(t, colmajor);
#pragma unroll
            for (int j = 0; j < 4; ++j) { const int c = j * 256 + F.lane * 4;
                f32x4 ga, b;
                if (isctx) { const f32x4 g = *(const f32x4*)(g1n + c), a = *(const f32x4*)(sc + c); ga = g * (a + 1.0f); b = *(const f32x4*)(sh + c); } else { ga = hga[j]; b = hsh[j]; }
                float o[4];
#pragma unroll
                for (int e = 0; e < 4; ++e) o[e] = v[q][j][e] * rstd * ga[e] + b[e];
                u32x2 w; w.x = pk2(o[0], o[1]); w.y = pk2(o[2], o[3]); *(u32x2*)(U + (size_t)urow * 1024 + c) = w; } }
    }
}

__device__ __forceinline__ void final_phase(const Frame& F, bool comb, int lprev, bool first) {
    const float* HL = (const float*)(F.ws + WS_HL); const bf16_t* YB = (const bf16_t*)(F.ws + WS_YBUF); const float* fg = F.in[I_FINALG];
    const float* g2 = comb ? modp(F, lprev, 0, 5) : nullptr;
    for (int t0 = (F.bid * NWAVES + F.wave) * 2; t0 < SEQ; t0 += F.G * NWAVES * 2) {
        f32x4 v[2][4]; u32x2 y0[2][4], y1[2][4]; float ss[2] = {0.f, 0.f};
#pragma unroll
        for (int q = 0; q < 2; ++q) { const int t = t0 + q; const float* src = (first ? F.in[I_X] : HL) + (size_t)t * 1024; const int tok = CTXN + t;
#pragma unroll
            for (int j = 0; j < 4; ++j) { const int c = j * 256 + F.lane * 4; v[q][j] = *(const f32x4*)(src + c);
                if (comb) { y0[q][j] = *(const u32x2*)(YB + ((size_t)tok * 2 + 0) * 1024 + c); y1[q][j] = *(const u32x2*)(YB + ((size_t)tok * 2 + 1) * 1024 + c); } } }
#pragma unroll
        for (int q = 0; q < 2; ++q) {
#pragma unroll
            for (int j = 0; j < 4; ++j) { const int c = j * 256 + F.lane * 4;
                if (comb) { const f32x4 g = *(const f32x4*)(g2 + c);
                    v[q][j][0] += g[0] * (bflo(y0[q][j].x) + bflo(y1[q][j].x)); v[q][j][1] += g[1] * (bfhi(y0[q][j].x) + bfhi(y1[q][j].x)); v[q][j][2] += g[2] * (bflo(y0[q][j].y) + bflo(y1[q][j].y)); v[q][j][3] += g[3] * (bfhi(y0[q][j].y) + bfhi(y1[q][j].y)); }
                ss[q] += v[q][j][0] * v[q][j][0] + v[q][j][1] * v[q][j][1] + v[q][j][2] * v[q][j][2] + v[q][j][3] * v[q][j][3]; }
            ss[q] = wave_sum(ss[q]); }
#pragma unroll
        for (int q = 0; q < 2; ++q) { const int t = t0 + q; const float rstd = rsqrtf(ss[q] * (1.0f / 1024.0f) + EPS);
#pragma unroll
            for (int j = 0; j < 4; ++j) { const int c = j * 256 + F.lane * 4; const f32x4 g = *(const f32x4*)(fg + c);
                f32x4 o;
#pragma unroll
                for (int e = 0; e < 4; ++e) o[e] = v[q][j][e] * rstd * g[e];
                *(f32x4*)(F.out + (size_t)t * 1024 + c) = o; } }
    }
}

__device__ __forceinline__ void hyena_filter_fft(const Frame& F, int vbid, int vG);
__device__ __forceinline__ float* scal_arr(const Frame& F, int k, int ch) { return (float*)(F.ws + WS_SCAL) + ((size_t)k * 8 + ch) * LT; }
__device__ __forceinline__ float* chs_arr(const Frame& F, int k, int ch) { return (float*)(F.ws + WS_CHS) + ((size_t)k * 8 + ch) * NCH; }
__device__ __forceinline__ bf16x8 bload16(__amdgpu_buffer_rsrc_t r, unsigned voff, unsigned soff) { const u32x4 x = __builtin_amdgcn_raw_buffer_load_b128(r, voff, soff, 0); return __builtin_bit_cast(bf16x8, x); }
__device__ __forceinline__ float logsigf(float x) { return fminf(x, 0.f) - log1pf(__expf(-fabsf(x))); }

__device__ __forceinline__ void mlstm_inproj(const Frame& F, int slot) {
    MultiSched<2> S; Prob pr[2];
    const char* W = (const char*)(F.ws + WS_WMIN) + (size_t)slot * 4096 * 1024 * 2;
    pr[0] = Prob{(const char*)(F.ws + WS_U), W, (char*)(F.ws + WS_XCM) + (size_t)4 * LT * 512 * 2, 0, 512 * 1024 * 2, (long long)LT * 512 * 2, NCH / 4, 2, 4, 0, 1024, 1024, 512, 2};
    pr[1] = Prob{(const char*)(F.ws + WS_U), W + (size_t)2048 * 1024 * 2, (char*)(F.ws + WS_OPRE), 0, 0, 0, NCH / 4, 8, 1, 65 * 8, 1024, 1024, 2048, 2};
    S.init(F, pr, 65 * 16);
    EpiStore E{nullptr, nullptr, nullptr, 0};
    pg8::gemm_phase<EpiStore, MultiSched<2>, false>(F.lds, 1024, S, E, F.tid);
}

__device__ __forceinline__ void mlstm_conv_gates(const Frame& F, int slot) {
    constexpr int TP = 4096 + 8;
    LAS bf16_t* tile = (LAS bf16_t*)F.lds;
    LAS float* part = (LAS float*)(F.lds + 16 * TP * 2);
    LAS float* gl = part + 8 * 256;
    bf16_t* XCp = (bf16_t*)(F.ws + WS_XCM) + (size_t)(F.tid >> 7) * LT * 512 + (F.tid & 127) * 4;
    const bf16_t* XMp = XCp + (size_t)4 * LT * 512;
    const bf16_t* GWT = (const bf16_t*)(F.ws + WS_GWT) + (size_t)slot * 16 * 4096;
    const int c4 = F.tid * 4;
    float cw[3][4], cb[4];
#pragma unroll
    for (int k = 0; k < 3; ++k) { const f32x4 w = *(const f32x4*)(F.in[I_MCONVW] + ((size_t)slot * 3 + k) * 2048 + c4); cw[k][0] = w[0]; cw[k][1] = w[1]; cw[k][2] = w[2]; cw[k][3] = w[3]; }
    { const f32x4 b = *(const f32x4*)(F.in[I_MCONVB] + (size_t)slot * 2048 + c4); cb[0] = b[0]; cb[1] = b[1]; cb[2] = b[2]; cb[3] = b[3]; }
    const int fr = F.lane & 15, fq = F.lane >> 4;
    bf16x8 gw[16];
#pragma unroll
    for (int kk = 0; kk < 16; ++kk) gw[kk] = *(const bf16x8*)(GWT + (size_t)fr * 4096 + F.wave * 512 + kk * 32 + fq * 8);
    for (int gc = F.bid; gc < NCH; gc += F.G) {
        const int seq_lo = gc < 4 ? 0 : CTXN, seq_hi = gc < 4 ? CTXN : LT;
        for (int sub = 0; sub < 4; ++sub) {
            const int r0 = gc * 64 + sub * 16;
            u32x2 xr[18];
#pragma unroll
            for (int i = 0; i < 18; ++i) { const int rr = r0 - 1 + i; xr[i] = (rr >= seq_lo && rr < seq_hi) ? *(const u32x2*)(XMp + (size_t)rr * 512) : (u32x2){0u, 0u}; }
#pragma unroll
            for (int rl = 0; rl < 16; ++rl) {
                const int row = r0 + rl; const u32x2 prv = xr[rl], cur = xr[rl + 1], nxt = xr[rl + 2];
                const float p[4] = {bflo(prv.x), bfhi(prv.x), bflo(prv.y), bfhi(prv.y)}, c[4] = {bflo(cur.x), bfhi(cur.x), bflo(cur.y), bfhi(cur.y)}, n[4] = {bflo(nxt.x), bfhi(nxt.x), bflo(nxt.y), bfhi(nxt.y)};
                float o[4];
#pragma unroll
                for (int e = 0; e < 4; ++e) o[e] = siluf(cb[e] + cw[0][e] * p[e] + cw[1][e] * c[e] + cw[2][e] * n[e]);
                u32x2 w; w.x = pk2(o[0], o[1]); w.y = pk2(o[2], o[3]);
                *(u32x2*)(XCp + (size_t)row * 512) = w;
                *(LAS u32x2*)(tile + rl * TP + c4) = w;
                *(LAS u32x2*)(tile + rl * TP + 2048 + c4) = cur;
            }
            LDS_BAR();
            {
                f32x4 acc = {0.f, 0.f, 0.f, 0.f};
#pragma unroll
                for (int kk = 0; kk < 16; ++kk) { const int k0 = F.wave * 512 + kk * 32 + fq * 8;
                    const bf16x8 a = *(const LAS bf16x8*)(tile + fr * TP + k0);
                    acc = __builtin_amdgcn_mfma_f32_16x16x32_bf16(a, gw[kk], acc, 0, 0, 0); }
#pragma unroll
                for (int r = 0; r < 4; ++r) part[F.wave * 256 + (fq * 4 + r) * 16 + fr] = acc[r];
            }
            LDS_BAR();
            if (F.tid < 256) { float a = F.in[I_MGATEB][slot * 16 + (F.tid & 15)];
#pragma unroll
                for (int w = 0; w < 8; ++w) a += part[w * 256 + F.tid];
                gl[(sub * 16 + (F.tid >> 4)) * 16 + (F.tid & 15)] = a; }
        }
        LDS_BAR();
        {
            const int ch = F.wave, dir = ch >> 2, h = ch & 3, j = F.lane, rl = dir ? 63 - j : j, row = gc * 64 + rl;
            const float ig = gl[rl * 16 + (2 * dir) * 4 + h], lf = logsigf(gl[rl * 16 + (2 * dir + 1) * 4 + h]);
            float b = lf;
#pragma unroll
            for (int o = 1; o < 64; o <<= 1) { const float t = __shfl_up(b, o); if (j >= o) b += t; }
            const float cq = ig - b; float pm = cq;
#pragma unroll
            for (int o = 1; o < 64; o <<= 1) { const float t = __shfl_up(pm, o); if (j >= o) pm = fmaxf(pm, t); }
            const float bl = __shfl(b, 63), gq = bl - b + ig, gm = wave_max(gq);
            scal_arr(F, 0, ch)[row] = b; scal_arr(F, 1, ch)[row] = b + pm; scal_arr(F, 2, ch)[row] = gq; scal_arr(F, 3, ch)[row] = cq;
            if (j == 0) { chs_arr(F, 0, ch)[gc] = bl; chs_arr(F, 1, ch)[gc] = gm; }
            const float wp = __expf(gq - gm);
            ((float*)(F.ws + WS_WGP))[(size_t)ch * LT + row] = wp;
            bf16_t* vx = (bf16_t*)(F.ws + WS_VTS) + (((((size_t)ch * NCH + gc) * 33 + 32) * 2 + (rl >> 5)) * 64 + 16 * ((rl & 31) >> 3)) * 8 + (rl & 7);
            vx[0] = f2bf(wp);
#pragma unroll
            for (int z = 1; z < 16; ++z) vx[z * 8] = 0;
        }
        LDS_BAR();
    }
}

__device__ __forceinline__ void mlstm_qkv(const Frame& F, int slot) {
    MultiSched<4> S; Prob pr[4];
    const char* WQ = (const char*)(F.ws + WS_WQ) + (size_t)slot * 4 * 256 * 512 * 2;
    const char* WK = (const char*)(F.ws + WS_WK) + (size_t)slot * 4 * 256 * 512 * 2;
    const char* WV = (const char*)(F.ws + WS_WV) + (size_t)slot * 4 * 512 * 512 * 2;
    const char* XC = (const char*)(F.ws + WS_XCM); const char* XM = XC + (size_t)4 * LT * 512 * 2; const long long HS = (long long)LT * 512 * 2;
    pr[0] = Prob{XC, WQ, (char*)(F.ws + WS_Q),  HS, 256 * 512 * 2, (long long)LT * 256 * 2, 65, 1, 4, 0,    512, 512,  0, 0};
    pr[1] = Prob{XC, WK, (char*)(F.ws + WS_KN), HS, 256 * 512 * 2, (long long)LT * 256 * 2, 65, 1, 4, 260,  512, 512,  0, 0};
    pr[2] = Prob{WK, XC, (char*)(F.ws + WS_KT), 256 * 512 * 2, HS, (long long)256 * LT * 2, 1, 65, 4, 520,  512,  512, 0,  0};
    pr[3] = Prob{WV, XM, (char*)(F.ws + WS_VT), 512 * 512 * 2, HS, (long long)512 * LT * 2, 2, 65, 4, 780, 512, 512, 0, 0};
    S.init(F, pr, 780 + 520);
    EpiStore E{nullptr, (const float*)(F.ws + WS_WGP), (bf16_t*)(F.ws + WS_VTS), 1};
    pg8::gemm_phase<EpiStore, MultiSched<4>, false>(F.lds, 512, S, E, F.tid);
}

constexpr int SCAN_NV = 4;
struct ScanBufR { bf16x8 q[8]; bf16x8 v[2]; float bq[4], aq[4]; float bl, gm; };
struct ScanBufU { bf16x8 k[8]; float bl, gm; };
__device__ __forceinline__ int scan_chunk(int dir, int st) { return dir == 0 ? st : (st < 4 ? 3 - st : 263 - st); }
#define SCAN_BAR() do { asm volatile("s_waitcnt lgkmcnt(0)" ::: "memory"); __builtin_amdgcn_s_barrier(); asm volatile("" ::: "memory"); } while (0)

template <bool DEN> __device__ __forceinline__ void scan_job(const Frame& F, const int ch, const int sl) {
    constexpr int CP = 256 + 16, NV = SCAN_NV;
    LAS bf16_t* Cs = (LAS bf16_t*)F.lds;
    LAS bf16x8* VS = (LAS bf16x8*)(F.lds + 2 * NV * 16 * CP * 2);
    const bf16_t* Q = (const bf16_t*)(F.ws + WS_Q); const bf16_t* KT = (const bf16_t*)(F.ws + WS_KT); const bf16_t* VTS = (const bf16_t*)(F.ws + WS_VTS);
    const int w = F.wave;
    {
        const int dir = ch >> 2, h = ch & 3; constexpr bool denjob = DEN; constexpr int ntile = DEN ? 1 : NV;
        const float* BL = chs_arr(F, 0, ch); const float* GM = chs_arr(F, 1, ch);
        __syncthreads();
        for (int i = F.tid; i < 2 * NV * 16 * CP / 2; i += NT) ((LAS unsigned*)Cs)[i] = 0u;
        float m = 0.f;
        if (w < 4) {
            const float* BQ = scal_arr(F, 0, ch); const float* AQ = scal_arr(F, 1, ch); float* MS = chs_arr(F, 2, ch);
            const int fr = F.lane & 15, fq = F.lane >> 4;
            const __amdgpu_buffer_rsrc_t rsQ = __builtin_amdgcn_make_buffer_rsrc((void*)(Q + (size_t)h * LT * 256), 0, LT * 256 * 2, 0x00020000);
            const __amdgpu_buffer_rsrc_t rsV = __builtin_amdgcn_make_buffer_rsrc((void*)(VTS + (size_t)ch * NCH * 33 * 1024), 0, NCH * 33 * 1024 * 2, 0x00020000);
            const unsigned loQ = (unsigned)F.lane * 16u + (unsigned)w * 8192u, loV = (unsigned)F.lane * 16u + (unsigned)(denjob ? 32 : sl * NV + w) * 2048u, loS = (unsigned)(16 * w + fq * 4) * 4u;
            char* ubO = (char*)(F.ws + WS_OINT) + ((((size_t)ch * NCH) * 32 + sl * NV) * 4 + w) * 512;
            {
                const unsigned g0 = (unsigned)scan_chunk(dir, 0);
#pragma unroll
                for (int kk = 0; kk < 2; ++kk) VS[((0 * NV + w) * 2 + kk) * 64 + F.lane] = bload16(rsV, loV, g0 * (33u * 2048u) + kk * 1024u);
            }
            __syncthreads();
            ScanBufR sb[3];
#define SCAN_LOAD_R(B, st_) do { const unsigned gc_ = (unsigned)scan_chunk(dir, st_), gn_ = (unsigned)scan_chunk(dir, ((st_) + 1 < NCH) ? (st_) + 1 : (st_)); sb[B].bl = BL[gc_]; sb[B].gm = GM[gc_]; \
            _Pragma("unroll") for (int i = 0; i < 8; ++i) sb[B].q[i] = bload16(rsQ, loQ, gc_ * 32768u + i * 1024u); \
            _Pragma("unroll") for (int kk = 0; kk < 2; ++kk) sb[B].v[kk] = bload16(rsV, loV, gn_ * (33u * 2048u) + kk * 1024u); \
            { const f32x4 a0_ = *(const f32x4*)((const char*)BQ + (size_t)gc_ * 256 + loS), a1_ = *(const f32x4*)((const char*)AQ + (size_t)gc_ * 256 + loS); \
              _Pragma("unroll") for (int e = 0; e < 4; ++e) { sb[B].bq[e] = a0_[e]; sb[B].aq[e] = a1_[e]; } } } while (0)
#define SCAN_LPART_R(LB, lst_, part) do { { const int lc_ = ((lst_) < NCH) ? (lst_) : NCH - 1;     \
            const unsigned gc2_ = (unsigned)scan_chunk(dir, lc_), gn2_ = (unsigned)scan_chunk(dir, (lc_ + 1 < NCH) ? lc_ + 1 : lc_); \
            __builtin_amdgcn_sched_barrier(0x38F); \
            sb[LB].q[2 * (part)] = bload16(rsQ, loQ, gc2_ * 32768u + (2 * (part)) * 1024u); sb[LB].q[2 * (part) + 1] = bload16(rsQ, loQ, gc2_ * 32768u + (2 * (part) + 1) * 1024u); \
            if ((part) == 0) { sb[LB].bl = BL[gc2_]; sb[LB].gm = GM[gc2_]; } \
            if ((part) == 1) { const f32x4 a0_ = *(const f32x4*)((const char*)BQ + (size_t)gc2_ * 256 + loS), a1_ = *(const f32x4*)((const char*)AQ + (size_t)gc2_ * 256 + loS); \
                _Pragma("unroll") for (int e = 0; e < 4; ++e) { sb[LB].bq[e] = a0_[e]; sb[LB].aq[e] = a1_[e]; } } \
            if ((part) >= 2) sb[LB].v[(part) - 2] = bload16(rsV, loV, gn2_ * (33u * 2048u) + ((part) - 2) * 1024u); \
            __builtin_amdgcn_sched_barrier(0); } } while (0)
#define SCAN_STEP_R(B, st_, CB, LB, lst_) do { const int gc_ = scan_chunk(dir, st_), row0_ = gc_ * 64; constexpr int cb_ = CB; \
            int ln_ = F.lane; asm volatile("" : "+v"(ln_)); const int fr_ = ln_ & 15, fq_ = ln_ >> 4;     \
            const float mn_ = fmaxf(sb[B].bl + m, sb[B].gm); \
            if (sl == 0 && w == 0 && ln_ == 0) MS[gc_] = m; \
            _Pragma("unroll") for (int kk = 0; kk < 2; ++kk) VS[(((cb_ ^ 1) * NV + w) * 2 + kk) * 64 + ln_] = sb[B].v[kk]; \
            float wj_[4]; _Pragma("unroll") for (int r = 0; r < 4; ++r) { const float in_ = sb[B].bq[r] + m, mj_ = fmaxf(in_, sb[B].aq[r]); wj_[r] = __expf(in_ - mj_); } \
            _Pragma("unroll") for (int t = 0; t < NV; ++t) { if (t < ntile) { f32x4 o_ = {0.f, 0.f, 0.f, 0.f}; \
                _Pragma("unroll") for (int kk = 0; kk < 8; ++kk) { const bf16x8 b_ = *(const LAS bf16x8*)(Cs + ((cb_ * NV + t) * 16 + fr_) * CP + kk * 32 + fq_ * 8); o_ = __builtin_amdgcn_mfma_f32_16x16x32_bf16(sb[B].q[kk], b_, o_, 0, 0, 0); } \
                if (!denjob) { u32x2 pw_; pw_.x = pk2(o_[0] * wj_[0], o_[1] * wj_[1]); pw_.y = pk2(o_[2] * wj_[2], o_[3] * wj_[3]); \
                    *(u32x2*)(ubO + ((size_t)gc_ * 32 + t) * 2048 + (unsigned)ln_ * 8u) = pw_; } \
                else if (fr_ == 0) { float* dn_ = (float*)(F.ws + WS_DENI) + (size_t)ch * LT + row0_ + 16 * w + fq_ * 4; \
                    _Pragma("unroll") for (int r = 0; r < 4; ++r) dn_[r] = o_[r] * wj_[r]; } } \
                SCAN_LPART_R(LB, lst_, t); }     \
            m = mn_; SCAN_BAR(); } while (0)
            SCAN_LOAD_R(0, 0); SCAN_LOAD_R(1, 1);
            static_assert((NCH - 2) % 6 == 0, "two peeled steps + whole groups of six (3 register buffers x 2 LDS state buffers): no guards inside the loop");
            SCAN_STEP_R(0, 0, 0, 2, 2);
            SCAN_STEP_R(1, 1, 1, 0, 3);
            for (int st = 2; st < NCH; st += 6) {
                SCAN_STEP_R(2, st, 0, 1, st + 2);
                SCAN_STEP_R(0, st + 1, 1, 2, st + 3);
                SCAN_STEP_R(1, st + 2, 0, 0, st + 4);
                SCAN_STEP_R(2, st + 3, 1, 1, st + 5);
                SCAN_STEP_R(0, st + 4, 0, 2, st + 6);
                SCAN_STEP_R(1, st + 5, 1, 0, st + 7);
            }
#undef SCAN_LPART_R
#undef SCAN_LOAD_R
#undef SCAN_STEP_R
        } else {
            const int u = w - 4; const int fr = F.lane & 15, fq = F.lane >> 4;
            const __amdgpu_buffer_rsrc_t rsK = __builtin_amdgcn_make_buffer_rsrc((void*)(KT + (size_t)h * 256 * LT), 0, 256 * LT * 2, 0x00020000);
            const unsigned loK = (unsigned)F.lane * 16u + (unsigned)u * 8192u;
            f32x4 acc[NV][4];
#pragma unroll
            for (int t = 0; t < NV; ++t)
#pragma unroll
                for (int d = 0; d < 4; ++d) acc[t][d] = (f32x4){0.f, 0.f, 0.f, 0.f};
            __syncthreads();
            ScanBufU sb[3];
#define SCAN_LOAD_U(B, st_) do { const unsigned gc_ = (unsigned)scan_chunk(dir, st_); sb[B].bl = BL[gc_]; sb[B].gm = GM[gc_]; \
            _Pragma("unroll") for (int i = 0; i < 8; ++i) sb[B].k[i] = bload16(rsK, loK, gc_ * 32768u + (unsigned)i * 1024u); } while (0)
#define SCAN_LPART_U(LB, lst_, part) do { { const unsigned gc2_ = (unsigned)scan_chunk(dir, ((lst_) < NCH) ? (lst_) : NCH - 1); \
            __builtin_amdgcn_sched_barrier(0x38F); \
            sb[LB].k[2 * (part)] = bload16(rsK, loK, gc2_ * 32768u + (unsigned)(2 * (part)) * 1024u); sb[LB].k[2 * (part) + 1] = bload16(rsK, loK, gc2_ * 32768u + (unsigned)(2 * (part) + 1) * 1024u); \
            if ((part) == 0) { sb[LB].bl = BL[gc2_]; sb[LB].gm = GM[gc2_]; } \
            __builtin_amdgcn_sched_barrier(0); } } while (0)
#define SCAN_STEP_U(B, st_, CB, LB, lst_) do { constexpr int cb_ = CB; \
            int ln_ = F.lane; asm volatile("" : "+v"(ln_)); const int fr_ = ln_ & 15, fq_ = ln_ >> 4; \
            const float bl_ = sb[B].bl, gm_ = sb[B].gm; const float mn_ = fmaxf(bl_ + m, gm_), dec_ = __expf(bl_ + m - mn_), sf_ = __expf(gm_ - mn_); \
            _Pragma("unroll") for (int t = 0; t < NV; ++t) { if (t < ntile) { \
                const bf16x8 v0_ = VS[((cb_ * NV + t) * 2 + 0) * 64 + ln_], v1_ = VS[((cb_ * NV + t) * 2 + 1) * 64 + ln_]; \
                _Pragma("unroll") for (int d = 0; d < 4; ++d) { f32x4 n_ = {0.f, 0.f, 0.f, 0.f}; \
                    n_ = __builtin_amdgcn_mfma_f32_16x16x32_bf16(sb[B].k[2 * d], v0_, n_, 0, 0, 0); n_ = __builtin_amdgcn_mfma_f32_16x16x32_bf16(sb[B].k[2 * d + 1], v1_, n_, 0, 0, 0); \
                    const f32x4 a_ = acc[t][d] * dec_ + n_ * sf_; acc[t][d] = a_; \
                    u32x2 pw_; pw_.x = pk2(a_[0], a_[1]); pw_.y = pk2(a_[2], a_[3]); \
                    *(LAS u32x2*)(Cs + (((cb_ ^ 1) * NV + t) * 16 + fr_) * CP + 16 * (4 * u + d) + fq_ * 4) = pw_; } } \
                SCAN_LPART_U(LB, lst_, t); } \
            m = mn_; SCAN_BAR(); } while (0)
            SCAN_LOAD_U(0, 0); SCAN_LOAD_U(1, 1);
            SCAN_STEP_U(0, 0, 0, 2, 2);
            SCAN_STEP_U(1, 1, 1, 0, 3);
            for (int st = 2; st < NCH; st += 6) {
                SCAN_STEP_U(2, st, 0, 1, st + 2);
                SCAN_STEP_U(0, st + 1, 1, 2, st + 3);
                SCAN_STEP_U(1, st + 2, 0, 0, st + 4);
                SCAN_STEP_U(2, st + 3, 1, 1, st + 5);
                SCAN_STEP_U(0, st + 4, 0, 2, st + 6);
                SCAN_STEP_U(1, st + 5, 1, 0, st + 7);
            }
#undef SCAN_LPART_U
#undef SCAN_LOAD_U
#undef SCAN_STEP_U
        }
    }
}

__device__ __forceinline__ void mlstm_scan(const Frame& F, int cvt_part) {
    constexpr int CP = 256 + 16, NV = SCAN_NV, NSL = 32 / NV;
    static_assert(NV == 4, "one reader wave per v-tile");
    LAS bf16_t* Cs = (LAS bf16_t*)F.lds;
    LAS bf16x8* VS = (LAS bf16x8*)(F.lds + 2 * NV * 16 * CP * 2);
    const bf16_t* Q = (const bf16_t*)(F.ws + WS_Q); const bf16_t* KT = (const bf16_t*)(F.ws + WS_KT); const bf16_t* VTS = (const bf16_t*)(F.ws + WS_VTS);
    const int w = F.wave;
    const int job = F.bid;
    if (job >= 8 * (NSL + 1)) { deferred_convert(F, cvt_part, job - 8 * (NSL + 1), F.G - 8 * (NSL + 1)); hyena_filter_fft(F, job - 8 * (NSL + 1), F.G - 8 * (NSL + 1)); return; }
    { const int ch = job & 7, sl = job >> 3;
      if (sl == NSL) scan_job<true>(F, ch, sl); else scan_job<false>(F, ch, sl); }
}

__device__ __forceinline__ void mlstm_intra(const Frame& F, int slot, int gc_lo) {
    constexpr int SP = 64 + 8;
    LAS float* sc = (LAS float*)F.lds;
    LAS bf16_t* Sb = (LAS bf16_t*)(F.lds + 2 * 6 * 64 * 4);
    LAS float* stt = (LAS float*)(F.lds + 2 * 6 * 64 * 4 + 2 * 64 * SP * 2);
    LAS float* mr = stt + 64 * 8 * 2;
    constexpr int HP = 512 + 8;
    LAS bf16_t* Hs = (LAS bf16_t*)(mr + 128);
    const bf16_t* Q = (const bf16_t*)(F.ws + WS_Q); const bf16_t* KN = (const bf16_t*)(F.ws + WS_KN); const bf16_t* VT = (const bf16_t*)(F.ws + WS_VT);
    const bf16_t* XCM = (const bf16_t*)(F.ws + WS_XCM); const bf16_t* OPRE = (const bf16_t*)(F.ws + WS_OPRE); bf16_t* Y = (bf16_t*)(F.ws + WS_Y);
    const float* NG = F.in[I_MNORMG] + (size_t)slot * 2048; const float* SK = F.in[I_MSKIP] + (size_t)slot * 2048;
    const int w = F.wave;
    const int nunit = (NCH - gc_lo) * 4;
    for (int un = F.bid; un < nunit; un += F.G) {
        int ln_ = F.lane; asm volatile("" : "+v"(ln_)); const int fr = ln_ & 15, fq = ln_ >> 4;
        const int tid_ = w * 64 + ln_;
        const int gc = gc_lo + un / 4, h = un & 3, row0 = gc * 64;
        LDS_BAR();
        if (tid_ < 128) { const int dir = tid_ >> 6, i = tid_ & 63, ch = dir * 4 + h, row = row0 + i;
            const float bq = scal_arr(F, 0, ch)[row], aq = scal_arr(F, 1, ch)[row], cq = scal_arr(F, 3, ch)[row], m0 = chs_arr(F, 2, ch)[gc];
            const float mj = fmaxf(bq + m0, aq);
            LAS float* s = sc + dir * 6 * 64;
            s[i] = bq; s[64 + i] = cq; s[128 + i] = mj; s[192 + i] = __expf(-mj); s[256 + i] = ((const float*)(F.ws + WS_DENI))[(size_t)ch * LT + row]; }
        const int it = w >> 1, st0 = (w & 1) * 2;
        f32x4 sa[2] = {{0.f, 0.f, 0.f, 0.f}, {0.f, 0.f, 0.f, 0.f}};
        {
            const __amdgpu_buffer_rsrc_t rsQi = __builtin_amdgcn_make_buffer_rsrc((void*)(Q + ((size_t)h * 1040 + gc * 4) * 4096), 0, 4 * 4096 * 2, 0x00020000);
            const __amdgpu_buffer_rsrc_t rsKi = __builtin_amdgcn_make_buffer_rsrc((void*)(KN + ((size_t)h * 1040 + gc * 4) * 4096), 0, 4 * 4096 * 2, 0x00020000);
            const unsigned lo = (unsigned)ln_ * 16u;
#pragma unroll
            for (int kk = 0; kk < 8; ++kk) { const bf16x8 a = bload16(rsQi, lo, (unsigned)((it * 8 + kk) * 1024)), b0 = bload16(rsKi, lo, (unsigned)((st0 * 8 + kk) * 1024)), b1 = bload16(rsKi, lo, (unsigned)(((st0 + 1) * 8 + kk) * 1024));
                sa[0] = __builtin_amdgcn_mfma_f32_16x16x32_bf16(a, b0, sa[0], 0, 0, 0); sa[1] = __builtin_amdgcn_mfma_f32_16x16x32_bf16(a, b1, sa[1], 0, 0, 0); }
        }
        LDS_BAR();
#pragma unroll
        for (int t = 0; t < 2; ++t) { const int s = 16 * (st0 + t) + fr;
#pragma unroll
            for (int r = 0; r < 4; ++r) { const int i = 16 * it + fq * 4 + r;
                const float wf = (s <= i) ? __expf(sc[i] + sc[64 + s] - sc[128 + i]) : 0.f;
                const float wb = (s >= i) ? __expf(sc[384 + i] + sc[384 + 64 + s] - sc[384 + 128 + i]) : 0.f;
                Sb[(0 * 64 + i) * SP + s] = f2bf(sa[t][r] * wf); Sb[(1 * 64 + i) * SP + s] = f2bf(sa[t][r] * wb); } }
        LDS_BAR();
        if (tid_ < 128) { const int dir = tid_ >> 6, i = tid_ & 63; float a = 0.f;
            for (int s = 0; s < 64; ++s) a += bf2f(Sb[(dir * 64 + i) * SP + s]);
            sc[dir * 384 + 320 + i] = a; }
        const __amdgpu_buffer_rsrc_t rsO0 = __builtin_amdgcn_make_buffer_rsrc((void*)(F.ws + WS_OINT + ((size_t)h * NCH + gc) * 65536), 0, 65536, 0x00020000);
        const __amdgpu_buffer_rsrc_t rsO1 = __builtin_amdgcn_make_buffer_rsrc((void*)(F.ws + WS_OINT + ((size_t)(4 + h) * NCH + gc) * 65536), 0, 65536, 0x00020000);
        const __amdgpu_buffer_rsrc_t rsVT = __builtin_amdgcn_make_buffer_rsrc((void*)(VT + ((size_t)h * NCH + gc) * 512 * 64), 0, 512 * 64 * 2, 0x00020000);
        f32x4 oa[2][4][4];
#pragma unroll
        for (int d = 0; d < 2; ++d)
#pragma unroll
            for (int a = 0; a < 4; ++a)
#pragma unroll
                for (int b = 0; b < 4; ++b) oa[d][a][b] = (f32x4){0.f, 0.f, 0.f, 0.f};
        {
#pragma unroll
            for (int kk = 0; kk < 2; ++kk) {
                bf16x8 vb[4];
#pragma unroll
                for (int vt = 0; vt < 4; ++vt) vb[vt] = bload16(rsVT, (unsigned)ln_ * 16u, (unsigned)(((4 * w + vt) * 2 + kk) * 1024));
#pragma unroll
                for (int d = 0; d < 2; ++d)
#pragma unroll
                    for (int a = 0; a < 4; ++a) { const bf16x8 sf = *(const LAS bf16x8*)(Sb + (d * 64 + 16 * a + fr) * SP + kk * 32 + fq * 8);
#pragma unroll
                        for (int vt = 0; vt < 4; ++vt) oa[d][a][vt] = __builtin_amdgcn_mfma_f32_16x16x32_bf16(sf, vb[vt], oa[d][a][vt], 0, 0, 0); }
            }
        }
        LDS_BAR();
        u32x2 oi[2][2][4];
#define OI_LOAD(buf, a_) do { _Pragma("unroll") for (int vt = 0; vt < 4; ++vt) { \
            oi[buf][0][vt] = __builtin_bit_cast(u32x2, __builtin_amdgcn_raw_buffer_load_b64(rsO0, (unsigned)ln_ * 8u, (unsigned)(((4 * w + vt) * 4 + (a_)) * 512), 0)); \
            oi[buf][1][vt] = __builtin_bit_cast(u32x2, __builtin_amdgcn_raw_buffer_load_b64(rsO1, (unsigned)ln_ * 8u, (unsigned)(((4 * w + vt) * 4 + (a_)) * 512), 0)); } } while (0)
        OI_LOAD(0, 0);
#pragma unroll
        for (int a = 0; a < 4; ++a) {
            if (a < 3) OI_LOAD((a + 1) & 1, a + 1);
            float den[2][4], emj[2][4];
#pragma unroll
            for (int d = 0; d < 2; ++d)
#pragma unroll
                for (int r = 0; r < 4; ++r) { const int i = 16 * a + fq * 4 + r; emj[d][r] = sc[d * 384 + 192 + i]; den[d][r] = __builtin_amdgcn_rcpf(fmaxf(fabsf(sc[d * 384 + 320 + i] + sc[d * 384 + 256 + i]), emj[d][r])); }
            float s1[4] = {0.f, 0.f, 0.f, 0.f}, s2[4] = {0.f, 0.f, 0.f, 0.f};
#pragma unroll
            for (int vt = 0; vt < 4; ++vt) {
                const u32x2 o0 = oi[a & 1][0][vt], o1 = oi[a & 1][1][vt];
                const float i0[4] = {bflo(o0.x), bfhi(o0.x), bflo(o0.y), bfhi(o0.y)}, i1[4] = {bflo(o1.x), bfhi(o1.x), bflo(o1.y), bfhi(o1.y)};
#pragma unroll
                for (int r = 0; r < 4; ++r) { const float hf = (oa[0][a][vt][r] + i0[r]) * den[0][r], hb = (oa[1][a][vt][r] + i1[r]) * den[1][r];
                    const float hs = hf + hb; s1[r] += hs; s2[r] += hs * hs; Hs[(16 * a + fq * 4 + r) * HP + 64 * w + 16 * vt + fr] = f2bf(hs); }
            }
#pragma unroll
            for (int r = 0; r < 4; ++r) {
#pragma unroll
                for (int o = 1; o < 16; o <<= 1) { s1[r] += __shfl_xor(s1[r], o); s2[r] += __shfl_xor(s2[r], o); }
                if (fr == 0) { const int i = 16 * a + fq * 4 + r; stt[(i * 8 + w) * 2] = s1[r]; stt[(i * 8 + w) * 2 + 1] = s2[r]; } }
            __builtin_amdgcn_sched_barrier(0);
        }
#undef OI_LOAD
        LDS_BAR();
        if (tid_ < 64) { float a = 0.f, b = 0.f;
#pragma unroll
            for (int ww = 0; ww < 8; ++ww) { a += stt[(tid_ * 8 + ww) * 2]; b += stt[(tid_ * 8 + ww) * 2 + 1]; }
            const float mu = a * (1.0f / 512.0f), var = fmaxf(b * (1.0f / 512.0f) - mu * mu, 0.f);
            mr[tid_ * 2] = mu; mr[tid_ * 2 + 1] = rsqrtf(var + EPS); }
        LDS_BAR();
        {
            const int i = tid_ >> 3; const float mu = mr[i * 2], rs = mr[i * 2 + 1]; const size_t row = (size_t)(row0 + i);
#pragma unroll 2
            for (int q = 0; q < 8; ++q) { const int v8 = (tid_ & 7) * 8 + 64 * q, c = h * 512 + v8;
                const u32x4 hv = *(const LAS u32x4*)(Hs + i * HP + v8), xv = *(const u32x4*)(XCM + ((size_t)h * LT + row) * 512 + v8), ov = *(const u32x4*)(OPRE + row * 2048 + c);
                const f32x4 g0 = *(const f32x4*)(NG + c), g1 = *(const f32x4*)(NG + c + 4), k0 = *(const f32x4*)(SK + c), k1 = *(const f32x4*)(SK + c + 4);
                float o[8];
#pragma unroll
                for (int e = 0; e < 8; ++e) { const unsigned hw = hv[e >> 1], xw = xv[e >> 1], ow = ov[e >> 1];
                    const float hh = (e & 1) ? bfhi(hw) : bflo(hw), xc = (e & 1) ? bfhi(xw) : bflo(xw), op = (e & 1) ? bfhi(ow) : bflo(ow);
                    const float ng = e < 4 ? g0[e & 3] : g1[e & 3], sk = e < 4 ? k0[e & 3] : k1[e & 3];
                    o[e] = ((hh - mu) * rs * ng + sk * xc) * sigmf(op); }
                u32x4 wv; wv.x = pk2(o[0], o[1]); wv.y = pk2(o[2], o[3]); wv.z = pk2(o[4], o[5]); wv.w = pk2(o[6], o[7]);
                *(u32x4*)(Y + row * 2048 + c) = wv; }
        }
    }
}

struct EpiResid {
    static constexpr bool PERM = false;
    float* HL; float* HC; const float* g_lat; const float* g_ctx; const float* bias; int rowbase; bool colmajor;
    __device__ __forceinline__ void operator()(const f32x4 (&acc)[2][2][4][2], const GUnit& u, int wr, int wc, int fr, int fq) const {
        const int col0 = u.pn * 256 + wc * 32 + 4 * fq;
        const bool isctx = (rowbase + u.pm * 256) < CTXN;
        const float* g = isctx ? g_ctx : g_lat;
        f32x4 gv[2][2], bv[2][2];
#pragma unroll
        for (int bj = 0; bj < 2; ++bj)
#pragma unroll
            for (int n = 0; n < 2; ++n) { gv[bj][n] = *(const f32x4*)(g + col0 + bj * 128 + n * 16); bv[bj][n] = bias ? *(const f32x4*)(bias + col0 + bj * 128 + n * 16) : (f32x4){0.f, 0.f, 0.f, 0.f}; }
#pragma unroll
        for (int ai = 0; ai < 2; ++ai)
#pragma unroll
            for (int m = 0; m < 4; ++m) { const int R = rowbase + u.pm * 256 + ai * 128 + wr * 64 + m * 16 + fr;
                float* rowp = isctx ? HC + (size_t)R * 1024 : HL + (size_t)scan_inv(R - CTXN, colmajor) * 1024;
#pragma unroll
                for (int bj = 0; bj < 2; ++bj)
#pragma unroll
                    for (int n = 0; n < 2; ++n) { float* p = rowp + col0 + bj * 128 + n * 16; const f32x4 o = *(const f32x4*)p; *(f32x4*)p = o + gv[bj][n] * (acc[ai][bj][m][n] + bv[bj][n]); } }
    }
};

__device__ __forceinline__ void mlstm_outproj(const Frame& F, int l, int slot, bool with_ctx, bool colmajor) {
    MultiSched<1> S; Prob pr[1];
    const int rowbase = with_ctx ? 0 : CTXN, nM = with_ctx ? 65 : 64;
    pr[0] = Prob{(const char*)(F.ws + WS_Y) + (size_t)rowbase * 2048 * 2, (const char*)(F.ws + WS_WMOUT) + (size_t)slot * 1024 * 2048 * 2, nullptr, 0, 0, 0, nM, 4, 1, 0, 2048, 2048, 0, 0};
    S.init(F, pr, nM * 4);
    EpiResid E{(float*)(F.ws + WS_HL), (float*)(F.ws + WS_HC), modp(F, l, 0, 2), modp(F, l, 1, 2), nullptr, rowbase, colmajor};
    pg8::gemm_phase<EpiResid, MultiSched<1>, false>(F.lds, 2048, S, E, F.tid);
}
__device__ __forceinline__ void hyena_filtergen(const Frame& F, int slot, bool with_ctx) {
    const bf16_t* Z2 = (const bf16_t*)(F.ws + WS_Z2) + (size_t)slot * SEQ * 64;
    const bf16_t* W3T = (const bf16_t*)(F.ws + WS_W3T) + (size_t)slot * 2048 * 64;
    const float* dec = F.in[I_HDECAY] + (size_t)slot * 2048;
    bf16_t* FILT = (bf16_t*)(F.ws + WS_FILT2);
    const int fr = F.lane & 15, fq = F.lane >> 4;
    for (int gw = F.bid * NWAVES + F.wave; gw < 128 * 16; gw += F.G * NWAVES) {
        const int oct = gw & 127, tg = gw >> 7, oc = oct * 16 + fr;
        bf16x8 b[2];
#pragma unroll
        for (int kk = 0; kk < 2; ++kk) b[kk] = *(const bf16x8*)(W3T + (size_t)oc * 64 + kk * 32 + fq * 8);
        const float dc = dec[oc];
        for (int tt = 0; tt < 64; ++tt) {
            const int t0 = (tg * 64 + tt) * 16;
            f32x4 acc = {0.f, 0.f, 0.f, 0.f};
#pragma unroll
            for (int kk = 0; kk < 2; ++kk) { const bf16x8 a = *(const bf16x8*)(Z2 + (size_t)(t0 + fr) * 64 + kk * 32 + fq * 8); acc = __builtin_amdgcn_mfma_f32_16x16x32_bf16(a, b[kk], acc, 0, 0, 0); }
            float o[4];
#pragma unroll
            for (int r = 0; r < 4; ++r) { const int t = t0 + fq * 4 + r; const float tau = fabsf((float)(t - SEQ / 2)) * (1.0f / (SEQ / 2)); o[r] = acc[r] * __expf(-tau * dc); }
            u32x2 w; w.x = pk2(o[0], o[1]); w.y = pk2(o[2], o[3]);
            *(u32x2*)(FILT + (size_t)oc * SEQ + t0 + fq * 4) = w;
        }
        if (with_ctx) {
            const bf16_t* Z2C = (const bf16_t*)(F.ws + WS_Z2C); float* FC = (float*)(F.ws + WS_FILTC);
            const int t0 = tg * 16;
            f32x4 acc = {0.f, 0.f, 0.f, 0.f};
#pragma unroll
            for (int kk = 0; kk < 2; ++kk) { const bf16x8 a = *(const bf16x8*)(Z2C + (size_t)(t0 + fr) * 64 + kk * 32 + fq * 8); acc = __builtin_amdgcn_mfma_f32_16x16x32_bf16(a, b[kk], acc, 0, 0, 0); }
#pragma unroll
            for (int r = 0; r < 4; ++r) { const int t = t0 + fq * 4 + r; const float tau = fabsf((float)(t - CTXN / 2)) * (1.0f / (CTXN / 2)); FC[(size_t)oc * CTXN + t] = acc[r] * __expf(-tau * dc); }
        }
    }
}

__device__ __forceinline__ void hyena_inproj(const Frame& F, int slot, bool with_ctx) {
    MultiSched<1> S; Prob pr[1];
    const int colbase = with_ctx ? 0 : CTXN, nN = with_ctx ? 65 : 64;
    pr[0] = Prob{(const char*)(F.ws + WS_WHIN) + (size_t)slot * 3072 * 1024 * 2, (const char*)(F.ws + WS_U) + (size_t)colbase * 1024 * 2, (char*)(F.ws + WS_ZT) + (size_t)colbase * 2, 0, 0, 0, 12, nN, 1, 0, 1024, 1024, LT, 2};
    S.init(F, pr, 12 * nN);
    EpiStore E{F.in[I_HINB] + (size_t)slot * 3072, nullptr, nullptr, 0};
    pg8::gemm_phase<EpiStore, MultiSched<1>, false>(F.lds, 1024, S, E, F.tid);
}

__device__ __forceinline__ f32x2 cmul(f32x2 a, f32x2 b) { return (f32x2){a.x * b.x - a.y * b.y, a.x * b.y + a.y * b.x}; }
__device__ __forceinline__ f32x2 cmulc(f32x2 a, f32x2 b) { return (f32x2){a.x * b.x + a.y * b.y, a.y * b.x - a.x * b.y}; }
__device__ __forceinline__ f32x2 cconj(f32x2 a) { return (f32x2){a.x, -a.y}; }
template <int R> __device__ __forceinline__ constexpr int brevR(int x) { int r = 0; for (int b = 1; b < R; b <<= 1) { r = (r << 1) | (x & 1); x >>= 1; } return r; }
template <int R> __device__ __forceinline__ constexpr int log2R() { int l = 0; for (int b = 1; b < R; b <<= 1) ++l; return l; }
template <int R, int HALF_, bool INV> __device__ __forceinline__ void dft_stage(f32x2 (&v)[R]) {
    constexpr float C32[16] = {1.0f, 0.9807852804032304f, 0.9238795325112867f, 0.8314696123025452f, 0.7071067811865476f, 0.5555702330196022f, 0.3826834323650898f, 0.1950903220161283f,
                               0.0f, -0.1950903220161283f, -0.3826834323650898f, -0.5555702330196022f, -0.7071067811865476f, -0.8314696123025452f, -0.9238795325112867f, -0.9807852804032304f};
    constexpr float S32[16] = {0.0f, 0.1950903220161283f, 0.3826834323650898f, 0.5555702330196022f, 0.7071067811865476f, 0.8314696123025452f, 0.9238795325112867f, 0.9807852804032304f,
                               1.0f, 0.9807852804032304f, 0.9238795325112867f, 0.8314696123025452f, 0.7071067811865476f, 0.5555702330196022f, 0.3826834323650898f, 0.1950903220161283f};
#pragma unroll
    for (int blk = 0; blk < R; blk += 2 * HALF_) {
#pragma unroll
        for (int j = 0; j < HALF_; ++j) {
            const f32x2 a = v[blk + j], b = v[blk + j + HALF_];
            v[blk + j] = a + b; const f32x2 d = a - b;
            constexpr int TS = 16 / HALF_;
            const int ti = j * TS;
            if (ti == 0) v[blk + j + HALF_] = d;
            else if (ti == 8) v[blk + j + HALF_] = INV ? (f32x2){-d.y, d.x} : (f32x2){d.y, -d.x};
            else { const f32x2 w = {C32[ti], INV ? S32[ti] : -S32[ti]}; v[blk + j + HALF_] = cmul(d, w); }
        }
    }
    if constexpr (HALF_ > 1) dft_stage<R, HALF_ / 2, INV>(v);
}
template <int R, bool INV> __device__ __forceinline__ void dft_reg(f32x2 (&v)[R]) { dft_stage<R, R / 2, INV>(v); }
__device__ __forceinline__ int fpad(int i) { return i + (i >> 5); }
__device__ __forceinline__ f32x2 unit_root(int num, int den_log2) {
    asm volatile("" : "+v"(num));
    float s, c; sincospif((float)num * (2.0f / (float)(1 << den_log2)), &s, &c); return (f32x2){c, -s};
}
template <bool INV> __device__ __forceinline__ void fft_pass_a(LAS f32x2* buf, int tid) {
#pragma unroll 1
    for (int rr = 0; rr < 2; ++rr) { const int r = tid + rr * 512, pr = fpad(r); f32x2 v[16];
        const f32x2 w1 = unit_root(r, 14);
        if (!INV) {
#pragma unroll
            for (int a = 0; a < 16; ++a) v[a] = buf[pr + a * 1056];
            dft_reg<16, false>(v);
            f32x2 w = w1;
            buf[pr] = v[0];
#pragma unroll
            for (int p = 1; p < 16; ++p) { buf[pr + p * 1056] = cmul(v[brevR<16>(p)], w); w = cmul(w, w1); }
        } else {
            f32x2 w = w1;
            v[0] = buf[pr];
#pragma unroll
            for (int p = 1; p < 16; ++p) { v[p] = cmulc(buf[pr + p * 1056], w); w = cmul(w, w1); }
            dft_reg<16, true>(v);
#pragma unroll
            for (int a = 0; a < 16; ++a) buf[pr + a * 1056] = v[brevR<16>(a)];
        }
    }
}
__device__ __forceinline__ void fft_pass_a_fwd_regs(LAS f32x2* buf, const f32x2 (&z)[16], int tid) {
#pragma unroll
    for (int rr = 0; rr < 2; ++rr) { const int r = tid + rr * 512, pr = fpad(r); f32x2 v[16];
        const f32x2 w1 = unit_root(r, 14);
#pragma unroll
        for (int a = 0; a < 16; ++a) v[a] = (a < 8) ? z[2 * a + rr] : (f32x2){0.f, 0.f};
        dft_reg<16, false>(v);
        f32x2 w = w1;
        buf[pr] = v[0];
#pragma unroll
        for (int p = 1; p < 16; ++p) { buf[pr + p * 1056] = cmul(v[brevR<16>(p)], w); w = cmul(w, w1); }
    }
}
__device__ __forceinline__ void fft_pass_a_inv_regs(const LAS f32x2* buf, f32x2 (&y)[16], int tid) {
#pragma unroll
    for (int rr = 0; rr < 2; ++rr) { const int r = tid + rr * 512, pr = fpad(r); f32x2 v[16];
        const f32x2 w1 = unit_root(r, 14);
        f32x2 w = w1;
        v[0] = buf[pr];
#pragma unroll
        for (int p = 1; p < 16; ++p) { v[p] = cmulc(buf[pr + p * 1056], w); w = cmul(w, w1); }
        dft_reg<16, true>(v);
#pragma unroll
        for (int a = 4; a < 12; ++a) y[2 * (a - 4) + rr] = v[brevR<16>(a)];
    }
}
template <bool INV> __device__ __forceinline__ void fft_pass_b(LAS f32x2* buf, int tid) {
    const int p1 = tid >> 5, r = tid & 31, pb = fpad(p1 * 1024 + r); f32x2 v[32];
    const f32x2 w1 = unit_root(r, 10);
    if (!INV) {
#pragma unroll
        for (int a = 0; a < 32; ++a) v[a] = buf[pb + a * 33];
        dft_reg<32, false>(v);
        f32x2 w = w1;
        buf[pb] = v[0];
#pragma unroll
        for (int p = 1; p < 32; ++p) { buf[pb + p * 33] = cmul(v[brevR<32>(p)], w); w = cmul(w, w1); }
    } else {
        f32x2 w = w1;
        v[0] = buf[pb];
#pragma unroll
        for (int p = 1; p < 32; ++p) { v[p] = cmulc(buf[pb + p * 33], w); w = cmul(w, w1); }
        dft_reg<32, true>(v);
#pragma unroll
        for (int a = 0; a < 32; ++a) buf[pb + a * 33] = v[brevR<32>(a)];
    }
}
template <bool INV> __device__ __forceinline__ void fft_pass_c(LAS f32x2* buf, int tid) {
    const int base = tid * 33; f32x2 v[32];
#pragma unroll
    for (int a = 0; a < 32; ++a) v[a] = buf[base + a];
    dft_reg<32, INV>(v);
#pragma unroll
    for (int a = 0; a < 32; ++a) buf[base + a] = v[brevR<32>(a)];
}
__device__ __forceinline__ void fft_fwd(LAS f32x2* buf, int tid) { fft_pass_a<false>(buf, tid); __syncthreads(); fft_pass_b<false>(buf, tid); __syncthreads(); fft_pass_c<false>(buf, tid); __syncthreads(); }
__device__ __forceinline__ void fft_inv(LAS f32x2* buf, int tid) { fft_pass_c<true>(buf, tid); __syncthreads(); fft_pass_b<true>(buf, tid); __syncthreads(); fft_pass_a<true>(buf, tid); __syncthreads(); }
__device__ __forceinline__ int fft_k_of_pos(int pos) { return (pos >> 10) + 16 * ((pos >> 5) & 31) + 512 * (pos & 31); }
__device__ __forceinline__ int fft_pos_of_k(int k) { return (k & 15) * 1024 + ((k >> 4) & 31) * 32 + (k >> 9); }

__device__ __forceinline__ int fft_pos_of_ci(int ci) { return (ci >> 9) * 1024 + ((ci >> 4) & 31) * 32 + (ci & 15); }
__device__ __forceinline__ void fft_save_pairs(const LAS f32x2* buf, f32x4* zh, const f32x2* twp, float scale, int tid) {
#pragma unroll 4
    for (int it = 0; it < 16; ++it) { const int ci = it * 512 + tid, pos = fft_pos_of_ci(ci), k = fft_k_of_pos(pos);
        const int pos2 = (k == 0) ? 16 : fft_pos_of_k(16384 - k);
        const f32x2 h1 = buf[fpad(pos)], h2 = buf[fpad(pos2)];
        if (k == 0) zh[ci] = (f32x4){(h1.x + h1.y) * scale, (h1.x - h1.y) * scale, h2.x * scale, -h2.y * scale};
        else { const f32x2 wn = twp[ci];
            const f32x2 eh = {0.5f * (h1.x + h2.x), 0.5f * (h1.y - h2.y)}, dh = {0.5f * (h1.x - h2.x), 0.5f * (h1.y + h2.y)};
            const f32x2 th = cmul(wn, (f32x2){dh.y, -dh.x});
            const f32x2 hk = (eh + th) * scale, hk2 = cconj(eh - th) * scale;
            zh[ci] = (f32x4){hk.x, hk.y, hk2.x, hk2.y}; } }
}
__device__ __forceinline__ void fft_pointwise(LAS f32x2* buf, const f32x4* zh, const f32x2* twp, int tid) {
#pragma unroll 2
    for (int it = 0; it < 16; ++it) { const int ci = it * 512 + tid, pos = fft_pos_of_ci(ci), k = fft_k_of_pos(pos);
        const f32x4 hq = zh[ci];
        if (k == 0) {
            const f32x2 z0 = buf[0], zm = buf[16];
            const float y0 = (z0.x + z0.y) * hq[0], yn = (z0.x - z0.y) * hq[1];
            buf[0] = (f32x2){0.5f * (y0 + yn), 0.5f * (y0 - yn)};
            const f32x2 ym = cmul(cconj(zm), (f32x2){hq[2], hq[3]});
            buf[16] = (f32x2){ym.x, -ym.y};
        } else {
            const int pp = fpad(pos), pp2 = fpad(fft_pos_of_k(16384 - k));
            const f32x2 z1 = buf[pp], z2 = buf[pp2];
            const f32x2 wn = twp[ci];
            const f32x2 ex = {0.5f * (z1.x + z2.x), 0.5f * (z1.y - z2.y)}, dx = {0.5f * (z1.x - z2.x), 0.5f * (z1.y + z2.y)};
            const f32x2 tx = cmul(wn, (f32x2){dx.y, -dx.x});
            const f32x2 xk = ex + tx, xk2 = cconj(ex - tx);
            const f32x2 yk = cmul(xk, (f32x2){hq[0], hq[1]}), yk2 = cmul(xk2, (f32x2){hq[2], hq[3]});
            const f32x2 e2 = {0.5f * (yk.x + yk2.x), 0.5f * (yk.y - yk2.y)}, d2 = {0.5f * (yk.x - yk2.x), 0.5f * (yk.y + yk2.y)};
            const f32x2 o2 = cmulc(d2, wn);
            buf[pp] = (f32x2){e2.x - o2.y, e2.y + o2.x};
            buf[pp2] = (f32x2){e2.x + o2.y, -(e2.y - o2.x)};
        }
    }
}
__device__ __forceinline__ f32x2 sconv2(const bf16_t* row, int n, int Ln, float w0, float w1, float w2, float b) {
    struct W3 { unsigned p, c, q; } t;
    __builtin_memcpy(&t, (const unsigned*)row + (n - 1), 12);
    const unsigned p = (n > 0) ? t.p : 0u, q = (2 * n + 2 < Ln) ? t.q : 0u, c = t.c;
    const float xm1 = bfhi(p), x0 = bflo(c), x1 = bfhi(c), x2 = bflo(q);
    return (f32x2){b + w0 * xm1 + w1 * x0 + w2 * x1, b + w0 * x0 + w1 * x1 + w2 * x2};
}
__device__ __forceinline__ float block_sum(LAS float* red, float v, int tid) {
    v = wave_sum(v);
    __syncthreads();
    if ((tid & 63) == 0) red[tid >> 6] = v;
    __syncthreads();
    float s = 0.f;
#pragma unroll
    for (int i = 0; i < 8; ++i) s += red[i];
    return s;
}

__device__ __forceinline__ void hyena_filter_fft(const Frame& F, int vbid, int vG) {
    LAS f32x2* buf = (LAS f32x2*)F.lds;
    LAS float* red = (LAS float*)(F.lds + (16384 + 512) * 8);
    const bf16_t* FILT = (const bf16_t*)(F.ws + WS_FILT2);
    const int tid = F.tid, pt = fpad(F.tid);
    for (int job = vbid; job < 2048; job += vG) {
        const int c = job >> 1, ord = job & 1;
        const unsigned* f32p = (const unsigned*)(FILT + (size_t)(ord * 1024 + c) * SEQ);
        float ss = 0.f; f32x2 fz[16];
        __syncthreads();
#pragma unroll
        for (int j = 0; j < 16; ++j) { const int n = tid + 512 * j; const unsigned w = f32p[n]; const float a = bflo(w), b = bfhi(w); ss += a * a + b * b; fz[j] = (f32x2){a, b}; }
        const float tot = block_sum(red, ss, tid);
        const float fsv = rsqrtf(tot + EPS) * (1.0f / 16384.0f);
        fft_pass_a_fwd_regs(buf, fz, tid); __syncthreads(); fft_pass_b<false>(buf, tid); __syncthreads(); fft_pass_c<false>(buf, tid); __syncthreads();
        fft_save_pairs(buf, (f32x4*)(F.ws + WS_ZHALL) + (size_t)job * 8192, (const f32x2*)(F.ws + WS_TWP), fsv, tid);
    }
    __syncthreads();
}

__device__ __forceinline__ void hyena_fft(const Frame& F, int slot, bool with_ctx) {
    LAS f32x2* buf = (LAS f32x2*)F.lds;
    LAS float* red = (LAS float*)(F.lds + (16384 + 512) * 8);
    const bf16_t* ZT = (const bf16_t*)(F.ws + WS_ZT); bf16_t* Y2T = (bf16_t*)(F.ws + WS_Y2T);
    const f32x2* twp = (const f32x2*)(F.ws + WS_TWP);
    const float* scw = F.in[I_HSCW] + (size_t)slot * 3 * 3072; const float* scb = F.in[I_HSCB] + (size_t)slot * 3072; const float* fb = F.in[I_HFBIAS] + (size_t)slot * 2048;
    const int tid = F.tid, pt = fpad(F.tid);
    for (int c = F.bid; c < 1024; c += F.G) {
        const f32x4* zh = (const f32x4*)(F.ws + WS_ZHALL) + (size_t)c * 2 * 8192;
        __syncthreads();
        f32x2 vv[16], yy[16];
        {
            const int zc = 2048 + c; const float w0 = scw[zc], w1 = scw[3072 + zc], w2 = scw[2 * 3072 + zc], b = scb[zc];
            const bf16_t* row = ZT + (size_t)zc * LT + CTXN;
#pragma unroll
            for (int j = 0; j < 16; ++j) { const int n = tid + 512 * j; vv[j] = sconv2(row, n, SEQ, w0, w1, w2, b); if ((j & 3) == 3) __builtin_amdgcn_sched_barrier(0); }
        }
        fft_pass_a_fwd_regs(buf, vv, tid); __syncthreads(); fft_pass_b<false>(buf, tid); __syncthreads(); fft_pass_c<false>(buf, tid); __syncthreads();
        fft_pointwise(buf, zh, twp, tid);
        __syncthreads();
        fft_pass_c<true>(buf, tid); __syncthreads(); fft_pass_b<true>(buf, tid); __syncthreads(); fft_pass_a_inv_regs(buf, yy, tid);
        {
            const int zc = c; const float w0 = scw[zc], w1 = scw[3072 + zc], w2 = scw[2 * 3072 + zc], b = scb[zc], fb0 = fb[c];
            const bf16_t* row = ZT + (size_t)zc * LT + CTXN;
#pragma unroll
            for (int j = 0; j < 16; ++j) { const int n = tid + 512 * j; const f32x2 x1 = sconv2(row, n, SEQ, w0, w1, w2, b);
                vv[j] = (f32x2){x1.x * (yy[j].x + vv[j].x * fb0), x1.y * (yy[j].y + vv[j].y * fb0)}; if ((j & 3) == 3) __builtin_amdgcn_sched_barrier(0); }
        }
        fft_pass_a_fwd_regs(buf, vv, tid); __syncthreads(); fft_pass_b<false>(buf, tid); __syncthreads(); fft_pass_c<false>(buf, tid); __syncthreads();
        fft_pointwise(buf, zh + 8192, twp, tid);
        __syncthreads();
        fft_pass_c<true>(buf, tid); __syncthreads(); fft_pass_b<true>(buf, tid); __syncthreads(); fft_pass_a_inv_regs(buf, yy, tid);
        {
            const int zc = 1024 + c; const float w0 = scw[zc], w1 = scw[3072 + zc], w2 = scw[2 * 3072 + zc], b = scb[zc], fb1 = fb[1024 + c];
            const bf16_t* row = ZT + (size_t)zc * LT + CTXN;
            unsigned* orow = (unsigned*)(Y2T + (size_t)c * LT + CTXN);
#pragma unroll
            for (int j = 0; j < 16; ++j) { const int n = tid + 512 * j; const f32x2 x2 = sconv2(row, n, SEQ, w0, w1, w2, b);
                orow[n] = pk2(x2.x * (yy[j].x + vv[j].x * fb1), x2.y * (yy[j].y + vv[j].y * fb1)); if ((j & 3) == 3) __builtin_amdgcn_sched_barrier(0); }
        }
        __syncthreads();
    }
    if (with_ctx) {
        LAS float* ub = (LAS float*)F.lds;
        LAS float* fbuf = ub + 512;
        const float* FC = (const float*)(F.ws + WS_FILTC);
        const int cc = tid >> 8, t = tid & 255;
        for (int c0 = F.bid * 2; c0 < 1024; c0 += F.G * 2) {
            const int c = c0 + cc;
            float cur, y1 = 0.f;
            { const int zc = 2048 + c; const bf16_t* row = ZT + (size_t)zc * LT;
              const float xm = t > 0 ? bf2f(row[t - 1]) : 0.f, x0 = bf2f(row[t]), xp = t < 255 ? bf2f(row[t + 1]) : 0.f;
              cur = scb[zc] + scw[zc] * xm + scw[3072 + zc] * x0 + scw[2 * 3072 + zc] * xp; }
#pragma unroll 1
            for (int ord = 0; ord < 2; ++ord) {
                __syncthreads();
                const float fv = FC[(size_t)(ord * 1024 + c) * CTXN + t];
                ub[cc * 256 + t] = cur; fbuf[cc * 256 + t] = fv;
                float ss = fv * fv;
                ss = wave_sum(ss);
                __syncthreads();
                if (F.lane == 0) red[F.wave] = ss;
                __syncthreads();
                const float tot = red[cc * 4] + red[cc * 4 + 1] + red[cc * 4 + 2] + red[cc * 4 + 3];
                const float fs = rsqrtf(tot + EPS);
                float acc = 0.f;
                const int jlo = max(0, t + 128 - 255), jhi = min(255, t + 128);
                for (int j = jlo; j <= jhi; ++j) acc += fbuf[cc * 256 + j] * ub[cc * 256 + t + 128 - j];
                const int zc = ord * 1024 + c; const bf16_t* row = ZT + (size_t)zc * LT;
                const float xm = t > 0 ? bf2f(row[t - 1]) : 0.f, x0 = bf2f(row[t]), xp = t < 255 ? bf2f(row[t + 1]) : 0.f;
                const float xg = scb[zc] + scw[zc] * xm + scw[3072 + zc] * x0 + scw[2 * 3072 + zc] * xp;
                const float yo = xg * (acc * fs + cur * fb[ord * 1024 + c]);
                if (ord == 0) { y1 = yo; cur = y1; } else Y2T[(size_t)c * LT + t] = f2bf(yo);
            }
        }
        __syncthreads();
    }
}

__device__ __forceinline__ void hyena_transpose(const Frame& F, bool with_ctx) {
    LAS bf16_t* tile = (LAS bf16_t*)F.lds;
    const bf16_t* Y2T = (const bf16_t*)(F.ws + WS_Y2T); bf16_t* Y2 = (bf16_t*)(F.ws + WS_Y2);
    const int tlo = with_ctx ? 0 : 4, ntt = NCH - tlo, ntile = 16 * ntt;
    for (int ti = F.bid; ti < ntile; ti += F.G) {
        const int c0 = (ti % 16) * 64, t0 = (tlo + ti / 16) * 64;
        LDS_BAR();
        { const int c = F.tid >> 3, t8 = (F.tid & 7) * 8; const u32x4 v = *(const u32x4*)(Y2T + (size_t)(c0 + c) * LT + t0 + t8); *(LAS u32x4*)(tile + c * 72 + t8) = v; }
        LDS_BAR();
        { const int t = F.tid >> 3, c8 = (F.tid & 7) * 8; bf16_t e[8];
#pragma unroll
          for (int j = 0; j < 8; ++j) e[j] = tile[(c8 + j) * 72 + t];
          u32x4 w; w.x = (unsigned)e[0] | ((unsigned)e[1] << 16); w.y = (unsigned)e[2] | ((unsigned)e[3] << 16); w.z = (unsigned)e[4] | ((unsigned)e[5] << 16); w.w = (unsigned)e[6] | ((unsigned)e[7] << 16);
          *(u32x4*)(Y2 + (size_t)(t0 + t) * 1024 + c0 + c8) = w; }
    }
}

__device__ __forceinline__ void hyena_outproj(const Frame& F, int l, int slot, bool with_ctx, bool colmajor) {
    MultiSched<1> S; Prob pr[1];
    const int rowbase = with_ctx ? 0 : CTXN, nM = with_ctx ? 65 : 64;
    pr[0] = Prob{(const char*)(F.ws + WS_Y2) + (size_t)rowbase * 1024 * 2, (const char*)(F.ws + WS_WHOUT) + (size_t)slot * 1024 * 1024 * 2, nullptr, 0, 0, 0, nM, 4, 1, 0, 1024, 1024, 0, 0};
    S.init(F, pr, nM * 4);
    EpiResid E{(float*)(F.ws + WS_HL), (float*)(F.ws + WS_HC), modp(F, l, 0, 2), modp(F, l, 1, 2), F.in[I_HOUTB] + (size_t)slot * 1024, rowbase, colmajor};
    pg8::gemm_phase<EpiResid, MultiSched<1>, false>(F.lds, 1024, S, E, F.tid);
}
constexpr int MOE_MAXG = 8;
constexpr int MOE_MAXU = 6;
constexpr int MOE_TAB = 131072;

__device__ __forceinline__ void moe_route(const Frame& F, int l, bool with_ctx) {
    constexpr int VP = 1028;
    LAS float* vs = (LAS float*)F.lds;
    LAS float* part = vs + 16 * VP;
    LAS float* lg = part + 8 * 16 * 48;
    LAS int* re = (LAS int*)(lg + 16 * 48);
    LAS float* rw = (LAS float*)(re + MOE_MAXG * 32);
    LAS int* rp = (LAS int*)(rw + MOE_MAXG * 32);
    LAS int* lc = rp + MOE_MAXG * 32;
    LAS int* lb = lc + 32;
    const float* HL = (const float*)(F.ws + WS_HL); const float* HC = (const float*)(F.ws + WS_HC); bf16_t* VN = (bf16_t*)(F.ws + WS_VN);
    const float* WC = (const float*)(F.ws + WS_WC) + (size_t)l * 1024 * 48;
    const float* g2n = F.in[I_N2G] + l * 1024;
    unsigned* cnt = (unsigned*)(F.ws + WS_CTL) + CW_CNT + l * 32 * 64;
    int* LIST = (int*)(F.ws + WS_LIST); float* AW = (float*)(F.ws + WS_AW);
    const int ntok = with_ctx ? LT : SEQ, tokbase = with_ctx ? 0 : CTXN, ngroups = ntok / 16;
    const int fr = F.lane & 15, fq = F.lane >> 4;
    float wcr[32][3];
#pragma unroll
    for (int st = 0; st < 32; ++st)
#pragma unroll
        for (int nt = 0; nt < 3; ++nt) wcr[st][nt] = WC[(size_t)(F.wave * 128 + st * 4 + fq) * 48 + nt * 16 + fr];
    int gi = 0;
    for (int grp = F.bid; grp < ngroups && gi < MOE_MAXG; grp += F.G, ++gi) {
        LDS_BAR();
#pragma unroll
        for (int rr = 0; rr < 2; ++rr) { const int i = 2 * F.wave + rr, tok = tokbase + grp * 16 + i; const bool isctx = tok < CTXN; const int s = isctx ? 1 : 0;
            const float* src = isctx ? HC + (size_t)tok * 1024 : HL + (size_t)(tok - CTXN) * 1024;
            const float* sh = modp(F, l, s, 3); const float* sc = modp(F, l, s, 4);
            f32x4 v[4]; float ss = 0.f;
#pragma unroll
            for (int j = 0; j < 4; ++j) { v[j] = *(const f32x4*)(src + j * 256 + F.lane * 4); ss += v[j][0] * v[j][0] + v[j][1] * v[j][1] + v[j][2] * v[j][2] + v[j][3] * v[j][3]; }
            ss = wave_sum(ss);
            const float rstd = rsqrtf(ss * (1.0f / 1024.0f) + EPS);
#pragma unroll
            for (int j = 0; j < 4; ++j) { const int c = j * 256 + F.lane * 4; const f32x4 g = *(const f32x4*)(g2n + c), a = *(const f32x4*)(sc + c), b = *(const f32x4*)(sh + c);
                f32x4 o;
#pragma unroll
                for (int e = 0; e < 4; ++e) o[e] = v[j][e] * rstd * g[e] * (1.0f + a[e]) + b[e];
                *(LAS f32x4*)(vs + i * VP + c) = o;
                u32x2 w; w.x = pk2(o[0], o[1]); w.y = pk2(o[2], o[3]); *(u32x2*)(VN + (size_t)tok * 1024 + c) = w; }
        }
        LDS_BAR();
        {
            f32x4 acc[3] = {{0.f, 0.f, 0.f, 0.f}, {0.f, 0.f, 0.f, 0.f}, {0.f, 0.f, 0.f, 0.f}};
#pragma unroll
            for (int st = 0; st < 32; ++st) { const int k = F.wave * 128 + st * 4 + fq; const float a = vs[fr * VP + k];
#pragma unroll
                for (int nt = 0; nt < 3; ++nt) acc[nt] = __builtin_amdgcn_mfma_f32_16x16x4f32(a, wcr[st][nt], acc[nt], 0, 0, 0); }
#pragma unroll
            for (int nt = 0; nt < 3; ++nt)
#pragma unroll
                for (int r = 0; r < 4; ++r) part[(F.wave * 16 + fq * 4 + r) * 48 + nt * 16 + fr] = acc[nt][r];
        }
        LDS_BAR();
        for (int idx = F.tid; idx < 16 * 48; idx += NT) { const int n = idx % 48; float a = (n < 4) ? F.in[I_RGB][l * 4 + n] : (n < 36 ? F.in[I_REB][l * 32 + n - 4] : 0.f);
#pragma unroll
            for (int w = 0; w < 8; ++w) a += part[w * 16 * 48 + idx];
            lg[idx] = a; }
        LDS_BAR();
        if (F.tid < 16) { const LAS float* q = lg + F.tid * 48;
            int gx = 0; float gm = q[0];
            for (int j = 1; j < 4; ++j) if (q[j] > gm) { gm = q[j]; gx = j; }
            float gs = 0.f; for (int j = 0; j < 4; ++j) gs += __expf(q[j] - gm);
            const float gw = 1.0f / gs;
            const LAS float* e = q + 4 + gx * 8;
            int i1 = 0; float m1 = e[0];
            for (int j = 1; j < 8; ++j) if (e[j] > m1) { m1 = e[j]; i1 = j; }
            int i2 = -1; float m2 = 0.f;
            for (int j = 0; j < 8; ++j) if (j != i1 && (i2 < 0 || e[j] > m2)) { m2 = e[j]; i2 = j; }
            const float x = __expf(m2 - m1), w1 = 1.0f / (1.0f + x), w2 = x / (1.0f + x);
            const int a0 = gi * 32 + F.tid * 2;
            re[a0] = gx * 8 + i1; rw[a0] = gw * w1; re[a0 + 1] = gx * 8 + i2; rw[a0 + 1] = gw * w2; }
    }
    LDS_BAR();
    if (F.tid < 32) lc[F.tid] = 0;
    LDS_BAR();
    const int na = gi * 32;
    if (F.tid < na) rp[F.tid] = __hip_atomic_fetch_add(&lc[re[F.tid]], 1, __ATOMIC_RELAXED, __HIP_MEMORY_SCOPE_WORKGROUP);
    LDS_BAR();
    if (F.tid < 32) lb[F.tid] = lc[F.tid] > 0 ? (int)__hip_atomic_fetch_add(cnt + F.tid * 64, (unsigned)lc[F.tid], RLX_AGENT) : 0;
    LDS_BAR();
    if (F.tid < na) { const int a = F.tid, g = a >> 5, i = (a >> 1) & 15, slot = a & 1, e = re[a];
        const int tok = tokbase + (F.bid + g * F.G) * 16 + i, gidx = tok * 2 + slot;
        LIST[(size_t)e * NASG + lb[e] + rp[a]] = gidx; AW[gidx] = rw[a]; }
}

struct MoeSched {
    LAS int* cnt; LAS int* tstart; LAS unsigned* rowtab;
    const char* A; const char* B; char* O; int total, G, c, mode;
    __device__ __forceinline__ void locate(int Lq, int& e, int& mt, int& pn) const {
        const int L = pg8::xcd_remap(Lq, total);
        const int mtg = L >> 2; pn = L & 3; e = 0;
        for (int j = 1; j < 32; ++j) if (tstart[j] <= mtg) e = j;
        mt = mtg - tstart[e];
    }
    __device__ __forceinline__ bool next(int i, GUnit& u) const {
        const int L = i * G + c; if (L >= total) return false;
        int e, mt, pn; locate(L, e, mt, pn);
        u.g = e; u.aux = mt; u.pm = tstart[e] + mt; u.pn = pn;
        if (mode == 0) { u.a = A; u.lda = 1024; u.b = B + ((size_t)e * 1024 + pn * 128) * 1024 * 2; u.ldb = 1024; u.hsb = 512; u.o = O + ((size_t)u.pm * 256 * 512 + pn * 128) * 2; u.ldo = 512; }
        else { u.a = A + (size_t)u.pm * 256 * 512 * 2; u.lda = 512; u.b = B + ((size_t)e * 1024 + pn * 256) * 512 * 2; u.ldb = 512; u.hsb = 128; u.o = O; u.ldo = 1024; }
        return true;
    }
    __device__ __forceinline__ unsigned grow(int slot, int r) const { return rowtab[slot * 256 + r]; }
};
__device__ __forceinline__ void moe_tables(const Frame& F, int l, MoeSched& S, int mode) {
    S.cnt = (LAS int*)(F.lds + MOE_TAB); S.tstart = S.cnt + 32; S.rowtab = (LAS unsigned*)(F.lds + MOE_TAB + 512);
    const unsigned* cnt = (const unsigned*)(F.ws + WS_CTL) + CW_CNT + l * 32 * 64;
    __syncthreads();
    if (F.tid < 32) S.cnt[F.tid] = (int)__hip_atomic_load(cnt + F.tid * 64, RLX_AGENT);
    __syncthreads();
    if (F.tid == 0) { int a = 0; for (int e = 0; e < 32; ++e) { S.tstart[e] = a; a += (S.cnt[e] + 255) >> 8; } S.tstart[32] = a; }
    __syncthreads();
    S.total = S.tstart[32] * 4; S.G = F.G; S.c = F.bid; S.mode = mode;
    if (mode == 0 && F.tid < 256) {
        const int* LIST = (const int*)(F.ws + WS_LIST);
        for (int slot = 0; slot < MOE_MAXU; ++slot) { const int L = slot * S.G + S.c; if (L >= S.total) break;
            int e, mt, pn; S.locate(L, e, mt, pn);
            const int idx = mt * 256 + F.tid; const int tok = idx < S.cnt[e] ? (LIST[(size_t)e * NASG + idx] >> 1) : 0;
            S.rowtab[slot * 256 + F.tid] = (unsigned)tok * 2048u; }
    }
    __syncthreads();
}
struct EpiSwiGLU {
    static constexpr bool PERM = true;
    __device__ __forceinline__ void operator()(const f32x4 (&acc)[2][2][4][2], const GUnit& u, int wr, int wc, int fr, int fq) const {
        bf16_t* base = (bf16_t*)u.o;
#pragma unroll
        for (int ai = 0; ai < 2; ++ai)
#pragma unroll
            for (int m = 0; m < 4; ++m) { const int r = ai * 128 + wr * 64 + m * 16 + fr; float o[8];
#pragma unroll
                for (int n = 0; n < 2; ++n)
#pragma unroll
                    for (int j = 0; j < 4; ++j) o[n * 4 + j] = siluf(acc[ai][0][m][n][j]) * acc[ai][1][m][n][j];
                u32x4 w; w.x = pk2(o[0], o[1]); w.y = pk2(o[2], o[3]); w.z = pk2(o[4], o[5]); w.w = pk2(o[6], o[7]);
                *(u32x4*)(base + (size_t)r * 512 + wc * 32 + 8 * fq) = w; }
    }
};
struct EpiScatter {
    static constexpr bool PERM = true;
    const int* LIST; const float* AW; bf16_t* YB; LAS int* cnt;
    __device__ __forceinline__ void operator()(const f32x4 (&acc)[2][2][4][2], const GUnit& u, int wr, int wc, int fr, int fq) const {
        const int ce = cnt[u.g];
#pragma unroll
        for (int ai = 0; ai < 2; ++ai)
#pragma unroll
            for (int m = 0; m < 4; ++m) { const int r = ai * 128 + wr * 64 + m * 16 + fr, idx = u.aux * 256 + r;
                if (idx < ce) { const int a = LIST[(size_t)u.g * NASG + idx]; const float w = AW[a];
                    bf16_t* rowp = YB + (size_t)a * 1024 + u.pn * 256 + wc * 32 + 8 * fq;
#pragma unroll
                    for (int bj = 0; bj < 2; ++bj) { const f32x4 v0 = acc[ai][bj][m][0] * w, v1 = acc[ai][bj][m][1] * w;
                        u32x4 q; q.x = pk2(v0[0], v0[1]); q.y = pk2(v0[2], v0[3]); q.z = pk2(v1[0], v1[1]); q.w = pk2(v1[2], v1[3]);
                        *(u32x4*)(rowp + bj * 128) = q; } } }
    }
};
__device__ __forceinline__ void moe_e1(const Frame& F, int l) {
    MoeSched S; moe_tables(F, l, S, 0);
    S.A = (const char*)(F.ws + WS_VN); S.B = (const char*)(F.ws + WS_W13) + (size_t)l * 32 * 1024 * 1024 * 2; S.O = (char*)(F.ws + WS_H1);
    EpiSwiGLU E;
    pg8::gemm_phase<EpiSwiGLU, MoeSched, true>(F.lds, 1024, S, E, F.tid);
}
__device__ __forceinline__ void moe_e2(const Frame& F, int l) {
    MoeSched S; moe_tables(F, l, S, 1);
    S.A = (const char*)(F.ws + WS_H1); S.B = (const char*)(F.ws + WS_W2) + (size_t)l * 32 * 1024 * 512 * 2; S.O = nullptr;
    EpiScatter E{(const int*)(F.ws + WS_LIST), (const float*)(F.ws + WS_AW), (bf16_t*)(F.ws + WS_YBUF), S.cnt};
    pg8::gemm_phase<EpiScatter, MoeSched, false>(F.lds, 512, S, E, F.tid);
}
#ifndef MK_LAYERS
#define MK_LAYERS 4
#endif
__global__ void __launch_bounds__(NT, 2) mk_fwd(Args args) {
    extern __shared__ __attribute__((aligned(16))) unsigned char lds_raw[];
    Frame F0;
    { Frame& F = F0;
    F.lds = (LAS unsigned char*)lds_raw; F.ws = args.ws; F.in = args.in; F.out = args.out;
    F.wave = __builtin_amdgcn_readfirstlane((int)threadIdx.x >> 6); F.lane = fresh_lane(); F.tid = F.wave * 64 + F.lane; F.G = gridDim.x; F.bid = blockIdx.x; }
    const Frame& F = F0;
    volatile LAS unsigned* xbw = (volatile LAS unsigned*)(F.lds + LDS_BYTES - 16);
    if (F.tid < 4) xbw[F.tid] = 0u;
    __syncthreads();
    unsigned* ctl = (unsigned*)(F.ws + WS_CTL);
    const int lo = args.ph_lo, hi = args.ph_hi;
    XcdBarrier bar; bar.bar = ctl + CW_BAR; bar.x = 0; bar.st = xbw;
    if (hi - lo > 1) bar = xcd_barrier_post(ctl + CW_BAR, xbw, F.tid);
    int ph = 0;
#ifdef MK_PROBE
    unsigned long long tacc = 0ull, tp0 = 0ull;
#define PROBE_T0(g) tp0 = __builtin_amdgcn_s_memrealtime();
#ifdef MK_PROBE_WG
#define PROBE_TMID(g) if (((MK_PROBE >> (g)) & 1) && F0.bid == MK_PROBE_WG) tacc += __builtin_amdgcn_s_memrealtime() - tp0;
#define PROBE_T1(g)
#else
#define PROBE_TMID(g)
#define PROBE_T1(g) if ((MK_PROBE >> (g)) & 1) tacc += __builtin_amdgcn_s_memrealtime() - tp0;
#endif
#else
#define PROBE_T0(g)
#define PROBE_T1(g)
#define PROBE_TMID(g)
#endif
#define PHASE_BEGIN(g) if (lo <= ph && ph < hi) { PROBE_T0(g) Frame F = F0; { const int t_ = F0.wave * 64 + fresh_lane(); F.tid = t_; F.lane = t_ & 63; }
#define PHASE_END(g)   PROBE_TMID(g) if (ph + 1 < hi) xcd_barrier(bar, F0.wave * 64 + fresh_lane()); PROBE_T1(g) } ++ph;

    PHASE_BEGIN(0) p0_prologue(F); PHASE_END(0)
    int lprev = -1;
#define LAYER_PAIR(IT) { constexpr int it = IT; \
        const int lm = 2 * it, lh = 2 * it + 1; const bool colmajor = (it == 1), ctxl = (it == 0); \
        if (lm < MK_LAYERS) { \
         \
        PHASE_BEGIN(1) n1_phase(F, lm, it > 0, true, it > 0, it == 0, colmajor); hyena_filtergen(F, it, ctxl); PHASE_END(1) \
        PHASE_BEGIN(2) mlstm_inproj(F, it); PHASE_END(2) \
        PHASE_BEGIN(3) mlstm_conv_gates(F, it); PHASE_END(3) \
        PHASE_BEGIN(4) mlstm_qkv(F, it); PHASE_END(4) \
        PHASE_BEGIN(5) mlstm_scan(F, it); PHASE_END(5) \
        PHASE_BEGIN(6) mlstm_intra(F, it, ctxl ? 0 : 4); PHASE_END(6) \
        PHASE_BEGIN(7) mlstm_outproj(F, lm, it, ctxl, colmajor); PHASE_END(7) \
        PHASE_BEGIN(8) moe_route(F, lm, ctxl); PHASE_END(8) \
        PHASE_BEGIN(9) moe_e1(F, lm); PHASE_END(9) \
        PHASE_BEGIN(10) moe_e2(F, lm); PHASE_END(10) \
        lprev = lm; \
        if (lh < MK_LAYERS) { \
         \
        PHASE_BEGIN(1) n1_phase(F, lh, true, ctxl, ctxl, false, colmajor); PHASE_END(1) \
        PHASE_BEGIN(11) hyena_inproj(F, it, ctxl); PHASE_END(11) \
        PHASE_BEGIN(12) hyena_fft(F, it, ctxl); PHASE_END(12) \
        PHASE_BEGIN(13) hyena_transpose(F, ctxl); PHASE_END(13) \
        PHASE_BEGIN(14) hyena_outproj(F, lh, it, ctxl, colmajor); PHASE_END(14) \
        PHASE_BEGIN(8) moe_route(F, lh, ctxl); PHASE_END(8) \
        PHASE_BEGIN(9) moe_e1(F, lh); PHASE_END(9) \
        PHASE_BEGIN(10) moe_e2(F, lh); PHASE_END(10) \
        lprev = lh; \
        } } }
    LAYER_PAIR(0)
    LAYER_PAIR(1)
    PHASE_BEGIN(15) final_phase(F, lprev >= 0, lprev, lprev < 0); PHASE_END(15)
#ifdef MK_PROBE_WG
    { unsigned long long* slot = (unsigned long long*)(F0.ws + WS_CTL) + 16;
      if (F0.bid == MK_PROBE_WG && F0.tid == 0) __hip_atomic_store(slot, tacc, __ATOMIC_RELAXED, __HIP_MEMORY_SCOPE_AGENT);
      xcd_barrier(bar, F0.wave * 64 + fresh_lane());
      { const unsigned long long tv = __hip_atomic_load(slot, __ATOMIC_RELAXED, __HIP_MEMORY_SCOPE_AGENT); tacc = ((unsigned long long)(unsigned)__builtin_amdgcn_readfirstlane((int)(tv >> 32)) << 32) | (unsigned)__builtin_amdgcn_readfirstlane((int)tv); } }
#endif
#ifdef MK_PROBE
    { const unsigned long long te = __builtin_amdgcn_s_memrealtime() + tacc * MK_PROBE_MULT; while (__builtin_amdgcn_s_memrealtime() < te) __builtin_amdgcn_s_sleep(8); }
#endif
}

extern "C" void kernel_launch(void* const* d_in, const int* in_sizes, int n_in, void* d_out, int out_size, void* d_ws, size_t ws_size, hipStream_t stream) {
    static int grid = 0;
    if (grid == 0) {
        if (n_in != 40 || out_size != SEQ * D || ws_size < WS_END) { fprintf(stderr, "kernel_launch: unexpected shapes (n_in %d out %d ws %zu)\n", n_in, out_size, ws_size); grid = -1; return; }
        int dev = 0, cus = 0, per_cu = 0;
        if (hipGetDevice(&dev) != hipSuccess || hipDeviceGetAttribute(&cus, hipDeviceAttributeMultiprocessorCount, dev) != hipSuccess) { grid = -1; return; }
        if (hipFuncSetAttribute((const void*)mk_fwd, hipFuncAttributeMaxDynamicSharedMemorySize, LDS_BYTES) != hipSuccess) { fprintf(stderr, "kernel_launch: hipFuncSetAttribute failed\n"); grid = -1; return; }
        if (hipOccupancyMaxActiveBlocksPerMultiprocessor(&per_cu, (const void*)mk_fwd, NT, LDS_BYTES) != hipSuccess || per_cu < 1) { fprintf(stderr, "kernel_launch: occupancy query says %d\n", per_cu); }
        (void)hipGetLastError();
        grid = cus;
        if (grid > 256) grid = 256;
        if (grid < 128) { fprintf(stderr, "kernel_launch: needs >= 128 CUs (got %d)\n", grid); grid = -1; return; }
    }
    if (grid < 0) return;
    (void)hipMemsetAsync((char*)d_ws + WS_CTL, 0, CTL_BYTES, stream);
    Args a{};
    for (int i = 0; i < 40; ++i) a.in[i] = (const float*)d_in[i];
    a.out = (float*)d_out; a.ws = (unsigned char*)d_ws;
#ifdef MK_SPLIT
    for (int p = 0; p < MK_SPLIT; ++p) { a.ph_lo = p; a.ph_hi = p + 1; hipLaunchKernelGGL(mk_fwd, dim3(grid), dim3(NT), LDS_BYTES, stream, a); }
#else
    a.ph_lo = 0; a.ph_hi = 1000;
    hipLaunchKernelGGL(mk_fwd, dim3(grid), dim3(NT), LDS_BYTES, stream, a);
#endif
}
```

```cpp
#include <hip/hip_runtime.h>
#include <cstdio>
#include <cstdint>

#define LAS __attribute__((address_space(3)))
#define GAS __attribute__((address_space(1)))
#define RLX_AGENT __ATOMIC_RELAXED, __HIP_MEMORY_SCOPE_AGENT
typedef unsigned short bf16_t;
typedef short bf16x8 __attribute__((ext_vector_type(8)));
typedef float f32x4 __attribute__((ext_vector_type(4)));
typedef float f32x2 __attribute__((ext_vector_type(2)));
typedef unsigned u32x4 __attribute__((ext_vector_type(4)));
typedef unsigned u32x2 __attribute__((ext_vector_type(2)));

constexpr int D = 1024, SEQ = 16384, CTXN = 256, LT = SEQ + CTXN;
constexpr int MI = 2048, MH = 4, DQK = 256, DV = 512, CH = 64, NCH = LT / CH;
constexpr int NEXP = 32, DE = 512, NASG = 2 * LT;
constexpr int HB = 16, HEMB = 33, HFH = 64;
constexpr float EPS = 1e-6f;
constexpr int NT = 512, NWAVES = 8;
constexpr int LDS_BYTES = 147456;

constexpr size_t MiB = 1u << 20;
constexpr size_t WS_CTL = 0, CTL_BYTES = 1 * MiB;
constexpr size_t WS_MODS = 4 * MiB;
constexpr size_t WS_WC = 5 * MiB;
constexpr size_t WS_Z2 = 6 * MiB;
constexpr size_t WS_Z2C = 10 * MiB;
constexpr size_t WS_SCAL = 11 * MiB;
constexpr size_t WS_CHS = 14 * MiB;
constexpr size_t WS_DENI = 15 * MiB;
constexpr size_t WS_LIST = 16 * MiB;
constexpr size_t WS_AW = 21 * MiB;
constexpr size_t WS_WGP = 26 * MiB;
constexpr size_t WS_FSC = 27 * MiB;
constexpr size_t WS_TWP = 28 * MiB;
constexpr size_t WS_GWT = 22 * MiB;
constexpr size_t WS_FILTC = 23 * MiB;
constexpr size_t WS_W3T = 25 * MiB;
constexpr size_t WS_WMIN = 32 * MiB;
constexpr size_t WS_WQ = 48 * MiB;
constexpr size_t WS_WK = 50 * MiB;
constexpr size_t WS_WV = 52 * MiB;
constexpr size_t WS_WMOUT = 56 * MiB;
constexpr size_t WS_WHIN = 64 * MiB;
constexpr size_t WS_WHOUT = 76 * MiB;
constexpr size_t WS_W13 = 96 * MiB;
constexpr size_t WS_W2 = 352 * MiB;
constexpr size_t WS_HL = 480 * MiB;
constexpr size_t WS_HC = 544 * MiB;
constexpr size_t WS_U = 546 * MiB;
constexpr size_t WS_VN = 580 * MiB;
constexpr size_t WS_YBUF = 614 * MiB;
constexpr size_t WS_H1 = 680 * MiB;
constexpr size_t WS_MIX = 722 * MiB;
constexpr size_t WS_XCM = WS_MIX;
constexpr size_t WS_OPRE = WS_MIX + 130 * MiB;
constexpr size_t WS_Q = WS_MIX + 195 * MiB;
constexpr size_t WS_KN = WS_MIX + 228 * MiB;
constexpr size_t WS_KT = WS_MIX + 261 * MiB;
constexpr size_t WS_VT = WS_MIX + 294 * MiB;
constexpr size_t WS_OINT = WS_MIX + 359 * MiB;
constexpr size_t WS_Y = WS_MIX + 495 * MiB;
constexpr size_t WS_ZT = WS_MIX;
constexpr size_t WS_FILT = WS_MIX + 98 * MiB;
constexpr size_t WS_Y2T = WS_MIX + 162 * MiB;
constexpr size_t WS_ZH = WS_MIX + 195 * MiB;
constexpr size_t WS_Y2 = WS_MIX + 259 * MiB;
constexpr size_t WS_VTS = WS_MIX + 560 * MiB;
constexpr size_t WS_FILT2 = WS_MIX + 696 * MiB;
constexpr size_t WS_ZHALL = WS_MIX + 760 * MiB;
constexpr size_t WS_END = WS_MIX + 1016 * MiB;

constexpr int CW_BAR = 4096;
constexpr int CW_CNT = 16384;
constexpr int CW_ERR = 8;

__device__ __forceinline__ float bf2f(bf16_t b) { return __uint_as_float(((unsigned)b) << 16); }
__device__ __forceinline__ unsigned pk2(float lo, float hi) { unsigned r; asm("v_cvt_pk_bf16_f32 %0, %1, %2" : "=v"(r) : "v"(lo), "v"(hi)); return r; }
__device__ __forceinline__ bf16_t f2bf(float f) { return (bf16_t)pk2(f, 0.f); }
__device__ __forceinline__ float bflo(unsigned w) { return __uint_as_float(w << 16); }
__device__ __forceinline__ float bfhi(unsigned w) { return __uint_as_float(w & 0xffff0000u); }
__device__ __forceinline__ float sigmf(float x) { return __builtin_amdgcn_rcpf(1.0f + __expf(-x)); }
__device__ __forceinline__ float siluf(float x) { return x * sigmf(x); }
#define LDS_BAR() do { asm volatile("s_waitcnt lgkmcnt(0)" ::: "memory"); __builtin_amdgcn_s_barrier(); asm volatile("" ::: "memory"); } while (0)
__device__ __forceinline__ int fresh_lane() { int l; asm volatile("v_mbcnt_lo_u32_b32 %0, -1, 0\n\tv_mbcnt_hi_u32_b32 %0, -1, %0" : "=v"(l)); return l; }
__device__ __forceinline__ float wave_sum(float v) {
#pragma unroll
    for (int o = 32; o > 0; o >>= 1) v += __shfl_xor(v, o);
    return v;
}
__device__ __forceinline__ float wave_max(float v) {
#pragma unroll
    for (int o = 32; o > 0; o >>= 1) v = fmaxf(v, __shfl_xor(v, o));
    return v;
}

#define XB_TMO      128
#define XB_XCNT(j)  (256  + 64 * (j))
#define XB_XSUB(j)  (1280 + 64 * (j))
#define XB_XGEN(j)  (2304 + 64 * (j))
#define XB_TOP      3328
#define XB_TOPGEN   3392
#define XCD_BAR_WORDS 3456
#define XB_SPIN_CAP (1u << 18)
__device__ __forceinline__ unsigned xb_ld(unsigned* p)              { return __hip_atomic_load(p, __ATOMIC_RELAXED, __HIP_MEMORY_SCOPE_AGENT); }
__device__ __forceinline__ unsigned xb_add(unsigned* p, unsigned v) { return __hip_atomic_fetch_add(p, v, __ATOMIC_RELAXED, __HIP_MEMORY_SCOPE_AGENT); }
__device__ __forceinline__ unsigned xb_xcc_id() { return (unsigned)__builtin_amdgcn_s_getreg((3 << 11) | 20) & 0xFu; }
#define XB_SPIN(cond, bar) do { unsigned _sp = 0; while (cond) { __builtin_amdgcn_s_sleep(1); \
    if ((++_sp & 255u) == 0u) { if (xb_ld(&(bar)[XB_TMO])) break; if (_sp > XB_SPIN_CAP) { atomicAdd(&(bar)[XB_TMO], 1u); break; } } } } while (0)
struct XcdBarrier { unsigned* bar; unsigned x; volatile LAS unsigned* st; };
__device__ __forceinline__ XcdBarrier xcd_barrier_post(unsigned* bar, volatile LAS unsigned* st, int tid) {
    XcdBarrier b; b.bar = bar; b.x = xb_xcc_id(); b.st = st;
    if (tid == 0) (void)xb_add(&bar[XB_XCNT(b.x)], 1u);
    return b;
}
__device__ __forceinline__ void xcd_barrier_complete(unsigned* bar, unsigned x, unsigned& nloc, unsigned& nx) {
    const unsigned G = gridDim.x * gridDim.y * gridDim.z;
    unsigned sum, cnt, mine, sp = 0u;
    for (;;) {
        sum = 0u; cnt = 0u; mine = 0u;
#pragma unroll
        for (unsigned j = 0; j < 16; ++j) { const unsigned c = xb_ld(&bar[XB_XCNT(j)]); sum += c; cnt += (c > 0u) ? 1u : 0u; mine = (j == x) ? c : mine; }
        if (sum == G) break;
        __builtin_amdgcn_s_sleep(1);
        if ((++sp & 255u) == 0u) { if (xb_ld(&bar[XB_TMO])) break; if (sp > XB_SPIN_CAP) { atomicAdd(&bar[XB_TMO], 1u); break; } }
    }
    nloc = mine > 0u ? mine : 1u; nx = cnt > 0u ? cnt : 1u;
}
__device__ __forceinline__ void xcd_barrier(const XcdBarrier& b, int tid) {
    asm volatile("s_waitcnt vmcnt(0)" ::: "memory");
    __syncthreads();
    if (tid == 0) {
        unsigned* bar = b.bar;
        __builtin_amdgcn_s_waitcnt(0);
        unsigned nloc = b.st[0], nx = b.st[1];
        if (nloc == 0u) { xcd_barrier_complete(bar, b.x, nloc, nx); b.st[0] = nloc; b.st[1] = nx; }
        const unsigned old = xb_add(&bar[XB_XSUB(b.x)], 1u);
        const unsigned gen = old / nloc;
        if (old + 1u == (gen + 1u) * nloc) {
            __builtin_amdgcn_fence(__ATOMIC_RELEASE, "agent");
            asm volatile("s_waitcnt vmcnt(0)" ::: "memory");
            const unsigned og = xb_add(&bar[XB_TOP], 1u);
            const unsigned tg = og / nx;
            if (og + 1u == (tg + 1u) * nx) xb_add(&bar[XB_TOPGEN], 1u);
            else XB_SPIN(xb_ld(&bar[XB_TOPGEN]) == tg, bar);
            __builtin_amdgcn_fence(__ATOMIC_ACQUIRE, "agent");
            xb_add(&bar[XB_XGEN(b.x)], 1u);
            asm volatile("s_waitcnt vmcnt(0)" ::: "memory");
        } else {
            XB_SPIN(xb_ld(&bar[XB_XGEN(b.x)]) == gen, bar);
            __builtin_amdgcn_fence(__ATOMIC_ACQUIRE, "agent");
            asm volatile("s_waitcnt vmcnt(0)" ::: "memory");
        }
    }
    __syncthreads();
}

namespace pg8 {
constexpr int BM = 256, BK = 64, HALF = 128, HTB = HALF * BK * 2, STAGE_BYTES = 8 * HTB;
__device__ __forceinline__ int lds_byte(int r, int c) { const int st = (r >> 4) * 2 + (c >> 5), rr = r & 15, cc = c & 31, ob = rr * 64 + cc * 2; return st * 1024 + (ob ^ (((ob >> 9) & 1) << 5)); }
__device__ __forceinline__ void stage_rc(int b, int& R, int& C) { const int st = b / 1024, sb = b % 1024, swz = sb ^ (((sb >> 9) & 1) << 5); R = (st >> 1) * 16 + swz / 64; C = (st & 1) * 32 + (swz % 64) / 2; }
__device__ __forceinline__ int perm32(int rho) { const int n = rho >> 4, i = rho & 15; return 8 * (i >> 2) + 4 * n + (i & 3); }

struct GUnit { const char* a; const char* b; char* o; int pm, pn, g, aux, lda, ldb, ldo, hsb, half; };

template <class Epi, class Sched, bool GATHER>
__device__ __forceinline__ void gemm_phase(LAS unsigned char* lds, const int K, const Sched& S, const Epi& E, int tid_in) {
    int tid_ = tid_in; asm volatile("" : "+v"(tid_));
    const int tid = tid_, wid = __builtin_amdgcn_readfirstlane(tid >> 6), lane = tid & 63, wr = wid >> 2, wc = wid & 3, fr = lane & 15, fq = lane >> 4;
    const int nt = K / BK;
    unsigned cvA0[2], cvA1[2], cvB[2];
#define PG8_OFFS(U, slot, vA0, vA1, vB) do { _Pragma("unroll") for (int i = 0; i < 2; ++i) { int R_, C_; stage_rc(tid * 16 + i * 8192, R_, C_); const int Rb_ = Epi::PERM ? ((R_ & ~31) + perm32(R_ & 31)) : R_; \
        if constexpr (GATHER) { vA0[i] = S.grow(slot, R_) + (unsigned)C_ * 2u; vA1[i] = S.grow(slot, R_ + HALF) + (unsigned)C_ * 2u; } \
        else { vA0[i] = (unsigned)(R_ * (U).lda + C_) * 2u; vA1[i] = (unsigned)((R_ + HALF) * (U).lda + C_) * 2u; } \
        vB[i] = (unsigned)(Rb_ * (U).ldb + C_) * 2u; } } while (0)
    const size_t kstep = (size_t)(BK * 2);
    const unsigned ldsw = (unsigned)wid * 1024u;
    const int aoff = lds_byte(wr * 64 + fr, fq * 8), boff = lds_byte(wc * 32 + fr, fq * 8);
#define PG8_SA(b, h) (((b) * 2 + (h)) * HTB)
#define PG8_SB(b, h) ((4 + (b) * 2 + (h)) * HTB)
#define PG8_STAGE(bufoff, gbase, voff) do { _Pragma("unroll") for (int _i = 0; _i < 2; ++_i) \
        __builtin_amdgcn_global_load_lds((const unsigned*)((const char*)(gbase) + (voff)[_i]), (LAS unsigned*)(lds + (bufoff) + ldsw + _i * 8192), 16, 0, 0); } while (0)
#define PG8_LDA(dst, b, h) do { _Pragma("unroll") for (int m = 0; m < 4; ++m) _Pragma("unroll") for (int k = 0; k < 2; ++k) dst[m][k] = *(const LAS bf16x8*)(lds + PG8_SA(b, h) + aoff + m * 2048 + k * 1024); } while (0)
#define PG8_LDB(dst, b, h) do { _Pragma("unroll") for (int n = 0; n < 2; ++n) _Pragma("unroll") for (int k = 0; k < 2; ++k) dst[n][k] = *(const LAS bf16x8*)(lds + PG8_SB(b, h) + boff + n * 2048 + k * 1024); } while (0)
#define PG8_MMA(ai, bj, At, Bt) do { __builtin_amdgcn_s_setprio(1); _Pragma("unroll") for (int m = 0; m < 4; ++m) _Pragma("unroll") for (int n = 0; n < 2; ++n) _Pragma("unroll") for (int k = 0; k < 2; ++k) \
        acc[ai][bj][m][n] = __builtin_amdgcn_mfma_f32_16x16x32_bf16(Bt[n][k], At[m][k], acc[ai][bj][m][n], 0, 0, 0); __builtin_amdgcn_s_setprio(0); } while (0)
#define PG8_WAIT_V(n) asm volatile("s_waitcnt vmcnt(" #n ")" ::: "memory")
#define PG8_WAIT_L(n) asm volatile("s_waitcnt lgkmcnt(" #n ")" ::: "memory")
#define PG8_BAR __builtin_amdgcn_s_barrier()
#define PG8_SCHED __builtin_amdgcn_sched_barrier(0)
    GUnit cur, nxt; int ui = 0;
    if (!S.next(0, cur)) return;
    PG8_OFFS(cur, 0, cvA0, cvA1, cvB);
    size_t chB = (size_t)cur.hsb * cur.ldb * 2;
    f32x4 acc[2][2][4][2];
#pragma unroll
    for (int a = 0; a < 2; ++a)
#pragma unroll
        for (int b = 0; b < 2; ++b)
#pragma unroll
            for (int m = 0; m < 4; ++m)
#pragma unroll
                for (int n = 0; n < 2; ++n) acc[a][b][m][n] = (f32x4){0.f, 0.f, 0.f, 0.f};
    bf16x8 At[4][2], B0[2][2], B1[2][2];
    const char* cA = cur.a; const char* cB = cur.b;
    PG8_STAGE(PG8_SB(0, 0), cB, cvB); PG8_STAGE(PG8_SA(0, 0), cA, cvA0); PG8_STAGE(PG8_SB(0, 1), cB + chB, cvB); PG8_STAGE(PG8_SA(0, 1), cA, cvA1);
    if (wr == 1) PG8_BAR;
    PG8_WAIT_V(4); PG8_BAR;
    PG8_STAGE(PG8_SB(1, 0), cB + kstep, cvB); PG8_STAGE(PG8_SA(1, 0), cA + kstep, cvA0); PG8_STAGE(PG8_SB(1, 1), cB + chB + kstep, cvB);
    PG8_WAIT_V(6); PG8_BAR;
    for (;;) {
        const bool has_next = S.next(ui + 1, nxt);
        const char* nA = has_next ? nxt.a : cA; const char* nB = has_next ? nxt.b : cB;
        for (int t = 0; t < nt; t += 2) {
            const bool last = (t == nt - 2);
            const char* a1 = cA + (size_t)(t + 1) * kstep;
            const char* a2 = last ? nA : cA + (size_t)(t + 2) * kstep; const char* b2 = last ? nB : cB + (size_t)(t + 2) * kstep;
            const char* a3 = a2 + kstep; const char* b3 = b2 + kstep;
            PG8_LDB(B0, 0, 0); PG8_SCHED; PG8_LDA(At, 0, 0); PG8_STAGE(PG8_SA(1, 1), a1, cvA1);
            PG8_WAIT_L(8); PG8_BAR; PG8_WAIT_L(0); PG8_MMA(0, 0, At, B0); PG8_BAR; PG8_SCHED;
            if (last && has_next) { PG8_OFFS(nxt, ui + 1, cvA0, cvA1, cvB); chB = (size_t)nxt.hsb * nxt.ldb * 2; }
            PG8_LDB(B1, 0, 1); PG8_STAGE(PG8_SB(0, 0), b2, cvB);
            PG8_BAR; PG8_WAIT_L(0); PG8_MMA(0, 1, At, B1); PG8_BAR;
            PG8_LDA(At, 0, 1); PG8_STAGE(PG8_SA(0, 0), a2, cvA0);
            PG8_BAR; PG8_WAIT_L(0); PG8_MMA(1, 0, At, B0); PG8_BAR; PG8_SCHED;
            PG8_STAGE(PG8_SB(0, 1), b2 + chB, cvB);
            PG8_WAIT_V(6); PG8_BAR; PG8_MMA(1, 1, At, B1); PG8_BAR;
            PG8_LDB(B0, 1, 0); PG8_SCHED; PG8_LDA(At, 1, 0); PG8_STAGE(PG8_SA(0, 1), a2, cvA1);
            PG8_WAIT_L(8); PG8_BAR; PG8_WAIT_L(0); PG8_MMA(0, 0, At, B0); PG8_BAR; PG8_SCHED;
            PG8_LDB(B1, 1, 1); PG8_STAGE(PG8_SB(1, 0), b3, cvB);
            PG8_BAR; PG8_WAIT_L(0); PG8_MMA(0, 1, At, B1); PG8_BAR;
            PG8_LDA(At, 1, 1); PG8_STAGE(PG8_SA(1, 0), a3, cvA0);
            PG8_BAR; PG8_WAIT_L(0); PG8_MMA(1, 0, At, B0); PG8_BAR; PG8_SCHED;
            PG8_STAGE(PG8_SB(1, 1), b3 + chB, cvB);
            PG8_WAIT_V(6); PG8_BAR; PG8_MMA(1, 1, At, B1); PG8_BAR;
        }
        E(acc, cur, wr, wc, fr, fq);
        if (!has_next) break;
#pragma unroll
        for (int a = 0; a < 2; ++a)
#pragma unroll
            for (int b = 0; b < 2; ++b)
#pragma unroll
                for (int m = 0; m < 4; ++m)
#pragma unroll
                    for (int n = 0; n < 2; ++n) acc[a][b][m][n] = (f32x4){0.f, 0.f, 0.f, 0.f};
        cur = nxt; cA = nA; cB = nB; ++ui;
    }
    PG8_WAIT_V(0);
    if (wr == 0) PG8_BAR;
    PG8_BAR;
#undef PG8_OFFS
#undef PG8_SA
#undef PG8_SB
#undef PG8_STAGE
#undef PG8_LDA
#undef PG8_LDB
#undef PG8_MMA
#undef PG8_WAIT_V
#undef PG8_WAIT_L
#undef PG8_BAR
#undef PG8_SCHED
}

__device__ __forceinline__ int xcd_remap(int wgid, int nwg) { const int q = nwg / 8, r = nwg % 8, xcd = wgid % 8, off = wgid / 8; return (xcd < r ? xcd * (q + 1) : r * (q + 1) + (xcd - r) * q) + off; }
}
using pg8::GUnit;

struct Args { const float* in[40]; float* out; unsigned char* ws; int ph_lo, ph_hi; };
struct Frame {
    LAS unsigned char* lds; unsigned char* ws; const float* const* in; float* out;
    int tid, lane, wave, G, bid;
};
struct Prob { const char* A; const char* B; char* O; long long sA, sB, sO;
              int nM, nN, nb, ustart; int lda, ldb, ldo; int osz; };
constexpr int SCHED_TAB = 131072 + 8192;
__device__ __forceinline__ int rfl(int v) { return __builtin_amdgcn_readfirstlane(v); }
__device__ __forceinline__ const char* rflp(const char* p) { const unsigned long long v = (unsigned long long)p; return (const char*)(((unsigned long long)(unsigned)rfl((int)(v >> 32)) << 32) | (unsigned)rfl((int)v)); }
template <int NP> struct MultiSched {
    LAS Prob* p; int total, G, c;
    __device__ __forceinline__ void init(const Frame& F, const Prob (&q)[NP], int total_) {
        p = (LAS Prob*)(F.lds + SCHED_TAB); total = total_; G = F.G; c = F.bid;
        __syncthreads();
        if (F.tid == 0) {
#pragma unroll
            for (int j = 0; j < NP; ++j) { p[j].A = q[j].A; p[j].B = q[j].B; p[j].O = q[j].O; p[j].sA = q[j].sA; p[j].sB = q[j].sB; p[j].sO = q[j].sO; p[j].nM = q[j].nM; p[j].nN = q[j].nN; p[j].nb = q[j].nb;
                p[j].ustart = q[j].ustart; p[j].lda = q[j].lda; p[j].ldb = q[j].ldb; p[j].ldo = q[j].ldo; p[j].osz = q[j].osz; } }
        __syncthreads();
    }
    __device__ __forceinline__ bool next(int i, GUnit& u) const {
        const long long Lq = (long long)i * G + c; if (Lq >= total) return false;
        int L = pg8::xcd_remap((int)Lq, total);
        int k = 0;
#pragma unroll
        for (int j = 1; j < NP; ++j) if (L >= p[j].ustart) k = j;
        k = rfl(k);
        const LAS Prob& q = p[k];
        const int nM = rfl(q.nM), nN = rfl(q.nN), lda = rfl(q.lda), ldb = rfl(q.ldb), ldo = rfl(q.ldo), osz = rfl(q.osz);
        L -= rfl(q.ustart);
        const int per = nM * nN, b = L / per, r = L - b * per, pm = r / nN, pn = r - pm * nN;
        u.pm = pm; u.pn = pn; u.g = b; u.aux = k; u.lda = lda; u.ldb = ldb; u.ldo = ldo; u.hsb = 128; u.half = 0;
        u.a = rflp(q.A) + b * (long long)rfl((int)q.sA) + (size_t)pm * 256 * lda * 2;
        u.b = rflp(q.B) + b * (long long)rfl((int)q.sB) + (size_t)pn * 256 * ldb * 2;
        u.o = (char*)rflp(q.O) + b * (long long)rfl((int)q.sO) + ((size_t)pm * 256 * ldo + (size_t)pn * 256) * osz;
        return true;
    }
};

struct EpiStore {
    static constexpr bool PERM = true;
    const float* rowbias;
    const float* wgp; bf16_t* vts;
    int fragmode;
    __device__ __forceinline__ void operator()(const f32x4 (&acc)[2][2][4][2], const GUnit& u, int wr, int wc, int fr, int fq) const {
        bf16_t* base = (bf16_t*)u.o;
#pragma unroll
        for (int ai = 0; ai < 2; ++ai)
#pragma unroll
            for (int m = 0; m < 4; ++m) { const int r = ai * 128 + wr * 64 + m * 16 + fr;
                const float rb = rowbias ? rowbias[u.pm * 256 + r] : 0.f;
#pragma unroll
                for (int bj = 0; bj < 2; ++bj) { const f32x4 v0 = acc[ai][bj][m][0] + rb, v1 = acc[ai][bj][m][1] + rb;
                    u32x4 w; w.x = pk2(v0[0], v0[1]); w.y = pk2(v0[2], v0[3]); w.z = pk2(v1[0], v1[1]); w.w = pk2(v1[2], v1[3]);
                    const int c = bj * 128 + wc * 32 + 8 * fq;
                    unsigned off;
                    if (fragmode == 0) off = (unsigned)(r * u.ldo + c);
                    else if (u.aux < 2) { const int R = u.pm * 256 + r; off = (unsigned)((((R >> 4) * 8 + (c >> 5)) * 64 + (R & 15) + 16 * fq) * 8); }
                    else { const int R = u.pm * 256 + r, s = u.pn * 256 + c, nrt = (u.aux == 2) ? 16 : 32;
                           off = (unsigned)(((((s >> 6) * nrt + (R >> 4)) * 2 + ((s >> 5) & 1)) * 64 + (R & 15) + 16 * fq) * 8); }
                    *(u32x4*)(base + off) = w; } }
        if (vts != nullptr && u.aux == 3) {
#pragma unroll 1
            for (int dir = 0; dir < 2; ++dir) { const int ch = dir * 4 + u.g;
                bf16_t* ob = vts + (size_t)ch * NCH * 33 * 1024;
#pragma unroll
                for (int bj = 0; bj < 2; ++bj) { const int c = bj * 128 + wc * 32 + 8 * fq, s = u.pn * 256 + c;
                    const f32x4 g0 = *(const f32x4*)(wgp + (size_t)ch * LT + s), g1 = *(const f32x4*)(wgp + (size_t)ch * LT + s + 4);
#pragma unroll
                    for (int ai = 0; ai < 2; ++ai)
#pragma unroll
                        for (int m = 0; m < 4; ++m) { const int R = u.pm * 256 + ai * 128 + wr * 64 + m * 16 + fr; const f32x4 v0 = acc[ai][bj][m][0] * g0, v1 = acc[ai][bj][m][1] * g1;
                            u32x4 w; w.x = pk2(v0[0], v0[1]); w.y = pk2(v0[2], v0[3]); w.z = pk2(v1[0], v1[1]); w.w = pk2(v1[2], v1[3]);
                            *(u32x4*)(ob + (unsigned)(((((s >> 6) * 33 + (R >> 4)) * 2 + ((s >> 5) & 1)) * 64 + (R & 15) + 16 * fq) * 8)) = w; }
                    asm volatile("" ::: "memory"); } }
        }
    }
};

enum { I_X = 0, I_C, I_CTX, I_CCTX, I_ADAW, I_ADAB, I_N1G, I_N2G, I_RGW, I_RGB, I_REW, I_REB, I_W13, I_W2,
       I_MINW, I_MCONVW, I_MCONVB, I_MQW, I_MKW, I_MVW, I_MGATEW, I_MGATEB, I_MNORMG, I_MSKIP, I_MOUTW,
       I_HINW, I_HINB, I_HSCW, I_HSCB, I_HFW1, I_HFB1, I_HFFREQ, I_HFW2, I_HFB2, I_HFW3, I_HDECAY, I_HFBIAS, I_HOUTW, I_HOUTB, I_FINALG };

__device__ __forceinline__ void tconv(const Frame& F, const float* src, bf16_t* dst, int B, int R, int C, float scale, int vbid, int vG) {
    LAS float* tile = (LAS float*)F.lds;
    const int tr = R / 64, tc = C / 64, ntile = B * tr * tc;
    for (int t = vbid; t < ntile; t += vG) {
        const int b = t / (tr * tc), rem = t - b * tr * tc, r0 = (rem / tc) * 64, c0 = (rem % tc) * 64;
        const float* s = src + ((size_t)b * R + r0) * C + c0;
        { const int r = F.tid >> 3, c8 = (F.tid & 7) * 8;
          const f32x4 v0 = *(const f32x4*)(s + (size_t)r * C + c8), v1 = *(const f32x4*)(s + (size_t)r * C + c8 + 4);
#pragma unroll
          for (int j = 0; j < 4; ++j) { tile[r * 65 + c8 + j] = v0[j]; tile[r * 65 + c8 + 4 + j] = v1[j]; } }
        LDS_BAR();
        { const int n = F.tid >> 3, k8 = (F.tid & 7) * 8; float v[8];
#pragma unroll
          for (int j = 0; j < 8; ++j) v[j] = tile[(k8 + j) * 65 + n] * scale;
          u32x4 w; w.x = pk2(v[0], v[1]); w.y = pk2(v[2], v[3]); w.z = pk2(v[4], v[5]); w.w = pk2(v[6], v[7]);
          *(u32x4*)(dst + ((size_t)b * C + c0 + n) * R + r0 + k8) = w; }
        LDS_BAR();
    }
}

__device__ __forceinline__ void adaln_units(const Frame& F, int u_lo, int u_hi, int vbid, int vG) {
    unsigned char* ws = F.ws;
    {
        LAS float* sv = (LAS float*)F.lds;
        LAS float* pr = sv + 2048;
        __syncthreads();
        for (int i = F.tid; i < 2048; i += NT) sv[i] = siluf(i < 1024 ? F.in[I_C][i] : F.in[I_CCTX][i - 1024]);
        __syncthreads();
        const int cl = F.tid & 63, kg = F.tid >> 6;
        for (int u = u_lo + vbid; u < u_hi; u += vG) {
            const int l = u / 96, col = (u % 96) * 64 + cl;
            const float* w = F.in[I_ADAW] + ((size_t)l * 1024 + kg * 128) * 6144 + col;
            float a0 = 0.f, a1 = 0.f;
#pragma unroll 16
            for (int k = 0; k < 128; ++k) { const float wv = w[(size_t)k * 6144]; a0 += sv[kg * 128 + k] * wv; a1 += sv[1024 + kg * 128 + k] * wv; }
            pr[(kg * 2 + 0) * 64 + cl] = a0; pr[(kg * 2 + 1) * 64 + cl] = a1;
            __syncthreads();
            if (F.tid < 128) { const int s2 = F.tid >> 6; float a = F.in[I_ADAB][l * 6144 + col];
#pragma unroll
                for (int g = 0; g < 8; ++g) a += pr[(g * 2 + s2) * 64 + cl];
                ((float*)(ws + WS_MODS))[(size_t)(l * 2 + s2) * 6144 + col] = a; }
            __syncthreads();
        }
    }
}
__device__ __forceinline__ void mlstm_wconv(const Frame& F, int slot, int vbid, int vG) {
    unsigned char* ws = F.ws;
    tconv(F, F.in[I_MINW] + (size_t)slot * 1024 * 4096, (bf16_t*)(ws + WS_WMIN) + (size_t)slot * 1024 * 4096, 1, 1024, 4096, 1.f, vbid, vG);
    tconv(F, F.in[I_MQW] + (size_t)slot * 4 * 512 * 256, (bf16_t*)(ws + WS_WQ) + (size_t)slot * 4 * 512 * 256, 4, 512, 256, 1.f, vbid, vG);
    tconv(F, F.in[I_MKW] + (size_t)slot * 4 * 512 * 256, (bf16_t*)(ws + WS_WK) + (size_t)slot * 4 * 512 * 256, 4, 512, 256, 0.0625f, vbid, vG);
    tconv(F, F.in[I_MVW] + (size_t)slot * 4 * 512 * 512, (bf16_t*)(ws + WS_WV) + (size_t)slot * 4 * 512 * 512, 4, 512, 512, 1.f, vbid, vG);
}
__device__ __forceinline__ void z2_rows(const Frame& F, int row_lo, int row_hi, int vbid, int vG);

__device__ __forceinline__ void p0_prologue(const Frame& F) {
    unsigned char* ws = F.ws;
    adaln_units(F, 0, 96, F.bid, F.G);
    mlstm_wconv(F, 0, F.bid, F.G);
    tconv(F, F.in[I_HFW3], (bf16_t*)(ws + WS_W3T), 1, 64, 2048, 1.f, F.bid, F.G);
    for (int ci = F.bid * NT + F.tid; ci < 8192; ci += F.G * NT) { const int k = (ci >> 9) + 16 * ((ci >> 4) & 31) + 512 * (ci & 15);
        float sn, cs; sincospif((float)k * (1.0f / 16384.0f), &sn, &cs); ((f32x2*)(ws + WS_TWP))[ci] = (f32x2){cs, -sn}; }
    const int gt = F.bid * NT + F.tid, gs = F.G * NT;
    for (int i = gt; i < 2 * 16 * 4096; i += gs) { const int s = i / 65536, r = i % 65536, n = r / 4096, k = r % 4096;
        ((bf16_t*)(ws + WS_GWT))[i] = f2bf(F.in[I_MGATEW][((size_t)s * 4096 + k) * 16 + n]); }
    for (int i = gt; i < 4 * 1024 * 48; i += gs) { const int l = i / 49152, r = i % 49152, k = r / 48, n = r % 48;
        float v = 0.f; if (n < 4) v = F.in[I_RGW][((size_t)l * 1024 + k) * 4 + n]; else if (n < 36) v = F.in[I_REW][((size_t)l * 1024 + k) * 32 + (n - 4)];
        ((float*)(ws + WS_WC))[i] = v; }
    z2_rows(F, 0, SEQ, F.bid, F.G);
    z2_rows(F, 2 * SEQ, 2 * SEQ + CTXN, F.bid, F.G);
}
__device__ __forceinline__ void z2_rows(const Frame& F, int row_lo, int row_hi, int vbid, int vG) {
    unsigned char* ws = F.ws;
    {
        LAS float* ft = (LAS float*)F.lds;
        LAS float* z1 = ft + 8 * 36;
        for (int r0 = row_lo + vbid * 8; r0 < row_hi; r0 += vG * 8) {
            const int rr = F.tid >> 6, j = F.tid & 63, row = r0 + rr;
            int slot, t, Ln; if (row < 2 * SEQ) { slot = row / SEQ; t = row % SEQ; Ln = SEQ; } else { slot = 0; t = row - 2 * SEQ; Ln = CTXN; }
            __syncthreads();
            if (j < 33) { float f;
                if (j == 0) f = (float)t / (float)(Ln - 1);
                else { const int b = (j - 1) % 16 + 1; const int ph = (t * b) % Ln; const float a = (float)ph / (float)Ln;
                       f = (j <= 16) ? cosf(6.283185307179586f * a) : sinf(6.283185307179586f * a); }
                ft[rr * 36 + j] = f; }
            __syncthreads();
            const float fr = F.in[I_HFFREQ][slot * 64 + j];
            { float a = F.in[I_HFB1][slot * 64 + j]; const float* w1 = F.in[I_HFW1] + (size_t)slot * 33 * 64 + j;
#pragma unroll
              for (int k = 0; k < 33; ++k) a += ft[rr * 36 + k] * w1[k * 64];
              z1[rr * 64 + j] = sinf(fr * a); }
            __syncthreads();
            { float a = F.in[I_HFB2][slot * 64 + j]; const float* w2 = F.in[I_HFW2] + (size_t)slot * 64 * 64 + j;
#pragma unroll 8
              for (int k = 0; k < 64; ++k) a += z1[rr * 64 + k] * w2[k * 64];
              const float z = sinf(fr * a);
              bf16_t* dst = (row < 2 * SEQ) ? (bf16_t*)(ws + WS_Z2) + (size_t)row * 64 : (bf16_t*)(ws + WS_Z2C) + (size_t)t * 64;
              dst[j] = f2bf(z); }
        }
        __syncthreads();
    }
}

__device__ __forceinline__ void deferred_convert(const Frame& F, int part, int vbid, int vG) {
    unsigned char* ws = F.ws;
    if (part == 0) {
        tconv(F, F.in[I_MOUTW], (bf16_t*)(ws + WS_WMOUT), 2, 2048, 1024, 1.f, vbid, vG);
        adaln_units(F, 96, 4 * 96, vbid, vG);
        mlstm_wconv(F, 1, vbid, vG);
        tconv(F, F.in[I_HFW3] + (size_t)64 * 2048, (bf16_t*)(ws + WS_W3T) + (size_t)64 * 2048, 1, 64, 2048, 1.f, vbid, vG);
        z2_rows(F, SEQ, 2 * SEQ, vbid, vG);
        tconv(F, F.in[I_HINW], (bf16_t*)(ws + WS_WHIN), 2, 1024, 3072, 1.f, vbid, vG);
        tconv(F, F.in[I_HOUTW], (bf16_t*)(ws + WS_WHOUT), 2, 1024, 1024, 1.f, vbid, vG);
    }
    tconv(F, F.in[I_W13] + (size_t)part * 64 * 1024 * 1024, (bf16_t*)(ws + WS_W13) + (size_t)part * 64 * 1024 * 1024, 64, 1024, 1024, 1.f, vbid, vG);
    tconv(F, F.in[I_W2] + (size_t)part * 64 * 512 * 1024, (bf16_t*)(ws + WS_W2) + (size_t)part * 64 * 512 * 1024, 64, 512, 1024, 1.f, vbid, vG);
}

__device__ __forceinline__ const float* modp(const Frame& F, int l, int s, int piece) { return (const float*)(F.ws + WS_MODS) + ((size_t)(l * 2 + s) * 6 + piece) * 1024; }
__device__ __forceinline__ int scan_pos(int t, bool colmajor) { return colmajor ? ((t & 63) * 256 + (t >> 6)) : t; }
__device__ __forceinline__ int scan_inv(int p, bool colmajor) { return colmajor ? ((p & 255) * 64 + (p >> 8)) : p; }

__device__ __forceinline__ void n1_phase(const Frame& F, int l, bool comb, bool ctx_rows, bool comb_ctx, bool first, bool colmajor) {
    bf16_t* HL = (bf16_t*)(F.ws + WS_HL); bf16_t* HC = (bf16_t*)(F.ws + WS_HC); bf16_t* U = (bf16_t*)(F.ws + WS_U);
    const bf16_t* YB = (const bf16_t*)(F.ws + WS_YBUF);
    const float* g1n = F.in[I_N1G] + l * 1024;
    const int nrows = SEQ + (ctx_rows ? CTXN : 0);
    f32x4 hg2[4], hga[4], hsh[4];
#pragma unroll
    for (int j = 0; j < 4; ++j) { const int c = j * 256 + F.lane * 4; const f32x4 g = *(const f32x4*)(g1n + c), a = *(const f32x4*)(modp(F, l, 0, 1) + c);
        hga[j] = g * (a + 1.0f); hsh[j] = *(const f32x4*)(modp(F, l, 0, 0) + c); hg2[j] = comb ? *(const f32x4*)(modp(F, l - 1, 0, 5) + c) : (f32x4){0.f, 0.f, 0.f, 0.f}; }
    for (int r0 = (F.bid * NWAVES + F.wave) * 2; r0 < nrows; r0 += F.G * NWAVES * 2) {
        f32x4 v[2][4]; float ss[2] = {0.f, 0.f};
        u32x2 y0[2][4], y1[2][4];
#pragma unroll
        for (int q = 0; q < 2; ++q) { const int r = r0 + q; const bool isctx = r >= SEQ; const int t = isctx ? r - SEQ : r;
            const float* src = (isctx ? F.in[I_CTX] : F.in[I_X]) + (size_t)t * 1024; const bf16_t* srch = (isctx ? HC : HL) + (size_t)t * 1024;
            const bool docomb = comb && (!isctx || comb_ctx); const int tok = isctx ? t : CTXN + t;
#pragma unroll
            for (int j = 0; j < 4; ++j) { const int c = j * 256 + F.lane * 4;
                if (first) v[q][j] = *(const f32x4*)(src + c); else { const u32x2 hb = *(const u32x2*)(srch + c); v[q][j] = (f32x4){bflo(hb.x), bfhi(hb.x), bflo(hb.y), bfhi(hb.y)}; }
                if (docomb) { y0[q][j] = *(const u32x2*)(YB + ((size_t)tok * 2 + 0) * 1024 + c); y1[q][j] = *(const u32x2*)(YB + ((size_t)tok * 2 + 1) * 1024 + c); } } }
#pragma unroll
        for (int q = 0; q < 2; ++q) { const int r = r0 + q; const bool isctx = r >= SEQ; const int t = isctx ? r - SEQ : r; const int s = isctx ? 1 : 0;
            bf16_t* dsth = (isctx ? HC : HL) + (size_t)t * 1024;
            const bool docomb = comb && (!isctx || comb_ctx);
            const float* g2 = docomb ? modp(F, l - 1, s, 5) : nullptr;
#pragma unroll
            for (int j = 0; j < 4; ++j) { const int c = j * 256 + F.lane * 4;
                if (docomb) { const f32x4 g = isctx ? *(const f32x4*)(g2 + c) : hg2[j];
                    v[q][j][0] += g[0] * (bflo(y0[q][j].x) + bflo(y1[q][j].x)); v[q][j][1] += g[1] * (bfhi(y0[q][j].x) + bfhi(y1[q][j].x)); v[q][j][2] += g[2] * (bflo(y0[q][j].y) + bflo(y1[q][j].y)); v[q][j][3] += g[3] * (bfhi(y0[q][j].y) + bfhi(y1[q][j].y)); }
                if (docomb || first) { u32x2 hw; hw.x = pk2(v[q][j][0], v[q][j][1]); hw.y = pk2(v[q][j][2], v[q][j][3]); *(u32x2*)(dsth + c) = hw; }
                ss[q] += v[q][j][0] * v[q][j][0] + v[q][j][1] * v[q][j][1] + v[q][j][2] * v[q][j][2] + v[q][j][3] * v[q][j][3]; }
            ss[q] = wave_sum(ss[q]); }
#pragma unroll
        for (int q = 0; q < 2; ++q) { const int r = r0 + q; const bool isctx = r >= SEQ; const int t = isctx ? r - SEQ : r; const int s = isctx ? 1 : 0;
            const float* sh = modp(F, l, s, 0); const float* sc = modp(F, l, s, 1);
            const float rstd = rsqrtf(ss[q] * (1.0f / 1024.0f) + EPS);
            const int urow = isctx ? t : CTXN + scan_pos(t, colmajor);
#pragma unroll
            for (int j = 0; j < 4; ++j) { const int c = j * 256 + F.lane * 4;
                f32x4 ga, b;
                if (isctx) { const f32x4 g = *(const f32x4*)(g1n + c), a = *(const f32x4*)(sc + c); ga = g * (a + 1.0f); b = *(const f32x4*)(sh + c); } else { ga = hga[j]; b = hsh[j]; }
                float o[4];
#pragma unroll
                for (int e = 0; e < 4; ++e) o[e] = v[q][j][e] * rstd * ga[e] + b[e];
                u32x2 w; w.x = pk2(o[0], o[1]); w.y = pk2(o[2], o[3]); *(u32x2*)(U + (size_t)urow * 1024 + c) = w; } }
    }
}

__device__ __forceinline__ void final_phase(const Frame& F, bool comb, int lprev, bool first) {
    const bf16_t* HL = (const bf16_t*)(F.ws + WS_HL); const bf16_t* YB = (const bf16_t*)(F.ws + WS_YBUF); const float* fg = F.in[I_FINALG];
    const float* g2 = comb ? modp(F, lprev, 0, 5) : nullptr;
    for (int t0 = (F.bid * NWAVES + F.wave) * 2; t0 < SEQ; t0 += F.G * NWAVES * 2) {
        f32x4 v[2][4]; u32x2 y0[2][4], y1[2][4]; float ss[2] = {0.f, 0.f};
#pragma unroll
        for (int q = 0; q < 2; ++q) { const int t = t0 + q; const float* src = F.in[I_X] + (size_t)t * 1024; const bf16_t* srch = HL + (size_t)t * 1024; const int tok = CTXN + t;
#pragma unroll
            for (int j = 0; j < 4; ++j) { const int c = j * 256 + F.lane * 4;
                if (first) v[q][j] = *(const f32x4*)(src + c); else { const u32x2 hb = *(const u32x2*)(srch + c); v[q][j] = (f32x4){bflo(hb.x), bfhi(hb.x), bflo(hb.y), bfhi(hb.y)}; }
                if (comb) { y0[q][j] = *(const u32x2*)(YB + ((size_t)tok * 2 + 0) * 1024 + c); y1[q][j] = *(const u32x2*)(YB + ((size_t)tok * 2 + 1) * 1024 + c); } } }
#pragma unroll
        for (int q = 0; q < 2; ++q) {
#pragma unroll
            for (int j = 0; j < 4; ++j) { const int c = j * 256 + F.lane * 4;
                if (comb) { const f32x4 g = *(const f32x4*)(g2 + c);
                    v[q][j][0] += g[0] * (bflo(y0[q][j].x) + bflo(y1[q][j].x)); v[q][j][1] += g[1] * (bfhi(y0[q][j].x) + bfhi(y1[q][j].x)); v[q][j][2] += g[2] * (bflo(y0[q][j].y) + bflo(y1[q][j].y)); v[q][j][3] += g[3] * (bfhi(y0[q][j].y) + bfhi(y1[q][j].y)); }
                ss[q] += v[q][j][0] * v[q][j][0] + v[q][j][1] * v[q][j][1] + v[q][j][2] * v[q][j][2] + v[q][j][3] * v[q][j][3]; }
            ss[q] = wave_sum(ss[q]); }
#pragma unroll
        for (int q = 0; q < 2; ++q) { const int t = t0 + q; const float rstd = rsqrtf(ss[q] * (1.0f / 1024.0f) + EPS);
#pragma unroll
            for (int j = 0; j < 4; ++j) { const int c = j * 256 + F.lane * 4; const f32x4 g = *(const f32x4*)(fg + c);
                f32x4 o;
#pragma unroll
                for (int e = 0; e < 4; ++e) o[e] = v[q][j][e] * rstd * g[e];
                *(f32x4*)(F.out + (size_t)t * 1024 + c) = o; } }
    }
}

__device__ __forceinline__ void hyena_filter_fft(const Frame& F, int vbid, int vG);
__device__ __forceinline__ float* scal_arr(const Frame& F, int k, int ch) { return (float*)(F.ws + WS_SCAL) + ((size_t)k * 8 + ch) * LT; }
__device__ __forceinline__ float* chs_arr(const Frame& F, int k, int ch) { return (float*)(F.ws + WS_CHS) + ((size_t)k * 8 + ch) * NCH; }
__device__ __forceinline__ bf16x8 bload16(__amdgpu_buffer_rsrc_t r, unsigned voff, unsigned soff) { const u32x4 x = __builtin_amdgcn_raw_buffer_load_b128(r, voff, soff, 0); return __builtin_bit_cast(bf16x8, x); }
__device__ __forceinline__ float logsigf(float x) { return fminf(x, 0.f) - log1pf(__expf(-fabsf(x))); }

__device__ __forceinline__ void mlstm_inproj(const Frame& F, int slot) {
    MultiSched<2> S; Prob pr[2];
    const char* W = (const char*)(F.ws + WS_WMIN) + (size_t)slot * 4096 * 1024 * 2;
    pr[0] = Prob{(const char*)(F.ws + WS_U), W, (char*)(F.ws + WS_XCM) + (size_t)4 * LT * 512 * 2, 0, 512 * 1024 * 2, (long long)LT * 512 * 2, NCH / 4, 2, 4, 0, 1024, 1024, 512, 2};
    pr[1] = Prob{(const char*)(F.ws + WS_U), W + (size_t)2048 * 1024 * 2, (char*)(F.ws + WS_OPRE), 0, 0, 0, NCH / 4, 8, 1, 65 * 8, 1024, 1024, 2048, 2};
    S.init(F, pr, 65 * 16);
    EpiStore E{nullptr, nullptr, nullptr, 0};
    pg8::gemm_phase<EpiStore, MultiSched<2>, false>(F.lds, 1024, S, E, F.tid);
}

__device__ __forceinline__ void mlstm_conv_gates(const Frame& F, int slot) {
    constexpr int TP = 4096 + 8;
    LAS bf16_t* tile = (LAS bf16_t*)F.lds;
    LAS float* part = (LAS float*)(F.lds + 16 * TP * 2);
    LAS float* gl = part + 8 * 256;
    bf16_t* XCp = (bf16_t*)(F.ws + WS_XCM) + (size_t)(F.tid >> 7) * LT * 512 + (F.tid & 127) * 4;
    const bf16_t* XMp = XCp + (size_t)4 * LT * 512;
    const bf16_t* GWT = (const bf16_t*)(F.ws + WS_GWT) + (size_t)slot * 16 * 4096;
    const int c4 = F.tid * 4;
    float cw[3][4], cb[4];
#pragma unroll
    for (int k = 0; k < 3; ++k) { const f32x4 w = *(const f32x4*)(F.in[I_MCONVW] + ((size_t)slot * 3 + k) * 2048 + c4); cw[k][0] = w[0]; cw[k][1] = w[1]; cw[k][2] = w[2]; cw[k][3] = w[3]; }
    { const f32x4 b = *(const f32x4*)(F.in[I_MCONVB] + (size_t)slot * 2048 + c4); cb[0] = b[0]; cb[1] = b[1]; cb[2] = b[2]; cb[3] = b[3]; }
    const int fr = F.lane & 15, fq = F.lane >> 4;
    bf16x8 gw[16];
#pragma unroll
    for (int kk = 0; kk < 16; ++kk) gw[kk] = *(const bf16x8*)(GWT + (size_t)fr * 4096 + F.wave * 512 + kk * 32 + fq * 8);
    for (int gc = F.bid; gc < NCH; gc += F.G) {
        const int seq_lo = gc < 4 ? 0 : CTXN, seq_hi = gc < 4 ? CTXN : LT;
        for (int sub = 0; sub < 4; ++sub) {
            const int r0 = gc * 64 + sub * 16;
            u32x2 xr[18];
#pragma unroll
            for (int i = 0; i < 18; ++i) { const int rr = r0 - 1 + i; xr[i] = (rr >= seq_lo && rr < seq_hi) ? *(const u32x2*)(XMp + (size_t)rr * 512) : (u32x2){0u, 0u}; }
#pragma unroll
            for (int rl = 0; rl < 16; ++rl) {
                const int row = r0 + rl; const u32x2 prv = xr[rl], cur = xr[rl + 1], nxt = xr[rl + 2];
                const float p[4] = {bflo(prv.x), bfhi(prv.x), bflo(prv.y), bfhi(prv.y)}, c[4] = {bflo(cur.x), bfhi(cur.x), bflo(cur.y), bfhi(cur.y)}, n[4] = {bflo(nxt.x), bfhi(nxt.x), bflo(nxt.y), bfhi(nxt.y)};
                float o[4];
#pragma unroll
                for (int e = 0; e < 4; ++e) o[e] = siluf(cb[e] + cw[0][e] * p[e] + cw[1][e] * c[e] + cw[2][e] * n[e]);
                u32x2 w; w.x = pk2(o[0], o[1]); w.y = pk2(o[2], o[3]);
                *(u32x2*)(XCp + (size_t)row * 512) = w;
                *(LAS u32x2*)(tile + rl * TP + c4) = w;
                *(LAS u32x2*)(tile + rl * TP + 2048 + c4) = cur;
            }
            LDS_BAR();
            {
                f32x4 acc = {0.f, 0.f, 0.f, 0.f};
#pragma unroll
                for (int kk = 0; kk < 16; ++kk) { const int k0 = F.wave * 512 + kk * 32 + fq * 8;
                    const bf16x8 a = *(const LAS bf16x8*)(tile + fr * TP + k0);
                    acc = __builtin_amdgcn_mfma_f32_16x16x32_bf16(a, gw[kk], acc, 0, 0, 0); }
#pragma unroll
                for (int r = 0; r < 4; ++r) part[F.wave * 256 + (fq * 4 + r) * 16 + fr] = acc[r];
            }
            LDS_BAR();
            if (F.tid < 256) { float a = F.in[I_MGATEB][slot * 16 + (F.tid & 15)];
#pragma unroll
                for (int w = 0; w < 8; ++w) a += part[w * 256 + F.tid];
                gl[(sub * 16 + (F.tid >> 4)) * 16 + (F.tid & 15)] = a; }
        }
        LDS_BAR();
        {
            const int ch = F.wave, dir = ch >> 2, h = ch & 3, j = F.lane, rl = dir ? 63 - j : j, row = gc * 64 + rl;
            const float ig = gl[rl * 16 + (2 * dir) * 4 + h], lf = logsigf(gl[rl * 16 + (2 * dir + 1) * 4 + h]);
            float b = lf;
#pragma unroll
            for (int o = 1; o < 64; o <<= 1) { const float t = __shfl_up(b, o); if (j >= o) b += t; }
            const float cq = ig - b; float pm = cq;
#pragma unroll
            for (int o = 1; o < 64; o <<= 1) { const float t = __shfl_up(pm, o); if (j >= o) pm = fmaxf(pm, t); }
            const float bl = __shfl(b, 63), gq = bl - b + ig, gm = wave_max(gq);
            scal_arr(F, 0, ch)[row] = b; scal_arr(F, 1, ch)[row] = b + pm; scal_arr(F, 2, ch)[row] = gq; scal_arr(F, 3, ch)[row] = cq;
            if (j == 0) { chs_arr(F, 0, ch)[gc] = bl; chs_arr(F, 1, ch)[gc] = gm; }
            const float wp = __expf(gq - gm);
            ((float*)(F.ws + WS_WGP))[(size_t)ch * LT + row] = wp;
            bf16_t* vx = (bf16_t*)(F.ws + WS_VTS) + (((((size_t)ch * NCH + gc) * 33 + 32) * 2 + (rl >> 5)) * 64 + 16 * ((rl & 31) >> 3)) * 8 + (rl & 7);
            vx[0] = f2bf(wp);
#pragma unroll
            for (int z = 1; z < 16; ++z) vx[z * 8] = 0;
        }
        LDS_BAR();
    }
}

__device__ __forceinline__ void mlstm_qkv(const Frame& F, int slot) {
    MultiSched<4> S; Prob pr[4];
    const char* WQ = (const char*)(F.ws + WS_WQ) + (size_t)slot * 4 * 256 * 512 * 2;
    const char* WK = (const char*)(F.ws + WS_WK) + (size_t)slot * 4 * 256 * 512 * 2;
    const char* WV = (const char*)(F.ws + WS_WV) + (size_t)slot * 4 * 512 * 512 * 2;
    const char* XC = (const char*)(F.ws + WS_XCM); const char* XM = XC + (size_t)4 * LT * 512 * 2; const long long HS = (long long)LT * 512 * 2;
    pr[0] = Prob{XC, WQ, (char*)(F.ws + WS_Q),  HS, 256 * 512 * 2, (long long)LT * 256 * 2, 65, 1, 4, 0,    512, 512,  0, 0};
    pr[1] = Prob{XC, WK, (char*)(F.ws + WS_KN), HS, 256 * 512 * 2, (long long)LT * 256 * 2, 65, 1, 4, 260,  512, 512,  0, 0};
    pr[2] = Prob{WK, XC, (char*)(F.ws + WS_KT), 256 * 512 * 2, HS, (long long)256 * LT * 2, 1, 65, 4, 520,  512,  512, 0,  0};
    pr[3] = Prob{WV, XM, (char*)(F.ws + WS_VT), 512 * 512 * 2, HS, (long long)512 * LT * 2, 2, 65, 4, 780, 512, 512, 0, 0};
    S.init(F, pr, 780 + 520);
    EpiStore E{nullptr, (const float*)(F.ws + WS_WGP), (bf16_t*)(F.ws + WS_VTS), 1};
    pg8::gemm_phase<EpiStore, MultiSched<4>, false>(F.lds, 512, S, E, F.tid);
}

constexpr int SCAN_NV = 4;
struct ScanBufR { bf16x8 q[8]; bf16x8 v[2]; float bq[4], aq[4]; float bl, gm; };
struct ScanBufU { bf16x8 k[8]; float bl, gm; };
__device__ __forceinline__ int scan_chunk(int dir, int st) { return dir == 0 ? st : (st < 4 ? 3 - st : 263 - st); }
#define SCAN_BAR() do { asm volatile("s_waitcnt lgkmcnt(0)" ::: "memory"); __builtin_amdgcn_s_barrier(); asm volatile("" ::: "memory"); } while (0)

template <bool DEN> __device__ __forceinline__ void scan_job(const Frame& F, const int ch, const int sl) {
    constexpr int CP = 256 + 16, NV = SCAN_NV;
    LAS bf16_t* Cs = (LAS bf16_t*)F.lds;
    LAS bf16x8* VS = (LAS bf16x8*)(F.lds + 2 * NV * 16 * CP * 2);
    const bf16_t* Q = (const bf16_t*)(F.ws + WS_Q); const bf16_t* KT = (const bf16_t*)(F.ws + WS_KT); const bf16_t* VTS = (const bf16_t*)(F.ws + WS_VTS);
    const int w = F.wave;
    {
        const int dir = ch >> 2, h = ch & 3; constexpr bool denjob = DEN; constexpr int ntile = DEN ? 1 : NV;
        const float* BL = chs_arr(F, 0, ch); const float* GM = chs_arr(F, 1, ch);
        __syncthreads();
        for (int i = F.tid; i < 2 * NV * 16 * CP / 2; i += NT) ((LAS unsigned*)Cs)[i] = 0u;
        float m = 0.f;
        if (w < 4) {
            const float* BQ = scal_arr(F, 0, ch); const float* AQ = scal_arr(F, 1, ch); float* MS = chs_arr(F, 2, ch);
            const int fr = F.lane & 15, fq = F.lane >> 4;
            const __amdgpu_buffer_rsrc_t rsQ = __builtin_amdgcn_make_buffer_rsrc((void*)(Q + (size_t)h * LT * 256), 0, LT * 256 * 2, 0x00020000);
            const __amdgpu_buffer_rsrc_t rsV = __builtin_amdgcn_make_buffer_rsrc((void*)(VTS + (size_t)ch * NCH * 33 * 1024), 0, NCH * 33 * 1024 * 2, 0x00020000);
            const unsigned loQ = (unsigned)F.lane * 16u + (unsigned)w * 8192u, loV = (unsigned)F.lane * 16u + (unsigned)(denjob ? 32 : sl * NV + w) * 2048u, loS = (unsigned)(16 * w + fq * 4) * 4u;
            char* ubO = (char*)(F.ws + WS_OINT) + ((((size_t)ch * NCH) * 32 + sl * NV) * 4 + w) * 512;
            {
                const unsigned g0 = (unsigned)scan_chunk(dir, 0);
#pragma unroll
                for (int kk = 0; kk < 2; ++kk) VS[((0 * NV + w) * 2 + kk) * 64 + F.lane] = bload16(rsV, loV, g0 * (33u * 2048u) + kk * 1024u);
            }
            __syncthreads();
            ScanBufR sb[3];
#define SCAN_LOAD_R(B, st_) do { const unsigned gc_ = (unsigned)scan_chunk(dir, st_), gn_ = (unsigned)scan_chunk(dir, ((st_) + 1 < NCH) ? (st_) + 1 : (st_)); sb[B].bl = BL[gc_]; sb[B].gm = GM[gc_]; \
            _Pragma("unroll") for (int i = 0; i < 8; ++i) sb[B].q[i] = bload16(rsQ, loQ, gc_ * 32768u + i * 1024u); \
            _Pragma("unroll") for (int kk = 0; kk < 2; ++kk) sb[B].v[kk] = bload16(rsV, loV, gn_ * (33u * 2048u) + kk * 1024u); \
            { const f32x4 a0_ = *(const f32x4*)((const char*)BQ + (size_t)gc_ * 256 + loS), a1_ = *(const f32x4*)((const char*)AQ + (size_t)gc_ * 256 + loS); \
              _Pragma("unroll") for (int e = 0; e < 4; ++e) { sb[B].bq[e] = a0_[e]; sb[B].aq[e] = a1_[e]; } } } while (0)
#define SCAN_LPART_R(LB, lst_, part) do { { const int lc_ = ((lst_) < NCH) ? (lst_) : NCH - 1;     \
            const unsigned gc2_ = (unsigned)scan_chunk(dir, lc_), gn2_ = (unsigned)scan_chunk(dir, (lc_ + 1 < NCH) ? lc_ + 1 : lc_); \
            __builtin_amdgcn_sched_barrier(0x38F); \
            sb[LB].q[2 * (part)] = bload16(rsQ, loQ, gc2_ * 32768u + (2 * (part)) * 1024u); sb[LB].q[2 * (part) + 1] = bload16(rsQ, loQ, gc2_ * 32768u + (2 * (part) + 1) * 1024u); \
            if ((part) == 0) { sb[LB].bl = BL[gc2_]; sb[LB].gm = GM[gc2_]; } \
            if ((part) == 1) { const f32x4 a0_ = *(const f32x4*)((const char*)BQ + (size_t)gc2_ * 256 + loS), a1_ = *(const f32x4*)((const char*)AQ + (size_t)gc2_ * 256 + loS); \
                _Pragma("unroll") for (int e = 0; e < 4; ++e) { sb[LB].bq[e] = a0_[e]; sb[LB].aq[e] = a1_[e]; } } \
            if ((part) >= 2) sb[LB].v[(part) - 2] = bload16(rsV, loV, gn2_ * (33u * 2048u) + ((part) - 2) * 1024u); \
            __builtin_amdgcn_sched_barrier(0); } } while (0)
#define SCAN_STEP_R(B, st_, CB, LB, lst_) do { const int gc_ = scan_chunk(dir, st_), row0_ = gc_ * 64; constexpr int cb_ = CB; \
            int ln_ = F.lane; asm volatile("" : "+v"(ln_)); const int fr_ = ln_ & 15, fq_ = ln_ >> 4;     \
            const float mn_ = fmaxf(sb[B].bl + m, sb[B].gm); \
            if (sl == 0 && w == 0 && ln_ == 0) MS[gc_] = m; \
            _Pragma("unroll") for (int kk = 0; kk < 2; ++kk) VS[(((cb_ ^ 1) * NV + w) * 2 + kk) * 64 + ln_] = sb[B].v[kk]; \
            float wj_[4]; _Pragma("unroll") for (int r = 0; r < 4; ++r) { const float in_ = sb[B].bq[r] + m, mj_ = fmaxf(in_, sb[B].aq[r]); wj_[r] = __expf(in_ - mj_); } \
            _Pragma("unroll") for (int t = 0; t < NV; ++t) { if (t < ntile) { f32x4 o_ = {0.f, 0.f, 0.f, 0.f}; \
                _Pragma("unroll") for (int kk = 0; kk < 8; ++kk) { const bf16x8 b_ = *(const LAS bf16x8*)(Cs + ((cb_ * NV + t) * 16 + fr_) * CP + kk * 32 + fq_ * 8); o_ = __builtin_amdgcn_mfma_f32_16x16x32_bf16(sb[B].q[kk], b_, o_, 0, 0, 0); } \
                if (!denjob) { u32x2 pw_; pw_.x = pk2(o_[0] * wj_[0], o_[1] * wj_[1]); pw_.y = pk2(o_[2] * wj_[2], o_[3] * wj_[3]); \
                    *(u32x2*)(ubO + ((size_t)gc_ * 32 + t) * 2048 + (unsigned)ln_ * 8u) = pw_; } \
                else if (fr_ == 0) { float* dn_ = (float*)(F.ws + WS_DENI) + (size_t)ch * LT + row0_ + 16 * w + fq_ * 4; \
                    _Pragma("unroll") for (int r = 0; r < 4; ++r) dn_[r] = o_[r] * wj_[r]; } } \
                SCAN_LPART_R(LB, lst_, t); }     \
            m = mn_; SCAN_BAR(); } while (0)
            SCAN_LOAD_R(0, 0); SCAN_LOAD_R(1, 1);
            static_assert((NCH - 2) % 6 == 0, "two peeled steps + whole groups of six (3 register buffers x 2 LDS state buffers): no guards inside the loop");
            SCAN_STEP_R(0, 0, 0, 2, 2);
            SCAN_STEP_R(1, 1, 1, 0, 3);
            for (int st = 2; st < NCH; st += 6) {
                SCAN_STEP_R(2, st, 0, 1, st + 2);
                SCAN_STEP_R(0, st + 1, 1, 2, st + 3);
                SCAN_STEP_R(1, st + 2, 0, 0, st + 4);
                SCAN_STEP_R(2, st + 3, 1, 1, st + 5);
                SCAN_STEP_R(0, st + 4, 0, 2, st + 6);
                SCAN_STEP_R(1, st + 5, 1, 0, st + 7);
            }
#undef SCAN_LPART_R
#undef SCAN_LOAD_R
#undef SCAN_STEP_R
        } else {
            const int u = w - 4; const int fr = F.lane & 15, fq = F.lane >> 4;
            const __amdgpu_buffer_rsrc_t rsK = __builtin_amdgcn_make_buffer_rsrc((void*)(KT + (size_t)h * 256 * LT), 0, 256 * LT * 2, 0x00020000);
            const unsigned loK = (unsigned)F.lane * 16u + (unsigned)u * 8192u;
            f32x4 acc[NV][4];
#pragma unroll
            for (int t = 0; t < NV; ++t)
#pragma unroll
                for (int d = 0; d < 4; ++d) acc[t][d] = (f32x4){0.f, 0.f, 0.f, 0.f};
            __syncthreads();
            ScanBufU sb[3];
#define SCAN_LOAD_U(B, st_) do { const unsigned gc_ = (unsigned)scan_chunk(dir, st_); sb[B].bl = BL[gc_]; sb[B].gm = GM[gc_]; \
            _Pragma("unroll") for (int i = 0; i < 8; ++i) sb[B].k[i] = bload16(rsK, loK, gc_ * 32768u + (unsigned)i * 1024u); } while (0)
#define SCAN_LPART_U(LB, lst_, part) do { { const unsigned gc2_ = (unsigned)scan_chunk(dir, ((lst_) < NCH) ? (lst_) : NCH - 1); \
            __builtin_amdgcn_sched_barrier(0x38F); \
            sb[LB].k[2 * (part)] = bload16(rsK, loK, gc2_ * 32768u + (unsigned)(2 * (part)) * 1024u); sb[LB].k[2 * (part) + 1] = bload16(rsK, loK, gc2_ * 32768u + (unsigned)(2 * (part) + 1) * 1024u); \
            if ((part) == 0) { sb[LB].bl = BL[gc2_]; sb[LB].gm = GM[gc2_]; } \
            __builtin_amdgcn_sched_barrier(0); } } while (0)
#define SCAN_STEP_U(B, st_, CB, LB, lst_) do { constexpr int cb_ = CB; \
            int ln_ = F.lane; asm volatile("" : "+v"(ln_)); const int fr_ = ln_ & 15, fq_ = ln_ >> 4; \
            const float bl_ = sb[B].bl, gm_ = sb[B].gm; const float mn_ = fmaxf(bl_ + m, gm_), dec_ = __expf(bl_ + m - mn_), sf_ = __expf(gm_ - mn_); \
            _Pragma("unroll") for (int t = 0; t < NV; ++t) { if (t < ntile) { \
                const bf16x8 v0_ = VS[((cb_ * NV + t) * 2 + 0) * 64 + ln_], v1_ = VS[((cb_ * NV + t) * 2 + 1) * 64 + ln_]; \
                _Pragma("unroll") for (int d = 0; d < 4; ++d) { f32x4 n_ = {0.f, 0.f, 0.f, 0.f}; \
                    n_ = __builtin_amdgcn_mfma_f32_16x16x32_bf16(sb[B].k[2 * d], v0_, n_, 0, 0, 0); n_ = __builtin_amdgcn_mfma_f32_16x16x32_bf16(sb[B].k[2 * d + 1], v1_, n_, 0, 0, 0); \
                    const f32x4 a_ = acc[t][d] * dec_ + n_ * sf_; acc[t][d] = a_; \
                    u32x2 pw_; pw_.x = pk2(a_[0], a_[1]); pw_.y = pk2(a_[2], a_[3]); \
                    *(LAS u32x2*)(Cs + (((cb_ ^ 1) * NV + t) * 16 + fr_) * CP + 16 * (4 * u + d) + fq_ * 4) = pw_; } } \
                SCAN_LPART_U(LB, lst_, t); } \
            m = mn_; SCAN_BAR(); } while (0)
            SCAN_LOAD_U(0, 0); SCAN_LOAD_U(1, 1);
            SCAN_STEP_U(0, 0, 0, 2, 2);
            SCAN_STEP_U(1, 1, 1, 0, 3);
            for (int st = 2; st < NCH; st += 6) {
                SCAN_STEP_U(2, st, 0, 1, st + 2);
                SCAN_STEP_U(0, st + 1, 1, 2, st + 3);
                SCAN_STEP_U(1, st + 2, 0, 0, st + 4);
                SCAN_STEP_U(2, st + 3, 1, 1, st + 5);
                SCAN_STEP_U(0, st + 4, 0, 2, st + 6);
                SCAN_STEP_U(1, st + 5, 1, 0, st + 7);
            }
#undef SCAN_LPART_U
#undef SCAN_LOAD_U
#undef SCAN_STEP_U
        }
    }
}

__device__ __forceinline__ void mlstm_scan(const Frame& F, int cvt_part) {
    constexpr int CP = 256 + 16, NV = SCAN_NV, NSL = 32 / NV;
    static_assert(NV == 4, "one reader wave per v-tile");
    LAS bf16_t* Cs = (LAS bf16_t*)F.lds;
    LAS bf16x8* VS = (LAS bf16x8*)(F.lds + 2 * NV * 16 * CP * 2);
    const bf16_t* Q = (const bf16_t*)(F.ws + WS_Q); const bf16_t* KT = (const bf16_t*)(F.ws + WS_KT); const bf16_t* VTS = (const bf16_t*)(F.ws + WS_VTS);
    const int w = F.wave;
    const int job = F.bid;
    if (job >= 8 * (NSL + 1)) { deferred_convert(F, cvt_part, job - 8 * (NSL + 1), F.G - 8 * (NSL + 1)); hyena_filter_fft(F, job - 8 * (NSL + 1), F.G - 8 * (NSL + 1)); return; }
    { const int ch = job & 7, sl = job >> 3;
      if (sl == NSL) scan_job<true>(F, ch, sl); else scan_job<false>(F, ch, sl); }
}

__device__ __forceinline__ void mlstm_intra(const Frame& F, int slot, int gc_lo) {
    constexpr int SP = 64 + 8;
    LAS float* sc = (LAS float*)F.lds;
    LAS bf16_t* Sb = (LAS bf16_t*)(F.lds + 2 * 6 * 64 * 4);
    LAS float* stt = (LAS float*)(F.lds + 2 * 6 * 64 * 4 + 2 * 64 * SP * 2);
    LAS float* mr = stt + 64 * 8 * 2;
    constexpr int HP = 512 + 8;
    LAS bf16_t* Hs = (LAS bf16_t*)(mr + 128);
    const bf16_t* Q = (const bf16_t*)(F.ws + WS_Q); const bf16_t* KN = (const bf16_t*)(F.ws + WS_KN); const bf16_t* VT = (const bf16_t*)(F.ws + WS_VT);
    const bf16_t* XCM = (const bf16_t*)(F.ws + WS_XCM); const bf16_t* OPRE = (const bf16_t*)(F.ws + WS_OPRE); bf16_t* Y = (bf16_t*)(F.ws + WS_Y);
    const float* NG = F.in[I_MNORMG] + (size_t)slot * 2048; const float* SK = F.in[I_MSKIP] + (size_t)slot * 2048;
    const int w = F.wave;
    const int nunit = (NCH - gc_lo) * 4;
    for (int un = F.bid; un < nunit; un += F.G) {
        int ln_ = F.lane; asm volatile("" : "+v"(ln_)); const int fr = ln_ & 15, fq = ln_ >> 4;
        const int tid_ = w * 64 + ln_;
        const int gc = gc_lo + un / 4, h = un & 3, row0 = gc * 64;
        LDS_BAR();
        if (tid_ < 128) { const int dir = tid_ >> 6, i = tid_ & 63, ch = dir * 4 + h, row = row0 + i;
            const float bq = scal_arr(F, 0, ch)[row], aq = scal_arr(F, 1, ch)[row], cq = scal_arr(F, 3, ch)[row], m0 = chs_arr(F, 2, ch)[gc];
            const float mj = fmaxf(bq + m0, aq);
            LAS float* s = sc + dir * 6 * 64;
            s[i] = bq; s[64 + i] = cq; s[128 + i] = mj; s[192 + i] = __expf(-mj); s[256 + i] = ((const float*)(F.ws + WS_DENI))[(size_t)ch * LT + row]; }
        const int it = w >> 1, st0 = (w & 1) * 2;
        f32x4 sa[2] = {{0.f, 0.f, 0.f, 0.f}, {0.f, 0.f, 0.f, 0.f}};
        {
            const __amdgpu_buffer_rsrc_t rsQi = __builtin_amdgcn_make_buffer_rsrc((void*)(Q + ((size_t)h * 1040 + gc * 4) * 4096), 0, 4 * 4096 * 2, 0x00020000);
            const __amdgpu_buffer_rsrc_t rsKi = __builtin_amdgcn_make_buffer_rsrc((void*)(KN + ((size_t)h * 1040 + gc * 4) * 4096), 0, 4 * 4096 * 2, 0x00020000);
            const unsigned lo = (unsigned)ln_ * 16u;
#pragma unroll
            for (int kk = 0; kk < 8; ++kk) { const bf16x8 a = bload16(rsQi, lo, (unsigned)((it * 8 + kk) * 1024)), b0 = bload16(rsKi, lo, (unsigned)((st0 * 8 + kk) * 1024)), b1 = bload16(rsKi, lo, (unsigned)(((st0 + 1) * 8 + kk) * 1024));
                sa[0] = __builtin_amdgcn_mfma_f32_16x16x32_bf16(a, b0, sa[0], 0, 0, 0); sa[1] = __builtin_amdgcn_mfma_f32_16x16x32_bf16(a, b1, sa[1], 0, 0, 0); }
        }
        LDS_BAR();
#pragma unroll
        for (int t = 0; t < 2; ++t) { const int s = 16 * (st0 + t) + fr;
#pragma unroll
            for (int r = 0; r < 4; ++r) { const int i = 16 * it + fq * 4 + r;
                const float wf = (s <= i) ? __expf(sc[i] + sc[64 + s] - sc[128 + i]) : 0.f;
                const float wb = (s >= i) ? __expf(sc[384 + i] + sc[384 + 64 + s] - sc[384 + 128 + i]) : 0.f;
                Sb[(0 * 64 + i) * SP + s] = f2bf(sa[t][r] * wf); Sb[(1 * 64 + i) * SP + s] = f2bf(sa[t][r] * wb); } }
        LDS_BAR();
        if (tid_ < 128) { const int dir = tid_ >> 6, i = tid_ & 63; float a = 0.f;
            for (int s = 0; s < 64; ++s) a += bf2f(Sb[(dir * 64 + i) * SP + s]);
            sc[dir * 384 + 320 + i] = a; }
        const __amdgpu_buffer_rsrc_t rsO0 = __builtin_amdgcn_make_buffer_rsrc((void*)(F.ws + WS_OINT + ((size_t)h * NCH + gc) * 65536), 0, 65536, 0x00020000);
        const __amdgpu_buffer_rsrc_t rsO1 = __builtin_amdgcn_make_buffer_rsrc((void*)(F.ws + WS_OINT + ((size_t)(4 + h) * NCH + gc) * 65536), 0, 65536, 0x00020000);
        const __amdgpu_buffer_rsrc_t rsVT = __builtin_amdgcn_make_buffer_rsrc((void*)(VT + ((size_t)h * NCH + gc) * 512 * 64), 0, 512 * 64 * 2, 0x00020000);
        f32x4 oa[2][4][4];
#pragma unroll
        for (int d = 0; d < 2; ++d)
#pragma unroll
            for (int a = 0; a < 4; ++a)
#pragma unroll
                for (int b = 0; b < 4; ++b) oa[d][a][b] = (f32x4){0.f, 0.f, 0.f, 0.f};
        {
#pragma unroll
            for (int kk = 0; kk < 2; ++kk) {
                bf16x8 vb[4];
#pragma unroll
                for (int vt = 0; vt < 4; ++vt) vb[vt] = bload16(rsVT, (unsigned)ln_ * 16u, (unsigned)(((4 * w + vt) * 2 + kk) * 1024));
#pragma unroll
                for (int d = 0; d < 2; ++d)
#pragma unroll
                    for (int a = 0; a < 4; ++a) { const bf16x8 sf = *(const LAS bf16x8*)(Sb + (d * 64 + 16 * a + fr) * SP + kk * 32 + fq * 8);
#pragma unroll
                        for (int vt = 0; vt < 4; ++vt) oa[d][a][vt] = __builtin_amdgcn_mfma_f32_16x16x32_bf16(sf, vb[vt], oa[d][a][vt], 0, 0, 0); }
            }
        }
        LDS_BAR();
        u32x2 oi[2][2][4];
#define OI_LOAD(buf, a_) do { _Pragma("unroll") for (int vt = 0; vt < 4; ++vt) { \
            oi[buf][0][vt] = __builtin_bit_cast(u32x2, __builtin_amdgcn_raw_buffer_load_b64(rsO0, (unsigned)ln_ * 8u, (unsigned)(((4 * w + vt) * 4 + (a_)) * 512), 0)); \
            oi[buf][1][vt] = __builtin_bit_cast(u32x2, __builtin_amdgcn_raw_buffer_load_b64(rsO1, (unsigned)ln_ * 8u, (unsigned)(((4 * w + vt) * 4 + (a_)) * 512), 0)); } } while (0)
        OI_LOAD(0, 0);
#pragma unroll
        for (int a = 0; a < 4; ++a) {
            if (a < 3) OI_LOAD((a + 1) & 1, a + 1);
            float den[2][4], emj[2][4];
#pragma unroll
            for (int d = 0; d < 2; ++d)
#pragma unroll
                for (int r = 0; r < 4; ++r) { const int i = 16 * a + fq * 4 + r; emj[d][r] = sc[d * 384 + 192 + i]; den[d][r] = __builtin_amdgcn_rcpf(fmaxf(fabsf(sc[d * 384 + 320 + i] + sc[d * 384 + 256 + i]), emj[d][r])); }
            float s1[4] = {0.f, 0.f, 0.f, 0.f}, s2[4] = {0.f, 0.f, 0.f, 0.f};
#pragma unroll
            for (int vt = 0; vt < 4; ++vt) {
                const u32x2 o0 = oi[a & 1][0][vt], o1 = oi[a & 1][1][vt];
                const float i0[4] = {bflo(o0.x), bfhi(o0.x), bflo(o0.y), bfhi(o0.y)}, i1[4] = {bflo(o1.x), bfhi(o1.x), bflo(o1.y), bfhi(o1.y)};
#pragma unroll
                for (int r = 0; r < 4; ++r) { const float hf = (oa[0][a][vt][r] + i0[r]) * den[0][r], hb = (oa[1][a][vt][r] + i1[r]) * den[1][r];
                    const float hs = hf + hb; s1[r] += hs; s2[r] += hs * hs; Hs[(16 * a + fq * 4 + r) * HP + 64 * w + 16 * vt + fr] = f2bf(hs); }
            }
#pragma unroll
            for (int r = 0; r < 4; ++r) {
#pragma unroll
                for (int o = 1; o < 16; o <<= 1) { s1[r] += __shfl_xor(s1[r], o); s2[r] += __shfl_xor(s2[r], o); }
                if (fr == 0) { const int i = 16 * a + fq * 4 + r; stt[(i * 8 + w) * 2] = s1[r]; stt[(i * 8 + w) * 2 + 1] = s2[r]; } }
            __builtin_amdgcn_sched_barrier(0);
        }
#undef OI_LOAD
        LDS_BAR();
        if (tid_ < 64) { float a = 0.f, b = 0.f;
#pragma unroll
            for (int ww = 0; ww < 8; ++ww) { a += stt[(tid_ * 8 + ww) * 2]; b += stt[(tid_ * 8 + ww) * 2 + 1]; }
            const float mu = a * (1.0f / 512.0f), var = fmaxf(b * (1.0f / 512.0f) - mu * mu, 0.f);
            mr[tid_ * 2] = mu; mr[tid_ * 2 + 1] = rsqrtf(var + EPS); }
        LDS_BAR();
        {
            const int i = tid_ >> 3; const float mu = mr[i * 2], rs = mr[i * 2 + 1]; const size_t row = (size_t)(row0 + i);
#pragma unroll 2
            for (int q = 0; q < 8; ++q) { const int v8 = (tid_ & 7) * 8 + 64 * q, c = h * 512 + v8;
                const u32x4 hv = *(const LAS u32x4*)(Hs + i * HP + v8), xv = *(const u32x4*)(XCM + ((size_t)h * LT + row) * 512 + v8), ov = *(const u32x4*)(OPRE + row * 2048 + c);
                const f32x4 g0 = *(const f32x4*)(NG + c), g1 = *(const f32x4*)(NG + c + 4), k0 = *(const f32x4*)(SK + c), k1 = *(const f32x4*)(SK + c + 4);
                float o[8];
#pragma unroll
                for (int e = 0; e < 8; ++e) { const unsigned hw = hv[e >> 1], xw = xv[e >> 1], ow = ov[e >> 1];
                    const float hh = (e & 1) ? bfhi(hw) : bflo(hw), xc = (e & 1) ? bfhi(xw) : bflo(xw), op = (e & 1) ? bfhi(ow) : bflo(ow);
                    const float ng = e < 4 ? g0[e & 3] : g1[e & 3], sk = e < 4 ? k0[e & 3] : k1[e & 3];
                    o[e] = ((hh - mu) * rs * ng + sk * xc) * sigmf(op); }
                u32x4 wv; wv.x = pk2(o[0], o[1]); wv.y = pk2(o[2], o[3]); wv.z = pk2(o[4], o[5]); wv.w = pk2(o[6], o[7]);
                *(u32x4*)(Y + row * 2048 + c) = wv; }
        }
    }
}

struct EpiResid {
    static constexpr bool PERM = false;
    bf16_t* HL; bf16_t* HC; const float* g_lat; const float* g_ctx; const float* bias; int rowbase; bool colmajor;
    __device__ __forceinline__ void operator()(const f32x4 (&acc)[2][2][4][2], const GUnit& u, int wr, int wc, int fr, int fq) const {
        const int col0 = u.pn * 256 + wc * 32 + 4 * fq;
        const bool isctx = (rowbase + u.pm * 256) < CTXN;
        const float* g = isctx ? g_ctx : g_lat;
        f32x4 gv[2][2], bv[2][2];
#pragma unroll
        for (int bj = 0; bj < 2; ++bj)
#pragma unroll
            for (int n = 0; n < 2; ++n) { gv[bj][n] = *(const f32x4*)(g + col0 + bj * 128 + n * 16); bv[bj][n] = bias ? *(const f32x4*)(bias + col0 + bj * 128 + n * 16) : (f32x4){0.f, 0.f, 0.f, 0.f}; }
#pragma unroll
        for (int ai = 0; ai < 2; ++ai)
#pragma unroll
            for (int m = 0; m < 4; ++m) { const int R = rowbase + u.pm * 256 + ai * 128 + wr * 64 + m * 16 + fr;
                bf16_t* rowp = isctx ? HC + (size_t)R * 1024 : HL + (size_t)scan_inv(R - CTXN, colmajor) * 1024;
#pragma unroll
                for (int bj = 0; bj < 2; ++bj)
#pragma unroll
                    for (int n = 0; n < 2; ++n) { bf16_t* p = rowp + col0 + bj * 128 + n * 16; const u32x2 hb = *(const u32x2*)p; const f32x4 o = (f32x4){bflo(hb.x), bfhi(hb.x), bflo(hb.y), bfhi(hb.y)} + gv[bj][n] * (acc[ai][bj][m][n] + bv[bj][n]);
                        u32x2 hw; hw.x = pk2(o[0], o[1]); hw.y = pk2(o[2], o[3]); *(u32x2*)p = hw; } }
    }
};

__device__ __forceinline__ void mlstm_outproj(const Frame& F, int l, int slot, bool with_ctx, bool colmajor) {
    MultiSched<1> S; Prob pr[1];
    const int rowbase = with_ctx ? 0 : CTXN, nM = with_ctx ? 65 : 64;
    pr[0] = Prob{(const char*)(F.ws + WS_Y) + (size_t)rowbase * 2048 * 2, (const char*)(F.ws + WS_WMOUT) + (size_t)slot * 1024 * 2048 * 2, nullptr, 0, 0, 0, nM, 4, 1, 0, 2048, 2048, 0, 0};
    S.init(F, pr, nM * 4);
    EpiResid E{(bf16_t*)(F.ws + WS_HL), (bf16_t*)(F.ws + WS_HC), modp(F, l, 0, 2), modp(F, l, 1, 2), nullptr, rowbase, colmajor};
    pg8::gemm_phase<EpiResid, MultiSched<1>, false>(F.lds, 2048, S, E, F.tid);
}
__device__ __forceinline__ void hyena_filtergen(const Frame& F, int slot, bool with_ctx) {
    const bf16_t* Z2 = (const bf16_t*)(F.ws + WS_Z2) + (size_t)slot * SEQ * 64;
    const bf16_t* W3T = (const bf16_t*)(F.ws + WS_W3T) + (size_t)slot * 2048 * 64;
    const float* dec = F.in[I_HDECAY] + (size_t)slot * 2048;
    bf16_t* FILT = (bf16_t*)(F.ws + WS_FILT2);
    const int fr = F.lane & 15, fq = F.lane >> 4;
    for (int gw = F.bid * NWAVES + F.wave; gw < 128 * 16; gw += F.G * NWAVES) {
        const int oct = gw & 127, tg = gw >> 7, oc = oct * 16 + fr;
        bf16x8 b[2];
#pragma unroll
        for (int kk = 0; kk < 2; ++kk) b[kk] = *(const bf16x8*)(W3T + (size_t)oc * 64 + kk * 32 + fq * 8);
        const float dc = dec[oc];
        for (int tt = 0; tt < 64; ++tt) {
            const int t0 = (tg * 64 + tt) * 16;
            f32x4 acc = {0.f, 0.f, 0.f, 0.f};
#pragma unroll
            for (int kk = 0; kk < 2; ++kk) { const bf16x8 a = *(const bf16x8*)(Z2 + (size_t)(t0 + fr) * 64 + kk * 32 + fq * 8); acc = __builtin_amdgcn_mfma_f32_16x16x32_bf16(a, b[kk], acc, 0, 0, 0); }
            float o[4];
#pragma unroll
            for (int r = 0; r < 4; ++r) { const int t = t0 + fq * 4 + r; const float tau = fabsf((float)(t - SEQ / 2)) * (1.0f / (SEQ / 2)); o[r] = acc[r] * __expf(-tau * dc); }
            u32x2 w; w.x = pk2(o[0], o[1]); w.y = pk2(o[2], o[3]);
            *(u32x2*)(FILT + (size_t)oc * SEQ + t0 + fq * 4) = w;
        }
        if (with_ctx) {
            const bf16_t* Z2C = (const bf16_t*)(F.ws + WS_Z2C); float* FC = (float*)(F.ws + WS_FILTC);
            const int t0 = tg * 16;
            f32x4 acc = {0.f, 0.f, 0.f, 0.f};
#pragma unroll
            for (int kk = 0; kk < 2; ++kk) { const bf16x8 a = *(const bf16x8*)(Z2C + (size_t)(t0 + fr) * 64 + kk * 32 + fq * 8); acc = __builtin_amdgcn_mfma_f32_16x16x32_bf16(a, b[kk], acc, 0, 0, 0); }
#pragma unroll
            for (int r = 0; r < 4; ++r) { const int t = t0 + fq * 4 + r; const float tau = fabsf((float)(t - CTXN / 2)) * (1.0f / (CTXN / 2)); FC[(size_t)oc * CTXN + t] = acc[r] * __expf(-tau * dc); }
        }
    }
}

__device__ __forceinline__ void hyena_inproj(const Frame& F, int slot, bool with_ctx) {
    MultiSched<1> S; Prob pr[1];
    const int colbase = with_ctx ? 0 : CTXN, nN = with_ctx ? 65 : 64;
    pr[0] = Prob{(const char*)(F.ws + WS_WHIN) + (size_t)slot * 3072 * 1024 * 2, (const char*)(F.ws + WS_U) + (size_t)colbase * 1024 * 2, (char*)(F.ws + WS_ZT) + (size_t)colbase * 2, 0, 0, 0, 12, nN, 1, 0, 1024, 1024, LT, 2};
    S.init(F, pr, 12 * nN);
    EpiStore E{F.in[I_HINB] + (size_t)slot * 3072, nullptr, nullptr, 0};
    pg8::gemm_phase<EpiStore, MultiSched<1>, false>(F.lds, 1024, S, E, F.tid);
}

__device__ __forceinline__ f32x2 cmul(f32x2 a, f32x2 b) { return (f32x2){a.x * b.x - a.y * b.y, a.x * b.y + a.y * b.x}; }
__device__ __forceinline__ f32x2 cmulc(f32x2 a, f32x2 b) { return (f32x2){a.x * b.x + a.y * b.y, a.y * b.x - a.x * b.y}; }
__device__ __forceinline__ f32x2 cconj(f32x2 a) { return (f32x2){a.x, -a.y}; }
template <int R> __device__ __forceinline__ constexpr int brevR(int x) { int r = 0; for (int b = 1; b < R; b <<= 1) { r = (r << 1) | (x & 1); x >>= 1; } return r; }
template <int R> __device__ __forceinline__ constexpr int log2R() { int l = 0; for (int b = 1; b < R; b <<= 1) ++l; return l; }
template <int R, int HALF_, bool INV> __device__ __forceinline__ void dft_stage(f32x2 (&v)[R]) {
    constexpr float C32[16] = {1.0f, 0.9807852804032304f, 0.9238795325112867f, 0.8314696123025452f, 0.7071067811865476f, 0.5555702330196022f, 0.3826834323650898f, 0.1950903220161283f,
                               0.0f, -0.1950903220161283f, -0.3826834323650898f, -0.5555702330196022f, -0.7071067811865476f, -0.8314696123025452f, -0.9238795325112867f, -0.9807852804032304f};
    constexpr float S32[16] = {0.0f, 0.1950903220161283f, 0.3826834323650898f, 0.5555702330196022f, 0.7071067811865476f, 0.8314696123025452f, 0.9238795325112867f, 0.9807852804032304f,
                               1.0f, 0.9807852804032304f, 0.9238795325112867f, 0.8314696123025452f, 0.7071067811865476f, 0.5555702330196022f, 0.3826834323650898f, 0.1950903220161283f};
#pragma unroll
    for (int blk = 0; blk < R; blk += 2 * HALF_) {
#pragma unroll
        for (int j = 0; j < HALF_; ++j) {
            const f32x2 a = v[blk + j], b = v[blk + j + HALF_];
            v[blk + j] = a + b; const f32x2 d = a - b;
            constexpr int TS = 16 / HALF_;
            const int ti = j * TS;
            if (ti == 0) v[blk + j + HALF_] = d;
            else if (ti == 8) v[blk + j + HALF_] = INV ? (f32x2){-d.y, d.x} : (f32x2){d.y, -d.x};
            else { const f32x2 w = {C32[ti], INV ? S32[ti] : -S32[ti]}; v[blk + j + HALF_] = cmul(d, w); }
        }
    }
    if constexpr (HALF_ > 1) dft_stage<R, HALF_ / 2, INV>(v);
}
template <int R, bool INV> __device__ __forceinline__ void dft_reg(f32x2 (&v)[R]) { dft_stage<R, R / 2, INV>(v); }
__device__ __forceinline__ int fpad(int i) { return i + (i >> 5); }
__device__ __forceinline__ f32x2 unit_root(int num, int den_log2) {
    asm volatile("" : "+v"(num));
    float s, c; sincospif((float)num * (2.0f / (float)(1 << den_log2)), &s, &c); return (f32x2){c, -s};
}
template <bool INV> __device__ __forceinline__ void fft_pass_a(LAS f32x2* buf, int tid) {
#pragma unroll 1
    for (int rr = 0; rr < 2; ++rr) { const int r = tid + rr * 512, pr = fpad(r); f32x2 v[16];
        const f32x2 w1 = unit_root(r, 14);
        if (!INV) {
#pragma unroll
            for (int a = 0; a < 16; ++a) v[a] = buf[pr + a * 1056];
            dft_reg<16, false>(v);
            f32x2 w = w1;
            buf[pr] = v[0];
#pragma unroll
            for (int p = 1; p < 16; ++p) { buf[pr + p * 1056] = cmul(v[brevR<16>(p)], w); w = cmul(w, w1); }
        } else {
            f32x2 w = w1;
            v[0] = buf[pr];
#pragma unroll
            for (int p = 1; p < 16; ++p) { v[p] = cmulc(buf[pr + p * 1056], w); w = cmul(w, w1); }
            dft_reg<16, true>(v);
#pragma unroll
            for (int a = 0; a < 16; ++a) buf[pr + a * 1056] = v[brevR<16>(a)];
        }
    }
}
__device__ __forceinline__ void fft_pass_a_fwd_regs(LAS f32x2* buf, const f32x2 (&z)[16], int tid) {
#pragma unroll
    for (int rr = 0; rr < 2; ++rr) { const int r = tid + rr * 512, pr = fpad(r); f32x2 v[16];
        const f32x2 w1 = unit_root(r, 14);
#pragma unroll
        for (int a = 0; a < 16; ++a) v[a] = (a < 8) ? z[2 * a + rr] : (f32x2){0.f, 0.f};
        dft_reg<16, false>(v);
        f32x2 w = w1;
        buf[pr] = v[0];
#pragma unroll
        for (int p = 1; p < 16; ++p) { buf[pr + p * 1056] = cmul(v[brevR<16>(p)], w); w = cmul(w, w1); }
    }
}
__device__ __forceinline__ void fft_pass_a_inv_regs(const LAS f32x2* buf, f32x2 (&y)[16], int tid) {
#pragma unroll
    for (int rr = 0; rr < 2; ++rr) { const int r = tid + rr * 512, pr = fpad(r); f32x2 v[16];
        const f32x2 w1 = unit_root(r, 14);
        f32x2 w = w1;
        v[0] = buf[pr];
#pragma unroll
        for (int p = 1; p < 16; ++p) { v[p] = cmulc(buf[pr + p * 1056], w); w = cmul(w, w1); }
        dft_reg<16, true>(v);
#pragma unroll
        for (int a = 4; a < 12; ++a) y[2 * (a - 4) + rr] = v[brevR<16>(a)];
    }
}
template <bool INV> __device__ __forceinline__ void fft_pass_b(LAS f32x2* buf, int tid) {
    const int p1 = tid >> 5, r = tid & 31, pb = fpad(p1 * 1024 + r); f32x2 v[32];
    const f32x2 w1 = unit_root(r, 10);
    if (!INV) {
#pragma unroll
        for (int a = 0; a < 32; ++a) v[a] = buf[pb + a * 33];
        dft_reg<32, false>(v);
        f32x2 w = w1;
        buf[pb] = v[0];
#pragma unroll
        for (int p = 1; p < 32; ++p) { buf[pb + p * 33] = cmul(v[brevR<32>(p)], w); w = cmul(w, w1); }
    } else {
        f32x2 w = w1;
        v[0] = buf[pb];
#pragma unroll
        for (int p = 1; p < 32; ++p) { v[p] = cmulc(buf[pb + p * 33], w); w = cmul(w, w1); }
        dft_reg<32, true>(v);
#pragma unroll
        for (int a = 0; a < 32; ++a) buf[pb + a * 33] = v[brevR<32>(a)];
    }
}
template <bool INV> __device__ __forceinline__ void fft_pass_c(LAS f32x2* buf, int tid) {
    const int base = tid * 33; f32x2 v[32];
#pragma unroll
    for (int a = 0; a < 32; ++a) v[a] = buf[base + a];
    dft_reg<32, INV>(v);
#pragma unroll
    for (int a = 0; a < 32; ++a) buf[base + a] = v[brevR<32>(a)];
}
__device__ __forceinline__ void fft_fwd(LAS f32x2* buf, int tid) { fft_pass_a<false>(buf, tid); __syncthreads(); fft_pass_b<false>(buf, tid); __syncthreads(); fft_pass_c<false>(buf, tid); __syncthreads(); }
__device__ __forceinline__ void fft_inv(LAS f32x2* buf, int tid) { fft_pass_c<true>(buf, tid); __syncthreads(); fft_pass_b<true>(buf, tid); __syncthreads(); fft_pass_a<true>(buf, tid); __syncthreads(); }
__device__ __forceinline__ int fft_k_of_pos(int pos) { return (pos >> 10) + 16 * ((pos >> 5) & 31) + 512 * (pos & 31); }
__device__ __forceinline__ int fft_pos_of_k(int k) { return (k & 15) * 1024 + ((k >> 4) & 31) * 32 + (k >> 9); }

__device__ __forceinline__ int fft_pos_of_ci(int ci) { return (ci >> 9) * 1024 + ((ci >> 4) & 31) * 32 + (ci & 15); }
__device__ __forceinline__ void fft_save_pairs(const LAS f32x2* buf, f32x4* zh, const f32x2* twp, float scale, int tid) {
#pragma unroll 4
    for (int it = 0; it < 16; ++it) { const int ci = it * 512 + tid, pos = fft_pos_of_ci(ci), k = fft_k_of_pos(pos);
        const int pos2 = (k == 0) ? 16 : fft_pos_of_k(16384 - k);
        const f32x2 h1 = buf[fpad(pos)], h2 = buf[fpad(pos2)];
        if (k == 0) zh[ci] = (f32x4){(h1.x + h1.y) * scale, (h1.x - h1.y) * scale, h2.x * scale, -h2.y * scale};
        else { const f32x2 wn = twp[ci];
            const f32x2 eh = {0.5f * (h1.x + h2.x), 0.5f * (h1.y - h2.y)}, dh = {0.5f * (h1.x - h2.x), 0.5f * (h1.y + h2.y)};
            const f32x2 th = cmul(wn, (f32x2){dh.y, -dh.x});
            const f32x2 hk = (eh + th) * scale, hk2 = cconj(eh - th) * scale;
            zh[ci] = (f32x4){hk.x, hk.y, hk2.x, hk2.y}; } }
}
__device__ __forceinline__ void fft_pointwise(LAS f32x2* buf, const f32x4* zh, const f32x2* twp, int tid) {
#pragma unroll 2
    for (int it = 0; it < 16; ++it) { const int ci = it * 512 + tid, pos = fft_pos_of_ci(ci), k = fft_k_of_pos(pos);
        const f32x4 hq = zh[ci];
        if (k == 0) {
            const f32x2 z0 = buf[0], zm = buf[16];
            const float y0 = (z0.x + z0.y) * hq[0], yn = (z0.x - z0.y) * hq[1];
            buf[0] = (f32x2){0.5f * (y0 + yn), 0.5f * (y0 - yn)};
            const f32x2 ym = cmul(cconj(zm), (f32x2){hq[2], hq[3]});
            buf[16] = (f32x2){ym.x, -ym.y};
        } else {
            const int pp = fpad(pos), pp2 = fpad(fft_pos_of_k(16384 - k));
            const f32x2 z1 = buf[pp], z2 = buf[pp2];
            const f32x2 wn = twp[ci];
            const f32x2 ex = {0.5f * (z1.x + z2.x), 0.5f * (z1.y - z2.y)}, dx = {0.5f * (z1.x - z2.x), 0.5f * (z1.y + z2.y)};
            const f32x2 tx = cmul(wn, (f32x2){dx.y, -dx.x});
            const f32x2 xk = ex + tx, xk2 = cconj(ex - tx);
            const f32x2 yk = cmul(xk, (f32x2){hq[0], hq[1]}), yk2 = cmul(xk2, (f32x2){hq[2], hq[3]});
            const f32x2 e2 = {0.5f * (yk.x + yk2.x), 0.5f * (yk.y - yk2.y)}, d2 = {0.5f * (yk.x - yk2.x), 0.5f * (yk.y + yk2.y)};
            const f32x2 o2 = cmulc(d2, wn);
            buf[pp] = (f32x2){e2.x - o2.y, e2.y + o2.x};
            buf[pp2] = (f32x2){e2.x + o2.y, -(e2.y - o2.x)};
        }
    }
}
__device__ __forceinline__ f32x2 sconv2(const bf16_t* row, int n, int Ln, float w0, float w1, float w2, float b) {
    struct W3 { unsigned p, c, q; } t;
    __builtin_memcpy(&t, (const unsigned*)row + (n - 1), 12);
    const unsigned p = (n > 0) ? t.p : 0u, q = (2 * n + 2 < Ln) ? t.q : 0u, c = t.c;
    const float xm1 = bfhi(p), x0 = bflo(c), x1 = bfhi(c), x2 = bflo(q);
    return (f32x2){b + w0 * xm1 + w1 * x0 + w2 * x1, b + w0 * x0 + w1 * x1 + w2 * x2};
}
__device__ __forceinline__ float block_sum(LAS float* red, float v, int tid) {
    v = wave_sum(v);
    __syncthreads();
    if ((tid & 63) == 0) red[tid >> 6] = v;
    __syncthreads();
    float s = 0.f;
#pragma unroll
    for (int i = 0; i < 8; ++i) s += red[i];
    return s;
}

__device__ __forceinline__ void hyena_filter_fft(const Frame& F, int vbid, int vG) {
    LAS f32x2* buf = (LAS f32x2*)F.lds;
    LAS float* red = (LAS float*)(F.lds + (16384 + 512) * 8);
    const bf16_t* FILT = (const bf16_t*)(F.ws + WS_FILT2);
    const int tid = F.tid, pt = fpad(F.tid);
    for (int job = vbid; job < 2048; job += vG) {
        const int c = job >> 1, ord = job & 1;
        const unsigned* f32p = (const unsigned*)(FILT + (size_t)(ord * 1024 + c) * SEQ);
        float ss = 0.f; f32x2 fz[16];
        __syncthreads();
#pragma unroll
        for (int j = 0; j < 16; ++j) { const int n = tid + 512 * j; const unsigned w = f32p[n]; const float a = bflo(w), b = bfhi(w); ss += a * a + b * b; fz[j] = (f32x2){a, b}; }
        const float tot = block_sum(red, ss, tid);
        const float fsv = rsqrtf(tot + EPS) * (1.0f / 16384.0f);
        fft_pass_a_fwd_regs(buf, fz, tid); __syncthreads(); fft_pass_b<false>(buf, tid); __syncthreads(); fft_pass_c<false>(buf, tid); __syncthreads();
        fft_save_pairs(buf, (f32x4*)(F.ws + WS_ZHALL) + (size_t)job * 8192, (const f32x2*)(F.ws + WS_TWP), fsv, tid);
    }
    __syncthreads();
}

__device__ __forceinline__ void hyena_fft(const Frame& F, int slot, bool with_ctx) {
    LAS f32x2* buf = (LAS f32x2*)F.lds;
    LAS float* red = (LAS float*)(F.lds + (16384 + 512) * 8);
    const bf16_t* ZT = (const bf16_t*)(F.ws + WS_ZT); bf16_t* Y2T = (bf16_t*)(F.ws + WS_Y2T);
    const f32x2* twp = (const f32x2*)(F.ws + WS_TWP);
    const float* scw = F.in[I_HSCW] + (size_t)slot * 3 * 3072; const float* scb = F.in[I_HSCB] + (size_t)slot * 3072; const float* fb = F.in[I_HFBIAS] + (size_t)slot * 2048;
    const int tid = F.tid, pt = fpad(F.tid);
    for (int c = F.bid; c < 1024; c += F.G) {
        const f32x4* zh = (const f32x4*)(F.ws + WS_ZHALL) + (size_t)c * 2 * 8192;
        __syncthreads();
        f32x2 vv[16], yy[16];
        {
            const int zc = 2048 + c; const float w0 = scw[zc], w1 = scw[3072 + zc], w2 = scw[2 * 3072 + zc], b = scb[zc];
            const bf16_t* row = ZT + (size_t)zc * LT + CTXN;
#pragma unroll
            for (int j = 0; j < 16; ++j) { const int n = tid + 512 * j; vv[j] = sconv2(row, n, SEQ, w0, w1, w2, b); if ((j & 3) == 3) __builtin_amdgcn_sched_barrier(0); }
        }
        fft_pass_a_fwd_regs(buf, vv, tid); __syncthreads(); fft_pass_b<false>(buf, tid); __syncthreads(); fft_pass_c<false>(buf, tid); __syncthreads();
        fft_pointwise(buf, zh, twp, tid);
        __syncthreads();
        fft_pass_c<true>(buf, tid); __syncthreads(); fft_pass_b<true>(buf, tid); __syncthreads(); fft_pass_a_inv_regs(buf, yy, tid);
        {
            const int zc = c; const float w0 = scw[zc], w1 = scw[3072 + zc], w2 = scw[2 * 3072 + zc], b = scb[zc], fb0 = fb[c];
            const bf16_t* row = ZT + (size_t)zc * LT + CTXN;
#pragma unroll
            for (int j = 0; j < 16; ++j) { const int n = tid + 512 * j; const f32x2 x1 = sconv2(row, n, SEQ, w0, w1, w2, b);
                vv[j] = (f32x2){x1.x * (yy[j].x + vv[j].x * fb0), x1.y * (yy[j].y + vv[j].y * fb0)}; if ((j & 3) == 3) __builtin_amdgcn_sched_barrier(0); }
        }
        fft_pass_a_fwd_regs(buf, vv, tid); __syncthreads(); fft_pass_b<false>(buf, tid); __syncthreads(); fft_pass_c<false>(buf, tid); __syncthreads();
        fft_pointwise(buf, zh + 8192, twp, tid);
        __syncthreads();
        fft_pass_c<true>(buf, tid); __syncthreads(); fft_pass_b<true>(buf, tid); __syncthreads(); fft_pass_a_inv_regs(buf, yy, tid);
        {
            const int zc = 1024 + c; const float w0 = scw[zc], w1 = scw[3072 + zc], w2 = scw[2 * 3072 + zc], b = scb[zc], fb1 = fb[1024 + c];
            const bf16_t* row = ZT + (size_t)zc * LT + CTXN;
            unsigned* orow = (unsigned*)(Y2T + (size_t)c * LT + CTXN);
#pragma unroll
            for (int j = 0; j < 16; ++j) { const int n = tid + 512 * j; const f32x2 x2 = sconv2(row, n, SEQ, w0, w1, w2, b);
                orow[n] = pk2(x2.x * (yy[j].x + vv[j].x * fb1), x2.y * (yy[j].y + vv[j].y * fb1)); if ((j & 3) == 3) __builtin_amdgcn_sched_barrier(0); }
        }
        __syncthreads();
    }
    if (with_ctx) {
        LAS float* ub = (LAS float*)F.lds;
        LAS float* fbuf = ub + 512;
        const float* FC = (const float*)(F.ws + WS_FILTC);
        const int cc = tid >> 8, t = tid & 255;
        for (int c0 = F.bid * 2; c0 < 1024; c0 += F.G * 2) {
            const int c = c0 + cc;
            float cur, y1 = 0.f;
            { const int zc = 2048 + c; const bf16_t* row = ZT + (size_t)zc * LT;
              const float xm = t > 0 ? bf2f(row[t - 1]) : 0.f, x0 = bf2f(row[t]), xp = t < 255 ? bf2f(row[t + 1]) : 0.f;
              cur = scb[zc] + scw[zc] * xm + scw[3072 + zc] * x0 + scw[2 * 3072 + zc] * xp; }
#pragma unroll 1
            for (int ord = 0; ord < 2; ++ord) {
                __syncthreads();
                const float fv = FC[(size_t)(ord * 1024 + c) * CTXN + t];
                ub[cc * 256 + t] = cur; fbuf[cc * 256 + t] = fv;
                float ss = fv * fv;
                ss = wave_sum(ss);
                __syncthreads();
                if (F.lane == 0) red[F.wave] = ss;
                __syncthreads();
                const float tot = red[cc * 4] + red[cc * 4 + 1] + red[cc * 4 + 2] + red[cc * 4 + 3];
                const float fs = rsqrtf(tot + EPS);
                float acc = 0.f;
                const int jlo = max(0, t + 128 - 255), jhi = min(255, t + 128);
                for (int j = jlo; j <= jhi; ++j) acc += fbuf[cc * 256 + j] * ub[cc * 256 + t + 128 - j];
                const int zc = ord * 1024 + c; const bf16_t* row = ZT + (size_t)zc * LT;
                const float xm = t > 0 ? bf2f(row[t - 1]) : 0.f, x0 = bf2f(row[t]), xp = t < 255 ? bf2f(row[t + 1]) : 0.f;
                const float xg = scb[zc] + scw[zc] * xm + scw[3072 + zc] * x0 + scw[2 * 3072 + zc] * xp;
                const float yo = xg * (acc * fs + cur * fb[ord * 1024 + c]);
                if (ord == 0) { y1 = yo; cur = y1; } else Y2T[(size_t)c * LT + t] = f2bf(yo);
            }
        }
        __syncthreads();
    }
}

__device__ __forceinline__ void hyena_transpose(const Frame& F, bool with_ctx) {
    LAS bf16_t* tile = (LAS bf16_t*)F.lds;
    const bf16_t* Y2T = (const bf16_t*)(F.ws + WS_Y2T); bf16_t* Y2 = (bf16_t*)(F.ws + WS_Y2);
    const int tlo = with_ctx ? 0 : 4, ntt = NCH - tlo, ntile = 16 * ntt;
    for (int ti = F.bid; ti < ntile; ti += F.G) {
        const int c0 = (ti % 16) * 64, t0 = (tlo + ti / 16) * 64;
        LDS_BAR();
        { const int c = F.tid >> 3, t8 = (F.tid & 7) * 8; const u32x4 v = *(const u32x4*)(Y2T + (size_t)(c0 + c) * LT + t0 + t8); *(LAS u32x4*)(tile + c * 72 + t8) = v; }
        LDS_BAR();
        { const int t = F.tid >> 3, c8 = (F.tid & 7) * 8; bf16_t e[8];
#pragma unroll
          for (int j = 0; j < 8; ++j) e[j] = tile[(c8 + j) * 72 + t];
          u32x4 w; w.x = (unsigned)e[0] | ((unsigned)e[1] << 16); w.y = (unsigned)e[2] | ((unsigned)e[3] << 16); w.z = (unsigned)e[4] | ((unsigned)e[5] << 16); w.w = (unsigned)e[6] | ((unsigned)e[7] << 16);
          *(u32x4*)(Y2 + (size_t)(t0 + t) * 1024 + c0 + c8) = w; }
    }
}

__device__ __forceinline__ void hyena_outproj(const Frame& F, int l, int slot, bool with_ctx, bool colmajor) {
    MultiSched<1> S; Prob pr[1];
    const int rowbase = with_ctx ? 0 : CTXN, nM = with_ctx ? 65 : 64;
    pr[0] = Prob{(const char*)(F.ws + WS_Y2) + (size_t)rowbase * 1024 * 2, (const char*)(F.ws + WS_WHOUT) + (size_t)slot * 1024 * 1024 * 2, nullptr, 0, 0, 0, nM, 4, 1, 0, 1024, 1024, 0, 0};
    S.init(F, pr, nM * 4);
    EpiResid E{(bf16_t*)(F.ws + WS_HL), (bf16_t*)(F.ws + WS_HC), modp(F, l, 0, 2), modp(F, l, 1, 2), F.in[I_HOUTB] + (size_t)slot * 1024, rowbase, colmajor};
    pg8::gemm_phase<EpiResid, MultiSched<1>, false>(F.lds, 1024, S, E, F.tid);
}
constexpr int MOE_MAXG = 8;
constexpr int MOE_MAXU = 6;
constexpr int MOE_TAB = 131072;

__device__ __forceinline__ void moe_route(const Frame& F, int l, bool with_ctx) {
    constexpr int VP = 1028;
    LAS float* vs = (LAS float*)F.lds;
    LAS float* part = vs + 16 * VP;
    LAS float* lg = part + 8 * 16 * 48;
    LAS int* re = (LAS int*)(lg + 16 * 48);
    LAS float* rw = (LAS float*)(re + MOE_MAXG * 32);
    LAS int* rp = (LAS int*)(rw + MOE_MAXG * 32);
    LAS int* lc = rp + MOE_MAXG * 32;
    LAS int* lb = lc + 32;
    const bf16_t* HL = (const bf16_t*)(F.ws + WS_HL); const bf16_t* HC = (const bf16_t*)(F.ws + WS_HC); bf16_t* VN = (bf16_t*)(F.ws + WS_VN);
    const float* WC = (const float*)(F.ws + WS_WC) + (size_t)l * 1024 * 48;
    const float* g2n = F.in[I_N2G] + l * 1024;
    unsigned* cnt = (unsigned*)(F.ws + WS_CTL) + CW_CNT + l * 32 * 64;
    int* LIST = (int*)(F.ws + WS_LIST); float* AW = (float*)(F.ws + WS_AW);
    const int ntok = with_ctx ? LT : SEQ, tokbase = with_ctx ? 0 : CTXN, ngroups = ntok / 16;
    const int fr = F.lane & 15, fq = F.lane >> 4;
    float wcr[32][3];
#pragma unroll
    for (int st = 0; st < 32; ++st)
#pragma unroll
        for (int nt = 0; nt < 3; ++nt) wcr[st][nt] = WC[(size_t)(F.wave * 128 + st * 4 + fq) * 48 + nt * 16 + fr];
    int gi = 0;
    for (int grp = F.bid; grp < ngroups && gi < MOE_MAXG; grp += F.G, ++gi) {
        LDS_BAR();
#pragma unroll
        for (int rr = 0; rr < 2; ++rr) { const int i = 2 * F.wave + rr, tok = tokbase + grp * 16 + i; const bool isctx = tok < CTXN; const int s = isctx ? 1 : 0;
            const bf16_t* src = isctx ? HC + (size_t)tok * 1024 : HL + (size_t)(tok - CTXN) * 1024;
            const float* sh = modp(F, l, s, 3); const float* sc = modp(F, l, s, 4);
            f32x4 v[4]; float ss = 0.f;
#pragma unroll
            for (int j = 0; j < 4; ++j) { const u32x2 hb = *(const u32x2*)(src + j * 256 + F.lane * 4); v[j] = (f32x4){bflo(hb.x), bfhi(hb.x), bflo(hb.y), bfhi(hb.y)}; ss += v[j][0] * v[j][0] + v[j][1] * v[j][1] + v[j][2] * v[j][2] + v[j][3] * v[j][3]; }
            ss = wave_sum(ss);
            const float rstd = rsqrtf(ss * (1.0f / 1024.0f) + EPS);
#pragma unroll
            for (int j = 0; j < 4; ++j) { const int c = j * 256 + F.lane * 4; const f32x4 g = *(const f32x4*)(g2n + c), a = *(const f32x4*)(sc + c), b = *(const f32x4*)(sh + c);
                f32x4 o;
#pragma unroll
                for (int e = 0; e < 4; ++e) o[e] = v[j][e] * rstd * g[e] * (1.0f + a[e]) + b[e];
                *(LAS f32x4*)(vs + i * VP + c) = o;
                u32x2 w; w.x = pk2(o[0], o[1]); w.y = pk2(o[2], o[3]); *(u32x2*)(VN + (size_t)tok * 1024 + c) = w; }
        }
        LDS_BAR();
        {
            f32x4 acc[3] = {{0.f, 0.f, 0.f, 0.f}, {0.f, 0.f, 0.f, 0.f}, {0.f, 0.f, 0.f, 0.f}};
#pragma unroll
            for (int st = 0; st < 32; ++st) { const int k = F.wave * 128 + st * 4 + fq; const float a = vs[fr * VP + k];
#pragma unroll
                for (int nt = 0; nt < 3; ++nt) acc[nt] = __builtin_amdgcn_mfma_f32_16x16x4f32(a, wcr[st][nt], acc[nt], 0, 0, 0); }
#pragma unroll
            for (int nt = 0; nt < 3; ++nt)
#pragma unroll
                for (int r = 0; r < 4; ++r) part[(F.wave * 16 + fq * 4 + r) * 48 + nt * 16 + fr] = acc[nt][r];
        }
        LDS_BAR();
        for (int idx = F.tid; idx < 16 * 48; idx += NT) { const int n = idx % 48; float a = (n < 4) ? F.in[I_RGB][l * 4 + n] : (n < 36 ? F.in[I_REB][l * 32 + n - 4] : 0.f);
#pragma unroll
            for (int w = 0; w < 8; ++w) a += part[w * 16 * 48 + idx];
            lg[idx] = a; }
        LDS_BAR();
        if (F.tid < 16) { const LAS float* q = lg + F.tid * 48;
            int gx = 0; float gm = q[0];
            for (int j = 1; j < 4; ++j) if (q[j] > gm) { gm = q[j]; gx = j; }
            float gs = 0.f; for (int j = 0; j < 4; ++j) gs += __expf(q[j] - gm);
            const float gw = 1.0f / gs;
            const LAS float* e = q + 4 + gx * 8;
            int i1 = 0; float m1 = e[0];
            for (int j = 1; j < 8; ++j) if (e[j] > m1) { m1 = e[j]; i1 = j; }
            int i2 = -1; float m2 = 0.f;
            for (int j = 0; j < 8; ++j) if (j != i1 && (i2 < 0 || e[j] > m2)) { m2 = e[j]; i2 = j; }
            const float x = __expf(m2 - m1), w1 = 1.0f / (1.0f + x), w2 = x / (1.0f + x);
            const int a0 = gi * 32 + F.tid * 2;
            re[a0] = gx * 8 + i1; rw[a0] = gw * w1; re[a0 + 1] = gx * 8 + i2; rw[a0 + 1] = gw * w2; }
    }
    LDS_BAR();
    if (F.tid < 32) lc[F.tid] = 0;
    LDS_BAR();
    const int na = gi * 32;
    if (F.tid < na) rp[F.tid] = __hip_atomic_fetch_add(&lc[re[F.tid]], 1, __ATOMIC_RELAXED, __HIP_MEMORY_SCOPE_WORKGROUP);
    LDS_BAR();
    if (F.tid < 32) lb[F.tid] = lc[F.tid] > 0 ? (int)__hip_atomic_fetch_add(cnt + F.tid * 64, (unsigned)lc[F.tid], RLX_AGENT) : 0;
    LDS_BAR();
    if (F.tid < na) { const int a = F.tid, g = a >> 5, i = (a >> 1) & 15, slot = a & 1, e = re[a];
        const int tok = tokbase + (F.bid + g * F.G) * 16 + i, gidx = tok * 2 + slot;
        LIST[(size_t)e * NASG + lb[e] + rp[a]] = gidx; AW[gidx] = rw[a]; }
}

struct MoeSched {
    LAS int* cnt; LAS int* tstart; LAS unsigned* rowtab;
    const char* A; const char* B; char* O; int total, G, c, mode;
    __device__ __forceinline__ void locate(int Lq, int& e, int& mt, int& pn) const {
        const int L = pg8::xcd_remap(Lq, total);
        const int mtg = L >> 2; pn = L & 3; e = 0;
        for (int j = 1; j < 32; ++j) if (tstart[j] <= mtg) e = j;
        mt = mtg - tstart[e];
    }
    __device__ __forceinline__ bool next(int i, GUnit& u) const {
        const int L = i * G + c; if (L >= total) return false;
        int e, mt, pn; locate(L, e, mt, pn);
        u.g = e; u.aux = mt; u.pm = tstart[e] + mt; u.pn = pn;
        if (mode == 0) { u.a = A; u.lda = 1024; u.b = B + ((size_t)e * 1024 + pn * 128) * 1024 * 2; u.ldb = 1024; u.hsb = 512; u.o = O + ((size_t)u.pm * 256 * 512 + pn * 128) * 2; u.ldo = 512; }
        else { u.a = A + (size_t)u.pm * 256 * 512 * 2; u.lda = 512; u.b = B + ((size_t)e * 1024 + pn * 256) * 512 * 2; u.ldb = 512; u.hsb = 128; u.o = O; u.ldo = 1024; }
        return true;
    }
    __device__ __forceinline__ unsigned grow(int slot, int r) const { return rowtab[slot * 256 + r]; }
};
__device__ __forceinline__ void moe_tables(const Frame& F, int l, MoeSched& S, int mode) {
    S.cnt = (LAS int*)(F.lds + MOE_TAB); S.tstart = S.cnt + 32; S.rowtab = (LAS unsigned*)(F.lds + MOE_TAB + 512);
    const unsigned* cnt = (const unsigned*)(F.ws + WS_CTL) + CW_CNT + l * 32 * 64;
    __syncthreads();
    if (F.tid < 32) S.cnt[F.tid] = (int)__hip_atomic_load(cnt + F.tid * 64, RLX_AGENT);
    __syncthreads();
    if (F.tid == 0) { int a = 0; for (int e = 0; e < 32; ++e) { S.tstart[e] = a; a += (S.cnt[e] + 255) >> 8; } S.tstart[32] = a; }
    __syncthreads();
    S.total = S.tstart[32] * 4; S.G = F.G; S.c = F.bid; S.mode = mode;
    if (mode == 0 && F.tid < 256) {
        const int* LIST = (const int*)(F.ws + WS_LIST);
        for (int slot = 0; slot < MOE_MAXU; ++slot) { const int L = slot * S.G + S.c; if (L >= S.total) break;
            int e, mt, pn; S.locate(L, e, mt, pn);
            const int idx = mt * 256 + F.tid; const int tok = idx < S.cnt[e] ? (LIST[(size_t)e * NASG + idx] >> 1) : 0;
            S.rowtab[slot * 256 + F.tid] = (unsigned)tok * 2048u; }
    }
    __syncthreads();
}
struct EpiSwiGLU {
    static constexpr bool PERM = true;
    __device__ __forceinline__ void operator()(const f32x4 (&acc)[2][2][4][2], const GUnit& u, int wr, int wc, int fr, int fq) const {
        bf16_t* base = (bf16_t*)u.o;
#pragma unroll
        for (int ai = 0; ai < 2; ++ai)
#pragma unroll
            for (int m = 0; m < 4; ++m) { const int r = ai * 128 + wr * 64 + m * 16 + fr; float o[8];
#pragma unroll
                for (int n = 0; n < 2; ++n)
#pragma unroll
                    for (int j = 0; j < 4; ++j) o[n * 4 + j] = siluf(acc[ai][0][m][n][j]) * acc[ai][1][m][n][j];
                u32x4 w; w.x = pk2(o[0], o[1]); w.y = pk2(o[2], o[3]); w.z = pk2(o[4], o[5]); w.w = pk2(o[6], o[7]);
                *(u32x4*)(base + (size_t)r * 512 + wc * 32 + 8 * fq) = w; }
    }
};
struct EpiScatter {
    static constexpr bool PERM = true;
    const int* LIST; const float* AW; bf16_t* YB; LAS int* cnt;
    __device__ __forceinline__ void operator()(const f32x4 (&acc)[2][2][4][2], const GUnit& u, int wr, int wc, int fr, int fq) const {
        const int ce = cnt[u.g];
#pragma unroll
        for (int ai = 0; ai < 2; ++ai)
#pragma unroll
            for (int m = 0; m < 4; ++m) { const int r = ai * 128 + wr * 64 + m * 16 + fr, idx = u.aux * 256 + r;
                if (idx < ce) { const int a = LIST[(size_t)u.g * NASG + idx]; const float w = AW[a];
                    bf16_t* rowp = YB + (size_t)a * 1024 + u.pn * 256 + wc * 32 + 8 * fq;
#pragma unroll
                    for (int bj = 0; bj < 2; ++bj) { const f32x4 v0 = acc[ai][bj][m][0] * w, v1 = acc[ai][bj][m][1] * w;
                        u32x4 q; q.x = pk2(v0[0], v0[1]); q.y = pk2(v0[2], v0[3]); q.z = pk2(v1[0], v1[1]); q.w = pk2(v1[2], v1[3]);
                        *(u32x4*)(rowp + bj * 128) = q; } } }
    }
};
__device__ __forceinline__ void moe_e1(const Frame& F, int l) {
    MoeSched S; moe_tables(F, l, S, 0);
    S.A = (const char*)(F.ws + WS_VN); S.B = (const char*)(F.ws + WS_W13) + (size_t)l * 32 * 1024 * 1024 * 2; S.O = (char*)(F.ws + WS_H1);
    EpiSwiGLU E;
    pg8::gemm_phase<EpiSwiGLU, MoeSched, true>(F.lds, 1024, S, E, F.tid);
}
__device__ __forceinline__ void moe_e2(const Frame& F, int l) {
    MoeSched S; moe_tables(F, l, S, 1);
    S.A = (const char*)(F.ws + WS_H1); S.B = (const char*)(F.ws + WS_W2) + (size_t)l * 32 * 1024 * 512 * 2; S.O = nullptr;
    EpiScatter E{(const int*)(F.ws + WS_LIST), (const float*)(F.ws + WS_AW), (bf16_t*)(F.ws + WS_YBUF), S.cnt};
    pg8::gemm_phase<EpiScatter, MoeSched, false>(F.lds, 512, S, E, F.tid);
}
#ifndef MK_LAYERS
#define MK_LAYERS 4
#endif
__global__ void __launch_bounds__(NT, 2) mk_fwd(Args args) {
    extern __shared__ __attribute__((aligned(16))) unsigned char lds_raw[];
    Frame F0;
    { Frame& F = F0;
    F.lds = (LAS unsigned char*)lds_raw; F.ws = args.ws; F.in = args.in; F.out = args.out;
    F.wave = __builtin_amdgcn_readfirstlane((int)threadIdx.x >> 6); F.lane = fresh_lane(); F.tid = F.wave * 64 + F.lane; F.G = gridDim.x; F.bid = blockIdx.x; }
    const Frame& F = F0;
    volatile LAS unsigned* xbw = (volatile LAS unsigned*)(F.lds + LDS_BYTES - 16);
    if (F.tid < 4) xbw[F.tid] = 0u;
    __syncthreads();
    unsigned* ctl = (unsigned*)(F.ws + WS_CTL);
    const int lo = args.ph_lo, hi = args.ph_hi;
    XcdBarrier bar; bar.bar = ctl + CW_BAR; bar.x = 0; bar.st = xbw;
    if (hi - lo > 1) bar = xcd_barrier_post(ctl + CW_BAR, xbw, F.tid);
    int ph = 0;
#ifdef MK_PROBE
    unsigned long long tacc = 0ull, tp0 = 0ull;
#define PROBE_T0(g) tp0 = __builtin_amdgcn_s_memrealtime();
#ifdef MK_PROBE_WG
#define PROBE_TMID(g) if (((MK_PROBE >> (g)) & 1) && F0.bid == MK_PROBE_WG) tacc += __builtin_amdgcn_s_memrealtime() - tp0;
#define PROBE_T1(g)
#else
#define PROBE_TMID(g)
#define PROBE_T1(g) if ((MK_PROBE >> (g)) & 1) tacc += __builtin_amdgcn_s_memrealtime() - tp0;
#endif
#else
#define PROBE_T0(g)
#define PROBE_T1(g)
#define PROBE_TMID(g)
#endif
#define PHASE_BEGIN(g) if (lo <= ph && ph < hi) { PROBE_T0(g) Frame F = F0; { const int t_ = F0.wave * 64 + fresh_lane(); F.tid = t_; F.lane = t_ & 63; }
#define PHASE_END(g)   PROBE_TMID(g) if (ph + 1 < hi) xcd_barrier(bar, F0.wave * 64 + fresh_lane()); PROBE_T1(g) } ++ph;

    PHASE_BEGIN(0) p0_prologue(F); PHASE_END(0)
    int lprev = -1;
#define LAYER_PAIR(IT) { constexpr int it = IT; \
        const int lm = 2 * it, lh = 2 * it + 1; const bool colmajor = (it == 1), ctxl = (it == 0); \
        if (lm < MK_LAYERS) { \
         \
        PHASE_BEGIN(1) n1_phase(F, lm, it > 0, true, it > 0, it == 0, colmajor); hyena_filtergen(F, it, ctxl); PHASE_END(1) \
        PHASE_BEGIN(2) mlstm_inproj(F, it); PHASE_END(2) \
        PHASE_BEGIN(3) mlstm_conv_gates(F, it); PHASE_END(3) \
        PHASE_BEGIN(4) mlstm_qkv(F, it); PHASE_END(4) \
        PHASE_BEGIN(5) mlstm_scan(F, it); PHASE_END(5) \
        PHASE_BEGIN(6) mlstm_intra(F, it, ctxl ? 0 : 4); PHASE_END(6) \
        PHASE_BEGIN(7) mlstm_outproj(F, lm, it, ctxl, colmajor); PHASE_END(7) \
        PHASE_BEGIN(8) moe_route(F, lm, ctxl); PHASE_END(8) \
        PHASE_BEGIN(9) moe_e1(F, lm); PHASE_END(9) \
        PHASE_BEGIN(10) moe_e2(F, lm); PHASE_END(10) \
        lprev = lm; \
        if (lh < MK_LAYERS) { \
         \
        PHASE_BEGIN(1) n1_phase(F, lh, true, ctxl, ctxl, false, colmajor); PHASE_END(1) \
        PHASE_BEGIN(11) hyena_inproj(F, it, ctxl); PHASE_END(11) \
        PHASE_BEGIN(12) hyena_fft(F, it, ctxl); PHASE_END(12) \
        PHASE_BEGIN(13) hyena_transpose(F, ctxl); PHASE_END(13) \
        PHASE_BEGIN(14) hyena_outproj(F, lh, it, ctxl, colmajor); PHASE_END(14) \
        PHASE_BEGIN(8) moe_route(F, lh, ctxl); PHASE_END(8) \
        PHASE_BEGIN(9) moe_e1(F, lh); PHASE_END(9) \
        PHASE_BEGIN(10) moe_e2(F, lh); PHASE_END(10) \
        lprev = lh; \
        } } }
    LAYER_PAIR(0)
    LAYER_PAIR(1)
    PHASE_BEGIN(15) final_phase(F, lprev >= 0, lprev, lprev < 0); PHASE_END(15)
#ifdef MK_PROBE_WG
    { unsigned long long* slot = (unsigned long long*)(F0.ws + WS_CTL) + 16;
      if (F0.bid == MK_PROBE_WG && F0.tid == 0) __hip_atomic_store(slot, tacc, __ATOMIC_RELAXED, __HIP_MEMORY_SCOPE_AGENT);
      xcd_barrier(bar, F0.wave * 64 + fresh_lane());
      { const unsigned long long tv = __hip_atomic_load(slot, __ATOMIC_RELAXED, __HIP_MEMORY_SCOPE_AGENT); tacc = ((unsigned long long)(unsigned)__builtin_amdgcn_readfirstlane((int)(tv >> 32)) << 32) | (unsigned)__builtin_amdgcn_readfirstlane((int)tv); } }
#endif
#ifdef MK_PROBE
    { const unsigned long long te = __builtin_amdgcn_s_memrealtime() + tacc * MK_PROBE_MULT; while (__builtin_amdgcn_s_memrealtime() < te) __builtin_amdgcn_s_sleep(8); }
#endif
}

extern "C" void kernel_launch(void* const* d_in, const int* in_sizes, int n_in, void* d_out, int out_size, void* d_ws, size_t ws_size, hipStream_t stream) {
    static int grid = 0;
    if (grid == 0) {
        if (n_in != 40 || out_size != SEQ * D || ws_size < WS_END) { fprintf(stderr, "kernel_launch: unexpected shapes (n_in %d out %d ws %zu)\n", n_in, out_size, ws_size); grid = -1; return; }
        int dev = 0, cus = 0, per_cu = 0;
        if (hipGetDevice(&dev) != hipSuccess || hipDeviceGetAttribute(&cus, hipDeviceAttributeMultiprocessorCount, dev) != hipSuccess) { grid = -1; return; }
        if (hipFuncSetAttribute((const void*)mk_fwd, hipFuncAttributeMaxDynamicSharedMemorySize, LDS_BYTES) != hipSuccess) { fprintf(stderr, "kernel_launch: hipFuncSetAttribute failed\n"); grid = -1; return; }
        if (hipOccupancyMaxActiveBlocksPerMultiprocessor(&per_cu, (const void*)mk_fwd, NT, LDS_BYTES) != hipSuccess || per_cu < 1) { fprintf(stderr, "kernel_launch: occupancy query says %d\n", per_cu); }
        (void)hipGetLastError();
        grid = cus;
        if (grid > 256) grid = 256;
        if (grid < 128) { fprintf(stderr, "kernel_launch: needs >= 128 CUs (got %d)\n", grid); grid = -1; return; }
    }
    if (grid < 0) return;
    (void)hipMemsetAsync((char*)d_ws + WS_CTL, 0, CTL_BYTES, stream);
    Args a{};
    for (int i = 0; i < 40; ++i) a.in[i] = (const float*)d_in[i];
    a.out = (float*)d_out; a.ws = (unsigned char*)d_ws;
#ifdef MK_SPLIT
    for (int p = 0; p < MK_SPLIT; ++p) { a.ph_lo = p; a.ph_hi = p + 1; hipLaunchKernelGGL(mk_fwd, dim3(grid), dim3(NT), LDS_BYTES, stream, a); }
#else
    a.ph_lo = 0; a.ph_hi = 1000;
    hipLaunchKernelGGL(mk_fwd, dim3(grid), dim3(NT), LDS_BYTES, stream, a);
#endif
}
```

```cpp
#include <hip/hip_runtime.h>
#include <cstdio>
#include <cstdint>

#define LAS __attribute__((address_space(3)))
#define GAS __attribute__((address_space(1)))
#define RLX_AGENT __ATOMIC_RELAXED, __HIP_MEMORY_SCOPE_AGENT
typedef unsigned short bf16_t;
typedef short bf16x8 __attribute__((ext_vector_type(8)));
typedef float f32x4 __attribute__((ext_vector_type(4)));
typedef float f32x2 __attribute__((ext_vector_type(2)));
typedef unsigned u32x4 __attribute__((ext_vector_type(4)));
typedef unsigned u32x2 __attribute__((ext_vector_type(2)));

constexpr int D = 1024, SEQ = 16384, CTXN = 256, LT = SEQ + CTXN;
constexpr int MI = 2048, MH = 4, DQK = 256, DV = 512, CH = 64, NCH = LT / CH;
constexpr int NEXP = 32, DE = 512, NASG = 2 * LT;
constexpr int HB = 16, HEMB = 33, HFH = 64;
constexpr float EPS = 1e-6f;
constexpr int NT = 512, NWAVES = 8;
constexpr int LDS_BYTES = 147456;

constexpr size_t MiB = 1u << 20;
constexpr size_t WS_CTL = 0, CTL_BYTES = 1 * MiB;
constexpr size_t WS_MODS = 4 * MiB;
constexpr size_t WS_WC = 5 * MiB;
constexpr size_t WS_Z2 = 6 * MiB;
constexpr size_t WS_Z2C = 10 * MiB;
constexpr size_t WS_SCAL = 11 * MiB;
constexpr size_t WS_CHS = 14 * MiB;
constexpr size_t WS_DENI = 15 * MiB;
constexpr size_t WS_LIST = 16 * MiB;
constexpr size_t WS_AW = 21 * MiB;
constexpr size_t WS_WGP = 26 * MiB;
constexpr size_t WS_FSC = 27 * MiB;
constexpr size_t WS_TWP = 28 * MiB;
constexpr size_t WS_GWT = 22 * MiB;
constexpr size_t WS_FILTC = 23 * MiB;
constexpr size_t WS_W3T = 25 * MiB;
constexpr size_t WS_WMIN = 32 * MiB;
constexpr size_t WS_WQ = 48 * MiB;
constexpr size_t WS_WK = 50 * MiB;
constexpr size_t WS_WV = 52 * MiB;
constexpr size_t WS_WMOUT = 56 * MiB;
constexpr size_t WS_WHIN = 64 * MiB;
constexpr size_t WS_WHOUT = 76 * MiB;
constexpr size_t WS_W13 = 96 * MiB;
constexpr size_t WS_W2 = 352 * MiB;
constexpr size_t WS_HL = 480 * MiB;
constexpr size_t WS_HC = 544 * MiB;
constexpr size_t WS_U = 546 * MiB;
constexpr size_t WS_VN = 580 * MiB;
constexpr size_t WS_YBUF = 614 * MiB;
constexpr size_t WS_H1 = 680 * MiB;
constexpr size_t WS_MIX = 722 * MiB;
constexpr size_t WS_XCM = WS_MIX;
constexpr size_t WS_OPRE = WS_MIX + 130 * MiB;
constexpr size_t WS_Q = WS_MIX + 195 * MiB;
constexpr size_t WS_KN = WS_MIX + 228 * MiB;
constexpr size_t WS_KT = WS_MIX + 261 * MiB;
constexpr size_t WS_VT = WS_MIX + 294 * MiB;
constexpr size_t WS_OINT = WS_MIX + 359 * MiB;
constexpr size_t WS_Y = WS_MIX + 495 * MiB;
constexpr size_t WS_ZT = WS_MIX;
constexpr size_t WS_FILT = WS_MIX + 98 * MiB;
constexpr size_t WS_Y2T = WS_MIX + 162 * MiB;
constexpr size_t WS_ZH = WS_MIX + 195 * MiB;
constexpr size_t WS_Y2 = WS_MIX + 259 * MiB;
constexpr size_t WS_VTS = WS_MIX + 560 * MiB;
constexpr size_t WS_FILT2 = WS_MIX + 696 * MiB;
constexpr size_t WS_ZHALL = WS_MIX + 760 * MiB;
constexpr size_t WS_END = WS_MIX + 1016 * MiB;

constexpr int CW_BAR = 4096;
constexpr int CW_CNT = 16384;
constexpr int CW_ERR = 8;

__device__ __forceinline__ float bf2f(bf16_t b) { return __uint_as_float(((unsigned)b) << 16); }
__device__ __forceinline__ unsigned pk2(float lo, float hi) { unsigned r; asm("v_cvt_pk_bf16_f32 %0, %1, %2" : "=v"(r) : "v"(lo), "v"(hi)); return r; }
__device__ __forceinline__ bf16_t f2bf(float f) { return (bf16_t)pk2(f, 0.f); }
__device__ __forceinline__ float bflo(unsigned w) { return __uint_as_float(w << 16); }
__device__ __forceinline__ float bfhi(unsigned w) { return __uint_as_float(w & 0xffff0000u); }
__device__ __forceinline__ float sigmf(float x) { return __builtin_amdgcn_rcpf(1.0f + __expf(-x)); }
__device__ __forceinline__ float siluf(float x) { return x * sigmf(x); }
#define LDS_BAR() do { asm volatile("s_waitcnt lgkmcnt(0)" ::: "memory"); __builtin_amdgcn_s_barrier(); asm volatile("" ::: "memory"); } while (0)
__device__ __forceinline__ int fresh_lane() { int l; asm volatile("v_mbcnt_lo_u32_b32 %0, -1, 0\n\tv_mbcnt_hi_u32_b32 %0, -1, %0" : "=v"(l)); return l; }
__device__ __forceinline__ float wave_sum(float v) {
#pragma unroll
    for (int o = 32; o > 0; o >>= 1) v += __shfl_xor(v, o);
    return v;
}
__device__ __forceinline__ float wave_max(float v) {
#pragma unroll
    for (int o = 32; o > 0; o >>= 1) v = fmaxf(v, __shfl_xor(v, o));
    return v;
}

#define XB_TMO      128
#define XB_XCNT(j)  (256  + 64 * (j))
#define XB_XSUB(j)  (1280 + 64 * (j))
#define XB_XGEN(j)  (2304 + 64 * (j))
#define XB_TOP      3328
#define XB_TOPGEN   3392
#define XCD_BAR_WORDS 3456
#define XB_SPIN_CAP (1u << 18)
__device__ __forceinline__ unsigned xb_ld(unsigned* p)              { return __hip_atomic_load(p, __ATOMIC_RELAXED, __HIP_MEMORY_SCOPE_AGENT); }
__device__ __forceinline__ unsigned xb_add(unsigned* p, unsigned v) { return __hip_atomic_fetch_add(p, v, __ATOMIC_RELAXED, __HIP_MEMORY_SCOPE_AGENT); }
__device__ __forceinline__ unsigned xb_xcc_id() { return (unsigned)__builtin_amdgcn_s_getreg((3 << 11) | 20) & 0xFu; }
#define XB_SPIN(cond, bar) do { unsigned _sp = 0; while (cond) { __builtin_amdgcn_s_sleep(1); \
    if ((++_sp & 255u) == 0u) { if (xb_ld(&(bar)[XB_TMO])) break; if (_sp > XB_SPIN_CAP) { atomicAdd(&(bar)[XB_TMO], 1u); break; } } } } while (0)
struct XcdBarrier { unsigned* bar; unsigned x; volatile LAS unsigned* st; };
__device__ __forceinline__ XcdBarrier xcd_barrier_post(unsigned* bar, volatile LAS unsigned* st, int tid) {
    XcdBarrier b; b.bar = bar; b.x = xb_xcc_id(); b.st = st;
    if (tid == 0) (void)xb_add(&bar[XB_XCNT(b.x)], 1u);
    return b;
}
__device__ __forceinline__ void xcd_barrier_complete(unsigned* bar, unsigned x, unsigned& nloc, unsigned& nx) {
    const unsigned G = gridDim.x * gridDim.y * gridDim.z;
    unsigned sum, cnt, mine, sp = 0u;
    for (;;) {
        sum = 0u; cnt = 0u; mine = 0u;
#pragma unroll
        for (unsigned j = 0; j < 16; ++j) { const unsigned c = xb_ld(&bar[XB_XCNT(j)]); sum += c; cnt += (c > 0u) ? 1u : 0u; mine = (j == x) ? c : mine; }
        if (sum == G) break;
        __builtin_amdgcn_s_sleep(1);
        if ((++sp & 255u) == 0u) { if (xb_ld(&bar[XB_TMO])) break; if (sp > XB_SPIN_CAP) { atomicAdd(&bar[XB_TMO], 1u); break; } }
    }
    nloc = mine > 0u ? mine : 1u; nx = cnt > 0u ? cnt : 1u;
}
__device__ __forceinline__ void xcd_barrier(const XcdBarrier& b, int tid) {
    asm volatile("s_waitcnt vmcnt(0)" ::: "memory");
    __syncthreads();
    if (tid == 0) {
        unsigned* bar = b.bar;
        __builtin_amdgcn_s_waitcnt(0);
        unsigned nloc = b.st[0], nx = b.st[1];
        if (nloc == 0u) { xcd_barrier_complete(bar, b.x, nloc, nx); b.st[0] = nloc; b.st[1] = nx; }
        const unsigned old = xb_add(&bar[XB_XSUB(b.x)], 1u);
        const unsigned gen = old / nloc;
        if (old + 1u == (gen + 1u) * nloc) {
            __builtin_amdgcn_fence(__ATOMIC_RELEASE, "agent");
            asm volatile("s_waitcnt vmcnt(0)" ::: "memory");
            const unsigned og = xb_add(&bar[XB_TOP], 1u);
            const unsigned tg = og / nx;
            if (og + 1u == (tg + 1u) * nx) xb_add(&bar[XB_TOPGEN], 1u);
            else XB_SPIN(xb_ld(&bar[XB_TOPGEN]) == tg, bar);
            __builtin_amdgcn_fence(__ATOMIC_ACQUIRE, "agent");
            xb_add(&bar[XB_XGEN(b.x)], 1u);
            asm volatile("s_waitcnt vmcnt(0)" ::: "memory");
        } else {
            XB_SPIN(xb_ld(&bar[XB_XGEN(b.x)]) == gen, bar);
            __builtin_amdgcn_fence(__ATOMIC_ACQUIRE, "agent");
            asm volatile("s_waitcnt vmcnt(0)" ::: "memory");
        }
    }
    __syncthreads();
}

namespace pg8 {
constexpr int BM = 256, BK = 64, HALF = 128, HTB = HALF * BK * 2, STAGE_BYTES = 8 * HTB;
__device__ __forceinline__ int lds_byte(int r, int c) { const int st = (r >> 4) * 2 + (c >> 5), rr = r & 15, cc = c & 31, ob = rr * 64 + cc * 2; return st * 1024 + (ob ^ (((ob >> 9) & 1) << 5)); }
__device__ __forceinline__ void stage_rc(int b, int& R, int& C) { const int st = b / 1024, sb = b % 1024, swz = sb ^ (((sb >> 9) & 1) << 5); R = (st >> 1) * 16 + swz / 64; C = (st & 1) * 32 + (swz % 64) / 2; }
__device__ __forceinline__ int perm32(int rho) { const int n = rho >> 4, i = rho & 15; return 8 * (i >> 2) + 4 * n + (i & 3); }

struct GUnit { const char* a; const char* b; char* o; int pm, pn, g, aux, lda, ldb, ldo, hsb, half; };

template <class Epi, class Sched, bool GATHER>
__device__ __forceinline__ void gemm_phase(LAS unsigned char* lds, const int K, const Sched& S, const Epi& E, int tid_in) {
    int tid_ = tid_in; asm volatile("" : "+v"(tid_));
    const int tid = tid_, wid = __builtin_amdgcn_readfirstlane(tid >> 6), lane = tid & 63, wr = wid >> 2, wc = wid & 3, fr = lane & 15, fq = lane >> 4;
    const int nt = K / BK;
    unsigned cvA0[2], cvA1[2], cvB[2];
#define PG8_OFFS(U, slot, vA0, vA1, vB) do { _Pragma("unroll") for (int i = 0; i < 2; ++i) { int R_, C_; stage_rc(tid * 16 + i * 8192, R_, C_); const int Rb_ = Epi::PERM ? ((R_ & ~31) + perm32(R_ & 31)) : R_; \
        if constexpr (GATHER) { vA0[i] = S.grow(slot, R_) + (unsigned)C_ * 2u; vA1[i] = S.grow(slot, R_ + HALF) + (unsigned)C_ * 2u; } \
        else { vA0[i] = (unsigned)(R_ * (U).lda + C_) * 2u; vA1[i] = (unsigned)((R_ + HALF) * (U).lda + C_) * 2u; } \
        vB[i] = (unsigned)(Rb_ * (U).ldb + C_) * 2u; } } while (0)
    const size_t kstep = (size_t)(BK * 2);
    const unsigned ldsw = (unsigned)wid * 1024u;
    const int aoff = lds_byte(wr * 64 + fr, fq * 8), boff = lds_byte(wc * 32 + fr, fq * 8);
#define PG8_SA(b, h) (((b) * 2 + (h)) * HTB)
#define PG8_SB(b, h) ((4 + (b) * 2 + (h)) * HTB)
#define PG8_STAGE(bufoff, gbase, voff) do { _Pragma("unroll") for (int _i = 0; _i < 2; ++_i) \
        __builtin_amdgcn_global_load_lds((const unsigned*)((const char*)(gbase) + (voff)[_i]), (LAS unsigned*)(lds + (bufoff) + ldsw + _i * 8192), 16, 0, 0); } while (0)
#define PG8_LDA(dst, b, h) do { _Pragma("unroll") for (int m = 0; m < 4; ++m) _Pragma("unroll") for (int k = 0; k < 2; ++k) dst[m][k] = *(const LAS bf16x8*)(lds + PG8_SA(b, h) + aoff + m * 2048 + k * 1024); } while (0)
#define PG8_LDB(dst, b, h) do { _Pragma("unroll") for (int n = 0; n < 2; ++n) _Pragma("unroll") for (int k = 0; k < 2; ++k) dst[n][k] = *(const LAS bf16x8*)(lds + PG8_SB(b, h) + boff + n * 2048 + k * 1024); } while (0)
#define PG8_MMA(ai, bj, At, Bt) do { __builtin_amdgcn_s_setprio(1); _Pragma("unroll") for (int m = 0; m < 4; ++m) _Pragma("unroll") for (int n = 0; n < 2; ++n) _Pragma("unroll") for (int k = 0; k < 2; ++k) \
        acc[ai][bj][m][n] = __builtin_amdgcn_mfma_f32_16x16x32_bf16(Bt[n][k], At[m][k], acc[ai][bj][m][n], 0, 0, 0); __builtin_amdgcn_s_setprio(0); } while (0)
#define PG8_WAIT_V(n) asm volatile("s_waitcnt vmcnt(" #n ")" ::: "memory")
#define PG8_WAIT_L(n) asm volatile("s_waitcnt lgkmcnt(" #n ")" ::: "memory")
#define PG8_BAR __builtin_amdgcn_s_barrier()
#define PG8_SCHED __builtin_amdgcn_sched_barrier(0)
    GUnit cur, nxt; int ui = 0;
    if (!S.next(0, cur)) return;
    PG8_OFFS(cur, 0, cvA0, cvA1, cvB);
    size_t chB = (size_t)cur.hsb * cur.ldb * 2;
    f32x4 acc[2][2][4][2];
#pragma unroll
    for (int a = 0; a < 2; ++a)
#pragma unroll
        for (int b = 0; b < 2; ++b)
#pragma unroll
            for (int m = 0; m < 4; ++m)
#pragma unroll
                for (int n = 0; n < 2; ++n) acc[a][b][m][n] = (f32x4){0.f, 0.f, 0.f, 0.f};
    bf16x8 At[4][2], B0[2][2], B1[2][2];
    const char* cA = cur.a; const char* cB = cur.b;
    PG8_STAGE(PG8_SB(0, 0), cB, cvB); PG8_STAGE(PG8_SA(0, 0), cA, cvA0); PG8_STAGE(PG8_SB(0, 1), cB + chB, cvB); PG8_STAGE(PG8_SA(0, 1), cA, cvA1);
    if (wr == 1) PG8_BAR;
    PG8_WAIT_V(4); PG8_BAR;
    PG8_STAGE(PG8_SB(1, 0), cB + kstep, cvB); PG8_STAGE(PG8_SA(1, 0), cA + kstep, cvA0); PG8_STAGE(PG8_SB(1, 1), cB + chB + kstep, cvB);
    PG8_WAIT_V(6); PG8_BAR;
    for (;;) {
        const bool has_next = S.next(ui + 1, nxt);
        const char* nA = has_next ? nxt.a : cA; const char* nB = has_next ? nxt.b : cB;
        for (int t = 0; t < nt; t += 2) {
            const bool last = (t == nt - 2);
            const char* a1 = cA + (size_t)(t + 1) * kstep;
            const char* a2 = last ? nA : cA + (size_t)(t + 2) * kstep; const char* b2 = last ? nB : cB + (size_t)(t + 2) * kstep;
            const char* a3 = a2 + kstep; const char* b3 = b2 + kstep;
            PG8_LDB(B0, 0, 0); PG8_SCHED; PG8_LDA(At, 0, 0); PG8_STAGE(PG8_SA(1, 1), a1, cvA1);
            PG8_WAIT_L(8); PG8_BAR; PG8_WAIT_L(0); PG8_MMA(0, 0, At, B0); PG8_BAR; PG8_SCHED;
            if (last && has_next) { PG8_OFFS(nxt, ui + 1, cvA0, cvA1, cvB); chB = (size_t)nxt.hsb * nxt.ldb * 2; }
            PG8_LDB(B1, 0, 1); PG8_STAGE(PG8_SB(0, 0), b2, cvB);
            PG8_BAR; PG8_WAIT_L(0); PG8_MMA(0, 1, At, B1); PG8_BAR;
            PG8_LDA(At, 0, 1); PG8_STAGE(PG8_SA(0, 0), a2, cvA0);
            PG8_BAR; PG8_WAIT_L(0); PG8_MMA(1, 0, At, B0); PG8_BAR; PG8_SCHED;
            PG8_STAGE(PG8_SB(0, 1), b2 + chB, cvB);
            PG8_WAIT_V(6); PG8_BAR; PG8_MMA(1, 1, At, B1); PG8_BAR;
            PG8_LDB(B0, 1, 0); PG8_SCHED; PG8_LDA(At, 1, 0); PG8_STAGE(PG8_SA(0, 1), a2, cvA1);
            PG8_WAIT_L(8); PG8_BAR; PG8_WAIT_L(0); PG8_MMA(0, 0, At, B0); PG8_BAR; PG8_SCHED;
            PG8_LDB(B1, 1, 1); PG8_STAGE(PG8_SB(1, 0), b3, cvB);
            PG8_BAR; PG8_WAIT_L(0); PG8_MMA(0, 1, At, B1); PG8_BAR;
            PG8_LDA(At, 1, 1); PG8_STAGE(PG8_SA(1, 0), a3, cvA0);
            PG8_BAR; PG8_WAIT_L(0); PG8_MMA(1, 0, At, B0); PG8_BAR; PG8_SCHED;
            PG8_STAGE(PG8_SB(1, 1), b3 + chB, cvB);
            PG8_WAIT_V(6); PG8_BAR; PG8_MMA(1, 1, At, B1); PG8_BAR;
        }
        E(acc, cur, wr, wc, fr, fq);
        if (!has_next) break;
#pragma unroll
        for (int a = 0; a < 2; ++a)
#pragma unroll
            for (int b = 0; b < 2; ++b)
#pragma unroll
                for (int m = 0; m < 4; ++m)
#pragma unroll
                    for (int n = 0; n < 2; ++n) acc[a][b][m][n] = (f32x4){0.f, 0.f, 0.f, 0.f};
        cur = nxt; cA = nA; cB = nB; ++ui;
    }
    PG8_WAIT_V(0);
    if (wr == 0) PG8_BAR;
    PG8_BAR;
#undef PG8_OFFS
#undef PG8_SA
#undef PG8_SB
#undef PG8_STAGE
#undef PG8_LDA
#undef PG8_LDB
#undef PG8_MMA
#undef PG8_WAIT_V
#undef PG8_WAIT_L
#undef PG8_BAR
#undef PG8_SCHED
}

__device__ __forceinline__ int xcd_remap(int wgid, int nwg) { const int q = nwg / 8, r = nwg % 8, xcd = wgid % 8, off = wgid / 8; return (xcd < r ? xcd * (q + 1) : r * (q + 1) + (xcd - r) * q) + off; }
}
using pg8::GUnit;

struct Args { const float* in[40]; float* out; unsigned char* ws; int ph_lo, ph_hi; };
struct Frame {
    LAS unsigned char* lds; unsigned char* ws; const float* const* in; float* out;
    int tid, lane, wave, G, bid;
};
struct Prob { const char* A; const char* B; char* O; long long sA, sB, sO;
              int nM, nN, nb, ustart; int lda, ldb, ldo; int osz; };
constexpr int SCHED_TAB = 131072 + 8192;
__device__ __forceinline__ int rfl(int v) { return __builtin_amdgcn_readfirstlane(v); }
__device__ __forceinline__ const char* rflp(const char* p) { const unsigned long long v = (unsigned long long)p; return (const char*)(((unsigned long long)(unsigned)rfl((int)(v >> 32)) << 32) | (unsigned)rfl((int)v)); }
template <int NP> struct MultiSched {
    LAS Prob* p; int total, G, c;
    __device__ __forceinline__ void init(const Frame& F, const Prob (&q)[NP], int total_) {
        p = (LAS Prob*)(F.lds + SCHED_TAB); total = total_; G = F.G; c = F.bid;
        __syncthreads();
        if (F.tid == 0) {
#pragma unroll
            for (int j = 0; j < NP; ++j) { p[j].A = q[j].A; p[j].B = q[j].B; p[j].O = q[j].O; p[j].sA = q[j].sA; p[j].sB = q[j].sB; p[j].sO = q[j].sO; p[j].nM = q[j].nM; p[j].nN = q[j].nN; p[j].nb = q[j].nb;
                p[j].ustart = q[j].ustart; p[j].lda = q[j].lda; p[j].ldb = q[j].ldb; p[j].ldo = q[j].ldo; p[j].osz = q[j].osz; } }
        __syncthreads();
    }
    __device__ __forceinline__ bool next(int i, GUnit& u) const {
        const long long Lq = (long long)i * G + c; if (Lq >= total) return false;
        int L = pg8::xcd_remap((int)Lq, total);
        int k = 0;
#pragma unroll
        for (int j = 1; j < NP; ++j) if (L >= p[j].ustart) k = j;
        k = rfl(k);
        const LAS Prob& q = p[k];
        const int nM = rfl(q.nM), nN = rfl(q.nN), lda = rfl(q.lda), ldb = rfl(q.ldb), ldo = rfl(q.ldo), osz = rfl(q.osz);
        L -= rfl(q.ustart);
        const int per = nM * nN, b = L / per, r = L - b * per, pm = r / nN, pn = r - pm * nN;
        u.pm = pm; u.pn = pn; u.g = b; u.aux = k; u.lda = lda; u.ldb = ldb; u.ldo = ldo; u.hsb = 128; u.half = 0;
        u.a = rflp(q.A) + b * (long long)rfl((int)q.sA) + (size_t)pm * 256 * lda * 2;
        u.b = rflp(q.B) + b * (long long)rfl((int)q.sB) + (size_t)pn * 256 * ldb * 2;
        u.o = (char*)rflp(q.O) + b * (long long)rfl((int)q.sO) + ((size_t)pm * 256 * ldo + (size_t)pn * 256) * osz;
        return true;
    }
};

struct EpiStore {
    static constexpr bool PERM = true;
    const float* rowbias;
    const float* wgp; bf16_t* vts;
    int fragmode;
    __device__ __forceinline__ void operator()(const f32x4 (&acc)[2][2][4][2], const GUnit& u, int wr, int wc, int fr, int fq) const {
        bf16_t* base = (bf16_t*)u.o;
#pragma unroll
        for (int ai = 0; ai < 2; ++ai)
#pragma unroll
            for (int m = 0; m < 4; ++m) { const int r = ai * 128 + wr * 64 + m * 16 + fr;
                const float rb = rowbias ? rowbias[u.pm * 256 + r] : 0.f;
#pragma unroll
                for (int bj = 0; bj < 2; ++bj) { const f32x4 v0 = acc[ai][bj][m][0] + rb, v1 = acc[ai][bj][m][1] + rb;
                    u32x4 w; w.x = pk2(v0[0], v0[1]); w.y = pk2(v0[2], v0[3]); w.z = pk2(v1[0], v1[1]); w.w = pk2(v1[2], v1[3]);
                    const int c = bj * 128 + wc * 32 + 8 * fq;
                    unsigned off;
                    if (fragmode == 0) off = (unsigned)(r * u.ldo + c);
                    else if (u.aux < 2) { const int R = u.pm * 256 + r; off = (unsigned)((((R >> 4) * 8 + (c >> 5)) * 64 + (R & 15) + 16 * fq) * 8); }
                    else { const int R = u.pm * 256 + r, s = u.pn * 256 + c, nrt = (u.aux == 2) ? 16 : 32;
                           off = (unsigned)(((((s >> 6) * nrt + (R >> 4)) * 2 + ((s >> 5) & 1)) * 64 + (R & 15) + 16 * fq) * 8); }
                    *(u32x4*)(base + off) = w; } }
        if (vts != nullptr && u.aux == 3) {
#pragma unroll 1
            for (int dir = 0; dir < 2; ++dir) { const int ch = dir * 4 + u.g;
                bf16_t* ob = vts + (size_t)ch * NCH * 33 * 1024;
#pragma unroll
                for (int bj = 0; bj < 2; ++bj) { const int c = bj * 128 + wc * 32 + 8 * fq, s = u.pn * 256 + c;
                    const f32x4 g0 = *(const f32x4*)(wgp + (size_t)ch * LT + s), g1 = *(const f32x4*)(wgp + (size_t)ch * LT + s + 4);
#pragma unroll
                    for (int ai = 0; ai < 2; ++ai)
#pragma unroll
                        for (int m = 0; m < 4; ++m) { const int R = u.pm * 256 + ai * 128 + wr * 64 + m * 16 + fr; const f32x4 v0 = acc[ai][bj][m][0] * g0, v1 = acc[ai][bj][m][1] * g1;
                            u32x4 w; w.x = pk2(v0[0], v0[1]); w.y = pk2(v0[2], v0[3]); w.z = pk2(v1[0], v1[1]); w.w = pk2(v1[2], v1[3]);
                            *(u32x4*)(ob + (unsigned)(((((s >> 6) * 33 + (R >> 4)) * 2 + ((s >> 5) & 1)) * 64 + (R & 15) + 16 * fq) * 8)) = w; }
                    asm volatile("" ::: "memory"); } }
        }
    }
};

enum { I_X = 0, I_C, I_CTX, I_CCTX, I_ADAW, I_ADAB, I_N1G, I_N2G, I_RGW, I_RGB, I_REW, I_REB, I_W13, I_W2,
       I_MINW, I_MCONVW, I_MCONVB, I_MQW, I_MKW, I_MVW, I_MGATEW, I_MGATEB, I_MNORMG, I_MSKIP, I_MOUTW,
       I_HINW, I_HINB, I_HSCW, I_HSCB, I_HFW1, I_HFB1, I_HFFREQ, I_HFW2, I_HFB2, I_HFW3, I_HDECAY, I_HFBIAS, I_HOUTW, I_HOUTB, I_FINALG };

__device__ __forceinline__ void tconv(const Frame& F, const float* src, bf16_t* dst, int B, int R, int C, float scale, int vbid, int vG) {
    LAS float* tile = (LAS float*)F.lds;
    const int tr = R / 64, tc = C / 64, ntile = B * tr * tc;
    for (int t = vbid; t < ntile; t += vG) {
        const int b = t / (tr * tc), rem = t - b * tr * tc, r0 = (rem / tc) * 64, c0 = (rem % tc) * 64;
        const float* s = src + ((size_t)b * R + r0) * C + c0;
        { const int r = F.tid >> 3, c8 = (F.tid & 7) * 8;
          const f32x4 v0 = *(const f32x4*)(s + (size_t)r * C + c8), v1 = *(const f32x4*)(s + (size_t)r * C + c8 + 4);
#pragma unroll
          for (int j = 0; j < 4; ++j) { tile[r * 65 + c8 + j] = v0[j]; tile[r * 65 + c8 + 4 + j] = v1[j]; } }
        LDS_BAR();
        { const int n = F.tid >> 3, k8 = (F.tid & 7) * 8; float v[8];
#pragma unroll
          for (int j = 0; j < 8; ++j) v[j] = tile[(k8 + j) * 65 + n] * scale;
          u32x4 w; w.x = pk2(v[0], v[1]); w.y = pk2(v[2], v[3]); w.z = pk2(v[4], v[5]); w.w = pk2(v[6], v[7]);
          *(u32x4*)(dst + ((size_t)b * C + c0 + n) * R + r0 + k8) = w; }
        LDS_BAR();
    }
}

__device__ __forceinline__ void adaln_units(const Frame& F, int u_lo, int u_hi, int vbid, int vG) {
    unsigned char* ws = F.ws;
    {
        LAS float* sv = (LAS float*)F.lds;
        LAS float* pr = sv + 2048;
        __syncthreads();
        for (int i = F.tid; i < 2048; i += NT) sv[i] = siluf(i < 1024 ? F.in[I_C][i] : F.in[I_CCTX][i - 1024]);
        __syncthreads();
        const int cl = F.tid & 63, kg = F.tid >> 6;
        for (int u = u_lo + vbid; u < u_hi; u += vG) {
            const int l = u / 96, col = (u % 96) * 64 + cl;
            const float* w = F.in[I_ADAW] + ((size_t)l * 1024 + kg * 128) * 6144 + col;
            float a0 = 0.f, a1 = 0.f;
#pragma unroll 16
            for (int k = 0; k < 128; ++k) { const float wv = w[(size_t)k * 6144]; a0 += sv[kg * 128 + k] * wv; a1 += sv[1024 + kg * 128 + k] * wv; }
            pr[(kg * 2 + 0) * 64 + cl] = a0; pr[(kg * 2 + 1) * 64 + cl] = a1;
            __syncthreads();
            if (F.tid < 128) { const int s2 = F.tid >> 6; float a = F.in[I_ADAB][l * 6144 + col];
#pragma unroll
                for (int g = 0; g < 8; ++g) a += pr[(g * 2 + s2) * 64 + cl];
                ((float*)(ws + WS_MODS))[(size_t)(l * 2 + s2) * 6144 + col] = a; }
            __syncthreads();
        }
    }
}
__device__ __forceinline__ void mlstm_wconv(const Frame& F, int slot, int vbid, int vG) {
    unsigned char* ws = F.ws;
    tconv(F, F.in[I_MINW] + (size_t)slot * 1024 * 4096, (bf16_t*)(ws + WS_WMIN) + (size_t)slot * 1024 * 4096, 1, 1024, 4096, 1.f, vbid, vG);
    tconv(F, F.in[I_MQW] + (size_t)slot * 4 * 512 * 256, (bf16_t*)(ws + WS_WQ) + (size_t)slot * 4 * 512 * 256, 4, 512, 256, 1.f, vbid, vG);
    tconv(F, F.in[I_MKW] + (size_t)slot * 4 * 512 * 256, (bf16_t*)(ws + WS_WK) + (size_t)slot * 4 * 512 * 256, 4, 512, 256, 0.0625f, vbid, vG);
    tconv(F, F.in[I_MVW] + (size_t)slot * 4 * 512 * 512, (bf16_t*)(ws + WS_WV) + (size_t)slot * 4 * 512 * 512, 4, 512, 512, 1.f, vbid, vG);
}
__device__ __forceinline__ void z2_rows(const Frame& F, int row_lo, int row_hi, int vbid, int vG);

__device__ __forceinline__ void p0_prologue(const Frame& F) {
    unsigned char* ws = F.ws;
    adaln_units(F, 0, 96, F.bid, F.G);
    mlstm_wconv(F, 0, F.bid, F.G);
    tconv(F, F.in[I_HFW3], (bf16_t*)(ws + WS_W3T), 1, 64, 2048, 1.f, F.bid, F.G);
    for (int ci = F.bid * NT + F.tid; ci < 8192; ci += F.G * NT) { const int k = (ci >> 9) + 16 * ((ci >> 4) & 31) + 512 * (ci & 15);
        float sn, cs; sincospif((float)k * (1.0f / 16384.0f), &sn, &cs); ((f32x2*)(ws + WS_TWP))[ci] = (f32x2){cs, -sn}; }
    const int gt = F.bid * NT + F.tid, gs = F.G * NT;
    for (int i = gt; i < 2 * 16 * 4096; i += gs) { const int s = i / 65536, r = i % 65536, n = r / 4096, k = r % 4096;
        ((bf16_t*)(ws + WS_GWT))[i] = f2bf(F.in[I_MGATEW][((size_t)s * 4096 + k) * 16 + n]); }
    for (int i = gt; i < 4 * 1024 * 48; i += gs) { const int l = i / 49152, r = i % 49152, k = r / 48, n = r % 48;
        float v = 0.f; if (n < 4) v = F.in[I_RGW][((size_t)l * 1024 + k) * 4 + n]; else if (n < 36) v = F.in[I_REW][((size_t)l * 1024 + k) * 32 + (n - 4)];
        ((float*)(ws + WS_WC))[i] = v; }
    z2_rows(F, 0, SEQ, F.bid, F.G);
    z2_rows(F, 2 * SEQ, 2 * SEQ + CTXN, F.bid, F.G);
}
__device__ __forceinline__ void z2_rows(const Frame& F, int row_lo, int row_hi, int vbid, int vG) {
    unsigned char* ws = F.ws;
    {
        LAS float* ft = (LAS float*)F.lds;
        LAS float* z1 = ft + 8 * 36;
        for (int r0 = row_lo + vbid * 8; r0 < row_hi; r0 += vG * 8) {
            const int rr = F.tid >> 6, j = F.tid & 63, row = r0 + rr;
            int slot, t, Ln; if (row < 2 * SEQ) { slot = row / SEQ; t = row % SEQ; Ln = SEQ; } else { slot = 0; t = row - 2 * SEQ; Ln = CTXN; }
            __syncthreads();
            if (j < 33) { float f;
                if (j == 0) f = (float)t / (float)(Ln - 1);
                else { const int b = (j - 1) % 16 + 1; const int ph = (t * b) % Ln; const float a = (float)ph / (float)Ln;
                       f = (j <= 16) ? cosf(6.283185307179586f * a) : sinf(6.283185307179586f * a); }
                ft[rr * 36 + j] = f; }
            __syncthreads();
            const float fr = F.in[I_HFFREQ][slot * 64 + j];
            { float a = F.in[I_HFB1][slot * 64 + j]; const float* w1 = F.in[I_HFW1] + (size_t)slot * 33 * 64 + j;
#pragma unroll
              for (int k = 0; k < 33; ++k) a += ft[rr * 36 + k] * w1[k * 64];
              z1[rr * 64 + j] = sinf(fr * a); }
            __syncthreads();
            { float a = F.in[I_HFB2][slot * 64 + j]; const float* w2 = F.in[I_HFW2] + (size_t)slot * 64 * 64 + j;
#pragma unroll 8
              for (int k = 0; k < 64; ++k) a += z1[rr * 64 + k] * w2[k * 64];
              const float z = sinf(fr * a);
              bf16_t* dst = (row < 2 * SEQ) ? (bf16_t*)(ws + WS_Z2) + (size_t)row * 64 : (bf16_t*)(ws + WS_Z2C) + (size_t)t * 64;
              dst[j] = f2bf(z); }
        }
        __syncthreads();
    }
}

__device__ __forceinline__ void deferred_convert(const Frame& F, int part, int vbid, int vG) {
    unsigned char* ws = F.ws;
    if (part == 0) {
        tconv(F, F.in[I_MOUTW], (bf16_t*)(ws + WS_WMOUT), 2, 2048, 1024, 1.f, vbid, vG);
        adaln_units(F, 96, 4 * 96, vbid, vG);
        mlstm_wconv(F, 1, vbid, vG);
        tconv(F, F.in[I_HFW3] + (size_t)64 * 2048, (bf16_t*)(ws + WS_W3T) + (size_t)64 * 2048, 1, 64, 2048, 1.f, vbid, vG);
        z2_rows(F, SEQ, 2 * SEQ, vbid, vG);
        tconv(F, F.in[I_HINW], (bf16_t*)(ws + WS_WHIN), 2, 1024, 3072, 1.f, vbid, vG);
        tconv(F, F.in[I_HOUTW], (bf16_t*)(ws + WS_WHOUT), 2, 1024, 1024, 1.f, vbid, vG);
    }
    tconv(F, F.in[I_W13] + (size_t)part * 64 * 1024 * 1024, (bf16_t*)(ws + WS_W13) + (size_t)part * 64 * 1024 * 1024, 64, 1024, 1024, 1.f, vbid, vG);
    tconv(F, F.in[I_W2] + (size_t)part * 64 * 512 * 1024, (bf16_t*)(ws + WS_W2) + (size_t)part * 64 * 512 * 1024, 64, 512, 1024, 1.f, vbid, vG);
}

__device__ __forceinline__ const float* modp(const Frame& F, int l, int s, int piece) { return (const float*)(F.ws + WS_MODS) + ((size_t)(l * 2 + s) * 6 + piece) * 1024; }
__device__ __forceinline__ int scan_pos(int t, bool colmajor) { return colmajor ? ((t & 63) * 256 + (t >> 6)) : t; }
__device__ __forceinline__ int scan_inv(int p, bool colmajor) { return colmajor ? ((p & 255) * 64 + (p >> 8)) : p; }

__device__ __forceinline__ void n1_phase(const Frame& F, int l, bool comb, bool ctx_rows, bool comb_ctx, bool first, bool colmajor) {
    bf16_t* HL = (bf16_t*)(F.ws + WS_HL); bf16_t* HC = (bf16_t*)(F.ws + WS_HC); bf16_t* U = (bf16_t*)(F.ws + WS_U);
    const bf16_t* YB = (const bf16_t*)(F.ws + WS_YBUF);
    const float* g1n = F.in[I_N1G] + l * 1024;
    const int nrows = SEQ + (ctx_rows ? CTXN : 0);
    f32x4 hg2[4], hga[4], hsh[4];
#pragma unroll
    for (int j = 0; j < 4; ++j) { const int c = j * 256 + F.lane * 4; const f32x4 g = *(const f32x4*)(g1n + c), a = *(const f32x4*)(modp(F, l, 0, 1) + c);
        hga[j] = g * (a + 1.0f); hsh[j] = *(const f32x4*)(modp(F, l, 0, 0) + c); hg2[j] = comb ? *(const f32x4*)(modp(F, l - 1, 0, 5) + c) : (f32x4){0.f, 0.f, 0.f, 0.f}; }
    for (int r0 = (F.bid * NWAVES + F.wave) * 2; r0 < nrows; r0 += F.G * NWAVES * 2) {
        f32x4 v[2][4]; float ss[2] = {0.f, 0.f};
        u32x2 y0[2][4], y1[2][4];
#pragma unroll
        for (int q = 0; q < 2; ++q) { const int r = r0 + q; const bool isctx = r >= SEQ; const int t = isctx ? r - SEQ : r;
            const float* src = (isctx ? F.in[I_CTX] : F.in[I_X]) + (size_t)t * 1024; const bf16_t* srch = (isctx ? HC : HL) + (size_t)t * 1024;
            const bool docomb = comb && (!isctx || comb_ctx); const int tok = isctx ? t : CTXN + t;
#pragma unroll
            for (int j = 0; j < 4; ++j) { const int c = j * 256 + F.lane * 4;
                if (first) v[q][j] = *(const f32x4*)(src + c); else { const u32x2 hb = *(const u32x2*)(srch + c); v[q][j] = (f32x4){bflo(hb.x), bfhi(hb.x), bflo(hb.y), bfhi(hb.y)}; }
                if (docomb) { y0[q][j] = *(const u32x2*)(YB + ((size_t)tok * 2 + 0) * 1024 + c); y1[q][j] = *(const u32x2*)(YB + ((size_t)tok * 2 + 1) * 1024 + c); } } }
#pragma unroll
        for (int q = 0; q < 2; ++q) { const int r = r0 + q; const bool isctx = r >= SEQ; const int t = isctx ? r - SEQ : r; const int s = isctx ? 1 : 0;
            bf16_t* dsth = (isctx ? HC : HL) + (size_t)t * 1024;
            const bool docomb = comb && (!isctx || comb_ctx);
            const float* g2 = docomb ? modp(F, l - 1, s, 5) : nullptr;
#pragma unroll
            for (int j = 0; j < 4; ++j) { const int c = j * 256 + F.lane * 4;
                if (docomb) { const f32x4 g = isctx ? *(const f32x4*)(g2 + c) : hg2[j];
                    v[q][j][0] += g[0] * (bflo(y0[q][j].x) + bflo(y1[q][j].x)); v[q][j][1] += g[1] * (bfhi(y0[q][j].x) + bfhi(y1[q][j].x)); v[q][j][2] += g[2] * (bflo(y0[q][j].y) + bflo(y1[q][j].y)); v[q][j][3] += g[3] * (bfhi(y0[q][j].y) + bfhi(y1[q][j].y)); }
                if (docomb || first) { u32x2 hw; hw.x = pk2(v[q][j][0], v[q][j][1]); hw.y = pk2(v[q][j][2], v[q][j][3]); *(u32x2*)(dsth + c) = hw; }
                ss[q] += v[q][j][0] * v[q][j][0] + v[q][j][1] * v[q][j][1] + v[q][j][2] * v[q][j][2] + v[q][j][3] * v[q][j][3]; }
            ss[q] = wave_sum(ss[q]); }
#pragma unroll
        for (int q = 0; q < 2; ++q) { const int r = r0 + q; const bool isctx = r >= SEQ; const int t = isctx ? r - SEQ : r; const int s = isctx ? 1 : 0;
            const float* sh = modp(F, l, s, 0); const float* sc = modp(F, l, s, 1);
            const float rstd = rsqrtf(ss[q] * (1.0f / 1024.0f) + EPS);
            const int urow = isctx ? t : CTXN + scan_pos(t, colmajor);
#pragma unroll
            for (int j = 0; j < 4; ++j) { const int c = j * 256 + F.lane * 4;
                f32x4 ga, b;
                if (isctx) { const f32x4 g = *(const f32x4*)(g1n + c), a = *(const f32x4*)(sc + c); ga = g * (a + 1.0f); b = *(const f32x4*)(sh + c); } else { ga = hga[j]; b = hsh[j]; }
                float o[4];
#pragma unroll
                for (int e = 0; e < 4; ++e) o[e] = v[q][j][e] * rstd * ga[e] + b[e];
                u32x2 w; w.x = pk2(o[0], o[1]); w.y = pk2(o[2], o[3]); *(u32x2*)(U + (size_t)urow * 1024 + c) = w; } }
    }
}

__device__ __forceinline__ void final_phase(const Frame& F, bool comb, int lprev, bool first) {
    const bf16_t* HL = (const bf16_t*)(F.ws + WS_HL); const bf16_t* YB = (const bf16_t*)(F.ws + WS_YBUF); const float* fg = F.in[I_FINALG];
    const float* g2 = comb ? modp(F, lprev, 0, 5) : nullptr;
    for (int t0 = (F.bid * NWAVES + F.wave) * 2; t0 < SEQ; t0 += F.G * NWAVES * 2) {
        f32x4 v[2][4]; u32x2 y0[2][4], y1[2][4]; float ss[2] = {0.f, 0.f};
#pragma unroll
        for (int q = 0; q < 2; ++q) { const int t = t0 + q; const float* src = F.in[I_X] + (size_t)t * 1024; const bf16_t* srch = HL + (size_t)t * 1024; const int tok = CTXN + t;
#pragma unroll
            for (int j = 0; j < 4; ++j) { const int c = j * 256 + F.lane * 4;
                if (first) v[q][j] = *(const f32x4*)(src + c); else { const u32x2 hb = *(const u32x2*)(srch + c); v[q][j] = (f32x4){bflo(hb.x), bfhi(hb.x), bflo(hb.y), bfhi(hb.y)}; }
                if (comb) { y0[q][j] = *(const u32x2*)(YB + ((size_t)tok * 2 + 0) * 1024 + c); y1[q][j] = *(const u32x2*)(YB + ((size_t)tok * 2 + 1) * 1024 + c); } } }
#pragma unroll
        for (int q = 0; q < 2; ++q) {
#pragma unroll
            for (int j = 0; j < 4; ++j) { const int c = j * 256 + F.lane * 4;
                if (comb) { const f32x4 g = *(const f32x4*)(g2 + c);
                    v[q][j][0] += g[0] * (bflo(y0[q][j].x) + bflo(y1[q][j].x)); v[q][j][1] += g[1] * (bfhi(y0[q][j].x) + bfhi(y1[q][j].x)); v[q][j][2] += g[2] * (bflo(y0[q][j].y) + bflo(y1[q][j].y)); v[q][j][3] += g[3] * (bfhi(y0[q][j].y) + bfhi(y1[q][j].y)); }
                ss[q] += v[q][j][0] * v[q][j][0] + v[q][j][1] * v[q][j][1] + v[q][j][2] * v[q][j][2] + v[q][j][3] * v[q][j][3]; }
            ss[q] = wave_sum(ss[q]); }
#pragma unroll
        for (int q = 0; q < 2; ++q) { const int t = t0 + q; const float rstd = rsqrtf(ss[q] * (1.0f / 1024.0f) + EPS);
#pragma unroll
            for (int j = 0; j < 4; ++j) { const int c = j * 256 + F.lane * 4; const f32x4 g = *(const f32x4*)(fg + c);
                f32x4 o;
#pragma unroll
                for (int e = 0; e < 4; ++e) o[e] = v[q][j][e] * rstd * g[e];
                *(f32x4*)(F.out + (size_t)t * 1024 + c) = o; } }
    }
}

__device__ __forceinline__ void hyena_filter_fft(const Frame& F, int vbid, int vG);
__device__ __forceinline__ float* scal_arr(const Frame& F, int k, int ch) { return (float*)(F.ws + WS_SCAL) + ((size_t)k * 8 + ch) * LT; }
__device__ __forceinline__ float* chs_arr(const Frame& F, int k, int ch) { return (float*)(F.ws + WS_CHS) + ((size_t)k * 8 + ch) * NCH; }
__device__ __forceinline__ bf16x8 bload16(__amdgpu_buffer_rsrc_t r, unsigned voff, unsigned soff) { const u32x4 x = __builtin_amdgcn_raw_buffer_load_b128(r, voff, soff, 0); return __builtin_bit_cast(bf16x8, x); }
__device__ __forceinline__ float logsigf(float x) { return fminf(x, 0.f) - log1pf(__expf(-fabsf(x))); }

__device__ __forceinline__ void mlstm_inproj(const Frame& F, int slot) {
    MultiSched<2> S; Prob pr[2];
    const char* W = (const char*)(F.ws + WS_WMIN) + (size_t)slot * 4096 * 1024 * 2;
    pr[0] = Prob{(const char*)(F.ws + WS_U), W, (char*)(F.ws + WS_XCM) + (size_t)4 * LT * 512 * 2, 0, 512 * 1024 * 2, (long long)LT * 512 * 2, NCH / 4, 2, 4, 0, 1024, 1024, 512, 2};
    pr[1] = Prob{(const char*)(F.ws + WS_U), W + (size_t)2048 * 1024 * 2, (char*)(F.ws + WS_OPRE), 0, 0, 0, NCH / 4, 8, 1, 65 * 8, 1024, 1024, 2048, 2};
    S.init(F, pr, 65 * 16);
    EpiStore E{nullptr, nullptr, nullptr, 0};
    pg8::gemm_phase<EpiStore, MultiSched<2>, false>(F.lds, 1024, S, E, F.tid);
}

__device__ __forceinline__ void mlstm_conv_gates(const Frame& F, int slot) {
    constexpr int TP = 4096 + 8;
    LAS bf16_t* tile = (LAS bf16_t*)F.lds;
    LAS float* part = (LAS float*)(F.lds + 16 * TP * 2);
    LAS float* gl = part + 8 * 256;
    bf16_t* XCp = (bf16_t*)(F.ws + WS_XCM) + (size_t)(F.tid >> 7) * LT * 512 + (F.tid & 127) * 4;
    const bf16_t* XMp = XCp + (size_t)4 * LT * 512;
    const bf16_t* GWT = (const bf16_t*)(F.ws + WS_GWT) + (size_t)slot * 16 * 4096;
    const int c4 = F.tid * 4;
    float cw[3][4], cb[4];
#pragma unroll
    for (int k = 0; k < 3; ++k) { const f32x4 w = *(const f32x4*)(F.in[I_MCONVW] + ((size_t)slot * 3 + k) * 2048 + c4); cw[k][0] = w[0]; cw[k][1] = w[1]; cw[k][2] = w[2]; cw[k][3] = w[3]; }
    { const f32x4 b = *(const f32x4*)(F.in[I_MCONVB] + (size_t)slot * 2048 + c4); cb[0] = b[0]; cb[1] = b[1]; cb[2] = b[2]; cb[3] = b[3]; }
    const int fr = F.lane & 15, fq = F.lane >> 4;
    bf16x8 gw[16];
#pragma unroll
    for (int kk = 0; kk < 16; ++kk) gw[kk] = *(const bf16x8*)(GWT + (size_t)fr * 4096 + F.wave * 512 + kk * 32 + fq * 8);
    for (int gc = F.bid; gc < NCH; gc += F.G) {
        const int seq_lo = gc < 4 ? 0 : CTXN, seq_hi = gc < 4 ? CTXN : LT;
        for (int sub = 0; sub < 4; ++sub) {
            const int r0 = gc * 64 + sub * 16;
            u32x2 xr[18];
#pragma unroll
            for (int i = 0; i < 18; ++i) { const int rr = r0 - 1 + i; xr[i] = (rr >= seq_lo && rr < seq_hi) ? *(const u32x2*)(XMp + (size_t)rr * 512) : (u32x2){0u, 0u}; }
#pragma unroll
            for (int rl = 0; rl < 16; ++rl) {
                const int row = r0 + rl; const u32x2 prv = xr[rl], cur = xr[rl + 1], nxt = xr[rl + 2];
                const float p[4] = {bflo(prv.x), bfhi(prv.x), bflo(prv.y), bfhi(prv.y)}, c[4] = {bflo(cur.x), bfhi(cur.x), bflo(cur.y), bfhi(cur.y)}, n[4] = {bflo(nxt.x), bfhi(nxt.x), bflo(nxt.y), bfhi(nxt.y)};
                float o[4];
#pragma unroll
                for (int e = 0; e < 4; ++e) o[e] = siluf(cb[e] + cw[0][e] * p[e] + cw[1][e] * c[e] + cw[2][e] * n[e]);
                u32x2 w; w.x = pk2(o[0], o[1]); w.y = pk2(o[2], o[3]);
                *(u32x2*)(XCp + (size_t)row * 512) = w;
                *(LAS u32x2*)(tile + rl * TP + c4) = w;
                *(LAS u32x2*)(tile + rl * TP + 2048 + c4) = cur;
            }
            LDS_BAR();
            {
                f32x4 acc = {0.f, 0.f, 0.f, 0.f};
#pragma unroll
                for (int kk = 0; kk < 16; ++kk) { const int k0 = F.wave * 512 + kk * 32 + fq * 8;
                    const bf16x8 a = *(const LAS bf16x8*)(tile + fr * TP + k0);
                    acc = __builtin_amdgcn_mfma_f32_16x16x32_bf16(a, gw[kk], acc, 0, 0, 0); }
#pragma unroll
                for (int r = 0; r < 4; ++r) part[F.wave * 256 + (fq * 4 + r) * 16 + fr] = acc[r];
            }
            LDS_BAR();
            if (F.tid < 256) { float a = F.in[I_MGATEB][slot * 16 + (F.tid & 15)];
#pragma unroll
                for (int w = 0; w < 8; ++w) a += part[w * 256 + F.tid];
                gl[(sub * 16 + (F.tid >> 4)) * 16 + (F.tid & 15)] = a; }
        }
        LDS_BAR();
        {
            const int ch = F.wave, dir = ch >> 2, h = ch & 3, j = F.lane, rl = dir ? 63 - j : j, row = gc * 64 + rl;
            const float ig = gl[rl * 16 + (2 * dir) * 4 + h], lf = logsigf(gl[rl * 16 + (2 * dir + 1) * 4 + h]);
            float b = lf;
#pragma unroll
            for (int o = 1; o < 64; o <<= 1) { const float t = __shfl_up(b, o); if (j >= o) b += t; }
            const float cq = ig - b; float pm = cq;
#pragma unroll
            for (int o = 1; o < 64; o <<= 1) { const float t = __shfl_up(pm, o); if (j >= o) pm = fmaxf(pm, t); }
            const float bl = __shfl(b, 63), gq = bl - b + ig, gm = wave_max(gq);
            scal_arr(F, 0, ch)[row] = b; scal_arr(F, 1, ch)[row] = b + pm; scal_arr(F, 2, ch)[row] = gq; scal_arr(F, 3, ch)[row] = cq;
            if (j == 0) { chs_arr(F, 0, ch)[gc] = bl; chs_arr(F, 1, ch)[gc] = gm; }
            const float wp = __expf(gq - gm);
            ((float*)(F.ws + WS_WGP))[(size_t)ch * LT + row] = wp;
            bf16_t* vx = (bf16_t*)(F.ws + WS_VTS) + (((((size_t)ch * NCH + gc) * 33 + 32) * 2 + (rl >> 5)) * 64 + 16 * ((rl & 31) >> 3)) * 8 + (rl & 7);
            vx[0] = f2bf(wp);
#pragma unroll
            for (int z = 1; z < 16; ++z) vx[z * 8] = 0;
        }
        LDS_BAR();
    }
}

__device__ __forceinline__ void mlstm_qkv(const Frame& F, int slot) {
    MultiSched<4> S; Prob pr[4];
    const char* WQ = (const char*)(F.ws + WS_WQ) + (size_t)slot * 4 * 256 * 512 * 2;
    const char* WK = (const char*)(F.ws + WS_WK) + (size_t)slot * 4 * 256 * 512 * 2;
    const char* WV = (const char*)(F.ws + WS_WV) + (size_t)slot * 4 * 512 * 512 * 2;
    const char* XC = (const char*)(F.ws + WS_XCM); const char* XM = XC + (size_t)4 * LT * 512 * 2; const long long HS = (long long)LT * 512 * 2;
    pr[0] = Prob{XC, WQ, (char*)(F.ws + WS_Q),  HS, 256 * 512 * 2, (long long)LT * 256 * 2, 65, 1, 4, 0,    512, 512,  0, 0};
    pr[1] = Prob{XC, WK, (char*)(F.ws + WS_KN), HS, 256 * 512 * 2, (long long)LT * 256 * 2, 65, 1, 4, 260,  512, 512,  0, 0};
    pr[2] = Prob{WK, XC, (char*)(F.ws + WS_KT), 256 * 512 * 2, HS, (long long)256 * LT * 2, 1, 65, 4, 520,  512,  512, 0,  0};
    pr[3] = Prob{WV, XM, (char*)(F.ws + WS_VT), 512 * 512 * 2, HS, (long long)512 * LT * 2, 2, 65, 4, 780, 512, 512, 0, 0};
    S.init(F, pr, 780 + 520);
    EpiStore E{nullptr, (const float*)(F.ws + WS_WGP), (bf16_t*)(F.ws + WS_VTS), 1};
    pg8::gemm_phase<EpiStore, MultiSched<4>, false>(F.lds, 512, S, E, F.tid);
}

constexpr int SCAN_NV = 4;
struct ScanBufR { bf16x8 q[8]; bf16x8 v[2]; float bq[4], aq[4]; float bl, gm; };
struct ScanBufU { bf16x8 k[8]; float bl, gm; };
__device__ __forceinline__ int scan_chunk(int dir, int st) { return dir == 0 ? st : (st < 4 ? 3 - st : 263 - st); }
#define SCAN_BAR() do { asm volatile("s_waitcnt lgkmcnt(0)" ::: "memory"); __builtin_amdgcn_s_barrier(); asm volatile("" ::: "memory"); } while (0)

template <bool DEN> __device__ __forceinline__ void scan_job(const Frame& F, const int ch, const int sl) {
    constexpr int CP = 256 + 16, NV = SCAN_NV;
    LAS bf16_t* Cs = (LAS bf16_t*)F.lds;
    LAS bf16x8* VS = (LAS bf16x8*)(F.lds + 2 * NV * 16 * CP * 2);
    const bf16_t* Q = (const bf16_t*)(F.ws + WS_Q); const bf16_t* KT = (const bf16_t*)(F.ws + WS_KT); const bf16_t* VTS = (const bf16_t*)(F.ws + WS_VTS);
    const int w = F.wave;
    {
        const int dir = ch >> 2, h = ch & 3; constexpr bool denjob = DEN; constexpr int ntile = DEN ? 1 : NV;
        const float* BL = chs_arr(F, 0, ch); const float* GM = chs_arr(F, 1, ch);
        __syncthreads();
        for (int i = F.tid; i < 2 * NV * 16 * CP / 2; i += NT) ((LAS unsigned*)Cs)[i] = 0u;
        float m = 0.f;
        if (w < 4) {
            const float* BQ = scal_arr(F, 0, ch); const float* AQ = scal_arr(F, 1, ch); float* MS = chs_arr(F, 2, ch);
            const int fr = F.lane & 15, fq = F.lane >> 4;
            const __amdgpu_buffer_rsrc_t rsQ = __builtin_amdgcn_make_buffer_rsrc((void*)(Q + (size_t)h * LT * 256), 0, LT * 256 * 2, 0x00020000);
            const __amdgpu_buffer_rsrc_t rsV = __builtin_amdgcn_make_buffer_rsrc((void*)(VTS + (size_t)ch * NCH * 33 * 1024), 0, NCH * 33 * 1024 * 2, 0x00020000);
            const unsigned loQ = (unsigned)F.lane * 16u + (unsigned)w * 8192u, loV = (unsigned)F.lane * 16u + (unsigned)(denjob ? 32 : sl * NV + w) * 2048u, loS = (unsigned)(16 * w + fq * 4) * 4u;
            char* ubO = (char*)(F.ws + WS_OINT) + ((((size_t)ch * NCH) * 32 + sl * NV) * 4 + w) * 512;
            {
                const unsigned g0 = (unsigned)scan_chunk(dir, 0);
#pragma unroll
                for (int kk = 0; kk < 2; ++kk) VS[((0 * NV + w) * 2 + kk) * 64 + F.lane] = bload16(rsV, loV, g0 * (33u * 2048u) + kk * 1024u);
            }
            __syncthreads();
            ScanBufR sb[3];
#define SCAN_LOAD_R(B, st_) do { const unsigned gc_ = (unsigned)scan_chunk(dir, st_), gn_ = (unsigned)scan_chunk(dir, ((st_) + 1 < NCH) ? (st_) + 1 : (st_)); sb[B].bl = BL[gc_]; sb[B].gm = GM[gc_]; \
            _Pragma("unroll") for (int i = 0; i < 8; ++i) sb[B].q[i] = bload16(rsQ, loQ, gc_ * 32768u + i * 1024u); \
            _Pragma("unroll") for (int kk = 0; kk < 2; ++kk) sb[B].v[kk] = bload16(rsV, loV, gn_ * (33u * 2048u) + kk * 1024u); \
            { const f32x4 a0_ = *(const f32x4*)((const char*)BQ + (size_t)gc_ * 256 + loS), a1_ = *(const f32x4*)((const char*)AQ + (size_t)gc_ * 256 + loS); \
              _Pragma("unroll") for (int e = 0; e < 4; ++e) { sb[B].bq[e] = a0_[e]; sb[B].aq[e] = a1_[e]; } } } while (0)
#define SCAN_LPART_R(LB, lst_, part) do { { const int lc_ = ((lst_) < NCH) ? (lst_) : NCH - 1;     \
            const unsigned gc2_ = (unsigned)scan_chunk(dir, lc_), gn2_ = (unsigned)scan_chunk(dir, (lc_ + 1 < NCH) ? lc_ + 1 : lc_); \
            __builtin_amdgcn_sched_barrier(0x38F); \
            sb[LB].q[2 * (part)] = bload16(rsQ, loQ, gc2_ * 32768u + (2 * (part)) * 1024u); sb[LB].q[2 * (part) + 1] = bload16(rsQ, loQ, gc2_ * 32768u + (2 * (part) + 1) * 1024u); \
            if ((part) == 0) { sb[LB].bl = BL[gc2_]; sb[LB].gm = GM[gc2_]; } \
            if ((part) == 1) { const f32x4 a0_ = *(const f32x4*)((const char*)BQ + (size_t)gc2_ * 256 + loS), a1_ = *(const f32x4*)((const char*)AQ + (size_t)gc2_ * 256 + loS); \
                _Pragma("unroll") for (int e = 0; e < 4; ++e) { sb[LB].bq[e] = a0_[e]; sb[LB].aq[e] = a1_[e]; } } \
            if ((part) >= 2) sb[LB].v[(part) - 2] = bload16(rsV, loV, gn2_ * (33u * 2048u) + ((part) - 2) * 1024u); \
            __builtin_amdgcn_sched_barrier(0); } } while (0)
#define SCAN_STEP_R(B, st_, CB, LB, lst_) do { const int gc_ = scan_chunk(dir, st_), row0_ = gc_ * 64; constexpr int cb_ = CB; \
            int ln_ = F.lane; asm volatile("" : "+v"(ln_)); const int fr_ = ln_ & 15, fq_ = ln_ >> 4;     \
            const float mn_ = fmaxf(sb[B].bl + m, sb[B].gm); \
            if (sl == 0 && w == 0 && ln_ == 0) MS[gc_] = m; \
            _Pragma("unroll") for (int kk = 0; kk < 2; ++kk) VS[(((cb_ ^ 1) * NV + w) * 2 + kk) * 64 + ln_] = sb[B].v[kk]; \
            float wj_[4]; _Pragma("unroll") for (int r = 0; r < 4; ++r) { const float in_ = sb[B].bq[r] + m, mj_ = fmaxf(in_, sb[B].aq[r]); wj_[r] = __expf(in_ - mj_); } \
            _Pragma("unroll") for (int t = 0; t < NV; ++t) { if (t < ntile) { f32x4 o_ = {0.f, 0.f, 0.f, 0.f}; \
                _Pragma("unroll") for (int kk = 0; kk < 8; ++kk) { const bf16x8 b_ = *(const LAS bf16x8*)(Cs + ((cb_ * NV + t) * 16 + fr_) * CP + kk * 32 + fq_ * 8); o_ = __builtin_amdgcn_mfma_f32_16x16x32_bf16(sb[B].q[kk], b_, o_, 0, 0, 0); } \
                if (!denjob) { u32x2 pw_; pw_.x = pk2(o_[0] * wj_[0], o_[1] * wj_[1]); pw_.y = pk2(o_[2] * wj_[2], o_[3] * wj_[3]); \
                    *(u32x2*)(ubO + ((size_t)gc_ * 32 + t) * 2048 + (unsigned)ln_ * 8u) = pw_; } \
                else if (fr_ == 0) { float* dn_ = (float*)(F.ws + WS_DENI) + (size_t)ch * LT + row0_ + 16 * w + fq_ * 4; \
                    _Pragma("unroll") for (int r = 0; r < 4; ++r) dn_[r] = o_[r] * wj_[r]; } } \
                SCAN_LPART_R(LB, lst_, t); }     \
            m = mn_; SCAN_BAR(); } while (0)
            SCAN_LOAD_R(0, 0); SCAN_LOAD_R(1, 1);
            static_assert((NCH - 2) % 6 == 0, "two peeled steps + whole groups of six (3 register buffers x 2 LDS state buffers): no guards inside the loop");
            SCAN_STEP_R(0, 0, 0, 2, 2);
            SCAN_STEP_R(1, 1, 1, 0, 3);
            for (int st = 2; st < NCH; st += 6) {
                SCAN_STEP_R(2, st, 0, 1, st + 2);
                SCAN_STEP_R(0, st + 1, 1, 2, st + 3);
                SCAN_STEP_R(1, st + 2, 0, 0, st + 4);
                SCAN_STEP_R(2, st + 3, 1, 1, st + 5);
                SCAN_STEP_R(0, st + 4, 0, 2, st + 6);
                SCAN_STEP_R(1, st + 5, 1, 0, st + 7);
            }
#undef SCAN_LPART_R
#undef SCAN_LOAD_R
#undef SCAN_STEP_R
        } else {
            const int u = w - 4; const int fr = F.lane & 15, fq = F.lane >> 4;
            const __amdgpu_buffer_rsrc_t rsK = __builtin_amdgcn_make_buffer_rsrc((void*)(KT + (size_t)h * 256 * LT), 0, 256 * LT * 2, 0x00020000);
            const unsigned loK = (unsigned)F.lane * 16u + (unsigned)u * 8192u;
            f32x4 acc[NV][4];
#pragma unroll
            for (int t = 0; t < NV; ++t)
#pragma unroll
                for (int d = 0; d < 4; ++d) acc[t][d] = (f32x4){0.f, 0.f, 0.f, 0.f};
            __syncthreads();
            ScanBufU sb[3];
#define SCAN_LOAD_U(B, st_) do { const unsigned gc_ = (unsigned)scan_chunk(dir, st_); sb[B].bl = BL[gc_]; sb[B].gm = GM[gc_]; \
            _Pragma("unroll") for (int i = 0; i < 8; ++i) sb[B].k[i] = bload16(rsK, loK, gc_ * 32768u + (unsigned)i * 1024u); } while (0)
#define SCAN_LPART_U(LB, lst_, part) do { { const unsigned gc2_ = (unsigned)scan_chunk(dir, ((lst_) < NCH) ? (lst_) : NCH - 1); \
            __builtin_amdgcn_sched_barrier(0x38F); \
            sb[LB].k[2 * (part)] = bload16(rsK, loK, gc2_ * 32768u + (unsigned)(2 * (part)) * 1024u); sb[LB].k[2 * (part) + 1] = bload16(rsK, loK, gc2_ * 32768u + (unsigned)(2 * (part) + 1) * 1024u); \
            if ((part) == 0) { sb[LB].bl = BL[gc2_]; sb[LB].gm = GM[gc2_]; } \
            __builtin_amdgcn_sched_barrier(0); } } while (0)
#define SCAN_STEP_U(B, st_, CB, LB, lst_) do { constexpr int cb_ = CB; \
            int ln_ = F.lane; asm volatile("" : "+v"(ln_)); const int fr_ = ln_ & 15, fq_ = ln_ >> 4; \
            const float bl_ = sb[B].bl, gm_ = sb[B].gm; const float mn_ = fmaxf(bl_ + m, gm_), dec_ = __expf(bl_ + m - mn_), sf_ = __expf(gm_ - mn_); \
            _Pragma("unroll") for (int t = 0; t < NV; ++t) { if (t < ntile) { \
                const bf16x8 v0_ = VS[((cb_ * NV + t) * 2 + 0) * 64 + ln_], v1_ = VS[((cb_ * NV + t) * 2 + 1) * 64 + ln_]; \
                _Pragma("unroll") for (int d = 0; d < 4; ++d) { f32x4 n_ = {0.f, 0.f, 0.f, 0.f}; \
                    n_ = __builtin_amdgcn_mfma_f32_16x16x32_bf16(sb[B].k[2 * d], v0_, n_, 0, 0, 0); n_ = __builtin_amdgcn_mfma_f32_16x16x32_bf16(sb[B].k[2 * d + 1], v1_, n_, 0, 0, 0); \
                    const f32x4 a_ = acc[t][d] * dec_ + n_ * sf_; acc[t][d] = a_; \
                    u32x2 pw_; pw_.x = pk2(a_[0], a_[1]); pw_.y = pk2(a_[2], a_[3]); \
                    *(LAS u32x2*)(Cs + (((cb_ ^ 1) * NV + t) * 16 + fr_) * CP + 16 * (4 * u + d) + fq_ * 4) = pw_; } } \
                SCAN_LPART_U(LB, lst_, t); } \
            m = mn_; SCAN_BAR(); } while (0)
            SCAN_LOAD_U(0, 0); SCAN_LOAD_U(1, 1);
            SCAN_STEP_U(0, 0, 0, 2, 2);
            SCAN_STEP_U(1, 1, 1, 0, 3);
            for (int st = 2; st < NCH; st += 6) {
                SCAN_STEP_U(2, st, 0, 1, st + 2);
                SCAN_STEP_U(0, st + 1, 1, 2, st + 3);
                SCAN_STEP_U(1, st + 2, 0, 0, st + 4);
                SCAN_STEP_U(2, st + 3, 1, 1, st + 5);
                SCAN_STEP_U(0, st + 4, 0, 2, st + 6);
                SCAN_STEP_U(1, st + 5, 1, 0, st + 7);
            }
#undef SCAN_LPART_U
#undef SCAN_LOAD_U
#undef SCAN_STEP_U
        }
    }
}

__device__ __forceinline__ void mlstm_scan(const Frame& F, int cvt_part) {
    constexpr int CP = 256 + 16, NV = SCAN_NV, NSL = 32 / NV;
    static_assert(NV == 4, "one reader wave per v-tile");
    LAS bf16_t* Cs = (LAS bf16_t*)F.lds;
    LAS bf16x8* VS = (LAS bf16x8*)(F.lds + 2 * NV * 16 * CP * 2);
    const bf16_t* Q = (const bf16_t*)(F.ws + WS_Q); const bf16_t* KT = (const bf16_t*)(F.ws + WS_KT); const bf16_t* VTS = (const bf16_t*)(F.ws + WS_VTS);
    const int w = F.wave;
    const int job = F.bid;
    if (job >= 8 * (NSL + 1)) { deferred_convert(F, cvt_part, job - 8 * (NSL + 1), F.G - 8 * (NSL + 1)); hyena_filter_fft(F, job - 8 * (NSL + 1), F.G - 8 * (NSL + 1)); return; }
    { const int ch = job & 7, sl = job >> 3;
      if (sl == NSL) scan_job<true>(F, ch, sl); else scan_job<false>(F, ch, sl); }
}

__device__ __forceinline__ void mlstm_intra(const Frame& F, int slot, int gc_lo) {
    constexpr int SP = 64 + 8;
    LAS float* sc = (LAS float*)F.lds;
    LAS bf16_t* Sb = (LAS bf16_t*)(F.lds + 2 * 6 * 64 * 4);
    LAS float* stt = (LAS float*)(F.lds + 2 * 6 * 64 * 4 + 2 * 64 * SP * 2);
    LAS float* mr = stt + 64 * 8 * 2;
    constexpr int HP = 512 + 8;
    LAS bf16_t* Hs = (LAS bf16_t*)(mr + 128);
    const bf16_t* Q = (const bf16_t*)(F.ws + WS_Q); const bf16_t* KN = (const bf16_t*)(F.ws + WS_KN); const bf16_t* VT = (const bf16_t*)(F.ws + WS_VT);
    const bf16_t* XCM = (const bf16_t*)(F.ws + WS_XCM); const bf16_t* OPRE = (const bf16_t*)(F.ws + WS_OPRE); bf16_t* Y = (bf16_t*)(F.ws + WS_Y);
    const float* NG = F.in[I_MNORMG] + (size_t)slot * 2048; const float* SK = F.in[I_MSKIP] + (size_t)slot * 2048;
    const int w = F.wave;
    const int nunit = (NCH - gc_lo) * 4;
    for (int un = F.bid; un < nunit; un += F.G) {
        int ln_ = F.lane; asm volatile("" : "+v"(ln_)); const int fr = ln_ & 15, fq = ln_ >> 4;
        const int tid_ = w * 64 + ln_;
        const int gc = gc_lo + un / 4, h = un & 3, row0 = gc * 64;
        LDS_BAR();
        if (tid_ < 128) { const int dir = tid_ >> 6, i = tid_ & 63, ch = dir * 4 + h, row = row0 + i;
            const float bq = scal_arr(F, 0, ch)[row], aq = scal_arr(F, 1, ch)[row], cq = scal_arr(F, 3, ch)[row], m0 = chs_arr(F, 2, ch)[gc];
            const float mj = fmaxf(bq + m0, aq);
            LAS float* s = sc + dir * 6 * 64;
            s[i] = bq; s[64 + i] = cq; s[128 + i] = mj; s[192 + i] = __expf(-mj); s[256 + i] = ((const float*)(F.ws + WS_DENI))[(size_t)ch * LT + row]; }
        const int it = w >> 1, st0 = (w & 1) * 2;
        f32x4 sa[2] = {{0.f, 0.f, 0.f, 0.f}, {0.f, 0.f, 0.f, 0.f}};
        {
            const __amdgpu_buffer_rsrc_t rsQi = __builtin_amdgcn_make_buffer_rsrc((void*)(Q + ((size_t)h * 1040 + gc * 4) * 4096), 0, 4 * 4096 * 2, 0x00020000);
            const __amdgpu_buffer_rsrc_t rsKi = __builtin_amdgcn_make_buffer_rsrc((void*)(KN + ((size_t)h * 1040 + gc * 4) * 4096), 0, 4 * 4096 * 2, 0x00020000);
            const unsigned lo = (unsigned)ln_ * 16u;
#pragma unroll
            for (int kk = 0; kk < 8; ++kk) { const bf16x8 a = bload16(rsQi, lo, (unsigned)((it * 8 + kk) * 1024)), b0 = bload16(rsKi, lo, (unsigned)((st0 * 8 + kk) * 1024)), b1 = bload16(rsKi, lo, (unsigned)(((st0 + 1) * 8 + kk) * 1024));
                sa[0] = __builtin_amdgcn_mfma_f32_16x16x32_bf16(a, b0, sa[0], 0, 0, 0); sa[1] = __builtin_amdgcn_mfma_f32_16x16x32_bf16(a, b1, sa[1], 0, 0, 0); }
        }
        LDS_BAR();
#pragma unroll
        for (int t = 0; t < 2; ++t) { const int s = 16 * (st0 + t) + fr;
#pragma unroll
            for (int r = 0; r < 4; ++r) { const int i = 16 * it + fq * 4 + r;
                const float wf = (s <= i) ? __expf(sc[i] + sc[64 + s] - sc[128 + i]) : 0.f;
                const float wb = (s >= i) ? __expf(sc[384 + i] + sc[384 + 64 + s] - sc[384 + 128 + i]) : 0.f;
                Sb[(0 * 64 + i) * SP + s] = f2bf(sa[t][r] * wf); Sb[(1 * 64 + i) * SP + s] = f2bf(sa[t][r] * wb); } }
        LDS_BAR();
        if (tid_ < 128) { const int dir = tid_ >> 6, i = tid_ & 63; float a = 0.f;
            for (int s = 0; s < 64; ++s) a += bf2f(Sb[(dir * 64 + i) * SP + s]);
            sc[dir * 384 + 320 + i] = a; }
        const __amdgpu_buffer_rsrc_t rsO0 = __builtin_amdgcn_make_buffer_rsrc((void*)(F.ws + WS_OINT + ((size_t)h * NCH + gc) * 65536), 0, 65536, 0x00020000);
        const __amdgpu_buffer_rsrc_t rsO1 = __builtin_amdgcn_make_buffer_rsrc((void*)(F.ws + WS_OINT + ((size_t)(4 + h) * NCH + gc) * 65536), 0, 65536, 0x00020000);
        const __amdgpu_buffer_rsrc_t rsVT = __builtin_amdgcn_make_buffer_rsrc((void*)(VT + ((size_t)h * NCH + gc) * 512 * 64), 0, 512 * 64 * 2, 0x00020000);
        f32x4 oa[2][4][4];
#pragma unroll
        for (int d = 0; d < 2; ++d)
#pragma unroll
            for (int a = 0; a < 4; ++a)
#pragma unroll
                for (int b = 0; b < 4; ++b) oa[d][a][b] = (f32x4){0.f, 0.f, 0.f, 0.f};
        {
#pragma unroll
            for (int kk = 0; kk < 2; ++kk) {
                bf16x8 vb[4];
#pragma unroll
                for (int vt = 0; vt < 4; ++vt) vb[vt] = bload16(rsVT, (unsigned)ln_ * 16u, (unsigned)(((4 * w + vt) * 2 + kk) * 1024));
#pragma unroll
                for (int d = 0; d < 2; ++d)
#pragma unroll
                    for (int a = 0; a < 4; ++a) { const bf16x8 sf = *(const LAS bf16x8*)(Sb + (d * 64 + 16 * a + fr) * SP + kk * 32 + fq * 8);
#pragma unroll
                        for (int vt = 0; vt < 4; ++vt) oa[d][a][vt] = __builtin_amdgcn_mfma_f32_16x16x32_bf16(sf, vb[vt], oa[d][a][vt], 0, 0, 0); }
            }
        }
        LDS_BAR();
        u32x2 oi[2][2][4];
#define OI_LOAD(buf, a_) do { _Pragma("unroll") for (int vt = 0; vt < 4; ++vt) { \
            oi[buf][0][vt] = __builtin_bit_cast(u32x2, __builtin_amdgcn_raw_buffer_load_b64(rsO0, (unsigned)ln_ * 8u, (unsigned)(((4 * w + vt) * 4 + (a_)) * 512), 0)); \
            oi[buf][1][vt] = __builtin_bit_cast(u32x2, __builtin_amdgcn_raw_buffer_load_b64(rsO1, (unsigned)ln_ * 8u, (unsigned)(((4 * w + vt) * 4 + (a_)) * 512), 0)); } } while (0)
        OI_LOAD(0, 0);
#pragma unroll
        for (int a = 0; a < 4; ++a) {
            if (a < 3) OI_LOAD((a + 1) & 1, a + 1);
            float den[2][4], emj[2][4];
#pragma unroll
            for (int d = 0; d < 2; ++d)
#pragma unroll
                for (int r = 0; r < 4; ++r) { const int i = 16 * a + fq * 4 + r; emj[d][r] = sc[d * 384 + 192 + i]; den[d][r] = __builtin_amdgcn_rcpf(fmaxf(fabsf(sc[d * 384 + 320 + i] + sc[d * 384 + 256 + i]), emj[d][r])); }
            float s1[4] = {0.f, 0.f, 0.f, 0.f}, s2[4] = {0.f, 0.f, 0.f, 0.f};
#pragma unroll
            for (int vt = 0; vt < 4; ++vt) {
                const u32x2 o0 = oi[a & 1][0][vt], o1 = oi[a & 1][1][vt];
                const float i0[4] = {bflo(o0.x), bfhi(o0.x), bflo(o0.y), bfhi(o0.y)}, i1[4] = {bflo(o1.x), bfhi(o1.x), bflo(o1.y), bfhi(o1.y)};
#pragma unroll
                for (int r = 0; r < 4; ++r) { const float hf = (oa[0][a][vt][r] + i0[r]) * den[0][r], hb = (oa[1][a][vt][r] + i1[r]) * den[1][r];
                    const float hs = hf + hb; s1[r] += hs; s2[r] += hs * hs; Hs[(16 * a + fq * 4 + r) * HP + 64 * w + 16 * vt + fr] = f2bf(hs); }
            }
#pragma unroll
            for (int r = 0; r < 4; ++r) {
#pragma unroll
                for (int o = 1; o < 16; o <<= 1) { s1[r] += __shfl_xor(s1[r], o); s2[r] += __shfl_xor(s2[r], o); }
                if (fr == 0) { const int i = 16 * a + fq * 4 + r; stt[(i * 8 + w) * 2] = s1[r]; stt[(i * 8 + w) * 2 + 1] = s2[r]; } }
            __builtin_amdgcn_sched_barrier(0);
        }
#undef OI_LOAD
        LDS_BAR();
        if (tid_ < 64) { float a = 0.f, b = 0.f;
#pragma unroll
            for (int ww = 0; ww < 8; ++ww) { a += stt[(tid_ * 8 + ww) * 2]; b += stt[(tid_ * 8 + ww) * 2 + 1]; }
            const float mu = a * (1.0f / 512.0f), var = fmaxf(b * (1.0f / 512.0f) - mu * mu, 0.f);
            mr[tid_ * 2] = mu; mr[tid_ * 2 + 1] = rsqrtf(var + EPS); }
        LDS_BAR();
        {
            const int i = tid_ >> 3; const float mu = mr[i * 2], rs = mr[i * 2 + 1]; const size_t row = (size_t)(row0 + i);
#pragma unroll 2
            for (int q = 0; q < 8; ++q) { const int v8 = (tid_ & 7) * 8 + 64 * q, c = h * 512 + v8;
                const u32x4 hv = *(const LAS u32x4*)(Hs + i * HP + v8), xv = *(const u32x4*)(XCM + ((size_t)h * LT + row) * 512 + v8), ov = *(const u32x4*)(OPRE + row * 2048 + c);
                const f32x4 g0 = *(const f32x4*)(NG + c), g1 = *(const f32x4*)(NG + c + 4), k0 = *(const f32x4*)(SK + c), k1 = *(const f32x4*)(SK + c + 4);
                float o[8];
#pragma unroll
                for (int e = 0; e < 8; ++e) { const unsigned hw = hv[e >> 1], xw = xv[e >> 1], ow = ov[e >> 1];
                    const float hh = (e & 1) ? bfhi(hw) : bflo(hw), xc = (e & 1) ? bfhi(xw) : bflo(xw), op = (e & 1) ? bfhi(ow) : bflo(ow);
                    const float ng = e < 4 ? g0[e & 3] : g1[e & 3], sk = e < 4 ? k0[e & 3] : k1[e & 3];
                    o[e] = ((hh - mu) * rs * ng + sk * xc) * sigmf(op); }
                u32x4 wv; wv.x = pk2(o[0], o[1]); wv.y = pk2(o[2], o[3]); wv.z = pk2(o[4], o[5]); wv.w = pk2(o[6], o[7]);
                *(u32x4*)(Y + row * 2048 + c) = wv; }
        }
    }
}

struct EpiResid {
    static constexpr bool PERM = false;
    bf16_t* HL; bf16_t* HC; const float* g_lat; const float* g_ctx; const float* bias; int rowbase; bool colmajor;
    __device__ __forceinline__ void operator()(const f32x4 (&acc)[2][2][4][2], const GUnit& u, int wr, int wc, int fr, int fq) const {
        const int col0 = u.pn * 256 + wc * 32 + 4 * fq;
        const bool isctx = (rowbase + u.pm * 256) < CTXN;
        const float* g = isctx ? g_ctx : g_lat;
        f32x4 gv[2][2], bv[2][2];
#pragma unroll
        for (int bj = 0; bj < 2; ++bj)
#pragma unroll
            for (int n = 0; n < 2; ++n) { gv[bj][n] = *(const f32x4*)(g + col0 + bj * 128 + n * 16); bv[bj][n] = bias ? *(const f32x4*)(bias + col0 + bj * 128 + n * 16) : (f32x4){0.f, 0.f, 0.f, 0.f}; }
#pragma unroll
        for (int ai = 0; ai < 2; ++ai)
#pragma unroll
            for (int m = 0; m < 4; ++m) { const int R = rowbase + u.pm * 256 + ai * 128 + wr * 64 + m * 16 + fr;
                bf16_t* rowp = isctx ? HC + (size_t)R * 1024 : HL + (size_t)scan_inv(R - CTXN, colmajor) * 1024;
#pragma unroll
                for (int bj = 0; bj < 2; ++bj)
#pragma unroll
                    for (int n = 0; n < 2; ++n) { bf16_t* p = rowp + col0 + bj * 128 + n * 16; const u32x2 hb = *(const u32x2*)p; const f32x4 o = (f32x4){bflo(hb.x), bfhi(hb.x), bflo(hb.y), bfhi(hb.y)} + gv[bj][n] * (acc[ai][bj][m][n] + bv[bj][n]);
                        u32x2 hw; hw.x = pk2(o[0], o[1]); hw.y = pk2(o[2], o[3]); *(u32x2*)p = hw; } }
    }
};

template <int K> __device__ __forceinline__ void ctx_panel(const Frame& F, const bf16_t* A, const bf16_t* W, const float* bias, const float* g, bf16_t* HC) {
    LAS float* red = (LAS float*)F.lds;
    constexpr int KW = K / 8;
    for (int u = F.bid; u < 256; u += F.G) {
        int ln_ = F.lane; asm volatile("" : "+v"(ln_)); const int fr = ln_ & 15, fq = ln_ >> 4;
        const int rt = u >> 4, cb = u & 15;
        LDS_BAR();
        const bf16_t* ap = A + (size_t)(rt * 16 + fr) * K + F.wave * KW + fq * 8;
        const bf16_t* wp = W + (size_t)(cb * 64 + fr) * K + F.wave * KW + fq * 8;
        f32x4 acc[4] = {{0.f, 0.f, 0.f, 0.f}, {0.f, 0.f, 0.f, 0.f}, {0.f, 0.f, 0.f, 0.f}, {0.f, 0.f, 0.f, 0.f}};
#pragma unroll 4
        for (int ks = 0; ks < KW / 32; ++ks) { const bf16x8 a = *(const bf16x8*)(ap + ks * 32);
#pragma unroll
            for (int nt = 0; nt < 4; ++nt) { const bf16x8 b = *(const bf16x8*)(wp + (size_t)nt * 16 * K + ks * 32); acc[nt] = __builtin_amdgcn_mfma_f32_16x16x32_bf16(a, b, acc[nt], 0, 0, 0); } }
#pragma unroll
        for (int nt = 0; nt < 4; ++nt)
#pragma unroll
            for (int r = 0; r < 4; ++r) red[(F.wave * 16 + fq * 4 + r) * 64 + nt * 16 + fr] = acc[nt][r];
        LDS_BAR();
        { const int tid_ = F.wave * 64 + ln_, row = tid_ >> 5, c = (tid_ & 31) * 2, col = cb * 64 + c;
          float s0 = bias ? bias[col] : 0.f, s1 = bias ? bias[col + 1] : 0.f;
#pragma unroll
          for (int w = 0; w < 8; ++w) { const f32x2 v = *(const LAS f32x2*)(red + (w * 16 + row) * 64 + c); s0 += v.x; s1 += v.y; }
          unsigned* hp = (unsigned*)(HC + (size_t)(rt * 16 + row) * 1024 + col); const unsigned hb = *hp;
          *hp = pk2(bflo(hb) + g[col] * s0, bfhi(hb) + g[col + 1] * s1); }
    }
}

__device__ __forceinline__ void mlstm_outproj(const Frame& F, int l, int slot, bool with_ctx, bool colmajor) {
    MultiSched<1> S; Prob pr[1];
    const int rowbase = CTXN, nM = 64;
    pr[0] = Prob{(const char*)(F.ws + WS_Y) + (size_t)rowbase * 2048 * 2, (const char*)(F.ws + WS_WMOUT) + (size_t)slot * 1024 * 2048 * 2, nullptr, 0, 0, 0, nM, 4, 1, 0, 2048, 2048, 0, 0};
    S.init(F, pr, nM * 4);
    EpiResid E{(bf16_t*)(F.ws + WS_HL), (bf16_t*)(F.ws + WS_HC), modp(F, l, 0, 2), modp(F, l, 1, 2), nullptr, rowbase, colmajor};
    pg8::gemm_phase<EpiResid, MultiSched<1>, false>(F.lds, 2048, S, E, F.tid);
    if (with_ctx) ctx_panel<2048>(F, (const bf16_t*)(F.ws + WS_Y), (const bf16_t*)(F.ws + WS_WMOUT) + (size_t)slot * 1024 * 2048, nullptr, modp(F, l, 1, 2), (bf16_t*)(F.ws + WS_HC));
}
__device__ __forceinline__ void hyena_filtergen(const Frame& F, int slot, bool with_ctx) {
    const bf16_t* Z2 = (const bf16_t*)(F.ws + WS_Z2) + (size_t)slot * SEQ * 64;
    const bf16_t* W3T = (const bf16_t*)(F.ws + WS_W3T) + (size_t)slot * 2048 * 64;
    const float* dec = F.in[I_HDECAY] + (size_t)slot * 2048;
    bf16_t* FILT = (bf16_t*)(F.ws + WS_FILT2);
    const int fr = F.lane & 15, fq = F.lane >> 4;
    for (int gw = F.bid * NWAVES + F.wave; gw < 128 * 16; gw += F.G * NWAVES) {
        const int oct = gw & 127, tg = gw >> 7, oc = oct * 16 + fr;
        bf16x8 b[2];
#pragma unroll
        for (int kk = 0; kk < 2; ++kk) b[kk] = *(const bf16x8*)(W3T + (size_t)oc * 64 + kk * 32 + fq * 8);
        const float dc = dec[oc];
        for (int tt = 0; tt < 64; ++tt) {
            const int t0 = (tg * 64 + tt) * 16;
            f32x4 acc = {0.f, 0.f, 0.f, 0.f};
#pragma unroll
            for (int kk = 0; kk < 2; ++kk) { const bf16x8 a = *(const bf16x8*)(Z2 + (size_t)(t0 + fr) * 64 + kk * 32 + fq * 8); acc = __builtin_amdgcn_mfma_f32_16x16x32_bf16(a, b[kk], acc, 0, 0, 0); }
            float o[4];
#pragma unroll
            for (int r = 0; r < 4; ++r) { const int t = t0 + fq * 4 + r; const float tau = fabsf((float)(t - SEQ / 2)) * (1.0f / (SEQ / 2)); o[r] = acc[r] * __expf(-tau * dc); }
            u32x2 w; w.x = pk2(o[0], o[1]); w.y = pk2(o[2], o[3]);
            *(u32x2*)(FILT + (size_t)oc * SEQ + t0 + fq * 4) = w;
        }
        if (with_ctx) {
            const bf16_t* Z2C = (const bf16_t*)(F.ws + WS_Z2C); float* FC = (float*)(F.ws + WS_FILTC);
            const int t0 = tg * 16;
            f32x4 acc = {0.f, 0.f, 0.f, 0.f};
#pragma unroll
            for (int kk = 0; kk < 2; ++kk) { const bf16x8 a = *(const bf16x8*)(Z2C + (size_t)(t0 + fr) * 64 + kk * 32 + fq * 8); acc = __builtin_amdgcn_mfma_f32_16x16x32_bf16(a, b[kk], acc, 0, 0, 0); }
#pragma unroll
            for (int r = 0; r < 4; ++r) { const int t = t0 + fq * 4 + r; const float tau = fabsf((float)(t - CTXN / 2)) * (1.0f / (CTXN / 2)); FC[(size_t)oc * CTXN + t] = acc[r] * __expf(-tau * dc); }
        }
    }
}

__device__ __forceinline__ void hyena_inproj(const Frame& F, int slot, bool with_ctx) {
    MultiSched<1> S; Prob pr[1];
    const int colbase = with_ctx ? 0 : CTXN, nN = with_ctx ? 65 : 64;
    pr[0] = Prob{(const char*)(F.ws + WS_WHIN) + (size_t)slot * 3072 * 1024 * 2, (const char*)(F.ws + WS_U) + (size_t)colbase * 1024 * 2, (char*)(F.ws + WS_ZT) + (size_t)colbase * 2, 0, 0, 0, 12, nN, 1, 0, 1024, 1024, LT, 2};
    S.init(F, pr, 12 * nN);
    EpiStore E{F.in[I_HINB] + (size_t)slot * 3072, nullptr, nullptr, 0};
    pg8::gemm_phase<EpiStore, MultiSched<1>, false>(F.lds, 1024, S, E, F.tid);
}

__device__ __forceinline__ f32x2 cmul(f32x2 a, f32x2 b) { return (f32x2){a.x * b.x - a.y * b.y, a.x * b.y + a.y * b.x}; }
__device__ __forceinline__ f32x2 cmulc(f32x2 a, f32x2 b) { return (f32x2){a.x * b.x + a.y * b.y, a.y * b.x - a.x * b.y}; }
__device__ __forceinline__ f32x2 cconj(f32x2 a) { return (f32x2){a.x, -a.y}; }
template <int R> __device__ __forceinline__ constexpr int brevR(int x) { int r = 0; for (int b = 1; b < R; b <<= 1) { r = (r << 1) | (x & 1); x >>= 1; } return r; }
template <int R> __device__ __forceinline__ constexpr int log2R() { int l = 0; for (int b = 1; b < R; b <<= 1) ++l; return l; }
template <int R, int HALF_, bool INV> __device__ __forceinline__ void dft_stage(f32x2 (&v)[R]) {
    constexpr float C32[16] = {1.0f, 0.9807852804032304f, 0.9238795325112867f, 0.8314696123025452f, 0.7071067811865476f, 0.5555702330196022f, 0.3826834323650898f, 0.1950903220161283f,
                               0.0f, -0.1950903220161283f, -0.3826834323650898f, -0.5555702330196022f, -0.7071067811865476f, -0.8314696123025452f, -0.9238795325112867f, -0.9807852804032304f};
    constexpr float S32[16] = {0.0f, 0.1950903220161283f, 0.3826834323650898f, 0.5555702330196022f, 0.7071067811865476f, 0.8314696123025452f, 0.9238795325112867f, 0.9807852804032304f,
                               1.0f, 0.9807852804032304f, 0.9238795325112867f, 0.8314696123025452f, 0.7071067811865476f, 0.5555702330196022f, 0.3826834323650898f, 0.1950903220161283f};
#pragma unroll
    for (int blk = 0; blk < R; blk += 2 * HALF_) {
#pragma unroll
        for (int j = 0; j < HALF_; ++j) {
            const f32x2 a = v[blk + j], b = v[blk + j + HALF_];
            v[blk + j] = a + b; const f32x2 d = a - b;
            constexpr int TS = 16 / HALF_;
            const int ti = j * TS;
            if (ti == 0) v[blk + j + HALF_] = d;
            else if (ti == 8) v[blk + j + HALF_] = INV ? (f32x2){-d.y, d.x} : (f32x2){d.y, -d.x};
            else { const f32x2 w = {C32[ti], INV ? S32[ti] : -S32[ti]}; v[blk + j + HALF_] = cmul(d, w); }
        }
    }
    if constexpr (HALF_ > 1) dft_stage<R, HALF_ / 2, INV>(v);
}
template <int R, bool INV> __device__ __forceinline__ void dft_reg(f32x2 (&v)[R]) { dft_stage<R, R / 2, INV>(v); }
__device__ __forceinline__ int fpad(int i) { return i + (i >> 5); }
__device__ __forceinline__ f32x2 unit_root(int num, int den_log2) {
    asm volatile("" : "+v"(num));
    float s, c; sincospif((float)num * (2.0f / (float)(1 << den_log2)), &s, &c); return (f32x2){c, -s};
}
template <bool INV> __device__ __forceinline__ void fft_pass_a(LAS f32x2* buf, int tid) {
#pragma unroll 1
    for (int rr = 0; rr < 2; ++rr) { const int r = tid + rr * 512, pr = fpad(r); f32x2 v[16];
        const f32x2 w1 = unit_root(r, 14);
        if (!INV) {
#pragma unroll
            for (int a = 0; a < 16; ++a) v[a] = buf[pr + a * 1056];
            dft_reg<16, false>(v);
            f32x2 w = w1;
            buf[pr] = v[0];
#pragma unroll
            for (int p = 1; p < 16; ++p) { buf[pr + p * 1056] = cmul(v[brevR<16>(p)], w); w = cmul(w, w1); }
        } else {
            f32x2 w = w1;
            v[0] = buf[pr];
#pragma unroll
            for (int p = 1; p < 16; ++p) { v[p] = cmulc(buf[pr + p * 1056], w); w = cmul(w, w1); }
            dft_reg<16, true>(v);
#pragma unroll
            for (int a = 0; a < 16; ++a) buf[pr + a * 1056] = v[brevR<16>(a)];
        }
    }
}
__device__ __forceinline__ void fft_pass_a_fwd_regs(LAS f32x2* buf, const f32x2 (&z)[16], int tid) {
#pragma unroll
    for (int rr = 0; rr < 2; ++rr) { const int r = tid + rr * 512, pr = fpad(r); f32x2 v[16];
        const f32x2 w1 = unit_root(r, 14);
#pragma unroll
        for (int a = 0; a < 16; ++a) v[a] = (a < 8) ? z[2 * a + rr] : (f32x2){0.f, 0.f};
        dft_reg<16, false>(v);
        f32x2 w = w1;
        buf[pr] = v[0];
#pragma unroll
        for (int p = 1; p < 16; ++p) { buf[pr + p * 1056] = cmul(v[brevR<16>(p)], w); w = cmul(w, w1); }
    }
}
__device__ __forceinline__ void fft_pass_a_inv_regs(const LAS f32x2* buf, f32x2 (&y)[16], int tid) {
#pragma unroll
    for (int rr = 0; rr < 2; ++rr) { const int r = tid + rr * 512, pr = fpad(r); f32x2 v[16];
        const f32x2 w1 = unit_root(r, 14);
        f32x2 w = w1;
        v[0] = buf[pr];
#pragma unroll
        for (int p = 1; p < 16; ++p) { v[p] = cmulc(buf[pr + p * 1056], w); w = cmul(w, w1); }
        dft_reg<16, true>(v);
#pragma unroll
        for (int a = 4; a < 12; ++a) y[2 * (a - 4) + rr] = v[brevR<16>(a)];
    }
}
template <bool INV> __device__ __forceinline__ void fft_pass_b(LAS f32x2* buf, int tid) {
    const int p1 = tid >> 5, r = tid & 31, pb = fpad(p1 * 1024 + r); f32x2 v[32];
    const f32x2 w1 = unit_root(r, 10);
    if (!INV) {
#pragma unroll
        for (int a = 0; a < 32; ++a) v[a] = buf[pb + a * 33];
        dft_reg<32, false>(v);
        f32x2 w = w1;
        buf[pb] = v[0];
#pragma unroll
        for (int p = 1; p < 32; ++p) { buf[pb + p * 33] = cmul(v[brevR<32>(p)], w); w = cmul(w, w1); }
    } else {
        f32x2 w = w1;
        v[0] = buf[pb];
#pragma unroll
        for (int p = 1; p < 32; ++p) { v[p] = cmulc(buf[pb + p * 33], w); w = cmul(w, w1); }
        dft_reg<32, true>(v);
#pragma unroll
        for (int a = 0; a < 32; ++a) buf[pb + a * 33] = v[brevR<32>(a)];
    }
}
template <bool INV> __device__ __forceinline__ void fft_pass_c(LAS f32x2* buf, int tid) {
    const int base = tid * 33; f32x2 v[32];
#pragma unroll
    for (int a = 0; a < 32; ++a) v[a] = buf[base + a];
    dft_reg<32, INV>(v);
#pragma unroll
    for (int a = 0; a < 32; ++a) buf[base + a] = v[brevR<32>(a)];
}
__device__ __forceinline__ void fft_fwd(LAS f32x2* buf, int tid) { fft_pass_a<false>(buf, tid); __syncthreads(); fft_pass_b<false>(buf, tid); __syncthreads(); fft_pass_c<false>(buf, tid); __syncthreads(); }
__device__ __forceinline__ void fft_inv(LAS f32x2* buf, int tid) { fft_pass_c<true>(buf, tid); __syncthreads(); fft_pass_b<true>(buf, tid); __syncthreads(); fft_pass_a<true>(buf, tid); __syncthreads(); }
__device__ __forceinline__ int fft_k_of_pos(int pos) { return (pos >> 10) + 16 * ((pos >> 5) & 31) + 512 * (pos & 31); }
__device__ __forceinline__ int fft_pos_of_k(int k) { return (k & 15) * 1024 + ((k >> 4) & 31) * 32 + (k >> 9); }

__device__ __forceinline__ int fft_pos_of_ci(int ci) { return (ci >> 9) * 1024 + ((ci >> 4) & 31) * 32 + (ci & 15); }
__device__ __forceinline__ void fft_save_pairs(const LAS f32x2* buf, f32x4* zh, const f32x2* twp, float scale, int tid) {
#pragma unroll 4
    for (int it = 0; it < 16; ++it) { const int ci = it * 512 + tid, pos = fft_pos_of_ci(ci), k = fft_k_of_pos(pos);
        const int pos2 = (k == 0) ? 16 : fft_pos_of_k(16384 - k);
        const f32x2 h1 = buf[fpad(pos)], h2 = buf[fpad(pos2)];
        if (k == 0) zh[ci] = (f32x4){(h1.x + h1.y) * scale, (h1.x - h1.y) * scale, h2.x * scale, -h2.y * scale};
        else { const f32x2 wn = twp[ci];
            const f32x2 eh = {0.5f * (h1.x + h2.x), 0.5f * (h1.y - h2.y)}, dh = {0.5f * (h1.x - h2.x), 0.5f * (h1.y + h2.y)};
            const f32x2 th = cmul(wn, (f32x2){dh.y, -dh.x});
            const f32x2 hk = (eh + th) * scale, hk2 = cconj(eh - th) * scale;
            zh[ci] = (f32x4){hk.x, hk.y, hk2.x, hk2.y}; } }
}
__device__ __forceinline__ void fft_pointwise(LAS f32x2* buf, const f32x4* zh, const f32x2* twp, int tid) {
#pragma unroll 2
    for (int it = 0; it < 16; ++it) { const int ci = it * 512 + tid, pos = fft_pos_of_ci(ci), k = fft_k_of_pos(pos);
        const f32x4 hq = zh[ci];
        if (k == 0) {
            const f32x2 z0 = buf[0], zm = buf[16];
            const float y0 = (z0.x + z0.y) * hq[0], yn = (z0.x - z0.y) * hq[1];
            buf[0] = (f32x2){0.5f * (y0 + yn), 0.5f * (y0 - yn)};
            const f32x2 ym = cmul(cconj(zm), (f32x2){hq[2], hq[3]});
            buf[16] = (f32x2){ym.x, -ym.y};
        } else {
            const int pp = fpad(pos), pp2 = fpad(fft_pos_of_k(16384 - k));
            const f32x2 z1 = buf[pp], z2 = buf[pp2];
            const f32x2 wn = twp[ci];
            const f32x2 ex = {0.5f * (z1.x + z2.x), 0.5f * (z1.y - z2.y)}, dx = {0.5f * (z1.x - z2.x), 0.5f * (z1.y + z2.y)};
            const f32x2 tx = cmul(wn, (f32x2){dx.y, -dx.x});
            const f32x2 xk = ex + tx, xk2 = cconj(ex - tx);
            const f32x2 yk = cmul(xk, (f32x2){hq[0], hq[1]}), yk2 = cmul(xk2, (f32x2){hq[2], hq[3]});
            const f32x2 e2 = {0.5f * (yk.x + yk2.x), 0.5f * (yk.y - yk2.y)}, d2 = {0.5f * (yk.x - yk2.x), 0.5f * (yk.y + yk2.y)};
            const f32x2 o2 = cmulc(d2, wn);
            buf[pp] = (f32x2){e2.x - o2.y, e2.y + o2.x};
            buf[pp2] = (f32x2){e2.x + o2.y, -(e2.y - o2.x)};
        }
    }
}
__device__ __forceinline__ f32x2 sconv2(const bf16_t* row, int n, int Ln, float w0, float w1, float w2, float b) {
    struct W3 { unsigned p, c, q; } t;
    __builtin_memcpy(&t, (const unsigned*)row + (n - 1), 12);
    const unsigned p = (n > 0) ? t.p : 0u, q = (2 * n + 2 < Ln) ? t.q : 0u, c = t.c;
    const float xm1 = bfhi(p), x0 = bflo(c), x1 = bfhi(c), x2 = bflo(q);
    return (f32x2){b + w0 * xm1 + w1 * x0 + w2 * x1, b + w0 * x0 + w1 * x1 + w2 * x2};
}
__device__ __forceinline__ float block_sum(LAS float* red, float v, int tid) {
    v = wave_sum(v);
    __syncthreads();
    if ((tid & 63) == 0) red[tid >> 6] = v;
    __syncthreads();
    float s = 0.f;
#pragma unroll
    for (int i = 0; i < 8; ++i) s += red[i];
    return s;
}

__device__ __forceinline__ void hyena_filter_fft(const Frame& F, int vbid, int vG) {
    LAS f32x2* buf = (LAS f32x2*)F.lds;
    LAS float* red = (LAS float*)(F.lds + (16384 + 512) * 8);
    const bf16_t* FILT = (const bf16_t*)(F.ws + WS_FILT2);
    const int tid = F.tid, pt = fpad(F.tid);
    for (int job = vbid; job < 2048; job += vG) {
        const int c = job >> 1, ord = job & 1;
        const unsigned* f32p = (const unsigned*)(FILT + (size_t)(ord * 1024 + c) * SEQ);
        float ss = 0.f; f32x2 fz[16];
        __syncthreads();
#pragma unroll
        for (int j = 0; j < 16; ++j) { const int n = tid + 512 * j; const unsigned w = f32p[n]; const float a = bflo(w), b = bfhi(w); ss += a * a + b * b; fz[j] = (f32x2){a, b}; }
        const float tot = block_sum(red, ss, tid);
        const float fsv = rsqrtf(tot + EPS) * (1.0f / 16384.0f);
        fft_pass_a_fwd_regs(buf, fz, tid); __syncthreads(); fft_pass_b<false>(buf, tid); __syncthreads(); fft_pass_c<false>(buf, tid); __syncthreads();
        fft_save_pairs(buf, (f32x4*)(F.ws + WS_ZHALL) + (size_t)job * 8192, (const f32x2*)(F.ws + WS_TWP), fsv, tid);
    }
    __syncthreads();
}

__device__ __forceinline__ void hyena_fft(const Frame& F, int slot, bool with_ctx) {
    LAS f32x2* buf = (LAS f32x2*)F.lds;
    LAS float* red = (LAS float*)(F.lds + (16384 + 512) * 8);
    const bf16_t* ZT = (const bf16_t*)(F.ws + WS_ZT); bf16_t* Y2T = (bf16_t*)(F.ws + WS_Y2T);
    const f32x2* twp = (const f32x2*)(F.ws + WS_TWP);
    const float* scw = F.in[I_HSCW] + (size_t)slot * 3 * 3072; const float* scb = F.in[I_HSCB] + (size_t)slot * 3072; const float* fb = F.in[I_HFBIAS] + (size_t)slot * 2048;
    const int tid = F.tid, pt = fpad(F.tid);
    for (int c = F.bid; c < 1024; c += F.G) {
        const f32x4* zh = (const f32x4*)(F.ws + WS_ZHALL) + (size_t)c * 2 * 8192;
        __syncthreads();
        f32x2 vv[16], yy[16];
        {
            const int zc = 2048 + c; const float w0 = scw[zc], w1 = scw[3072 + zc], w2 = scw[2 * 3072 + zc], b = scb[zc];
            const bf16_t* row = ZT + (size_t)zc * LT + CTXN;
#pragma unroll
            for (int j = 0; j < 16; ++j) { const int n = tid + 512 * j; vv[j] = sconv2(row, n, SEQ, w0, w1, w2, b); if ((j & 3) == 3) __builtin_amdgcn_sched_barrier(0); }
        }
        fft_pass_a_fwd_regs(buf, vv, tid); __syncthreads(); fft_pass_b<false>(buf, tid); __syncthreads(); fft_pass_c<false>(buf, tid); __syncthreads();
        fft_pointwise(buf, zh, twp, tid);
        __syncthreads();
        fft_pass_c<true>(buf, tid); __syncthreads(); fft_pass_b<true>(buf, tid); __syncthreads(); fft_pass_a_inv_regs(buf, yy, tid);
        {
            const int zc = c; const float w0 = scw[zc], w1 = scw[3072 + zc], w2 = scw[2 * 3072 + zc], b = scb[zc], fb0 = fb[c];
            const bf16_t* row = ZT + (size_t)zc * LT + CTXN;
#pragma unroll
            for (int j = 0; j < 16; ++j) { const int n = tid + 512 * j; const f32x2 x1 = sconv2(row, n, SEQ, w0, w1, w2, b);
                vv[j] = (f32x2){x1.x * (yy[j].x + vv[j].x * fb0), x1.y * (yy[j].y + vv[j].y * fb0)}; if ((j & 3) == 3) __builtin_amdgcn_sched_barrier(0); }
        }
        fft_pass_a_fwd_regs(buf, vv, tid); __syncthreads(); fft_pass_b<false>(buf, tid); __syncthreads(); fft_pass_c<false>(buf, tid); __syncthreads();
        fft_pointwise(buf, zh + 8192, twp, tid);
        __syncthreads();
        fft_pass_c<true>(buf, tid); __syncthreads(); fft_pass_b<true>(buf, tid); __syncthreads(); fft_pass_a_inv_regs(buf, yy, tid);
        {
            const int zc = 1024 + c; const float w0 = scw[zc], w1 = scw[3072 + zc], w2 = scw[2 * 3072 + zc], b = scb[zc], fb1 = fb[1024 + c];
            const bf16_t* row = ZT + (size_t)zc * LT + CTXN;
            unsigned* orow = (unsigned*)(Y2T + (size_t)c * LT + CTXN);
#pragma unroll
            for (int j = 0; j < 16; ++j) { const int n = tid + 512 * j; const f32x2 x2 = sconv2(row, n, SEQ, w0, w1, w2, b);
                orow[n] = pk2(x2.x * (yy[j].x + vv[j].x * fb1), x2.y * (yy[j].y + vv[j].y * fb1)); if ((j & 3) == 3) __builtin_amdgcn_sched_barrier(0); }
        }
        __syncthreads();
    }
    if (with_ctx) {
        LAS float* ub = (LAS float*)F.lds;
        LAS float* fbuf = ub + 512;
        const float* FC = (const float*)(F.ws + WS_FILTC);
        const int cc = tid >> 8, t = tid & 255;
        for (int c0 = F.bid * 2; c0 < 1024; c0 += F.G * 2) {
            const int c = c0 + cc;
            float cur, y1 = 0.f;
            { const int zc = 2048 + c; const bf16_t* row = ZT + (size_t)zc * LT;
              const float xm = t > 0 ? bf2f(row[t - 1]) : 0.f, x0 = bf2f(row[t]), xp = t < 255 ? bf2f(row[t + 1]) : 0.f;
              cur = scb[zc] + scw[zc] * xm + scw[3072 + zc] * x0 + scw[2 * 3072 + zc] * xp; }
#pragma unroll 1
            for (int ord = 0; ord < 2; ++ord) {
                __syncthreads();
                const float fv = FC[(size_t)(ord * 1024 + c) * CTXN + t];
                ub[cc * 256 + t] = cur; fbuf[cc * 256 + t] = fv;
                float ss = fv * fv;
                ss = wave_sum(ss);
                __syncthreads();
                if (F.lane == 0) red[F.wave] = ss;
                __syncthreads();
                const float tot = red[cc * 4] + red[cc * 4 + 1] + red[cc * 4 + 2] + red[cc * 4 + 3];
                const float fs = rsqrtf(tot + EPS);
                float acc = 0.f;
                const int jlo = max(0, t + 128 - 255), jhi = min(255, t + 128);
                for (int j = jlo; j <= jhi; ++j) acc += fbuf[cc * 256 + j] * ub[cc * 256 + t + 128 - j];
                const int zc = ord * 1024 + c; const bf16_t* row = ZT + (size_t)zc * LT;
                const float xm = t > 0 ? bf2f(row[t - 1]) : 0.f, x0 = bf2f(row[t]), xp = t < 255 ? bf2f(row[t + 1]) : 0.f;
                const float xg = scb[zc] + scw[zc] * xm + scw[3072 + zc] * x0 + scw[2 * 3072 + zc] * xp;
                const float yo = xg * (acc * fs + cur * fb[ord * 1024 + c]);
                if (ord == 0) { y1 = yo; cur = y1; } else Y2T[(size_t)c * LT + t] = f2bf(yo);
            }
        }
        __syncthreads();
    }
}

__device__ __forceinline__ void hyena_transpose(const Frame& F, bool with_ctx) {
    LAS bf16_t* tile = (LAS bf16_t*)F.lds;
    const bf16_t* Y2T = (const bf16_t*)(F.ws + WS_Y2T); bf16_t* Y2 = (bf16_t*)(F.ws + WS_Y2);
    const int tlo = with_ctx ? 0 : 4, ntt = NCH - tlo, ntile = 16 * ntt;
    for (int ti = F.bid; ti < ntile; ti += F.G) {
        const int c0 = (ti % 16) * 64, t0 = (tlo + ti / 16) * 64;
        LDS_BAR();
        { const int c = F.tid >> 3, t8 = (F.tid & 7) * 8; const u32x4 v = *(const u32x4*)(Y2T + (size_t)(c0 + c) * LT + t0 + t8); *(LAS u32x4*)(tile + c * 72 + t8) = v; }
        LDS_BAR();
        { const int t = F.tid >> 3, c8 = (F.tid & 7) * 8; bf16_t e[8];
#pragma unroll
          for (int j = 0; j < 8; ++j) e[j] = tile[(c8 + j) * 72 + t];
          u32x4 w; w.x = (unsigned)e[0] | ((unsigned)e[1] << 16); w.y = (unsigned)e[2] | ((unsigned)e[3] << 16); w.z = (unsigned)e[4] | ((unsigned)e[5] << 16); w.w = (unsigned)e[6] | ((unsigned)e[7] << 16);
          *(u32x4*)(Y2 + (size_t)(t0 + t) * 1024 + c0 + c8) = w; }
    }
}

__device__ __forceinline__ void hyena_outproj(const Frame& F, int l, int slot, bool with_ctx, bool colmajor) {
    MultiSched<1> S; Prob pr[1];
    const int rowbase = CTXN, nM = 64;
    pr[0] = Prob{(const char*)(F.ws + WS_Y2) + (size_t)rowbase * 1024 * 2, (const char*)(F.ws + WS_WHOUT) + (size_t)slot * 1024 * 1024 * 2, nullptr, 0, 0, 0, nM, 4, 1, 0, 1024, 1024, 0, 0};
    S.init(F, pr, nM * 4);
    EpiResid E{(bf16_t*)(F.ws + WS_HL), (bf16_t*)(F.ws + WS_HC), modp(F, l, 0, 2), modp(F, l, 1, 2), F.in[I_HOUTB] + (size_t)slot * 1024, rowbase, colmajor};
    pg8::gemm_phase<EpiResid, MultiSched<1>, false>(F.lds, 1024, S, E, F.tid);
    if (with_ctx) ctx_panel<1024>(F, (const bf16_t*)(F.ws + WS_Y2), (const bf16_t*)(F.ws + WS_WHOUT) + (size_t)slot * 1024 * 1024, F.in[I_HOUTB] + (size_t)slot * 1024, modp(F, l, 1, 2), (bf16_t*)(F.ws + WS_HC));
}
constexpr int MOE_MAXG = 8;
constexpr int MOE_MAXU = 6;
constexpr int MOE_TAB = 131072;

__device__ __forceinline__ void moe_route(const Frame& F, int l, bool with_ctx) {
    constexpr int VP = 1028;
    LAS float* vs = (LAS float*)F.lds;
    LAS float* part = vs + 16 * VP;
    LAS float* lg = part + 8 * 16 * 48;
    LAS int* re = (LAS int*)(lg + 16 * 48);
    LAS float* rw = (LAS float*)(re + MOE_MAXG * 32);
    LAS int* rp = (LAS int*)(rw + MOE_MAXG * 32);
    LAS int* lc = rp + MOE_MAXG * 32;
    LAS int* lb = lc + 32;
    const bf16_t* HL = (const bf16_t*)(F.ws + WS_HL); const bf16_t* HC = (const bf16_t*)(F.ws + WS_HC); bf16_t* VN = (bf16_t*)(F.ws + WS_VN);
    const float* WC = (const float*)(F.ws + WS_WC) + (size_t)l * 1024 * 48;
    const float* g2n = F.in[I_N2G] + l * 1024;
    unsigned* cnt = (unsigned*)(F.ws + WS_CTL) + CW_CNT + l * 32 * 64;
    int* LIST = (int*)(F.ws + WS_LIST); float* AW = (float*)(F.ws + WS_AW);
    const int ntok = with_ctx ? LT : SEQ, tokbase = with_ctx ? 0 : CTXN, ngroups = ntok / 16;
    const int fr = F.lane & 15, fq = F.lane >> 4;
    float wcr[32][3];
#pragma unroll
    for (int st = 0; st < 32; ++st)
#pragma unroll
        for (int nt = 0; nt < 3; ++nt) wcr[st][nt] = WC[(size_t)(F.wave * 128 + st * 4 + fq) * 48 + nt * 16 + fr];
    int gi = 0;
    for (int grp = F.bid; grp < ngroups && gi < MOE_MAXG; grp += F.G, ++gi) {
        LDS_BAR();
#pragma unroll
        for (int rr = 0; rr < 2; ++rr) { const int i = 2 * F.wave + rr, tok = tokbase + grp * 16 + i; const bool isctx = tok < CTXN; const int s = isctx ? 1 : 0;
            const bf16_t* src = isctx ? HC + (size_t)tok * 1024 : HL + (size_t)(tok - CTXN) * 1024;
            const float* sh = modp(F, l, s, 3); const float* sc = modp(F, l, s, 4);
            f32x4 v[4]; float ss = 0.f;
#pragma unroll
            for (int j = 0; j < 4; ++j) { const u32x2 hb = *(const u32x2*)(src + j * 256 + F.lane * 4); v[j] = (f32x4){bflo(hb.x), bfhi(hb.x), bflo(hb.y), bfhi(hb.y)}; ss += v[j][0] * v[j][0] + v[j][1] * v[j][1] + v[j][2] * v[j][2] + v[j][3] * v[j][3]; }
            ss = wave_sum(ss);
            const float rstd = rsqrtf(ss * (1.0f / 1024.0f) + EPS);
#pragma unroll
            for (int j = 0; j < 4; ++j) { const int c = j * 256 + F.lane * 4; const f32x4 g = *(const f32x4*)(g2n + c), a = *(const f32x4*)(sc + c), b = *(const f32x4*)(sh + c);
                f32x4 o;
#pragma unroll
                for (int e = 0; e < 4; ++e) o[e] = v[j][e] * rstd * g[e] * (1.0f + a[e]) + b[e];
                *(LAS f32x4*)(vs + i * VP + c) = o;
                u32x2 w; w.x = pk2(o[0], o[1]); w.y = pk2(o[2], o[3]); *(u32x2*)(VN + (size_t)tok * 1024 + c) = w; }
        }
        LDS_BAR();
        {
            f32x4 acc[3] = {{0.f, 0.f, 0.f, 0.f}, {0.f, 0.f, 0.f, 0.f}, {0.f, 0.f, 0.f, 0.f}};
#pragma unroll
            for (int st = 0; st < 32; ++st) { const int k = F.wave * 128 + st * 4 + fq; const float a = vs[fr * VP + k];
#pragma unroll
                for (int nt = 0; nt < 3; ++nt) acc[nt] = __builtin_amdgcn_mfma_f32_16x16x4f32(a, wcr[st][nt], acc[nt], 0, 0, 0); }
#pragma unroll
            for (int nt = 0; nt < 3; ++nt)
#pragma unroll
                for (int r = 0; r < 4; ++r) part[(F.wave * 16 + fq * 4 + r) * 48 + nt * 16 + fr] = acc[nt][r];
        }
        LDS_BAR();
        for (int idx = F.tid; idx < 16 * 48; idx += NT) { const int n = idx % 48; float a = (n < 4) ? F.in[I_RGB][l * 4 + n] : (n < 36 ? F.in[I_REB][l * 32 + n - 4] : 0.f);
#pragma unroll
            for (int w = 0; w < 8; ++w) a += part[w * 16 * 48 + idx];
            lg[idx] = a; }
        LDS_BAR();
        if (F.tid < 16) { const LAS float* q = lg + F.tid * 48;
            int gx = 0; float gm = q[0];
            for (int j = 1; j < 4; ++j) if (q[j] > gm) { gm = q[j]; gx = j; }
            float gs = 0.f; for (int j = 0; j < 4; ++j) gs += __expf(q[j] - gm);
            const float gw = 1.0f / gs;
            const LAS float* e = q + 4 + gx * 8;
            int i1 = 0; float m1 = e[0];
            for (int j = 1; j < 8; ++j) if (e[j] > m1) { m1 = e[j]; i1 = j; }
            int i2 = -1; float m2 = 0.f;
            for (int j = 0; j < 8; ++j) if (j != i1 && (i2 < 0 || e[j] > m2)) { m2 = e[j]; i2 = j; }
            const float x = __expf(m2 - m1), w1 = 1.0f / (1.0f + x), w2 = x / (1.0f + x);
            const int a0 = gi * 32 + F.tid * 2;
            re[a0] = gx * 8 + i1; rw[a0] = gw * w1; re[a0 + 1] = gx * 8 + i2; rw[a0 + 1] = gw * w2; }
    }
    LDS_BAR();
    if (F.tid < 32) lc[F.tid] = 0;
    LDS_BAR();
    const int na = gi * 32;
    if (F.tid < na) rp[F.tid] = __hip_atomic_fetch_add(&lc[re[F.tid]], 1, __ATOMIC_RELAXED, __HIP_MEMORY_SCOPE_WORKGROUP);
    LDS_BAR();
    if (F.tid < 32) lb[F.tid] = lc[F.tid] > 0 ? (int)__hip_atomic_fetch_add(cnt + F.tid * 64, (unsigned)lc[F.tid], RLX_AGENT) : 0;
    LDS_BAR();
    if (F.tid < na) { const int a = F.tid, g = a >> 5, i = (a >> 1) & 15, slot = a & 1, e = re[a];
        const int tok = tokbase + (F.bid + g * F.G) * 16 + i, gidx = tok * 2 + slot;
        LIST[(size_t)e * NASG + lb[e] + rp[a]] = gidx; AW[gidx] = rw[a]; }
}

struct MoeSched {
    LAS int* cnt; LAS int* tstart; LAS unsigned* rowtab;
    const char* A; const char* B; char* O; int total, G, c, mode;
    __device__ __forceinline__ void locate(int Lq, int& e, int& mt, int& pn) const {
        const int L = pg8::xcd_remap(Lq, total);
        const int mtg = L >> 2; pn = L & 3; e = 0;
        for (int j = 1; j < 32; ++j) if (tstart[j] <= mtg) e = j;
        mt = mtg - tstart[e];
    }
    __device__ __forceinline__ bool next(int i, GUnit& u) const {
        const int L = i * G + c; if (L >= total) return false;
        int e, mt, pn; locate(L, e, mt, pn);
        u.g = e; u.aux = mt; u.pm = tstart[e] + mt; u.pn = pn;
        if (mode == 0) { u.a = A; u.lda = 1024; u.b = B + ((size_t)e * 1024 + pn * 128) * 1024 * 2; u.ldb = 1024; u.hsb = 512; u.o = O + ((size_t)u.pm * 256 * 512 + pn * 128) * 2; u.ldo = 512; }
        else { u.a = A + (size_t)u.pm * 256 * 512 * 2; u.lda = 512; u.b = B + ((size_t)e * 1024 + pn * 256) * 512 * 2; u.ldb = 512; u.hsb = 128; u.o = O; u.ldo = 1024; }
        return true;
    }
    __device__ __forceinline__ unsigned grow(int slot, int r) const { return rowtab[slot * 256 + r]; }
};
__device__ __forceinline__ void moe_tables(const Frame& F, int l, MoeSched& S, int mode) {
    S.cnt = (LAS int*)(F.lds + MOE_TAB); S.tstart = S.cnt + 32; S.rowtab = (LAS unsigned*)(F.lds + MOE_TAB + 512);
    const unsigned* cnt = (const unsigned*)(F.ws + WS_CTL) + CW_CNT + l * 32 * 64;
    __syncthreads();
    if (F.tid < 32) S.cnt[F.tid] = (int)__hip_atomic_load(cnt + F.tid * 64, RLX_AGENT);
    __syncthreads();
    if (F.tid == 0) { int a = 0; for (int e = 0; e < 32; ++e) { S.tstart[e] = a; a += (S.cnt[e] + 255) >> 8; } S.tstart[32] = a; }
    __syncthreads();
    S.total = S.tstart[32] * 4; S.G = F.G; S.c = F.bid; S.mode = mode;
    if (mode == 0 && F.tid < 256) {
        const int* LIST = (const int*)(F.ws + WS_LIST);
        for (int slot = 0; slot < MOE_MAXU; ++slot) { const int L = slot * S.G + S.c; if (L >= S.total) break;
            int e, mt, pn; S.locate(L, e, mt, pn);
            const int idx = mt * 256 + F.tid; const int tok = idx < S.cnt[e] ? (LIST[(size_t)e * NASG + idx] >> 1) : 0;
            S.rowtab[slot * 256 + F.tid] = (unsigned)tok * 2048u; }
    }
    __syncthreads();
}
struct EpiSwiGLU {
    static constexpr bool PERM = true;
    __device__ __forceinline__ void operator()(const f32x4 (&acc)[2][2][4][2], const GUnit& u, int wr, int wc, int fr, int fq) const {
        bf16_t* base = (bf16_t*)u.o;
#pragma unroll
        for (int ai = 0; ai < 2; ++ai)
#pragma unroll
            for (int m = 0; m < 4; ++m) { const int r = ai * 128 + wr * 64 + m * 16 + fr; float o[8];
#pragma unroll
                for (int n = 0; n < 2; ++n)
#pragma unroll
                    for (int j = 0; j < 4; ++j) o[n * 4 + j] = siluf(acc[ai][0][m][n][j]) * acc[ai][1][m][n][j];
                u32x4 w; w.x = pk2(o[0], o[1]); w.y = pk2(o[2], o[3]); w.z = pk2(o[4], o[5]); w.w = pk2(o[6], o[7]);
                *(u32x4*)(base + (size_t)r * 512 + wc * 32 + 8 * fq) = w; }
    }
};
struct EpiScatter {
    static constexpr bool PERM = true;
    const int* LIST; const float* AW; bf16_t* YB; LAS int* cnt;
    __device__ __forceinline__ void operator()(const f32x4 (&acc)[2][2][4][2], const GUnit& u, int wr, int wc, int fr, int fq) const {
        const int ce = cnt[u.g];
#pragma unroll
        for (int ai = 0; ai < 2; ++ai)
#pragma unroll
            for (int m = 0; m < 4; ++m) { const int r = ai * 128 + wr * 64 + m * 16 + fr, idx = u.aux * 256 + r;
                if (idx < ce) { const int a = LIST[(size_t)u.g * NASG + idx]; const float w = AW[a];
                    bf16_t* rowp = YB + (size_t)a * 1024 + u.pn * 256 + wc * 32 + 8 * fq;
#pragma unroll
                    for (int bj = 0; bj < 2; ++bj) { const f32x4 v0 = acc[ai][bj][m][0] * w, v1 = acc[ai][bj][m][1] * w;
                        u32x4 q; q.x = pk2(v0[0], v0[1]); q.y = pk2(v0[2], v0[3]); q.z = pk2(v1[0], v1[1]); q.w = pk2(v1[2], v1[3]);
                        *(u32x4*)(rowp + bj * 128) = q; } } }
    }
};
__device__ __forceinline__ void moe_e1(const Frame& F, int l) {
    MoeSched S; moe_tables(F, l, S, 0);
    S.A = (const char*)(F.ws + WS_VN); S.B = (const char*)(F.ws + WS_W13) + (size_t)l * 32 * 1024 * 1024 * 2; S.O = (char*)(F.ws + WS_H1);
    EpiSwiGLU E;
    pg8::gemm_phase<EpiSwiGLU, MoeSched, true>(F.lds, 1024, S, E, F.tid);
}
__device__ __forceinline__ void moe_e2(const Frame& F, int l) {
    MoeSched S; moe_tables(F, l, S, 1);
    S.A = (const char*)(F.ws + WS_H1); S.B = (const char*)(F.ws + WS_W2) + (size_t)l * 32 * 1024 * 512 * 2; S.O = nullptr;
    EpiScatter E{(const int*)(F.ws + WS_LIST), (const float*)(F.ws + WS_AW), (bf16_t*)(F.ws + WS_YBUF), S.cnt};
    pg8::gemm_phase<EpiScatter, MoeSched, false>(F.lds, 512, S, E, F.tid);
}
#ifndef MK_LAYERS
#define MK_LAYERS 4
#endif
__global__ void __launch_bounds__(NT, 2) mk_fwd(Args args) {
    extern __shared__ __attribute__((aligned(16))) unsigned char lds_raw[];
    Frame F0;
    { Frame& F = F0;
    F.lds = (LAS unsigned char*)lds_raw; F.ws = args.ws; F.in = args.in; F.out = args.out;
    F.wave = __builtin_amdgcn_readfirstlane((int)threadIdx.x >> 6); F.lane = fresh_lane(); F.tid = F.wave * 64 + F.lane; F.G = gridDim.x; F.bid = blockIdx.x; }
    const Frame& F = F0;
    volatile LAS unsigned* xbw = (volatile LAS unsigned*)(F.lds + LDS_BYTES - 16);
    if (F.tid < 4) xbw[F.tid] = 0u;
    __syncthreads();
    unsigned* ctl = (unsigned*)(F.ws + WS_CTL);
    const int lo = args.ph_lo, hi = args.ph_hi;
    XcdBarrier bar; bar.bar = ctl + CW_BAR; bar.x = 0; bar.st = xbw;
    if (hi - lo > 1) bar = xcd_barrier_post(ctl + CW_BAR, xbw, F.tid);
    int ph = 0;
#ifdef MK_PROBE
    unsigned long long tacc = 0ull, tp0 = 0ull;
#define PROBE_T0(g) tp0 = __builtin_amdgcn_s_memrealtime();
#ifdef MK_PROBE_WG
#define PROBE_TMID(g) if (((MK_PROBE >> (g)) & 1) && F0.bid == MK_PROBE_WG) tacc += __builtin_amdgcn_s_memrealtime() - tp0;
#define PROBE_T1(g)
#elif defined(MK_PROBE_SEL)
#define PROBE_TMID(g) if (((MK_PROBE >> (g)) & 1) && (MK_PROBE_SEL)) tacc += __builtin_amdgcn_s_memrealtime() - tp0;
#define PROBE_T1(g)
#else
#define PROBE_TMID(g)
#define PROBE_T1(g) if ((MK_PROBE >> (g)) & 1) tacc += __builtin_amdgcn_s_memrealtime() - tp0;
#endif
#else
#define PROBE_T0(g)
#define PROBE_T1(g)
#define PROBE_TMID(g)
#endif
#define PHASE_BEGIN(g) if (lo <= ph && ph < hi) { PROBE_T0(g) Frame F = F0; { const int t_ = F0.wave * 64 + fresh_lane(); F.tid = t_; F.lane = t_ & 63; }
#define PHASE_END(g)   PROBE_TMID(g) if (ph + 1 < hi) xcd_barrier(bar, F0.wave * 64 + fresh_lane()); PROBE_T1(g) } ++ph;

    PHASE_BEGIN(0) p0_prologue(F); PHASE_END(0)
    int lprev = -1;
#define LAYER_PAIR(IT) { constexpr int it = IT; \
        const int lm = 2 * it, lh = 2 * it + 1; const bool colmajor = (it == 1), ctxl = (it == 0); \
        if (lm < MK_LAYERS) { \
         \
        PHASE_BEGIN(1) n1_phase(F, lm, it > 0, true, it > 0, it == 0, colmajor); hyena_filtergen(F, it, ctxl); PHASE_END(1) \
        PHASE_BEGIN(2) mlstm_inproj(F, it); PHASE_END(2) \
        PHASE_BEGIN(3) mlstm_conv_gates(F, it); PHASE_END(3) \
        PHASE_BEGIN(4) mlstm_qkv(F, it); PHASE_END(4) \
        PHASE_BEGIN(5) mlstm_scan(F, it); PHASE_END(5) \
        PHASE_BEGIN(6) mlstm_intra(F, it, ctxl ? 0 : 4); PHASE_END(6) \
        PHASE_BEGIN(7) mlstm_outproj(F, lm, it, ctxl, colmajor); PHASE_END(7) \
        PHASE_BEGIN(8) moe_route(F, lm, ctxl); PHASE_END(8) \
        PHASE_BEGIN(9) moe_e1(F, lm); PHASE_END(9) \
        PHASE_BEGIN(10) moe_e2(F, lm); PHASE_END(10) \
        lprev = lm; \
        if (lh < MK_LAYERS) { \
         \
        PHASE_BEGIN(1) n1_phase(F, lh, true, ctxl, ctxl, false, colmajor); PHASE_END(1) \
        PHASE_BEGIN(11) hyena_inproj(F, it, ctxl); PHASE_END(11) \
        PHASE_BEGIN(12) hyena_fft(F, it, ctxl); PHASE_END(12) \
        PHASE_BEGIN(13) hyena_transpose(F, ctxl); PHASE_END(13) \
        PHASE_BEGIN(14) hyena_outproj(F, lh, it, ctxl, colmajor); PHASE_END(14) \
        PHASE_BEGIN(8) moe_route(F, lh, ctxl); PHASE_END(8) \
        PHASE_BEGIN(9) moe_e1(F, lh); PHASE_END(9) \
        PHASE_BEGIN(10) moe_e2(F, lh); PHASE_END(10) \
        lprev = lh; \
        } } }
    LAYER_PAIR(0)
    LAYER_PAIR(1)
    PHASE_BEGIN(15) final_phase(F, lprev >= 0, lprev, lprev < 0); PHASE_END(15)
#ifdef MK_PROBE_WG
    { unsigned long long* slot = (unsigned long long*)(F0.ws + WS_CTL) + 16;
      if (F0.bid == MK_PROBE_WG && F0.tid == 0) __hip_atomic_store(slot, tacc, __ATOMIC_RELAXED, __HIP_MEMORY_SCOPE_AGENT);
      xcd_barrier(bar, F0.wave * 64 + fresh_lane());
      { const unsigned long long tv = __hip_atomic_load(slot, __ATOMIC_RELAXED, __HIP_MEMORY_SCOPE_AGENT); tacc = ((unsigned long long)(unsigned)__builtin_amdgcn_readfirstlane((int)(tv >> 32)) << 32) | (unsigned)__builtin_amdgcn_readfirstlane((int)tv); } }
#endif
#ifdef MK_PROBE
    { const unsigned long long te = __builtin_amdgcn_s_memrealtime() + tacc * MK_PROBE_MULT; while (__builtin_amdgcn_s_memrealtime() < te) __builtin_amdgcn_s_sleep(8); }
#endif
}

extern "C" void kernel_launch(void* const* d_in, const int* in_sizes, int n_in, void* d_out, int out_size, void* d_ws, size_t ws_size, hipStream_t stream) {
    static int grid = 0;
    if (grid == 0) {
        if (n_in != 40 || out_size != SEQ * D || ws_size < WS_END) { fprintf(stderr, "kernel_launch: unexpected shapes (n_in %d out %d ws %zu)\n", n_in, out_size, ws_size); grid = -1; return; }
        int dev = 0, cus = 0, per_cu = 0;
        if (hipGetDevice(&dev) != hipSuccess || hipDeviceGetAttribute(&cus, hipDeviceAttributeMultiprocessorCount, dev) != hipSuccess) { grid = -1; return; }
        if (hipFuncSetAttribute((const void*)mk_fwd, hipFuncAttributeMaxDynamicSharedMemorySize, LDS_BYTES) != hipSuccess) { fprintf(stderr, "kernel_launch: hipFuncSetAttribute failed\n"); grid = -1; return; }
        if (hipOccupancyMaxActiveBlocksPerMultiprocessor(&per_cu, (const void*)mk_fwd, NT, LDS_BYTES) != hipSuccess || per_cu < 1) { fprintf(stderr, "kernel_launch: occupancy query says %d\n", per_cu); }
        (void)hipGetLastError();
        grid = cus;
        if (grid > 256) grid = 256;
        if (grid < 128) { fprintf(stderr, "kernel_launch: needs >= 128 CUs (got %d)\n", grid); grid = -1; return; }
    }
    if (grid < 0) return;
    (void)hipMemsetAsync((char*)d_ws + WS_CTL, 0, CTL_BYTES, stream);
    Args a{};
    for (int i = 0; i < 40; ++i) a.in[i] = (const float*)d_in[i];
    a.out = (float*)d_out; a.ws = (unsigned char*)d_ws;
#ifdef MK_SPLIT
    for (int p = 0; p < MK_SPLIT; ++p) { a.ph_lo = p; a.ph_hi = p + 1; hipLaunchKernelGGL(mk_fwd, dim3(grid), dim3(NT), LDS_BYTES, stream, a); }
#else
    a.ph_lo = 0; a.ph_hi = 1000;
    hipLaunchKernelGGL(mk_fwd, dim3(grid), dim3(NT), LDS_BYTES, stream, a);
#endif
}
```

```cpp
#include <hip/hip_runtime.h>
#include <cstdio>
#include <cstdint>

#define LAS __attribute__((address_space(3)))
#define GAS __attribute__((address_space(1)))
#define RLX_AGENT __ATOMIC_RELAXED, __HIP_MEMORY_SCOPE_AGENT
typedef unsigned short bf16_t;
typedef short bf16x8 __attribute__((ext_vector_type(8)));
typedef float f32x4 __attribute__((ext_vector_type(4)));
typedef float f32x2 __attribute__((ext_vector_type(2)));
typedef unsigned u32x4 __attribute__((ext_vector_type(4)));
typedef unsigned u32x2 __attribute__((ext_vector_type(2)));

constexpr int D = 1024, SEQ = 16384, CTXN = 256, LT = SEQ + CTXN;
constexpr int MI = 2048, MH = 4, DQK = 256, DV = 512, CH = 64, NCH = LT / CH;
constexpr int NEXP = 32, DE = 512, NASG = 2 * LT;
constexpr int HB = 16, HEMB = 33, HFH = 64;
constexpr float EPS = 1e-6f;
constexpr int NT = 512, NWAVES = 8;
constexpr int LDS_BYTES = 147456;

constexpr size_t MiB = 1u << 20;
constexpr size_t WS_CTL = 0, CTL_BYTES = 1 * MiB;
constexpr size_t WS_MODS = 4 * MiB;
constexpr size_t WS_WC = 5 * MiB;
constexpr size_t WS_Z2 = 6 * MiB;
constexpr size_t WS_Z2C = 10 * MiB;
constexpr size_t WS_SCAL = 11 * MiB;
constexpr size_t WS_CHS = 14 * MiB;
constexpr size_t WS_DENI = 15 * MiB;
constexpr size_t WS_LIST = 16 * MiB;
constexpr size_t WS_AW = 21 * MiB;
constexpr size_t WS_WGP = 26 * MiB;
constexpr size_t WS_FSC = 27 * MiB;
constexpr size_t WS_TWP = 28 * MiB;
constexpr size_t WS_GWT = 22 * MiB;
constexpr size_t WS_FILTC = 23 * MiB;
constexpr size_t WS_W3T = 25 * MiB;
constexpr size_t WS_WMIN = 32 * MiB;
constexpr size_t WS_WQ = 48 * MiB;
constexpr size_t WS_WK = 50 * MiB;
constexpr size_t WS_WV = 52 * MiB;
constexpr size_t WS_WMOUT = 56 * MiB;
constexpr size_t WS_WHIN = 64 * MiB;
constexpr size_t WS_WHOUT = 76 * MiB;
constexpr size_t WS_W13 = 96 * MiB;
constexpr size_t WS_W2 = 352 * MiB;
constexpr size_t WS_HL = 480 * MiB;
constexpr size_t WS_HC = 544 * MiB;
constexpr size_t WS_U = 546 * MiB;
constexpr size_t WS_VN = 580 * MiB;
constexpr size_t WS_YBUF = 614 * MiB;
constexpr size_t WS_H1 = 680 * MiB;
constexpr size_t WS_MIX = 722 * MiB;
constexpr size_t WS_XCM = WS_MIX;
constexpr size_t WS_OPRE = WS_MIX + 130 * MiB;
constexpr size_t WS_Q = WS_MIX + 195 * MiB;
constexpr size_t WS_KN = WS_MIX + 228 * MiB;
constexpr size_t WS_KT = WS_MIX + 261 * MiB;
constexpr size_t WS_VT = WS_MIX + 294 * MiB;
constexpr size_t WS_OINT = WS_MIX + 359 * MiB;
constexpr size_t WS_Y = WS_MIX + 495 * MiB;
constexpr size_t WS_ZT = WS_MIX;
constexpr size_t WS_FILT = WS_MIX + 98 * MiB;
constexpr size_t WS_Y2T = WS_MIX + 162 * MiB;
constexpr size_t WS_ZH = WS_MIX + 195 * MiB;
constexpr size_t WS_Y2 = WS_MIX + 259 * MiB;
constexpr size_t WS_VTS = WS_MIX + 560 * MiB;
constexpr size_t WS_FILT2 = WS_MIX + 696 * MiB;
constexpr size_t WS_ZHALL = WS_MIX + 760 * MiB;
constexpr size_t WS_END = WS_MIX + 1016 * MiB;

constexpr int CW_BAR = 4096;
constexpr int CW_CNT = 16384;
constexpr int CW_ERR = 8;

__device__ __forceinline__ float bf2f(bf16_t b) { return __uint_as_float(((unsigned)b) << 16); }
__device__ __forceinline__ unsigned pk2(float lo, float hi) { unsigned r; asm("v_cvt_pk_bf16_f32 %0, %1, %2" : "=v"(r) : "v"(lo), "v"(hi)); return r; }
__device__ __forceinline__ bf16_t f2bf(float f) { return (bf16_t)pk2(f, 0.f); }
__device__ __forceinline__ float bflo(unsigned w) { return __uint_as_float(w << 16); }
__device__ __forceinline__ float bfhi(unsigned w) { return __uint_as_float(w & 0xffff0000u); }
__device__ __forceinline__ float sigmf(float x) { return __builtin_amdgcn_rcpf(1.0f + __expf(-x)); }
__device__ __forceinline__ float siluf(float x) { return x * sigmf(x); }
#define LDS_BAR() do { asm volatile("s_waitcnt lgkmcnt(0)" ::: "memory"); __builtin_amdgcn_s_barrier(); asm volatile("" ::: "memory"); } while (0)
__device__ __forceinline__ int fresh_lane() { int l; asm volatile("v_mbcnt_lo_u32_b32 %0, -1, 0\n\tv_mbcnt_hi_u32_b32 %0, -1, %0" : "=v"(l)); return l; }
__device__ __forceinline__ float wave_sum(float v) {
#pragma unroll
    for (int o = 32; o > 0; o >>= 1) v += __shfl_xor(v, o);
    return v;
}
__device__ __forceinline__ float wave_max(float v) {
#pragma unroll
    for (int o = 32; o > 0; o >>= 1) v = fmaxf(v, __shfl_xor(v, o));
    return v;
}

#define XB_TMO      128
#define XB_XCNT(j)  (256  + 64 * (j))
#define XB_XSUB(j)  (1280 + 64 * (j))
#define XB_XGEN(j)  (2304 + 64 * (j))
#define XB_TOP      3328
#define XB_TOPGEN   3392
#define XCD_BAR_WORDS 3456
#define XB_SPIN_CAP (1u << 18)
__device__ __forceinline__ unsigned xb_ld(unsigned* p)              { return __hip_atomic_load(p, __ATOMIC_RELAXED, __HIP_MEMORY_SCOPE_AGENT); }
__device__ __forceinline__ unsigned xb_add(unsigned* p, unsigned v) { return __hip_atomic_fetch_add(p, v, __ATOMIC_RELAXED, __HIP_MEMORY_SCOPE_AGENT); }
__device__ __forceinline__ unsigned xb_xcc_id() { return (unsigned)__builtin_amdgcn_s_getreg((3 << 11) | 20) & 0xFu; }
#define XB_SPIN(cond, bar) do { unsigned _sp = 0; while (cond) { __builtin_amdgcn_s_sleep(1); \
    if ((++_sp & 255u) == 0u) { if (xb_ld(&(bar)[XB_TMO])) break; if (_sp > XB_SPIN_CAP) { atomicAdd(&(bar)[XB_TMO], 1u); break; } } } } while (0)
struct XcdBarrier { unsigned* bar; unsigned x; volatile LAS unsigned* st; };
__device__ __forceinline__ XcdBarrier xcd_barrier_post(unsigned* bar, volatile LAS unsigned* st, int tid) {
    XcdBarrier b; b.bar = bar; b.x = xb_xcc_id(); b.st = st;
    if (tid == 0) (void)xb_add(&bar[XB_XCNT(b.x)], 1u);
    return b;
}
__device__ __forceinline__ void xcd_barrier_complete(unsigned* bar, unsigned x, unsigned& nloc, unsigned& nx) {
    const unsigned G = gridDim.x * gridDim.y * gridDim.z;
    unsigned sum, cnt, mine, sp = 0u;
    for (;;) {
        sum = 0u; cnt = 0u; mine = 0u;
#pragma unroll
        for (unsigned j = 0; j < 16; ++j) { const unsigned c = xb_ld(&bar[XB_XCNT(j)]); sum += c; cnt += (c > 0u) ? 1u : 0u; mine = (j == x) ? c : mine; }
        if (sum == G) break;
        __builtin_amdgcn_s_sleep(1);
        if ((++sp & 255u) == 0u) { if (xb_ld(&bar[XB_TMO])) break; if (sp > XB_SPIN_CAP) { atomicAdd(&bar[XB_TMO], 1u); break; } }
    }
    nloc = mine > 0u ? mine : 1u; nx = cnt > 0u ? cnt : 1u;
}
__device__ __forceinline__ void xcd_barrier(const XcdBarrier& b, int tid) {
    asm volatile("s_waitcnt vmcnt(0)" ::: "memory");
    __syncthreads();
    if (tid == 0) {
        unsigned* bar = b.bar;
        __builtin_amdgcn_s_waitcnt(0);
        unsigned nloc = b.st[0], nx = b.st[1];
        if (nloc == 0u) { xcd_barrier_complete(bar, b.x, nloc, nx); b.st[0] = nloc; b.st[1] = nx; }
        const unsigned old = xb_add(&bar[XB_XSUB(b.x)], 1u);
        const unsigned gen = old / nloc;
        if (old + 1u == (gen + 1u) * nloc) {
            __builtin_amdgcn_fence(__ATOMIC_RELEASE, "agent");
            asm volatile("s_waitcnt vmcnt(0)" ::: "memory");
            const unsigned og = xb_add(&bar[XB_TOP], 1u);
            const unsigned tg = og / nx;
            if (og + 1u == (tg + 1u) * nx) xb_add(&bar[XB_TOPGEN], 1u);
            else XB_SPIN(xb_ld(&bar[XB_TOPGEN]) == tg, bar);
            __builtin_amdgcn_fence(__ATOMIC_ACQUIRE, "agent");
            xb_add(&bar[XB_XGEN(b.x)], 1u);
            asm volatile("s_waitcnt vmcnt(0)" ::: "memory");
        } else {
            XB_SPIN(xb_ld(&bar[XB_XGEN(b.x)]) == gen, bar);
            __builtin_amdgcn_fence(__ATOMIC_ACQUIRE, "agent");
            asm volatile("s_waitcnt vmcnt(0)" ::: "memory");
        }
    }
    __syncthreads();
}

namespace pg8 {
constexpr int BM = 256, BK = 64, HALF = 128, HTB = HALF * BK * 2, STAGE_BYTES = 8 * HTB;
__device__ __forceinline__ int lds_byte(int r, int c) { const int st = (r >> 4) * 2 + (c >> 5), rr = r & 15, cc = c & 31, ob = rr * 64 + cc * 2; return st * 1024 + (ob ^ (((ob >> 9) & 1) << 5)); }
__device__ __forceinline__ void stage_rc(int b, int& R, int& C) { const int st = b / 1024, sb = b % 1024, swz = sb ^ (((sb >> 9) & 1) << 5); R = (st >> 1) * 16 + swz / 64; C = (st & 1) * 32 + (swz % 64) / 2; }
__device__ __forceinline__ int perm32(int rho) { const int n = rho >> 4, i = rho & 15; return 8 * (i >> 2) + 4 * n + (i & 3); }

struct GUnit { const char* a; const char* b; char* o; int pm, pn, g, aux, lda, ldb, ldo, hsb, half; };

template <class Epi, class Sched, bool GATHER>
__device__ __forceinline__ void gemm_phase(LAS unsigned char* lds, const int K, const Sched& S, const Epi& E, int tid_in) {
    int tid_ = tid_in; asm volatile("" : "+v"(tid_));
    const int tid = tid_, wid = __builtin_amdgcn_readfirstlane(tid >> 6), lane = tid & 63, wr = wid >> 2, wc = wid & 3, fr = lane & 15, fq = lane >> 4;
    const int nt = K / BK;
    unsigned cvA0[2], cvA1[2], cvB[2];
#define PG8_OFFS(U, slot, vA0, vA1, vB) do { _Pragma("unroll") for (int i = 0; i < 2; ++i) { int R_, C_; stage_rc(tid * 16 + i * 8192, R_, C_); const int Rb_ = Epi::PERM ? ((R_ & ~31) + perm32(R_ & 31)) : R_; \
        if constexpr (GATHER) { vA0[i] = S.grow(slot, R_) + (unsigned)C_ * 2u; vA1[i] = S.grow(slot, R_ + HALF) + (unsigned)C_ * 2u; } \
        else { vA0[i] = (unsigned)(R_ * (U).lda + C_) * 2u; vA1[i] = (unsigned)((R_ + HALF) * (U).lda + C_) * 2u; } \
        vB[i] = (unsigned)(Rb_ * (U).ldb + C_) * 2u; } } while (0)
    const size_t kstep = (size_t)(BK * 2);
    const unsigned ldsw = (unsigned)wid * 1024u;
    const int aoff = lds_byte(wr * 64 + fr, fq * 8), boff = lds_byte(wc * 32 + fr, fq * 8);
#define PG8_SA(b, h) (((b) * 2 + (h)) * HTB)
#define PG8_SB(b, h) ((4 + (b) * 2 + (h)) * HTB)
#define PG8_STAGE(bufoff, gbase, voff) do { _Pragma("unroll") for (int _i = 0; _i < 2; ++_i) \
        __builtin_amdgcn_global_load_lds((const unsigned*)((const char*)(gbase) + (voff)[_i]), (LAS unsigned*)(lds + (bufoff) + ldsw + _i * 8192), 16, 0, 0); } while (0)
#define PG8_LDA(dst, b, h) do { _Pragma("unroll") for (int m = 0; m < 4; ++m) _Pragma("unroll") for (int k = 0; k < 2; ++k) dst[m][k] = *(const LAS bf16x8*)(lds + PG8_SA(b, h) + aoff + m * 2048 + k * 1024); } while (0)
#define PG8_LDB(dst, b, h) do { _Pragma("unroll") for (int n = 0; n < 2; ++n) _Pragma("unroll") for (int k = 0; k < 2; ++k) dst[n][k] = *(const LAS bf16x8*)(lds + PG8_SB(b, h) + boff + n * 2048 + k * 1024); } while (0)
#define PG8_MMA(ai, bj, At, Bt) do { __builtin_amdgcn_s_setprio(1); _Pragma("unroll") for (int m = 0; m < 4; ++m) _Pragma("unroll") for (int n = 0; n < 2; ++n) _Pragma("unroll") for (int k = 0; k < 2; ++k) \
        acc[ai][bj][m][n] = __builtin_amdgcn_mfma_f32_16x16x32_bf16(Bt[n][k], At[m][k], acc[ai][bj][m][n], 0, 0, 0); __builtin_amdgcn_s_setprio(0); } while (0)
#define PG8_WAIT_V(n) asm volatile("s_waitcnt vmcnt(" #n ")" ::: "memory")
#define PG8_WAIT_L(n) asm volatile("s_waitcnt lgkmcnt(" #n ")" ::: "memory")
#define PG8_BAR __builtin_amdgcn_s_barrier()
#define PG8_SCHED __builtin_amdgcn_sched_barrier(0)
    GUnit cur, nxt; int ui = 0;
    if (!S.next(0, cur)) return;
    PG8_OFFS(cur, 0, cvA0, cvA1, cvB);
    size_t chB = (size_t)cur.hsb * cur.ldb * 2;
    f32x4 acc[2][2][4][2];
#pragma unroll
    for (int a = 0; a < 2; ++a)
#pragma unroll
        for (int b = 0; b < 2; ++b)
#pragma unroll
            for (int m = 0; m < 4; ++m)
#pragma unroll
                for (int n = 0; n < 2; ++n) acc[a][b][m][n] = (f32x4){0.f, 0.f, 0.f, 0.f};
    bf16x8 At[4][2], B0[2][2], B1[2][2];
    const char* cA = cur.a; const char* cB = cur.b;
    PG8_STAGE(PG8_SB(0, 0), cB, cvB); PG8_STAGE(PG8_SA(0, 0), cA, cvA0); PG8_STAGE(PG8_SB(0, 1), cB + chB, cvB); PG8_STAGE(PG8_SA(0, 1), cA, cvA1);
    if (wr == 1) PG8_BAR;
    PG8_WAIT_V(4); PG8_BAR;
    PG8_STAGE(PG8_SB(1, 0), cB + kstep, cvB); PG8_STAGE(PG8_SA(1, 0), cA + kstep, cvA0); PG8_STAGE(PG8_SB(1, 1), cB + chB + kstep, cvB);
    PG8_WAIT_V(6); PG8_BAR;
    for (;;) {
        const bool has_next = S.next(ui + 1, nxt);
        const char* nA = has_next ? nxt.a : cA; const char* nB = has_next ? nxt.b : cB;
        for (int t = 0; t < nt; t += 2) {
            const bool last = (t == nt - 2);
            const char* a1 = cA + (size_t)(t + 1) * kstep;
            const char* a2 = last ? nA : cA + (size_t)(t + 2) * kstep; const char* b2 = last ? nB : cB + (size_t)(t + 2) * kstep;
            const char* a3 = a2 + kstep; const char* b3 = b2 + kstep;
            PG8_LDB(B0, 0, 0); PG8_SCHED; PG8_LDA(At, 0, 0); PG8_STAGE(PG8_SA(1, 1), a1, cvA1);
            PG8_WAIT_L(8); PG8_BAR; PG8_WAIT_L(0); PG8_MMA(0, 0, At, B0); PG8_BAR; PG8_SCHED;
            if (last && has_next) { PG8_OFFS(nxt, ui + 1, cvA0, cvA1, cvB); chB = (size_t)nxt.hsb * nxt.ldb * 2; }
            PG8_LDB(B1, 0, 1); PG8_STAGE(PG8_SB(0, 0), b2, cvB);
            PG8_BAR; PG8_WAIT_L(0); PG8_MMA(0, 1, At, B1); PG8_BAR;
            PG8_LDA(At, 0, 1); PG8_STAGE(PG8_SA(0, 0), a2, cvA0);
            PG8_BAR; PG8_WAIT_L(0); PG8_MMA(1, 0, At, B0); PG8_BAR; PG8_SCHED;
            PG8_STAGE(PG8_SB(0, 1), b2 + chB, cvB);
            PG8_WAIT_V(6); PG8_BAR; PG8_MMA(1, 1, At, B1); PG8_BAR;
            PG8_LDB(B0, 1, 0); PG8_SCHED; PG8_LDA(At, 1, 0); PG8_STAGE(PG8_SA(0, 1), a2, cvA1);
            PG8_WAIT_L(8); PG8_BAR; PG8_WAIT_L(0); PG8_MMA(0, 0, At, B0); PG8_BAR; PG8_SCHED;
            PG8_LDB(B1, 1, 1); PG8_STAGE(PG8_SB(1, 0), b3, cvB);
            PG8_BAR; PG8_WAIT_L(0); PG8_MMA(0, 1, At, B1); PG8_BAR;
            PG8_LDA(At, 1, 1); PG8_STAGE(PG8_SA(1, 0), a3, cvA0);
            PG8_BAR; PG8_WAIT_L(0); PG8_MMA(1, 0, At, B0); PG8_BAR; PG8_SCHED;
            PG8_STAGE(PG8_SB(1, 1), b3 + chB, cvB);
            PG8_WAIT_V(6); PG8_BAR; PG8_MMA(1, 1, At, B1); PG8_BAR;
        }
        E(acc, cur, wr, wc, fr, fq);
        if (!has_next) break;
#pragma unroll
        for (int a = 0; a < 2; ++a)
#pragma unroll
            for (int b = 0; b < 2; ++b)
#pragma unroll
                for (int m = 0; m < 4; ++m)
#pragma unroll
                    for (int n = 0; n < 2; ++n) acc[a][b][m][n] = (f32x4){0.f, 0.f, 0.f, 0.f};
        cur = nxt; cA = nA; cB = nB; ++ui;
    }
    PG8_WAIT_V(0);
    if (wr == 0) PG8_BAR;
    PG8_BAR;
#undef PG8_OFFS
#undef PG8_SA
#undef PG8_SB
#undef PG8_STAGE
#undef PG8_LDA
#undef PG8_LDB
#undef PG8_MMA
#undef PG8_WAIT_V
#undef PG8_WAIT_L
#undef PG8_BAR
#undef PG8_SCHED
}

__device__ __forceinline__ int xcd_remap(int wgid, int nwg) { const int q = nwg / 8, r = nwg % 8, xcd = wgid % 8, off = wgid / 8; return (xcd < r ? xcd * (q + 1) : r * (q + 1) + (xcd - r) * q) + off; }
}
using pg8::GUnit;

struct Args { const float* in[40]; float* out; unsigned char* ws; int ph_lo, ph_hi; };
struct Frame {
    LAS unsigned char* lds; unsigned char* ws; const float* const* in; float* out;
    int tid, lane, wave, G, bid;
};
struct Prob { const char* A; const char* B; char* O; long long sA, sB, sO;
              int nM, nN, nb, ustart; int lda, ldb, ldo; int osz; };
constexpr int SCHED_TAB = 131072 + 8192;
__device__ __forceinline__ int rfl(int v) { return __builtin_amdgcn_readfirstlane(v); }
__device__ __forceinline__ const char* rflp(const char* p) { const unsigned long long v = (unsigned long long)p; return (const char*)(((unsigned long long)(unsigned)rfl((int)(v >> 32)) << 32) | (unsigned)rfl((int)v)); }
template <int NP> struct MultiSched {
    LAS Prob* p; int total, G, c;
    __device__ __forceinline__ void init(const Frame& F, const Prob (&q)[NP], int total_) {
        p = (LAS Prob*)(F.lds + SCHED_TAB); total = total_; G = F.G; c = F.bid;
        __syncthreads();
        if (F.tid == 0) {
#pragma unroll
            for (int j = 0; j < NP; ++j) { p[j].A = q[j].A; p[j].B = q[j].B; p[j].O = q[j].O; p[j].sA = q[j].sA; p[j].sB = q[j].sB; p[j].sO = q[j].sO; p[j].nM = q[j].nM; p[j].nN = q[j].nN; p[j].nb = q[j].nb;
                p[j].ustart = q[j].ustart; p[j].lda = q[j].lda; p[j].ldb = q[j].ldb; p[j].ldo = q[j].ldo; p[j].osz = q[j].osz; } }
        __syncthreads();
    }
    __device__ __forceinline__ bool next(int i, GUnit& u) const {
        const long long Lq = (long long)i * G + c; if (Lq >= total) return false;
        int L = pg8::xcd_remap((int)Lq, total);
        int k = 0;
#pragma unroll
        for (int j = 1; j < NP; ++j) if (L >= p[j].ustart) k = j;
        k = rfl(k);
        const LAS Prob& q = p[k];
        const int nM = rfl(q.nM), nN = rfl(q.nN), lda = rfl(q.lda), ldb = rfl(q.ldb), ldo = rfl(q.ldo), osz = rfl(q.osz);
        L -= rfl(q.ustart);
        const int per = nM * nN, b = L / per, r = L - b * per, pm = r / nN, pn = r - pm * nN;
        u.pm = pm; u.pn = pn; u.g = b; u.aux = k; u.lda = lda; u.ldb = ldb; u.ldo = ldo; u.hsb = 128; u.half = 0;
        u.a = rflp(q.A) + b * (long long)rfl((int)q.sA) + (size_t)pm * 256 * lda * 2;
        u.b = rflp(q.B) + b * (long long)rfl((int)q.sB) + (size_t)pn * 256 * ldb * 2;
        u.o = (char*)rflp(q.O) + b * (long long)rfl((int)q.sO) + ((size_t)pm * 256 * ldo + (size_t)pn * 256) * osz;
        return true;
    }
};

struct EpiStore {
    static constexpr bool PERM = true;
    const float* rowbias;
    const float* wgp; bf16_t* vts;
    int fragmode;
    __device__ __forceinline__ void operator()(const f32x4 (&acc)[2][2][4][2], const GUnit& u, int wr, int wc, int fr, int fq) const {
        bf16_t* base = (bf16_t*)u.o;
#pragma unroll
        for (int ai = 0; ai < 2; ++ai)
#pragma unroll
            for (int m = 0; m < 4; ++m) { const int r = ai * 128 + wr * 64 + m * 16 + fr;
                const float rb = rowbias ? rowbias[u.pm * 256 + r] : 0.f;
#pragma unroll
                for (int bj = 0; bj < 2; ++bj) { const f32x4 v0 = acc[ai][bj][m][0] + rb, v1 = acc[ai][bj][m][1] + rb;
                    u32x4 w; w.x = pk2(v0[0], v0[1]); w.y = pk2(v0[2], v0[3]); w.z = pk2(v1[0], v1[1]); w.w = pk2(v1[2], v1[3]);
                    const int c = bj * 128 + wc * 32 + 8 * fq;
                    unsigned off;
                    if (fragmode == 0) off = (unsigned)(r * u.ldo + c);
                    else if (u.aux < 2) { const int R = u.pm * 256 + r; off = (unsigned)((((R >> 4) * 8 + (c >> 5)) * 64 + (R & 15) + 16 * fq) * 8); }
                    else { const int R = u.pm * 256 + r, s = u.pn * 256 + c, nrt = (u.aux == 2) ? 16 : 32;
                           off = (unsigned)(((((s >> 6) * nrt + (R >> 4)) * 2 + ((s >> 5) & 1)) * 64 + (R & 15) + 16 * fq) * 8); }
                    *(u32x4*)(base + off) = w; } }
        if (vts != nullptr && u.aux == 3) {
#pragma unroll 1
            for (int dir = 0; dir < 2; ++dir) { const int ch = dir * 4 + u.g;
                bf16_t* ob = vts + (size_t)ch * NCH * 33 * 1024;
#pragma unroll
                for (int bj = 0; bj < 2; ++bj) { const int c = bj * 128 + wc * 32 + 8 * fq, s = u.pn * 256 + c;
                    const f32x4 g0 = *(const f32x4*)(wgp + (size_t)ch * LT + s), g1 = *(const f32x4*)(wgp + (size_t)ch * LT + s + 4);
#pragma unroll
                    for (int ai = 0; ai < 2; ++ai)
#pragma unroll
                        for (int m = 0; m < 4; ++m) { const int R = u.pm * 256 + ai * 128 + wr * 64 + m * 16 + fr; const f32x4 v0 = acc[ai][bj][m][0] * g0, v1 = acc[ai][bj][m][1] * g1;
                            u32x4 w; w.x = pk2(v0[0], v0[1]); w.y = pk2(v0[2], v0[3]); w.z = pk2(v1[0], v1[1]); w.w = pk2(v1[2], v1[3]);
                            *(u32x4*)(ob + (unsigned)(((((s >> 6) * 33 + (R >> 4)) * 2 + ((s >> 5) & 1)) * 64 + (R & 15) + 16 * fq) * 8)) = w; }
                    asm volatile("" ::: "memory"); } }
        }
    }
};

enum { I_X = 0, I_C, I_CTX, I_CCTX, I_ADAW, I_ADAB, I_N1G, I_N2G, I_RGW, I_RGB, I_REW, I_REB, I_W13, I_W2,
       I_MINW, I_MCONVW, I_MCONVB, I_MQW, I_MKW, I_MVW, I_MGATEW, I_MGATEB, I_MNORMG, I_MSKIP, I_MOUTW,
       I_HINW, I_HINB, I_HSCW, I_HSCB, I_HFW1, I_HFB1, I_HFFREQ, I_HFW2, I_HFB2, I_HFW3, I_HDECAY, I_HFBIAS, I_HOUTW, I_HOUTB, I_FINALG };

__device__ __forceinline__ void tconv(const Frame& F, const float* src, bf16_t* dst, int B, int R, int C, float scale, int vbid, int vG) {
    LAS float* tile = (LAS float*)F.lds;
    const int tr = R / 64, tc = C / 64, ntile = B * tr * tc;
    for (int t = vbid; t < ntile; t += vG) {
        const int b = t / (tr * tc), rem = t - b * tr * tc, r0 = (rem / tc) * 64, c0 = (rem % tc) * 64;
        const float* s = src + ((size_t)b * R + r0) * C + c0;
        { const int r = F.tid >> 3, c8 = (F.tid & 7) * 8;
          const f32x4 v0 = *(const f32x4*)(s + (size_t)r * C + c8), v1 = *(const f32x4*)(s + (size_t)r * C + c8 + 4);
#pragma unroll
          for (int j = 0; j < 4; ++j) { tile[r * 65 + c8 + j] = v0[j]; tile[r * 65 + c8 + 4 + j] = v1[j]; } }
        LDS_BAR();
        { const int n = F.tid >> 3, k8 = (F.tid & 7) * 8; float v[8];
#pragma unroll
          for (int j = 0; j < 8; ++j) v[j] = tile[(k8 + j) * 65 + n] * scale;
          u32x4 w; w.x = pk2(v[0], v[1]); w.y = pk2(v[2], v[3]); w.z = pk2(v[4], v[5]); w.w = pk2(v[6], v[7]);
          *(u32x4*)(dst + ((size_t)b * C + c0 + n) * R + r0 + k8) = w; }
        LDS_BAR();
    }
}

__device__ __forceinline__ void adaln_units(const Frame& F, int u_lo, int u_hi, int vbid, int vG) {
    unsigned char* ws = F.ws;
    {
        LAS float* sv = (LAS float*)F.lds;
        LAS float* pr = sv + 2048;
        __syncthreads();
        for (int i = F.tid; i < 2048; i += NT) sv[i] = siluf(i < 1024 ? F.in[I_C][i] : F.in[I_CCTX][i - 1024]);
        __syncthreads();
        const int cl = F.tid & 63, kg = F.tid >> 6;
        for (int u = u_lo + vbid; u < u_hi; u += vG) {
            const int l = u / 96, col = (u % 96) * 64 + cl;
            const float* w = F.in[I_ADAW] + ((size_t)l * 1024 + kg * 128) * 6144 + col;
            float a0 = 0.f, a1 = 0.f;
#pragma unroll 16
            for (int k = 0; k < 128; ++k) { const float wv = w[(size_t)k * 6144]; a0 += sv[kg * 128 + k] * wv; a1 += sv[1024 + kg * 128 + k] * wv; }
            pr[(kg * 2 + 0) * 64 + cl] = a0; pr[(kg * 2 + 1) * 64 + cl] = a1;
            __syncthreads();
            if (F.tid < 128) { const int s2 = F.tid >> 6; float a = F.in[I_ADAB][l * 6144 + col];
#pragma unroll
                for (int g = 0; g < 8; ++g) a += pr[(g * 2 + s2) * 64 + cl];
                ((float*)(ws + WS_MODS))[(size_t)(l * 2 + s2) * 6144 + col] = a; }
            __syncthreads();
        }
    }
}
__device__ __forceinline__ void mlstm_wconv(const Frame& F, int slot, int vbid, int vG) {
    unsigned char* ws = F.ws;
    tconv(F, F.in[I_MINW] + (size_t)slot * 1024 * 4096, (bf16_t*)(ws + WS_WMIN) + (size_t)slot * 1024 * 4096, 1, 1024, 4096, 1.f, vbid, vG);
    tconv(F, F.in[I_MQW] + (size_t)slot * 4 * 512 * 256, (bf16_t*)(ws + WS_WQ) + (size_t)slot * 4 * 512 * 256, 4, 512, 256, 1.f, vbid, vG);
    tconv(F, F.in[I_MKW] + (size_t)slot * 4 * 512 * 256, (bf16_t*)(ws + WS_WK) + (size_t)slot * 4 * 512 * 256, 4, 512, 256, 0.0625f, vbid, vG);
    tconv(F, F.in[I_MVW] + (size_t)slot * 4 * 512 * 512, (bf16_t*)(ws + WS_WV) + (size_t)slot * 4 * 512 * 512, 4, 512, 512, 1.f, vbid, vG);
}
__device__ __forceinline__ void z2_rows(const Frame& F, int row_lo, int row_hi, int vbid, int vG);

__device__ __forceinline__ void p0_prologue(const Frame& F) {
    unsigned char* ws = F.ws;
    adaln_units(F, 0, 96, F.bid, F.G);
    mlstm_wconv(F, 0, F.bid, F.G);
    tconv(F, F.in[I_HFW3], (bf16_t*)(ws + WS_W3T), 1, 64, 2048, 1.f, F.bid, F.G);
    for (int ci = F.bid * NT + F.tid; ci < 8192; ci += F.G * NT) { const int k = (ci >> 9) + 16 * ((ci >> 4) & 31) + 512 * (ci & 15);
        float sn, cs; sincospif((float)k * (1.0f / 16384.0f), &sn, &cs); ((f32x2*)(ws + WS_TWP))[ci] = (f32x2){cs, -sn}; }
    const int gt = F.bid * NT + F.tid, gs = F.G * NT;
    for (int i = gt; i < 2 * 16 * 4096; i += gs) { const int s = i / 65536, r = i % 65536, n = r / 4096, k = r % 4096;
        ((bf16_t*)(ws + WS_GWT))[i] = f2bf(F.in[I_MGATEW][((size_t)s * 4096 + k) * 16 + n]); }
    for (int i = gt; i < 4 * 1024 * 48; i += gs) { const int l = i / 49152, r = i % 49152, k = r / 48, n = r % 48;
        float v = 0.f; if (n < 4) v = F.in[I_RGW][((size_t)l * 1024 + k) * 4 + n]; else if (n < 36) v = F.in[I_REW][((size_t)l * 1024 + k) * 32 + (n - 4)];
        ((float*)(ws + WS_WC))[i] = v; }
    z2_rows(F, 0, SEQ, F.bid, F.G);
    z2_rows(F, 2 * SEQ, 2 * SEQ + CTXN, F.bid, F.G);
}
__device__ __forceinline__ void z2_rows(const Frame& F, int row_lo, int row_hi, int vbid, int vG) {
    unsigned char* ws = F.ws;
    {
        LAS float* ft = (LAS float*)F.lds;
        LAS float* z1 = ft + 8 * 36;
        for (int r0 = row_lo + vbid * 8; r0 < row_hi; r0 += vG * 8) {
            const int rr = F.tid >> 6, j = F.tid & 63, row = r0 + rr;
            int slot, t, Ln; if (row < 2 * SEQ) { slot = row / SEQ; t = row % SEQ; Ln = SEQ; } else { slot = 0; t = row - 2 * SEQ; Ln = CTXN; }
            __syncthreads();
            if (j < 33) { float f;
                if (j == 0) f = (float)t / (float)(Ln - 1);
                else { const int b = (j - 1) % 16 + 1; const int ph = (t * b) % Ln; const float a = (float)ph / (float)Ln;
                       f = (j <= 16) ? cosf(6.283185307179586f * a) : sinf(6.283185307179586f * a); }
                ft[rr * 36 + j] = f; }
            __syncthreads();
            const float fr = F.in[I_HFFREQ][slot * 64 + j];
            { float a = F.in[I_HFB1][slot * 64 + j]; const float* w1 = F.in[I_HFW1] + (size_t)slot * 33 * 64 + j;
#pragma unroll
              for (int k = 0; k < 33; ++k) a += ft[rr * 36 + k] * w1[k * 64];
              z1[rr * 64 + j] = sinf(fr * a); }
            __syncthreads();
            { float a = F.in[I_HFB2][slot * 64 + j]; const float* w2 = F.in[I_HFW2] + (size_t)slot * 64 * 64 + j;
#pragma unroll 8
              for (int k = 0; k < 64; ++k) a += z1[rr * 64 + k] * w2[k * 64];
              const float z = sinf(fr * a);
              bf16_t* dst = (row < 2 * SEQ) ? (bf16_t*)(ws + WS_Z2) + (size_t)row * 64 : (bf16_t*)(ws + WS_Z2C) + (size_t)t * 64;
              dst[j] = f2bf(z); }
        }
        __syncthreads();
    }
}

__device__ __forceinline__ void deferred_convert(const Frame& F, int part, int vbid, int vG) {
    unsigned char* ws = F.ws;
    if (part == 0) {
        tconv(F, F.in[I_MOUTW], (bf16_t*)(ws + WS_WMOUT), 2, 2048, 1024, 1.f, vbid, vG);
        adaln_units(F, 96, 4 * 96, vbid, vG);
        mlstm_wconv(F, 1, vbid, vG);
        tconv(F, F.in[I_HFW3] + (size_t)64 * 2048, (bf16_t*)(ws + WS_W3T) + (size_t)64 * 2048, 1, 64, 2048, 1.f, vbid, vG);
        z2_rows(F, SEQ, 2 * SEQ, vbid, vG);
        tconv(F, F.in[I_HINW], (bf16_t*)(ws + WS_WHIN), 2, 1024, 3072, 1.f, vbid, vG);
        tconv(F, F.in[I_HOUTW], (bf16_t*)(ws + WS_WHOUT), 2, 1024, 1024, 1.f, vbid, vG);
    }
    tconv(F, F.in[I_W13] + (size_t)part * 64 * 1024 * 1024, (bf16_t*)(ws + WS_W13) + (size_t)part * 64 * 1024 * 1024, 64, 1024, 1024, 1.f, vbid, vG);
    tconv(F, F.in[I_W2] + (size_t)part * 64 * 512 * 1024, (bf16_t*)(ws + WS_W2) + (size_t)part * 64 * 512 * 1024, 64, 512, 1024, 1.f, vbid, vG);
}

__device__ __forceinline__ const float* modp(const Frame& F, int l, int s, int piece) { return (const float*)(F.ws + WS_MODS) + ((size_t)(l * 2 + s) * 6 + piece) * 1024; }
__device__ __forceinline__ int scan_pos(int t, bool colmajor) { return colmajor ? ((t & 63) * 256 + (t >> 6)) : t; }
__device__ __forceinline__ int scan_inv(int p, bool colmajor) { return colmajor ? ((p & 255) * 64 + (p >> 8)) : p; }

__device__ __forceinline__ void n1_phase(const Frame& F, int l, bool comb, bool ctx_rows, bool comb_ctx, bool first, bool colmajor) {
    bf16_t* HL = (bf16_t*)(F.ws + WS_HL); bf16_t* HC = (bf16_t*)(F.ws + WS_HC); bf16_t* U = (bf16_t*)(F.ws + WS_U);
    const bf16_t* YB = (const bf16_t*)(F.ws + WS_YBUF);
    const float* g1n = F.in[I_N1G] + l * 1024;
    const int nrows = SEQ + (ctx_rows ? CTXN : 0);
    f32x4 hg2[4], hga[4], hsh[4];
#pragma unroll
    for (int j = 0; j < 4; ++j) { const int c = j * 256 + F.lane * 4; const f32x4 g = *(const f32x4*)(g1n + c), a = *(const f32x4*)(modp(F, l, 0, 1) + c);
        hga[j] = g * (a + 1.0f); hsh[j] = *(const f32x4*)(modp(F, l, 0, 0) + c); hg2[j] = comb ? *(const f32x4*)(modp(F, l - 1, 0, 5) + c) : (f32x4){0.f, 0.f, 0.f, 0.f}; }
    for (int r0 = (F.bid * NWAVES + F.wave) * 2; r0 < nrows; r0 += F.G * NWAVES * 2) {
        f32x4 v[2][4]; float ss[2] = {0.f, 0.f};
        u32x2 y0[2][4], y1[2][4];
#pragma unroll
        for (int q = 0; q < 2; ++q) { const int r = r0 + q; const bool isctx = r >= SEQ; const int t = isctx ? r - SEQ : r;
            const float* src = (isctx ? F.in[I_CTX] : F.in[I_X]) + (size_t)t * 1024; const bf16_t* srch = (isctx ? HC : HL) + (size_t)t * 1024;
            const bool docomb = comb && (!isctx || comb_ctx); const int tok = isctx ? t : CTXN + t;
#pragma unroll
            for (int j = 0; j < 4; ++j) { const int c = j * 256 + F.lane * 4;
                if (first) v[q][j] = *(const f32x4*)(src + c); else { const u32x2 hb = *(const u32x2*)(srch + c); v[q][j] = (f32x4){bflo(hb.x), bfhi(hb.x), bflo(hb.y), bfhi(hb.y)}; }
                if (docomb) { y0[q][j] = *(const u32x2*)(YB + ((size_t)tok * 2 + 0) * 1024 + c); y1[q][j] = *(const u32x2*)(YB + ((size_t)tok * 2 + 1) * 1024 + c); } } }
#pragma unroll
        for (int q = 0; q < 2; ++q) { const int r = r0 + q; const bool isctx = r >= SEQ; const int t = isctx ? r - SEQ : r; const int s = isctx ? 1 : 0;
            bf16_t* dsth = (isctx ? HC : HL) + (size_t)t * 1024;
            const bool docomb = comb && (!isctx || comb_ctx);
            const float* g2 = docomb ? modp(F, l - 1, s, 5) : nullptr;
#pragma unroll
            for (int j = 0; j < 4; ++j) { const int c = j * 256 + F.lane * 4;
                if (docomb) { const f32x4 g = isctx ? *(const f32x4*)(g2 + c) : hg2[j];
                    v[q][j][0] += g[0] * (bflo(y0[q][j].x) + bflo(y1[q][j].x)); v[q][j][1] += g[1] * (bfhi(y0[q][j].x) + bfhi(y1[q][j].x)); v[q][j][2] += g[2] * (bflo(y0[q][j].y) + bflo(y1[q][j].y)); v[q][j][3] += g[3] * (bfhi(y0[q][j].y) + bfhi(y1[q][j].y)); }
                if (docomb || first) { u32x2 hw; hw.x = pk2(v[q][j][0], v[q][j][1]); hw.y = pk2(v[q][j][2], v[q][j][3]); *(u32x2*)(dsth + c) = hw; }
                ss[q] += v[q][j][0] * v[q][j][0] + v[q][j][1] * v[q][j][1] + v[q][j][2] * v[q][j][2] + v[q][j][3] * v[q][j][3]; }
            ss[q] = wave_sum(ss[q]); }
#pragma unroll
        for (int q = 0; q < 2; ++q) { const int r = r0 + q; const bool isctx = r >= SEQ; const int t = isctx ? r - SEQ : r; const int s = isctx ? 1 : 0;
            const float* sh = modp(F, l, s, 0); const float* sc = modp(F, l, s, 1);
            const float rstd = rsqrtf(ss[q] * (1.0f / 1024.0f) + EPS);
            const int urow = isctx ? t : CTXN + scan_pos(t, colmajor);
#pragma unroll
            for (int j = 0; j < 4; ++j) { const int c = j * 256 + F.lane * 4;
                f32x4 ga, b;
                if (isctx) { const f32x4 g = *(const f32x4*)(g1n + c), a = *(const f32x4*)(sc + c); ga = g * (a + 1.0f); b = *(const f32x4*)(sh + c); } else { ga = hga[j]; b = hsh[j]; }
                float o[4];
#pragma unroll
                for (int e = 0; e < 4; ++e) o[e] = v[q][j][e] * rstd * ga[e] + b[e];
                u32x2 w; w.x = pk2(o[0], o[1]); w.y = pk2(o[2], o[3]); *(u32x2*)(U + (size_t)urow * 1024 + c) = w; } }
    }
}

__device__ __forceinline__ void final_phase(const Frame& F, bool comb, int lprev, bool first) {
    const bf16_t* HL = (const bf16_t*)(F.ws + WS_HL); const bf16_t* YB = (const bf16_t*)(F.ws + WS_YBUF); const float* fg = F.in[I_FINALG];
    const float* g2 = comb ? modp(F, lprev, 0, 5) : nullptr;
    for (int t0 = (F.bid * NWAVES + F.wave) * 2; t0 < SEQ; t0 += F.G * NWAVES * 2) {
        f32x4 v[2][4]; u32x2 y0[2][4], y1[2][4]; float ss[2] = {0.f, 0.f};
#pragma unroll
        for (int q = 0; q < 2; ++q) { const int t = t0 + q; const float* src = F.in[I_X] + (size_t)t * 1024; const bf16_t* srch = HL + (size_t)t * 1024; const int tok = CTXN + t;
#pragma unroll
            for (int j = 0; j < 4; ++j) { const int c = j * 256 + F.lane * 4;
                if (first) v[q][j] = *(const f32x4*)(src + c); else { const u32x2 hb = *(const u32x2*)(srch + c); v[q][j] = (f32x4){bflo(hb.x), bfhi(hb.x), bflo(hb.y), bfhi(hb.y)}; }
                if (comb) { y0[q][j] = *(const u32x2*)(YB + ((size_t)tok * 2 + 0) * 1024 + c); y1[q][j] = *(const u32x2*)(YB + ((size_t)tok * 2 + 1) * 1024 + c); } } }
#pragma unroll
        for (int q = 0; q < 2; ++q) {
#pragma unroll
            for (int j = 0; j < 4; ++j) { const int c = j * 256 + F.lane * 4;
                if (comb) { const f32x4 g = *(const f32x4*)(g2 + c);
                    v[q][j][0] += g[0] * (bflo(y0[q][j].x) + bflo(y1[q][j].x)); v[q][j][1] += g[1] * (bfhi(y0[q][j].x) + bfhi(y1[q][j].x)); v[q][j][2] += g[2] * (bflo(y0[q][j].y) + bflo(y1[q][j].y)); v[q][j][3] += g[3] * (bfhi(y0[q][j].y) + bfhi(y1[q][j].y)); }
                ss[q] += v[q][j][0] * v[q][j][0] + v[q][j][1] * v[q][j][1] + v[q][j][2] * v[q][j][2] + v[q][j][3] * v[q][j][3]; }
            ss[q] = wave_sum(ss[q]); }
#pragma unroll
        for (int q = 0; q < 2; ++q) { const int t = t0 + q; const float rstd = rsqrtf(ss[q] * (1.0f / 1024.0f) + EPS);
#pragma unroll
            for (int j = 0; j < 4; ++j) { const int c = j * 256 + F.lane * 4; const f32x4 g = *(const f32x4*)(fg + c);
                f32x4 o;
#pragma unroll
                for (int e = 0; e < 4; ++e) o[e] = v[q][j][e] * rstd * g[e];
                *(f32x4*)(F.out + (size_t)t * 1024 + c) = o; } }
    }
}

__device__ __forceinline__ void hyena_filter_fft(const Frame& F, int vbid, int vG);
__device__ __forceinline__ float* scal_arr(const Frame& F, int k, int ch) { return (float*)(F.ws + WS_SCAL) + ((size_t)k * 8 + ch) * LT; }
__device__ __forceinline__ float* chs_arr(const Frame& F, int k, int ch) { return (float*)(F.ws + WS_CHS) + ((size_t)k * 8 + ch) * NCH; }
__device__ __forceinline__ bf16x8 bload16(__amdgpu_buffer_rsrc_t r, unsigned voff, unsigned soff) { const u32x4 x = __builtin_amdgcn_raw_buffer_load_b128(r, voff, soff, 0); return __builtin_bit_cast(bf16x8, x); }
__device__ __forceinline__ float logsigf(float x) { return fminf(x, 0.f) - log1pf(__expf(-fabsf(x))); }

__device__ __forceinline__ void mlstm_inproj(const Frame& F, int slot) {
    MultiSched<2> S; Prob pr[2];
    const char* W = (const char*)(F.ws + WS_WMIN) + (size_t)slot * 4096 * 1024 * 2;
    pr[0] = Prob{(const char*)(F.ws + WS_U), W, (char*)(F.ws + WS_XCM) + (size_t)4 * LT * 512 * 2, 0, 512 * 1024 * 2, (long long)LT * 512 * 2, NCH / 4, 2, 4, 0, 1024, 1024, 512, 2};
    pr[1] = Prob{(const char*)(F.ws + WS_U), W + (size_t)2048 * 1024 * 2, (char*)(F.ws + WS_OPRE), 0, 0, 0, NCH / 4, 8, 1, 65 * 8, 1024, 1024, 2048, 2};
    S.init(F, pr, 65 * 16);
    EpiStore E{nullptr, nullptr, nullptr, 0};
    pg8::gemm_phase<EpiStore, MultiSched<2>, false>(F.lds, 1024, S, E, F.tid);
}

__device__ __forceinline__ void mlstm_conv_gates(const Frame& F, int slot) {
    constexpr int TP = 4096 + 8;
    LAS bf16_t* tile = (LAS bf16_t*)F.lds;
    LAS float* part = (LAS float*)(F.lds + 16 * TP * 2);
    LAS float* gl = part + 8 * 256;
    bf16_t* XCp = (bf16_t*)(F.ws + WS_XCM) + (size_t)(F.tid >> 7) * LT * 512 + (F.tid & 127) * 4;
    const bf16_t* XMp = XCp + (size_t)4 * LT * 512;
    const bf16_t* GWT = (const bf16_t*)(F.ws + WS_GWT) + (size_t)slot * 16 * 4096;
    const int c4 = F.tid * 4;
    float cw[3][4], cb[4];
#pragma unroll
    for (int k = 0; k < 3; ++k) { const f32x4 w = *(const f32x4*)(F.in[I_MCONVW] + ((size_t)slot * 3 + k) * 2048 + c4); cw[k][0] = w[0]; cw[k][1] = w[1]; cw[k][2] = w[2]; cw[k][3] = w[3]; }
    { const f32x4 b = *(const f32x4*)(F.in[I_MCONVB] + (size_t)slot * 2048 + c4); cb[0] = b[0]; cb[1] = b[1]; cb[2] = b[2]; cb[3] = b[3]; }
    const int fr = F.lane & 15, fq = F.lane >> 4;
    bf16x8 gw[16];
#pragma unroll
    for (int kk = 0; kk < 16; ++kk) gw[kk] = *(const bf16x8*)(GWT + (size_t)fr * 4096 + F.wave * 512 + kk * 32 + fq * 8);
    for (int gc = F.bid; gc < NCH; gc += F.G) {
        const int seq_lo = gc < 4 ? 0 : CTXN, seq_hi = gc < 4 ? CTXN : LT;
        for (int sub = 0; sub < 4; ++sub) {
            const int r0 = gc * 64 + sub * 16;
            u32x2 xr[18];
#pragma unroll
            for (int i = 0; i < 18; ++i) { const int rr = r0 - 1 + i; xr[i] = (rr >= seq_lo && rr < seq_hi) ? *(const u32x2*)(XMp + (size_t)rr * 512) : (u32x2){0u, 0u}; }
#pragma unroll
            for (int rl = 0; rl < 16; ++rl) {
                const int row = r0 + rl; const u32x2 prv = xr[rl], cur = xr[rl + 1], nxt = xr[rl + 2];
                const float p[4] = {bflo(prv.x), bfhi(prv.x), bflo(prv.y), bfhi(prv.y)}, c[4] = {bflo(cur.x), bfhi(cur.x), bflo(cur.y), bfhi(cur.y)}, n[4] = {bflo(nxt.x), bfhi(nxt.x), bflo(nxt.y), bfhi(nxt.y)};
                float o[4];
#pragma unroll
                for (int e = 0; e < 4; ++e) o[e] = siluf(cb[e] + cw[0][e] * p[e] + cw[1][e] * c[e] + cw[2][e] * n[e]);
                u32x2 w; w.x = pk2(o[0], o[1]); w.y = pk2(o[2], o[3]);
                *(u32x2*)(XCp + (size_t)row * 512) = w;
                *(LAS u32x2*)(tile + rl * TP + c4) = w;
                *(LAS u32x2*)(tile + rl * TP + 2048 + c4) = cur;
            }
            LDS_BAR();
            {
                f32x4 acc = {0.f, 0.f, 0.f, 0.f};
#pragma unroll
                for (int kk = 0; kk < 16; ++kk) { const int k0 = F.wave * 512 + kk * 32 + fq * 8;
                    const bf16x8 a = *(const LAS bf16x8*)(tile + fr * TP + k0);
                    acc = __builtin_amdgcn_mfma_f32_16x16x32_bf16(a, gw[kk], acc, 0, 0, 0); }
#pragma unroll
                for (int r = 0; r < 4; ++r) part[F.wave * 256 + (fq * 4 + r) * 16 + fr] = acc[r];
            }
            LDS_BAR();
            if (F.tid < 256) { float a = F.in[I_MGATEB][slot * 16 + (F.tid & 15)];
#pragma unroll
                for (int w = 0; w < 8; ++w) a += part[w * 256 + F.tid];
                gl[(sub * 16 + (F.tid >> 4)) * 16 + (F.tid & 15)] = a; }
        }
        LDS_BAR();
        {
            const int ch = F.wave, dir = ch >> 2, h = ch & 3, j = F.lane, rl = dir ? 63 - j : j, row = gc * 64 + rl;
            const float ig = gl[rl * 16 + (2 * dir) * 4 + h], lf = logsigf(gl[rl * 16 + (2 * dir + 1) * 4 + h]);
            float b = lf;
#pragma unroll
            for (int o = 1; o < 64; o <<= 1) { const float t = __shfl_up(b, o); if (j >= o) b += t; }
            const float cq = ig - b; float pm = cq;
#pragma unroll
            for (int o = 1; o < 64; o <<= 1) { const float t = __shfl_up(pm, o); if (j >= o) pm = fmaxf(pm, t); }
            const float bl = __shfl(b, 63), gq = bl - b + ig, gm = wave_max(gq);
            scal_arr(F, 0, ch)[row] = b; scal_arr(F, 1, ch)[row] = b + pm; scal_arr(F, 2, ch)[row] = gq; scal_arr(F, 3, ch)[row] = cq;
            if (j == 0) { chs_arr(F, 0, ch)[gc] = bl; chs_arr(F, 1, ch)[gc] = gm; }
            const float wp = __expf(gq - gm);
            ((float*)(F.ws + WS_WGP))[(size_t)ch * LT + row] = wp;
            bf16_t* vx = (bf16_t*)(F.ws + WS_VTS) + (((((size_t)ch * NCH + gc) * 33 + 32) * 2 + (rl >> 5)) * 64 + 16 * ((rl & 31) >> 3)) * 8 + (rl & 7);
            vx[0] = f2bf(wp);
#pragma unroll
            for (int z = 1; z < 16; ++z) vx[z * 8] = 0;
        }
        LDS_BAR();
    }
}

__device__ __forceinline__ void mlstm_qkv(const Frame& F, int slot) {
    MultiSched<4> S; Prob pr[4];
    const char* WQ = (const char*)(F.ws + WS_WQ) + (size_t)slot * 4 * 256 * 512 * 2;
    const char* WK = (const char*)(F.ws + WS_WK) + (size_t)slot * 4 * 256 * 512 * 2;
    const char* WV = (const char*)(F.ws + WS_WV) + (size_t)slot * 4 * 512 * 512 * 2;
    const char* XC = (const char*)(F.ws + WS_XCM); const char* XM = XC + (size_t)4 * LT * 512 * 2; const long long HS = (long long)LT * 512 * 2;
    pr[0] = Prob{XC, WQ, (char*)(F.ws + WS_Q),  HS, 256 * 512 * 2, (long long)LT * 256 * 2, 65, 1, 4, 0,    512, 512,  0, 0};
    pr[1] = Prob{XC, WK, (char*)(F.ws + WS_KN), HS, 256 * 512 * 2, (long long)LT * 256 * 2, 65, 1, 4, 260,  512, 512,  0, 0};
    pr[2] = Prob{WK, XC, (char*)(F.ws + WS_KT), 256 * 512 * 2, HS, (long long)256 * LT * 2, 1, 65, 4, 520,  512,  512, 0,  0};
    pr[3] = Prob{WV, XM, (char*)(F.ws + WS_VT), 512 * 512 * 2, HS, (long long)512 * LT * 2, 2, 65, 4, 780, 512, 512, 0, 0};
    S.init(F, pr, 780 + 520);
    EpiStore E{nullptr, (const float*)(F.ws + WS_WGP), (bf16_t*)(F.ws + WS_VTS), 1};
    pg8::gemm_phase<EpiStore, MultiSched<4>, false>(F.lds, 512, S, E, F.tid);
}

constexpr int SCAN_NV = 4;
struct ScanBufR { bf16x8 q[8]; bf16x8 v[2]; float bq[4], aq[4]; float bl, gm; };
struct ScanBufU { bf16x8 k[8]; float bl, gm; };
__device__ __forceinline__ int scan_chunk(int dir, int st) { return dir == 0 ? st : (st < 4 ? 3 - st : 263 - st); }
#define SCAN_BAR() do { asm volatile("s_waitcnt lgkmcnt(0)" ::: "memory"); __builtin_amdgcn_s_barrier(); asm volatile("" ::: "memory"); } while (0)

template <bool DEN> __device__ __forceinline__ void scan_job(const Frame& F, const int ch, const int sl) {
    constexpr int CP = 256 + 16, NV = SCAN_NV;
    LAS bf16_t* Cs = (LAS bf16_t*)F.lds;
    LAS bf16x8* VS = (LAS bf16x8*)(F.lds + 2 * NV * 16 * CP * 2);
    const bf16_t* Q = (const bf16_t*)(F.ws + WS_Q); const bf16_t* KT = (const bf16_t*)(F.ws + WS_KT); const bf16_t* VTS = (const bf16_t*)(F.ws + WS_VTS);
    const int w = F.wave;
    {
        const int dir = ch >> 2, h = ch & 3; constexpr bool denjob = DEN; constexpr int ntile = DEN ? 1 : NV;
        const float* BL = chs_arr(F, 0, ch); const float* GM = chs_arr(F, 1, ch);
        __syncthreads();
        for (int i = F.tid; i < 2 * NV * 16 * CP / 2; i += NT) ((LAS unsigned*)Cs)[i] = 0u;
        float m = 0.f;
        if (w < 4) {
            const float* BQ = scal_arr(F, 0, ch); const float* AQ = scal_arr(F, 1, ch); float* MS = chs_arr(F, 2, ch);
            const int fr = F.lane & 15, fq = F.lane >> 4;
            const __amdgpu_buffer_rsrc_t rsQ = __builtin_amdgcn_make_buffer_rsrc((void*)(Q + (size_t)h * LT * 256), 0, LT * 256 * 2, 0x00020000);
            const __amdgpu_buffer_rsrc_t rsV = __builtin_amdgcn_make_buffer_rsrc((void*)(VTS + (size_t)ch * NCH * 33 * 1024), 0, NCH * 33 * 1024 * 2, 0x00020000);
            const unsigned loQ = (unsigned)F.lane * 16u + (unsigned)w * 8192u, loV = (unsigned)F.lane * 16u + (unsigned)(denjob ? 32 : sl * NV + w) * 2048u, loS = (unsigned)(16 * w + fq * 4) * 4u;
            char* ubO = (char*)(F.ws + WS_OINT) + ((((size_t)ch * NCH) * 32 + sl * NV) * 4 + w) * 512;
            {
                const unsigned g0 = (unsigned)scan_chunk(dir, 0);
#pragma unroll
                for (int kk = 0; kk < 2; ++kk) VS[((0 * NV + w) * 2 + kk) * 64 + F.lane] = bload16(rsV, loV, g0 * (33u * 2048u) + kk * 1024u);
            }
            __syncthreads();
            ScanBufR sb[3];
#define SCAN_LOAD_R(B, st_) do { const unsigned gc_ = (unsigned)scan_chunk(dir, st_), gn_ = (unsigned)scan_chunk(dir, ((st_) + 1 < NCH) ? (st_) + 1 : (st_)); sb[B].bl = BL[gc_]; sb[B].gm = GM[gc_]; \
            _Pragma("unroll") for (int i = 0; i < 8; ++i) sb[B].q[i] = bload16(rsQ, loQ, gc_ * 32768u + i * 1024u); \
            _Pragma("unroll") for (int kk = 0; kk < 2; ++kk) sb[B].v[kk] = bload16(rsV, loV, gn_ * (33u * 2048u) + kk * 1024u); \
            { const f32x4 a0_ = *(const f32x4*)((const char*)BQ + (size_t)gc_ * 256 + loS), a1_ = *(const f32x4*)((const char*)AQ + (size_t)gc_ * 256 + loS); \
              _Pragma("unroll") for (int e = 0; e < 4; ++e) { sb[B].bq[e] = a0_[e]; sb[B].aq[e] = a1_[e]; } } } while (0)
#define SCAN_LPART_R(LB, lst_, part) do { { const int lc_ = ((lst_) < NCH) ? (lst_) : NCH - 1;     \
            const unsigned gc2_ = (unsigned)scan_chunk(dir, lc_), gn2_ = (unsigned)scan_chunk(dir, (lc_ + 1 < NCH) ? lc_ + 1 : lc_); \
            __builtin_amdgcn_sched_barrier(0x38F); \
            sb[LB].q[2 * (part)] = bload16(rsQ, loQ, gc2_ * 32768u + (2 * (part)) * 1024u); sb[LB].q[2 * (part) + 1] = bload16(rsQ, loQ, gc2_ * 32768u + (2 * (part) + 1) * 1024u); \
            if ((part) == 0) { sb[LB].bl = BL[gc2_]; sb[LB].gm = GM[gc2_]; } \
            if ((part) == 1) { const f32x4 a0_ = *(const f32x4*)((const char*)BQ + (size_t)gc2_ * 256 + loS), a1_ = *(const f32x4*)((const char*)AQ + (size_t)gc2_ * 256 + loS); \
                _Pragma("unroll") for (int e = 0; e < 4; ++e) { sb[LB].bq[e] = a0_[e]; sb[LB].aq[e] = a1_[e]; } } \
            if ((part) >= 2) sb[LB].v[(part) - 2] = bload16(rsV, loV, gn2_ * (33u * 2048u) + ((part) - 2) * 1024u); \
            __builtin_amdgcn_sched_barrier(0); } } while (0)
#define SCAN_STEP_R(B, st_, CB, LB, lst_) do { const int gc_ = scan_chunk(dir, st_), row0_ = gc_ * 64; constexpr int cb_ = CB; \
            int ln_ = F.lane; asm volatile("" : "+v"(ln_)); const int fr_ = ln_ & 15, fq_ = ln_ >> 4;     \
            const float mn_ = fmaxf(sb[B].bl + m, sb[B].gm); \
            if (sl == 0 && w == 0 && ln_ == 0) MS[gc_] = m; \
            _Pragma("unroll") for (int kk = 0; kk < 2; ++kk) VS[(((cb_ ^ 1) * NV + w) * 2 + kk) * 64 + ln_] = sb[B].v[kk]; \
            float wj_[4]; _Pragma("unroll") for (int r = 0; r < 4; ++r) { const float in_ = sb[B].bq[r] + m, mj_ = fmaxf(in_, sb[B].aq[r]); wj_[r] = __expf(in_ - mj_); } \
            _Pragma("unroll") for (int t = 0; t < NV; ++t) { if (t < ntile) { f32x4 o_ = {0.f, 0.f, 0.f, 0.f}; \
                _Pragma("unroll") for (int kk = 0; kk < 8; ++kk) { const bf16x8 b_ = *(const LAS bf16x8*)(Cs + ((cb_ * NV + t) * 16 + fr_) * CP + kk * 32 + fq_ * 8); o_ = __builtin_amdgcn_mfma_f32_16x16x32_bf16(sb[B].q[kk], b_, o_, 0, 0, 0); } \
                if (!denjob) { u32x2 pw_; pw_.x = pk2(o_[0] * wj_[0], o_[1] * wj_[1]); pw_.y = pk2(o_[2] * wj_[2], o_[3] * wj_[3]); \
                    *(u32x2*)(ubO + ((size_t)gc_ * 32 + t) * 2048 + (unsigned)ln_ * 8u) = pw_; } \
                else if (fr_ == 0) { float* dn_ = (float*)(F.ws + WS_DENI) + (size_t)ch * LT + row0_ + 16 * w + fq_ * 4; \
                    _Pragma("unroll") for (int r = 0; r < 4; ++r) dn_[r] = o_[r] * wj_[r]; } } \
                SCAN_LPART_R(LB, lst_, t); }     \
            m = mn_; SCAN_BAR(); } while (0)
            SCAN_LOAD_R(0, 0); SCAN_LOAD_R(1, 1);
            static_assert((NCH - 2) % 6 == 0, "two peeled steps + whole groups of six (3 register buffers x 2 LDS state buffers): no guards inside the loop");
            SCAN_STEP_R(0, 0, 0, 2, 2);
            SCAN_STEP_R(1, 1, 1, 0, 3);
            for (int st = 2; st < NCH; st += 6) {
                SCAN_STEP_R(2, st, 0, 1, st + 2);
                SCAN_STEP_R(0, st + 1, 1, 2, st + 3);
                SCAN_STEP_R(1, st + 2, 0, 0, st + 4);
                SCAN_STEP_R(2, st + 3, 1, 1, st + 5);
                SCAN_STEP_R(0, st + 4, 0, 2, st + 6);
                SCAN_STEP_R(1, st + 5, 1, 0, st + 7);
            }
#undef SCAN_LPART_R
#undef SCAN_LOAD_R
#undef SCAN_STEP_R
        } else {
            const int u = w - 4; const int fr = F.lane & 15, fq = F.lane >> 4;
            const __amdgpu_buffer_rsrc_t rsK = __builtin_amdgcn_make_buffer_rsrc((void*)(KT + (size_t)h * 256 * LT), 0, 256 * LT * 2, 0x00020000);
            const unsigned loK = (unsigned)F.lane * 16u + (unsigned)u * 8192u;
            f32x4 acc[NV][4];
#pragma unroll
            for (int t = 0; t < NV; ++t)
#pragma unroll
                for (int d = 0; d < 4; ++d) acc[t][d] = (f32x4){0.f, 0.f, 0.f, 0.f};
            __syncthreads();
            ScanBufU sb[3];
#define SCAN_LOAD_U(B, st_) do { const unsigned gc_ = (unsigned)scan_chunk(dir, st_); sb[B].bl = BL[gc_]; sb[B].gm = GM[gc_]; \
            _Pragma("unroll") for (int i = 0; i < 8; ++i) sb[B].k[i] = bload16(rsK, loK, gc_ * 32768u + (unsigned)i * 1024u); } while (0)
#define SCAN_LPART_U(LB, lst_, part) do { { const unsigned gc2_ = (unsigned)scan_chunk(dir, ((lst_) < NCH) ? (lst_) : NCH - 1); \
            __builtin_amdgcn_sched_barrier(0x38F); \
            sb[LB].k[2 * (part)] = bload16(rsK, loK, gc2_ * 32768u + (unsigned)(2 * (part)) * 1024u); sb[LB].k[2 * (part) + 1] = bload16(rsK, loK, gc2_ * 32768u + (unsigned)(2 * (part) + 1) * 1024u); \
            if ((part) == 0) { sb[LB].bl = BL[gc2_]; sb[LB].gm = GM[gc2_]; } \
            __builtin_amdgcn_sched_barrier(0); } } while (0)
#define SCAN_STEP_U(B, st_, CB, LB, lst_) do { constexpr int cb_ = CB; \
            int ln_ = F.lane; asm volatile("" : "+v"(ln_)); const int fr_ = ln_ & 15, fq_ = ln_ >> 4; \
            const float bl_ = sb[B].bl, gm_ = sb[B].gm; const float mn_ = fmaxf(bl_ + m, gm_), dec_ = __expf(bl_ + m - mn_), sf_ = __expf(gm_ - mn_); \
            _Pragma("unroll") for (int t = 0; t < NV; ++t) { if (t < ntile) { \
                const bf16x8 v0_ = VS[((cb_ * NV + t) * 2 + 0) * 64 + ln_], v1_ = VS[((cb_ * NV + t) * 2 + 1) * 64 + ln_]; \
                _Pragma("unroll") for (int d = 0; d < 4; ++d) { f32x4 n_ = {0.f, 0.f, 0.f, 0.f}; \
                    n_ = __builtin_amdgcn_mfma_f32_16x16x32_bf16(sb[B].k[2 * d], v0_, n_, 0, 0, 0); n_ = __builtin_amdgcn_mfma_f32_16x16x32_bf16(sb[B].k[2 * d + 1], v1_, n_, 0, 0, 0); \
                    const f32x4 a_ = acc[t][d] * dec_ + n_ * sf_; acc[t][d] = a_; \
                    u32x2 pw_; pw_.x = pk2(a_[0], a_[1]); pw_.y = pk2(a_[2], a_[3]); \
                    *(LAS u32x2*)(Cs + (((cb_ ^ 1) * NV + t) * 16 + fr_) * CP + 16 * (4 * u + d) + fq_ * 4) = pw_; } } \
                SCAN_LPART_U(LB, lst_, t); } \
            m = mn_; SCAN_BAR(); } while (0)
            SCAN_LOAD_U(0, 0); SCAN_LOAD_U(1, 1);
            SCAN_STEP_U(0, 0, 0, 2, 2);
            SCAN_STEP_U(1, 1, 1, 0, 3);
            for (int st = 2; st < NCH; st += 6) {
                SCAN_STEP_U(2, st, 0, 1, st + 2);
                SCAN_STEP_U(0, st + 1, 1, 2, st + 3);
                SCAN_STEP_U(1, st + 2, 0, 0, st + 4);
                SCAN_STEP_U(2, st + 3, 1, 1, st + 5);
                SCAN_STEP_U(0, st + 4, 0, 2, st + 6);
                SCAN_STEP_U(1, st + 5, 1, 0, st + 7);
            }
#undef SCAN_LPART_U
#undef SCAN_LOAD_U
#undef SCAN_STEP_U
        }
    }
}

__device__ __forceinline__ void mlstm_scan(const Frame& F, int cvt_part) {
    constexpr int CP = 256 + 16, NV = SCAN_NV, NSL = 32 / NV;
    static_assert(NV == 4, "one reader wave per v-tile");
    LAS bf16_t* Cs = (LAS bf16_t*)F.lds;
    LAS bf16x8* VS = (LAS bf16x8*)(F.lds + 2 * NV * 16 * CP * 2);
    const bf16_t* Q = (const bf16_t*)(F.ws + WS_Q); const bf16_t* KT = (const bf16_t*)(F.ws + WS_KT); const bf16_t* VTS = (const bf16_t*)(F.ws + WS_VTS);
    const int w = F.wave;
    const int job = F.bid;
    if (job >= 8 * (NSL + 1)) { deferred_convert(F, cvt_part, job - 8 * (NSL + 1), F.G - 8 * (NSL + 1)); hyena_filter_fft(F, job - 8 * (NSL + 1), F.G - 8 * (NSL + 1)); return; }
    { const int ch = job & 7, sl = job >> 3;
      if (sl == NSL) scan_job<true>(F, ch, sl); else scan_job<false>(F, ch, sl); }
}

__device__ __forceinline__ void mlstm_intra(const Frame& F, int slot, int gc_lo) {
    constexpr int SP = 64 + 8;
    LAS float* sc = (LAS float*)F.lds;
    LAS bf16_t* Sb = (LAS bf16_t*)(F.lds + 2 * 6 * 64 * 4);
    LAS float* stt = (LAS float*)(F.lds + 2 * 6 * 64 * 4 + 2 * 64 * SP * 2);
    LAS float* mr = stt + 64 * 8 * 2;
    constexpr int HP = 512 + 8;
    LAS bf16_t* Hs = (LAS bf16_t*)(mr + 128);
    const bf16_t* Q = (const bf16_t*)(F.ws + WS_Q); const bf16_t* KN = (const bf16_t*)(F.ws + WS_KN); const bf16_t* VT = (const bf16_t*)(F.ws + WS_VT);
    const bf16_t* XCM = (const bf16_t*)(F.ws + WS_XCM); const bf16_t* OPRE = (const bf16_t*)(F.ws + WS_OPRE); bf16_t* Y = (bf16_t*)(F.ws + WS_Y);
    const float* NG = F.in[I_MNORMG] + (size_t)slot * 2048; const float* SK = F.in[I_MSKIP] + (size_t)slot * 2048;
    const int w = F.wave;
    const int nunit = (NCH - gc_lo) * 4;
    for (int un = F.bid; un < nunit; un += F.G) {
        int ln_ = F.lane; asm volatile("" : "+v"(ln_)); const int fr = ln_ & 15, fq = ln_ >> 4;
        const int tid_ = w * 64 + ln_;
        const int gc = gc_lo + un / 4, h = un & 3, row0 = gc * 64;
        LDS_BAR();
        if (tid_ < 128) { const int dir = tid_ >> 6, i = tid_ & 63, ch = dir * 4 + h, row = row0 + i;
            const float bq = scal_arr(F, 0, ch)[row], aq = scal_arr(F, 1, ch)[row], cq = scal_arr(F, 3, ch)[row], m0 = chs_arr(F, 2, ch)[gc];
            const float mj = fmaxf(bq + m0, aq);
            LAS float* s = sc + dir * 6 * 64;
            s[i] = bq; s[64 + i] = cq; s[128 + i] = mj; s[192 + i] = __expf(-mj); s[256 + i] = ((const float*)(F.ws + WS_DENI))[(size_t)ch * LT + row]; }
        const int it = w >> 1, st0 = (w & 1) * 2;
        f32x4 sa[2] = {{0.f, 0.f, 0.f, 0.f}, {0.f, 0.f, 0.f, 0.f}};
        {
            const __amdgpu_buffer_rsrc_t rsQi = __builtin_amdgcn_make_buffer_rsrc((void*)(Q + ((size_t)h * 1040 + gc * 4) * 4096), 0, 4 * 4096 * 2, 0x00020000);
            const __amdgpu_buffer_rsrc_t rsKi = __builtin_amdgcn_make_buffer_rsrc((void*)(KN + ((size_t)h * 1040 + gc * 4) * 4096), 0, 4 * 4096 * 2, 0x00020000);
            const unsigned lo = (unsigned)ln_ * 16u;
#pragma unroll
            for (int kk = 0; kk < 8; ++kk) { const bf16x8 a = bload16(rsQi, lo, (unsigned)((it * 8 + kk) * 1024)), b0 = bload16(rsKi, lo, (unsigned)((st0 * 8 + kk) * 1024)), b1 = bload16(rsKi, lo, (unsigned)(((st0 + 1) * 8 + kk) * 1024));
                sa[0] = __builtin_amdgcn_mfma_f32_16x16x32_bf16(a, b0, sa[0], 0, 0, 0); sa[1] = __builtin_amdgcn_mfma_f32_16x16x32_bf16(a, b1, sa[1], 0, 0, 0); }
        }
        LDS_BAR();
#pragma unroll
        for (int t = 0; t < 2; ++t) { const int s = 16 * (st0 + t) + fr;
#pragma unroll
            for (int r = 0; r < 4; ++r) { const int i = 16 * it + fq * 4 + r;
                const float wf = (s <= i) ? __expf(sc[i] + sc[64 + s] - sc[128 + i]) : 0.f;
                const float wb = (s >= i) ? __expf(sc[384 + i] + sc[384 + 64 + s] - sc[384 + 128 + i]) : 0.f;
                Sb[(0 * 64 + i) * SP + s] = f2bf(sa[t][r] * wf); Sb[(1 * 64 + i) * SP + s] = f2bf(sa[t][r] * wb); } }
        LDS_BAR();
        if (tid_ < 128) { const int dir = tid_ >> 6, i = tid_ & 63; float a = 0.f;
            for (int s = 0; s < 64; ++s) a += bf2f(Sb[(dir * 64 + i) * SP + s]);
            sc[dir * 384 + 320 + i] = a; }
        const __amdgpu_buffer_rsrc_t rsO0 = __builtin_amdgcn_make_buffer_rsrc((void*)(F.ws + WS_OINT + ((size_t)h * NCH + gc) * 65536), 0, 65536, 0x00020000);
        const __amdgpu_buffer_rsrc_t rsO1 = __builtin_amdgcn_make_buffer_rsrc((void*)(F.ws + WS_OINT + ((size_t)(4 + h) * NCH + gc) * 65536), 0, 65536, 0x00020000);
        const __amdgpu_buffer_rsrc_t rsVT = __builtin_amdgcn_make_buffer_rsrc((void*)(VT + ((size_t)h * NCH + gc) * 512 * 64), 0, 512 * 64 * 2, 0x00020000);
        f32x4 oa[2][4][4];
#pragma unroll
        for (int d = 0; d < 2; ++d)
#pragma unroll
            for (int a = 0; a < 4; ++a)
#pragma unroll
                for (int b = 0; b < 4; ++b) oa[d][a][b] = (f32x4){0.f, 0.f, 0.f, 0.f};
        {
#pragma unroll
            for (int kk = 0; kk < 2; ++kk) {
                bf16x8 vb[4];
#pragma unroll
                for (int vt = 0; vt < 4; ++vt) vb[vt] = bload16(rsVT, (unsigned)ln_ * 16u, (unsigned)(((4 * w + vt) * 2 + kk) * 1024));
#pragma unroll
                for (int d = 0; d < 2; ++d)
#pragma unroll
                    for (int a = 0; a < 4; ++a) { const bf16x8 sf = *(const LAS bf16x8*)(Sb + (d * 64 + 16 * a + fr) * SP + kk * 32 + fq * 8);
#pragma unroll
                        for (int vt = 0; vt < 4; ++vt) oa[d][a][vt] = __builtin_amdgcn_mfma_f32_16x16x32_bf16(sf, vb[vt], oa[d][a][vt], 0, 0, 0); }
            }
        }
        LDS_BAR();
        u32x2 oi[2][2][4];
#define OI_LOAD(buf, a_) do { _Pragma("unroll") for (int vt = 0; vt < 4; ++vt) { \
            oi[buf][0][vt] = __builtin_bit_cast(u32x2, __builtin_amdgcn_raw_buffer_load_b64(rsO0, (unsigned)ln_ * 8u, (unsigned)(((4 * w + vt) * 4 + (a_)) * 512), 0)); \
            oi[buf][1][vt] = __builtin_bit_cast(u32x2, __builtin_amdgcn_raw_buffer_load_b64(rsO1, (unsigned)ln_ * 8u, (unsigned)(((4 * w + vt) * 4 + (a_)) * 512), 0)); } } while (0)
        OI_LOAD(0, 0);
#pragma unroll
        for (int a = 0; a < 4; ++a) {
            if (a < 3) OI_LOAD((a + 1) & 1, a + 1);
            float den[2][4], emj[2][4];
#pragma unroll
            for (int d = 0; d < 2; ++d)
#pragma unroll
                for (int r = 0; r < 4; ++r) { const int i = 16 * a + fq * 4 + r; emj[d][r] = sc[d * 384 + 192 + i]; den[d][r] = __builtin_amdgcn_rcpf(fmaxf(fabsf(sc[d * 384 + 320 + i] + sc[d * 384 + 256 + i]), emj[d][r])); }
            float s1[4] = {0.f, 0.f, 0.f, 0.f}, s2[4] = {0.f, 0.f, 0.f, 0.f};
#pragma unroll
            for (int vt = 0; vt < 4; ++vt) {
                const u32x2 o0 = oi[a & 1][0][vt], o1 = oi[a & 1][1][vt];
                const float i0[4] = {bflo(o0.x), bfhi(o0.x), bflo(o0.y), bfhi(o0.y)}, i1[4] = {bflo(o1.x), bfhi(o1.x), bflo(o1.y), bfhi(o1.y)};
#pragma unroll
                for (int r = 0; r < 4; ++r) { const float hf = (oa[0][a][vt][r] + i0[r]) * den[0][r], hb = (oa[1][a][vt][r] + i1[r]) * den[1][r];
                    const float hs = hf + hb; s1[r] += hs; s2[r] += hs * hs; Hs[(16 * a + fq * 4 + r) * HP + 64 * w + 16 * vt + fr] = f2bf(hs); }
            }
#pragma unroll
            for (int r = 0; r < 4; ++r) {
#pragma unroll
                for (int o = 1; o < 16; o <<= 1) { s1[r] += __shfl_xor(s1[r], o); s2[r] += __shfl_xor(s2[r], o); }
                if (fr == 0) { const int i = 16 * a + fq * 4 + r; stt[(i * 8 + w) * 2] = s1[r]; stt[(i * 8 + w) * 2 + 1] = s2[r]; } }
            __builtin_amdgcn_sched_barrier(0);
        }
#undef OI_LOAD
        LDS_BAR();
        if (tid_ < 64) { float a = 0.f, b = 0.f;
#pragma unroll
            for (int ww = 0; ww < 8; ++ww) { a += stt[(tid_ * 8 + ww) * 2]; b += stt[(tid_ * 8 + ww) * 2 + 1]; }
            const float mu = a * (1.0f / 512.0f), var = fmaxf(b * (1.0f / 512.0f) - mu * mu, 0.f);
            mr[tid_ * 2] = mu; mr[tid_ * 2 + 1] = rsqrtf(var + EPS); }
        LDS_BAR();
        {
            const int i = tid_ >> 3; const float mu = mr[i * 2], rs = mr[i * 2 + 1]; const size_t row = (size_t)(row0 + i);
#pragma unroll 2
            for (int q = 0; q < 8; ++q) { const int v8 = (tid_ & 7) * 8 + 64 * q, c = h * 512 + v8;
                const u32x4 hv = *(const LAS u32x4*)(Hs + i * HP + v8), xv = *(const u32x4*)(XCM + ((size_t)h * LT + row) * 512 + v8), ov = *(const u32x4*)(OPRE + row * 2048 + c);
                const f32x4 g0 = *(const f32x4*)(NG + c), g1 = *(const f32x4*)(NG + c + 4), k0 = *(const f32x4*)(SK + c), k1 = *(const f32x4*)(SK + c + 4);
                float o[8];
#pragma unroll
                for (int e = 0; e < 8; ++e) { const unsigned hw = hv[e >> 1], xw = xv[e >> 1], ow = ov[e >> 1];
                    const float hh = (e & 1) ? bfhi(hw) : bflo(hw), xc = (e & 1) ? bfhi(xw) : bflo(xw), op = (e & 1) ? bfhi(ow) : bflo(ow);
                    const float ng = e < 4 ? g0[e & 3] : g1[e & 3], sk = e < 4 ? k0[e & 3] : k1[e & 3];
                    o[e] = ((hh - mu) * rs * ng + sk * xc) * sigmf(op); }
                u32x4 wv; wv.x = pk2(o[0], o[1]); wv.y = pk2(o[2], o[3]); wv.z = pk2(o[4], o[5]); wv.w = pk2(o[6], o[7]);
                *(u32x4*)(Y + row * 2048 + c) = wv; }
        }
    }
}

struct EpiResid {
    static constexpr bool PERM = false;
    bf16_t* HL; bf16_t* HC; const float* g_lat; const float* g_ctx; const float* bias; int rowbase; bool colmajor;
    __device__ __forceinline__ void operator()(const f32x4 (&acc)[2][2][4][2], const GUnit& u, int wr, int wc, int fr, int fq) const {
        const int col0 = u.pn * 256 + wc * 32 + 4 * fq;
        const bool isctx = (rowbase + u.pm * 256) < CTXN;
        const float* g = isctx ? g_ctx : g_lat;
        f32x4 gv[2][2], bv[2][2];
#pragma unroll
        for (int bj = 0; bj < 2; ++bj)
#pragma unroll
            for (int n = 0; n < 2; ++n) { gv[bj][n] = *(const f32x4*)(g + col0 + bj * 128 + n * 16); bv[bj][n] = bias ? *(const f32x4*)(bias + col0 + bj * 128 + n * 16) : (f32x4){0.f, 0.f, 0.f, 0.f}; }
#pragma unroll
        for (int ai = 0; ai < 2; ++ai)
#pragma unroll
            for (int m = 0; m < 4; ++m) { const int R = rowbase + u.pm * 256 + ai * 128 + wr * 64 + m * 16 + fr;
                bf16_t* rowp = isctx ? HC + (size_t)R * 1024 : HL + (size_t)scan_inv(R - CTXN, colmajor) * 1024;
#pragma unroll
                for (int bj = 0; bj < 2; ++bj)
#pragma unroll
                    for (int n = 0; n < 2; ++n) { bf16_t* p = rowp + col0 + bj * 128 + n * 16; const u32x2 hb = *(const u32x2*)p; const f32x4 o = (f32x4){bflo(hb.x), bfhi(hb.x), bflo(hb.y), bfhi(hb.y)} + gv[bj][n] * (acc[ai][bj][m][n] + bv[bj][n]);
                        u32x2 hw; hw.x = pk2(o[0], o[1]); hw.y = pk2(o[2], o[3]); *(u32x2*)p = hw; } }
    }
};

template <int K> __device__ __forceinline__ void ctx_panel(const Frame& F, const bf16_t* A, const bf16_t* W, const float* bias, const float* g, bf16_t* HC) {
    LAS float* red = (LAS float*)F.lds;
    constexpr int KW = K / 8;
    for (int u = F.bid; u < 256; u += F.G) {
        int ln_ = F.lane; asm volatile("" : "+v"(ln_)); const int fr = ln_ & 15, fq = ln_ >> 4;
        const int rt = u >> 4, cb = u & 15;
        LDS_BAR();
        const bf16_t* ap = A + (size_t)(rt * 16 + fr) * K + F.wave * KW + fq * 8;
        const bf16_t* wp = W + (size_t)(cb * 64 + fr) * K + F.wave * KW + fq * 8;
        f32x4 acc[4] = {{0.f, 0.f, 0.f, 0.f}, {0.f, 0.f, 0.f, 0.f}, {0.f, 0.f, 0.f, 0.f}, {0.f, 0.f, 0.f, 0.f}};
#pragma unroll 4
        for (int ks = 0; ks < KW / 32; ++ks) { const bf16x8 a = *(const bf16x8*)(ap + ks * 32);
#pragma unroll
            for (int nt = 0; nt < 4; ++nt) { const bf16x8 b = *(const bf16x8*)(wp + (size_t)nt * 16 * K + ks * 32); acc[nt] = __builtin_amdgcn_mfma_f32_16x16x32_bf16(a, b, acc[nt], 0, 0, 0); } }
#pragma unroll
        for (int nt = 0; nt < 4; ++nt)
#pragma unroll
            for (int r = 0; r < 4; ++r) red[(F.wave * 16 + fq * 4 + r) * 64 + nt * 16 + fr] = acc[nt][r];
        LDS_BAR();
        { const int tid_ = F.wave * 64 + ln_, row = tid_ >> 5, c = (tid_ & 31) * 2, col = cb * 64 + c;
          float s0 = bias ? bias[col] : 0.f, s1 = bias ? bias[col + 1] : 0.f;
#pragma unroll
          for (int w = 0; w < 8; ++w) { const f32x2 v = *(const LAS f32x2*)(red + (w * 16 + row) * 64 + c); s0 += v.x; s1 += v.y; }
          unsigned* hp = (unsigned*)(HC + (size_t)(rt * 16 + row) * 1024 + col); const unsigned hb = *hp;
          *hp = pk2(bflo(hb) + g[col] * s0, bfhi(hb) + g[col + 1] * s1); }
    }
}

__device__ __forceinline__ void mlstm_outproj(const Frame& F, int l, int slot, bool with_ctx, bool colmajor) {
    MultiSched<1> S; Prob pr[1];
    const int rowbase = CTXN, nM = 64;
    pr[0] = Prob{(const char*)(F.ws + WS_Y) + (size_t)rowbase * 2048 * 2, (const char*)(F.ws + WS_WMOUT) + (size_t)slot * 1024 * 2048 * 2, nullptr, 0, 0, 0, nM, 4, 1, 0, 2048, 2048, 0, 0};
    S.init(F, pr, nM * 4);
    EpiResid E{(bf16_t*)(F.ws + WS_HL), (bf16_t*)(F.ws + WS_HC), modp(F, l, 0, 2), modp(F, l, 1, 2), nullptr, rowbase, colmajor};
    pg8::gemm_phase<EpiResid, MultiSched<1>, false>(F.lds, 2048, S, E, F.tid);
    if (with_ctx) ctx_panel<2048>(F, (const bf16_t*)(F.ws + WS_Y), (const bf16_t*)(F.ws + WS_WMOUT) + (size_t)slot * 1024 * 2048, nullptr, modp(F, l, 1, 2), (bf16_t*)(F.ws + WS_HC));
}
__device__ __forceinline__ void hyena_filtergen(const Frame& F, int slot, bool with_ctx) {
    const bf16_t* Z2 = (const bf16_t*)(F.ws + WS_Z2) + (size_t)slot * SEQ * 64;
    const bf16_t* W3T = (const bf16_t*)(F.ws + WS_W3T) + (size_t)slot * 2048 * 64;
    const float* dec = F.in[I_HDECAY] + (size_t)slot * 2048;
    bf16_t* FILT = (bf16_t*)(F.ws + WS_FILT2);
    const int fr = F.lane & 15, fq = F.lane >> 4;
    for (int gw = F.bid * NWAVES + F.wave; gw < 128 * 16; gw += F.G * NWAVES) {
        const int oct = gw & 127, tg = gw >> 7, oc = oct * 16 + fr;
        bf16x8 b[2];
#pragma unroll
        for (int kk = 0; kk < 2; ++kk) b[kk] = *(const bf16x8*)(W3T + (size_t)oc * 64 + kk * 32 + fq * 8);
        const float dc = dec[oc];
        for (int tt = 0; tt < 64; ++tt) {
            const int t0 = (tg * 64 + tt) * 16;
            f32x4 acc = {0.f, 0.f, 0.f, 0.f};
#pragma unroll
            for (int kk = 0; kk < 2; ++kk) { const bf16x8 a = *(const bf16x8*)(Z2 + (size_t)(t0 + fr) * 64 + kk * 32 + fq * 8); acc = __builtin_amdgcn_mfma_f32_16x16x32_bf16(a, b[kk], acc, 0, 0, 0); }
            float o[4];
#pragma unroll
            for (int r = 0; r < 4; ++r) { const int t = t0 + fq * 4 + r; const float tau = fabsf((float)(t - SEQ / 2)) * (1.0f / (SEQ / 2)); o[r] = acc[r] * __expf(-tau * dc); }
            u32x2 w; w.x = pk2(o[0], o[1]); w.y = pk2(o[2], o[3]);
            *(u32x2*)(FILT + (size_t)oc * SEQ + t0 + fq * 4) = w;
        }
        if (with_ctx) {
            const bf16_t* Z2C = (const bf16_t*)(F.ws + WS_Z2C); float* FC = (float*)(F.ws + WS_FILTC);
            const int t0 = tg * 16;
            f32x4 acc = {0.f, 0.f, 0.f, 0.f};
#pragma unroll
            for (int kk = 0; kk < 2; ++kk) { const bf16x8 a = *(const bf16x8*)(Z2C + (size_t)(t0 + fr) * 64 + kk * 32 + fq * 8); acc = __builtin_amdgcn_mfma_f32_16x16x32_bf16(a, b[kk], acc, 0, 0, 0); }
#pragma unroll
            for (int r = 0; r < 4; ++r) { const int t = t0 + fq * 4 + r; const float tau = fabsf((float)(t - CTXN / 2)) * (1.0f / (CTXN / 2)); FC[(size_t)oc * CTXN + t] = acc[r] * __expf(-tau * dc); }
        }
    }
}

__device__ __forceinline__ void hyena_inproj(const Frame& F, int slot, bool with_ctx) {
    MultiSched<1> S; Prob pr[1];
    const int colbase = with_ctx ? 0 : CTXN, nN = with_ctx ? 65 : 64;
    pr[0] = Prob{(const char*)(F.ws + WS_WHIN) + (size_t)slot * 3072 * 1024 * 2, (const char*)(F.ws + WS_U) + (size_t)colbase * 1024 * 2, (char*)(F.ws + WS_ZT) + (size_t)colbase * 2, 0, 0, 0, 12, nN, 1, 0, 1024, 1024, LT, 2};
    S.init(F, pr, 12 * nN);
    EpiStore E{F.in[I_HINB] + (size_t)slot * 3072, nullptr, nullptr, 0};
    pg8::gemm_phase<EpiStore, MultiSched<1>, false>(F.lds, 1024, S, E, F.tid);
}

__device__ __forceinline__ f32x2 cmul(f32x2 a, f32x2 b) { return (f32x2){a.x * b.x - a.y * b.y, a.x * b.y + a.y * b.x}; }
__device__ __forceinline__ f32x2 cmulc(f32x2 a, f32x2 b) { return (f32x2){a.x * b.x + a.y * b.y, a.y * b.x - a.x * b.y}; }
__device__ __forceinline__ f32x2 cconj(f32x2 a) { return (f32x2){a.x, -a.y}; }
template <int R> __device__ __forceinline__ constexpr int brevR(int x) { int r = 0; for (int b = 1; b < R; b <<= 1) { r = (r << 1) | (x & 1); x >>= 1; } return r; }
template <int R> __device__ __forceinline__ constexpr int log2R() { int l = 0; for (int b = 1; b < R; b <<= 1) ++l; return l; }
template <int R, int HALF_, bool INV> __device__ __forceinline__ void dft_stage(f32x2 (&v)[R]) {
    constexpr float C32[16] = {1.0f, 0.9807852804032304f, 0.9238795325112867f, 0.8314696123025452f, 0.7071067811865476f, 0.5555702330196022f, 0.3826834323650898f, 0.1950903220161283f,
                               0.0f, -0.1950903220161283f, -0.3826834323650898f, -0.5555702330196022f, -0.7071067811865476f, -0.8314696123025452f, -0.9238795325112867f, -0.9807852804032304f};
    constexpr float S32[16] = {0.0f, 0.1950903220161283f, 0.3826834323650898f, 0.5555702330196022f, 0.7071067811865476f, 0.8314696123025452f, 0.9238795325112867f, 0.9807852804032304f,
                               1.0f, 0.9807852804032304f, 0.9238795325112867f, 0.8314696123025452f, 0.7071067811865476f, 0.5555702330196022f, 0.3826834323650898f, 0.1950903220161283f};
#pragma unroll
    for (int blk = 0; blk < R; blk += 2 * HALF_) {
#pragma unroll
        for (int j = 0; j < HALF_; ++j) {
            const f32x2 a = v[blk + j], b = v[blk + j + HALF_];
            v[blk + j] = a + b; const f32x2 d = a - b;
            constexpr int TS = 16 / HALF_;
            const int ti = j * TS;
            if (ti == 0) v[blk + j + HALF_] = d;
            else if (ti == 8) v[blk + j + HALF_] = INV ? (f32x2){-d.y, d.x} : (f32x2){d.y, -d.x};
            else { const f32x2 w = {C32[ti], INV ? S32[ti] : -S32[ti]}; v[blk + j + HALF_] = cmul(d, w); }
        }
    }
    if constexpr (HALF_ > 1) dft_stage<R, HALF_ / 2, INV>(v);
}
template <int R, bool INV> __device__ __forceinline__ void dft_reg(f32x2 (&v)[R]) { dft_stage<R, R / 2, INV>(v); }
__device__ __forceinline__ int fpad(int i) { return i + (i >> 5); }
__device__ __forceinline__ f32x2 unit_root(int num, int den_log2) {
    asm volatile("" : "+v"(num));
    float s, c; sincospif((float)num * (2.0f / (float)(1 << den_log2)), &s, &c); return (f32x2){c, -s};
}
template <bool INV> __device__ __forceinline__ void fft_pass_a(LAS f32x2* buf, int tid) {
#pragma unroll 1
    for (int rr = 0; rr < 2; ++rr) { const int r = tid + rr * 512, pr = fpad(r); f32x2 v[16];
        const f32x2 w1 = unit_root(r, 14);
        if (!INV) {
#pragma unroll
            for (int a = 0; a < 16; ++a) v[a] = buf[pr + a * 1056];
            dft_reg<16, false>(v);
            f32x2 w = w1;
            buf[pr] = v[0];
#pragma unroll
            for (int p = 1; p < 16; ++p) { buf[pr + p * 1056] = cmul(v[brevR<16>(p)], w); w = cmul(w, w1); }
        } else {
            f32x2 w = w1;
            v[0] = buf[pr];
#pragma unroll
            for (int p = 1; p < 16; ++p) { v[p] = cmulc(buf[pr + p * 1056], w); w = cmul(w, w1); }
            dft_reg<16, true>(v);
#pragma unroll
            for (int a = 0; a < 16; ++a) buf[pr + a * 1056] = v[brevR<16>(a)];
        }
    }
}
__device__ __forceinline__ void fft_pass_a_fwd_regs(LAS f32x2* buf, const f32x2 (&z)[16], int tid) {
#pragma unroll
    for (int rr = 0; rr < 2; ++rr) { const int r = tid + rr * 512, pr = fpad(r); f32x2 v[16];
        const f32x2 w1 = unit_root(r, 14);
#pragma unroll
        for (int a = 0; a < 16; ++a) v[a] = (a < 8) ? z[2 * a + rr] : (f32x2){0.f, 0.f};
        dft_reg<16, false>(v);
        f32x2 w = w1;
        buf[pr] = v[0];
#pragma unroll
        for (int p = 1; p < 16; ++p) { buf[pr + p * 1056] = cmul(v[brevR<16>(p)], w); w = cmul(w, w1); }
    }
}
__device__ __forceinline__ void fft_pass_a_inv_regs(const LAS f32x2* buf, f32x2 (&y)[16], int tid) {
#pragma unroll
    for (int rr = 0; rr < 2; ++rr) { const int r = tid + rr * 512, pr = fpad(r); f32x2 v[16];
        const f32x2 w1 = unit_root(r, 14);
        f32x2 w = w1;
        v[0] = buf[pr];
#pragma unroll
        for (int p = 1; p < 16; ++p) { v[p] = cmulc(buf[pr + p * 1056], w); w = cmul(w, w1); }
        dft_reg<16, true>(v);
#pragma unroll
        for (int a = 4; a < 12; ++a) y[2 * (a - 4) + rr] = v[brevR<16>(a)];
    }
}
template <bool INV> __device__ __forceinline__ void fft_pass_b(LAS f32x2* buf, int tid) {
    const int p1 = tid >> 5, r = tid & 31, pb = fpad(p1 * 1024 + r); f32x2 v[32];
    const f32x2 w1 = unit_root(r, 10);
    if (!INV) {
#pragma unroll
        for (int a = 0; a < 32; ++a) v[a] = buf[pb + a * 33];
        dft_reg<32, false>(v);
        f32x2 w = w1;
        buf[pb] = v[0];
#pragma unroll
        for (int p = 1; p < 32; ++p) { buf[pb + p * 33] = cmul(v[brevR<32>(p)], w); w = cmul(w, w1); }
    } else {
        f32x2 w = w1;
        v[0] = buf[pb];
#pragma unroll
        for (int p = 1; p < 32; ++p) { v[p] = cmulc(buf[pb + p * 33], w); w = cmul(w, w1); }
        dft_reg<32, true>(v);
#pragma unroll
        for (int a = 0; a < 32; ++a) buf[pb + a * 33] = v[brevR<32>(a)];
    }
}
template <bool INV> __device__ __forceinline__ void fft_pass_c(LAS f32x2* buf, int tid) {
    const int base = tid * 33; f32x2 v[32];
#pragma unroll
    for (int a = 0; a < 32; ++a) v[a] = buf[base + a];
    dft_reg<32, INV>(v);
#pragma unroll
    for (int a = 0; a < 32; ++a) buf[base + a] = v[brevR<32>(a)];
}
__device__ __forceinline__ void fft_fwd(LAS f32x2* buf, int tid) { fft_pass_a<false>(buf, tid); __syncthreads(); fft_pass_b<false>(buf, tid); __syncthreads(); fft_pass_c<false>(buf, tid); __syncthreads(); }
__device__ __forceinline__ void fft_inv(LAS f32x2* buf, int tid) { fft_pass_c<true>(buf, tid); __syncthreads(); fft_pass_b<true>(buf, tid); __syncthreads(); fft_pass_a<true>(buf, tid); __syncthreads(); }
__device__ __forceinline__ int fft_k_of_pos(int pos) { return (pos >> 10) + 16 * ((pos >> 5) & 31) + 512 * (pos & 31); }
__device__ __forceinline__ int fft_pos_of_k(int k) { return (k & 15) * 1024 + ((k >> 4) & 31) * 32 + (k >> 9); }

__device__ __forceinline__ int fft_pos_of_ci(int ci) { return (ci >> 9) * 1024 + ((ci >> 4) & 31) * 32 + (ci & 15); }
__device__ __forceinline__ void fft_save_pairs(const LAS f32x2* buf, f32x4* zh, const f32x2* twp, float scale, int tid) {
#pragma unroll 4
    for (int it = 0; it < 16; ++it) { const int ci = it * 512 + tid, pos = fft_pos_of_ci(ci), k = fft_k_of_pos(pos);
        const int pos2 = (k == 0) ? 16 : fft_pos_of_k(16384 - k);
        const f32x2 h1 = buf[fpad(pos)], h2 = buf[fpad(pos2)];
        if (k == 0) zh[ci] = (f32x4){(h1.x + h1.y) * scale, (h1.x - h1.y) * scale, h2.x * scale, -h2.y * scale};
        else { const f32x2 wn = twp[ci];
            const f32x2 eh = {0.5f * (h1.x + h2.x), 0.5f * (h1.y - h2.y)}, dh = {0.5f * (h1.x - h2.x), 0.5f * (h1.y + h2.y)};
            const f32x2 th = cmul(wn, (f32x2){dh.y, -dh.x});
            const f32x2 hk = (eh + th) * scale, hk2 = cconj(eh - th) * scale;
            zh[ci] = (f32x4){hk.x, hk.y, hk2.x, hk2.y}; } }
}
__device__ __forceinline__ void fft_pointwise(LAS f32x2* buf, const f32x4* zh, const f32x2* twp, int tid) {
#pragma unroll 2
    for (int it = 0; it < 16; ++it) { const int ci = it * 512 + tid, pos = fft_pos_of_ci(ci), k = fft_k_of_pos(pos);
        const f32x4 hq = zh[ci];
        if (k == 0) {
            const f32x2 z0 = buf[0], zm = buf[16];
            const float y0 = (z0.x + z0.y) * hq[0], yn = (z0.x - z0.y) * hq[1];
            buf[0] = (f32x2){0.5f * (y0 + yn), 0.5f * (y0 - yn)};
            const f32x2 ym = cmul(cconj(zm), (f32x2){hq[2], hq[3]});
            buf[16] = (f32x2){ym.x, -ym.y};
        } else {
            const int pp = fpad(pos), pp2 = fpad(fft_pos_of_k(16384 - k));
            const f32x2 z1 = buf[pp], z2 = buf[pp2];
            const f32x2 wn = twp[ci];
            const f32x2 ex = {0.5f * (z1.x + z2.x), 0.5f * (z1.y - z2.y)}, dx = {0.5f * (z1.x - z2.x), 0.5f * (z1.y + z2.y)};
            const f32x2 tx = cmul(wn, (f32x2){dx.y, -dx.x});
            const f32x2 xk = ex + tx, xk2 = cconj(ex - tx);
            const f32x2 yk = cmul(xk, (f32x2){hq[0], hq[1]}), yk2 = cmul(xk2, (f32x2){hq[2], hq[3]});
            const f32x2 e2 = {0.5f * (yk.x + yk2.x), 0.5f * (yk.y - yk2.y)}, d2 = {0.5f * (yk.x - yk2.x), 0.5f * (yk.y + yk2.y)};
            const f32x2 o2 = cmulc(d2, wn);
            buf[pp] = (f32x2){e2.x - o2.y, e2.y + o2.x};
            buf[pp2] = (f32x2){e2.x + o2.y, -(e2.y - o2.x)};
        }
    }
}
__device__ __forceinline__ f32x2 sconv2(const bf16_t* row, int n, int Ln, float w0, float w1, float w2, float b) {
    struct W3 { unsigned p, c, q; } t;
    __builtin_memcpy(&t, (const unsigned*)row + (n - 1), 12);
    const unsigned p = (n > 0) ? t.p : 0u, q = (2 * n + 2 < Ln) ? t.q : 0u, c = t.c;
    const float xm1 = bfhi(p), x0 = bflo(c), x1 = bfhi(c), x2 = bflo(q);
    return (f32x2){b + w0 * xm1 + w1 * x0 + w2 * x1, b + w0 * x0 + w1 * x1 + w2 * x2};
}
__device__ __forceinline__ float block_sum(LAS float* red, float v, int tid) {
    v = wave_sum(v);
    __syncthreads();
    if ((tid & 63) == 0) red[tid >> 6] = v;
    __syncthreads();
    float s = 0.f;
#pragma unroll
    for (int i = 0; i < 8; ++i) s += red[i];
    return s;
}

__device__ __forceinline__ void hyena_filter_fft(const Frame& F, int vbid, int vG) {
    LAS f32x2* buf = (LAS f32x2*)F.lds;
    LAS float* red = (LAS float*)(F.lds + (16384 + 512) * 8);
    const bf16_t* FILT = (const bf16_t*)(F.ws + WS_FILT2);
    const int tid = F.tid, pt = fpad(F.tid);
    for (int job = vbid; job < 2048; job += vG) {
        const int c = job >> 1, ord = job & 1;
        const unsigned* f32p = (const unsigned*)(FILT + (size_t)(ord * 1024 + c) * SEQ);
        float ss = 0.f; f32x2 fz[16];
        __syncthreads();
#pragma unroll
        for (int j = 0; j < 16; ++j) { const int n = tid + 512 * j; const unsigned w = f32p[n]; const float a = bflo(w), b = bfhi(w); ss += a * a + b * b; fz[j] = (f32x2){a, b}; }
        const float tot = block_sum(red, ss, tid);
        const float fsv = rsqrtf(tot + EPS) * (1.0f / 16384.0f);
        fft_pass_a_fwd_regs(buf, fz, tid); __syncthreads(); fft_pass_b<false>(buf, tid); __syncthreads(); fft_pass_c<false>(buf, tid); __syncthreads();
        fft_save_pairs(buf, (f32x4*)(F.ws + WS_ZHALL) + (size_t)job * 8192, (const f32x2*)(F.ws + WS_TWP), fsv, tid);
    }
    __syncthreads();
}

__device__ __forceinline__ void hyena_fft(const Frame& F, int slot, bool with_ctx) {
    LAS f32x2* buf = (LAS f32x2*)F.lds;
    LAS float* red = (LAS float*)(F.lds + (16384 + 512) * 8);
    const bf16_t* ZT = (const bf16_t*)(F.ws + WS_ZT); bf16_t* Y2T = (bf16_t*)(F.ws + WS_Y2T);
    const f32x2* twp = (const f32x2*)(F.ws + WS_TWP);
    const float* scw = F.in[I_HSCW] + (size_t)slot * 3 * 3072; const float* scb = F.in[I_HSCB] + (size_t)slot * 3072; const float* fb = F.in[I_HFBIAS] + (size_t)slot * 2048;
    const int tid = F.tid, pt = fpad(F.tid);
    for (int c = F.bid; c < 1024; c += F.G) {
        const f32x4* zh = (const f32x4*)(F.ws + WS_ZHALL) + (size_t)c * 2 * 8192;
        __syncthreads();
        f32x2 vv[16], yy[16];
        {
            const int zc = 2048 + c; const float w0 = scw[zc], w1 = scw[3072 + zc], w2 = scw[2 * 3072 + zc], b = scb[zc];
            const bf16_t* row = ZT + (size_t)zc * LT + CTXN;
#pragma unroll
            for (int j = 0; j < 16; ++j) { const int n = tid + 512 * j; vv[j] = sconv2(row, n, SEQ, w0, w1, w2, b); if ((j & 3) == 3) __builtin_amdgcn_sched_barrier(0); }
        }
        fft_pass_a_fwd_regs(buf, vv, tid); __syncthreads(); fft_pass_b<false>(buf, tid); __syncthreads(); fft_pass_c<false>(buf, tid); __syncthreads();
        fft_pointwise(buf, zh, twp, tid);
        __syncthreads();
        fft_pass_c<true>(buf, tid); __syncthreads(); fft_pass_b<true>(buf, tid); __syncthreads(); fft_pass_a_inv_regs(buf, yy, tid);
        {
            const int zc = c; const float w0 = scw[zc], w1 = scw[3072 + zc], w2 = scw[2 * 3072 + zc], b = scb[zc], fb0 = fb[c];
            const bf16_t* row = ZT + (size_t)zc * LT + CTXN;
#pragma unroll
            for (int j = 0; j < 16; ++j) { const int n = tid + 512 * j; const f32x2 x1 = sconv2(row, n, SEQ, w0, w1, w2, b);
                vv[j] = (f32x2){x1.x * (yy[j].x + vv[j].x * fb0), x1.y * (yy[j].y + vv[j].y * fb0)}; if ((j & 3) == 3) __builtin_amdgcn_sched_barrier(0); }
        }
        fft_pass_a_fwd_regs(buf, vv, tid); __syncthreads(); fft_pass_b<false>(buf, tid); __syncthreads(); fft_pass_c<false>(buf, tid); __syncthreads();
        fft_pointwise(buf, zh + 8192, twp, tid);
        __syncthreads();
        fft_pass_c<true>(buf, tid); __syncthreads(); fft_pass_b<true>(buf, tid); __syncthreads(); fft_pass_a_inv_regs(buf, yy, tid);
        {
            const int zc = 1024 + c; const float w0 = scw[zc], w1 = scw[3072 + zc], w2 = scw[2 * 3072 + zc], b = scb[zc], fb1 = fb[1024 + c];
            const bf16_t* row = ZT + (size_t)zc * LT + CTXN;
            unsigned* orow = (unsigned*)(Y2T + (size_t)c * LT + CTXN);
#pragma unroll
            for (int j = 0; j < 16; ++j) { const int n = tid + 512 * j; const f32x2 x2 = sconv2(row, n, SEQ, w0, w1, w2, b);
                orow[n] = pk2(x2.x * (yy[j].x + vv[j].x * fb1), x2.y * (yy[j].y + vv[j].y * fb1)); if ((j & 3) == 3) __builtin_amdgcn_sched_barrier(0); }
        }
        __syncthreads();
    }
    if (with_ctx) {
        LAS float* ub = (LAS float*)F.lds;
        LAS float* fbuf = ub + 512;
        const float* FC = (const float*)(F.ws + WS_FILTC);
        const int cc = tid >> 8, t = tid & 255;
        for (int c0 = F.bid * 2; c0 < 1024; c0 += F.G * 2) {
            const int c = c0 + cc;
            float cur, y1 = 0.f;
            { const int zc = 2048 + c; const bf16_t* row = ZT + (size_t)zc * LT;
              const float xm = t > 0 ? bf2f(row[t - 1]) : 0.f, x0 = bf2f(row[t]), xp = t < 255 ? bf2f(row[t + 1]) : 0.f;
              cur = scb[zc] + scw[zc] * xm + scw[3072 + zc] * x0 + scw[2 * 3072 + zc] * xp; }
#pragma unroll 1
            for (int ord = 0; ord < 2; ++ord) {
                __syncthreads();
                const float fv = FC[(size_t)(ord * 1024 + c) * CTXN + t];
                ub[cc * 256 + t] = cur; fbuf[cc * 256 + t] = fv;
                float ss = fv * fv;
                ss = wave_sum(ss);
                __syncthreads();
                if (F.lane == 0) red[F.wave] = ss;
                __syncthreads();
                const float tot = red[cc * 4] + red[cc * 4 + 1] + red[cc * 4 + 2] + red[cc * 4 + 3];
                const float fs = rsqrtf(tot + EPS);
                float acc = 0.f;
                const int jlo = max(0, t + 128 - 255), jhi = min(255, t + 128);
                for (int j = jlo; j <= jhi; ++j) acc += fbuf[cc * 256 + j] * ub[cc * 256 + t + 128 - j];
                const int zc = ord * 1024 + c; const bf16_t* row = ZT + (size_t)zc * LT;
                const float xm = t > 0 ? bf2f(row[t - 1]) : 0.f, x0 = bf2f(row[t]), xp = t < 255 ? bf2f(row[t + 1]) : 0.f;
                const float xg = scb[zc] + scw[zc] * xm + scw[3072 + zc] * x0 + scw[2 * 3072 + zc] * xp;
                const float yo = xg * (acc * fs + cur * fb[ord * 1024 + c]);
                if (ord == 0) { y1 = yo; cur = y1; } else Y2T[(size_t)c * LT + t] = f2bf(yo);
            }
        }
        __syncthreads();
    }
}

__device__ __forceinline__ void hyena_transpose(const Frame& F, bool with_ctx) {
    LAS bf16_t* tile = (LAS bf16_t*)F.lds;
    const bf16_t* Y2T = (const bf16_t*)(F.ws + WS_Y2T); bf16_t* Y2 = (bf16_t*)(F.ws + WS_Y2);
    const int tlo = with_ctx ? 0 : 4, ntt = NCH - tlo, ntile = 16 * ntt;
    for (int ti = F.bid; ti < ntile; ti += F.G) {
        const int c0 = (ti % 16) * 64, t0 = (tlo + ti / 16) * 64;
        LDS_BAR();
        { const int c = F.tid >> 3, t8 = (F.tid & 7) * 8; const u32x4 v = *(const u32x4*)(Y2T + (size_t)(c0 + c) * LT + t0 + t8); *(LAS u32x4*)(tile + c * 72 + t8) = v; }
        LDS_BAR();
        { const int t = F.tid >> 3, c8 = (F.tid & 7) * 8; bf16_t e[8];
#pragma unroll
          for (int j = 0; j < 8; ++j) e[j] = tile[(c8 + j) * 72 + t];
          u32x4 w; w.x = (unsigned)e[0] | ((unsigned)e[1] << 16); w.y = (unsigned)e[2] | ((unsigned)e[3] << 16); w.z = (unsigned)e[4] | ((unsigned)e[5] << 16); w.w = (unsigned)e[6] | ((unsigned)e[7] << 16);
          *(u32x4*)(Y2 + (size_t)(t0 + t) * 1024 + c0 + c8) = w; }
    }
}

__device__ __forceinline__ void hyena_outproj(const Frame& F, int l, int slot, bool with_ctx, bool colmajor) {
    MultiSched<1> S; Prob pr[1];
    const int rowbase = CTXN, nM = 64;
    pr[0] = Prob{(const char*)(F.ws + WS_Y2) + (size_t)rowbase * 1024 * 2, (const char*)(F.ws + WS_WHOUT) + (size_t)slot * 1024 * 1024 * 2, nullptr, 0, 0, 0, nM, 4, 1, 0, 1024, 1024, 0, 0};
    S.init(F, pr, nM * 4);
    EpiResid E{(bf16_t*)(F.ws + WS_HL), (bf16_t*)(F.ws + WS_HC), modp(F, l, 0, 2), modp(F, l, 1, 2), F.in[I_HOUTB] + (size_t)slot * 1024, rowbase, colmajor};
    pg8::gemm_phase<EpiResid, MultiSched<1>, false>(F.lds, 1024, S, E, F.tid);
    if (with_ctx) ctx_panel<1024>(F, (const bf16_t*)(F.ws + WS_Y2), (const bf16_t*)(F.ws + WS_WHOUT) + (size_t)slot * 1024 * 1024, F.in[I_HOUTB] + (size_t)slot * 1024, modp(F, l, 1, 2), (bf16_t*)(F.ws + WS_HC));
}
constexpr int MOE_MAXG = 8;
constexpr int MOE_MAXU = 6;
constexpr int MOE_TAB = 131072;

__device__ __forceinline__ void moe_route(const Frame& F, int l, bool with_ctx) {
    constexpr int VP = 1028;
    LAS float* vs = (LAS float*)F.lds;
    LAS float* part = vs + 16 * VP;
    LAS float* lg = part + 8 * 16 * 48;
    LAS int* re = (LAS int*)(lg + 16 * 48);
    LAS float* rw = (LAS float*)(re + MOE_MAXG * 32);
    LAS int* rp = (LAS int*)(rw + MOE_MAXG * 32);
    LAS int* lc = rp + MOE_MAXG * 32;
    LAS int* lb = lc + 32;
    const bf16_t* HL = (const bf16_t*)(F.ws + WS_HL); const bf16_t* HC = (const bf16_t*)(F.ws + WS_HC); bf16_t* VN = (bf16_t*)(F.ws + WS_VN);
    const float* WC = (const float*)(F.ws + WS_WC) + (size_t)l * 1024 * 48;
    const float* g2n = F.in[I_N2G] + l * 1024;
    unsigned* cnt = (unsigned*)(F.ws + WS_CTL) + CW_CNT + l * 32 * 64;
    int* LIST = (int*)(F.ws + WS_LIST); float* AW = (float*)(F.ws + WS_AW);
    const int ntok = with_ctx ? LT : SEQ, tokbase = with_ctx ? 0 : CTXN, ngroups = ntok / 16;
    const int fr = F.lane & 15, fq = F.lane >> 4;
    float wcr[32][3];
#pragma unroll
    for (int st = 0; st < 32; ++st)
#pragma unroll
        for (int nt = 0; nt < 3; ++nt) wcr[st][nt] = WC[(size_t)(F.wave * 128 + st * 4 + fq) * 48 + nt * 16 + fr];
    int gi = 0;
    for (int grp = F.bid; grp < ngroups && gi < MOE_MAXG; grp += F.G, ++gi) {
        LDS_BAR();
#pragma unroll
        for (int rr = 0; rr < 2; ++rr) { const int i = 2 * F.wave + rr, tok = tokbase + grp * 16 + i; const bool isctx = tok < CTXN; const int s = isctx ? 1 : 0;
            const bf16_t* src = isctx ? HC + (size_t)tok * 1024 : HL + (size_t)(tok - CTXN) * 1024;
            const float* sh = modp(F, l, s, 3); const float* sc = modp(F, l, s, 4);
            f32x4 v[4]; float ss = 0.f;
#pragma unroll
            for (int j = 0; j < 4; ++j) { const u32x2 hb = *(const u32x2*)(src + j * 256 + F.lane * 4); v[j] = (f32x4){bflo(hb.x), bfhi(hb.x), bflo(hb.y), bfhi(hb.y)}; ss += v[j][0] * v[j][0] + v[j][1] * v[j][1] + v[j][2] * v[j][2] + v[j][3] * v[j][3]; }
            ss = wave_sum(ss);
            const float rstd = rsqrtf(ss * (1.0f / 1024.0f) + EPS);
#pragma unroll
            for (int j = 0; j < 4; ++j) { const int c = j * 256 + F.lane * 4; const f32x4 g = *(const f32x4*)(g2n + c), a = *(const f32x4*)(sc + c), b = *(const f32x4*)(sh + c);
                f32x4 o;
#pragma unroll
                for (int e = 0; e < 4; ++e) o[e] = v[j][e] * rstd * g[e] * (1.0f + a[e]) + b[e];
                *(LAS f32x4*)(vs + i * VP + c) = o;
                u32x2 w; w.x = pk2(o[0], o[1]); w.y = pk2(o[2], o[3]); *(u32x2*)(VN + (size_t)tok * 1024 + c) = w; }
        }
        LDS_BAR();
        {
            f32x4 acc[3] = {{0.f, 0.f, 0.f, 0.f}, {0.f, 0.f, 0.f, 0.f}, {0.f, 0.f, 0.f, 0.f}};
#pragma unroll
            for (int st = 0; st < 32; ++st) { const int k = F.wave * 128 + st * 4 + fq; const float a = vs[fr * VP + k];
#pragma unroll
                for (int nt = 0; nt < 3; ++nt) acc[nt] = __builtin_amdgcn_mfma_f32_16x16x4f32(a, wcr[st][nt], acc[nt], 0, 0, 0); }
#pragma unroll
            for (int nt = 0; nt < 3; ++nt)
#pragma unroll
                for (int r = 0; r < 4; ++r) part[(F.wave * 16 + fq * 4 + r) * 48 + nt * 16 + fr] = acc[nt][r];
        }
        LDS_BAR();
        for (int idx = F.tid; idx < 16 * 48; idx += NT) { const int n = idx % 48; float a = (n < 4) ? F.in[I_RGB][l * 4 + n] : (n < 36 ? F.in[I_REB][l * 32 + n - 4] : 0.f);
#pragma unroll
            for (int w = 0; w < 8; ++w) a += part[w * 16 * 48 + idx];
            lg[idx] = a; }
        LDS_BAR();
        if (F.tid < 16) { const LAS float* q = lg + F.tid * 48;
            int gx = 0; float gm = q[0];
            for (int j = 1; j < 4; ++j) if (q[j] > gm) { gm = q[j]; gx = j; }
            float gs = 0.f; for (int j = 0; j < 4; ++j) gs += __expf(q[j] - gm);
            const float gw = 1.0f / gs;
            const LAS float* e = q + 4 + gx * 8;
            int i1 = 0; float m1 = e[0];
            for (int j = 1; j < 8; ++j) if (e[j] > m1) { m1 = e[j]; i1 = j; }
            int i2 = -1; float m2 = 0.f;
            for (int j = 0; j < 8; ++j) if (j != i1 && (i2 < 0 || e[j] > m2)) { m2 = e[j]; i2 = j; }
            const float x = __expf(m2 - m1), w1 = 1.0f / (1.0f + x), w2 = x / (1.0f + x);
            const int a0 = gi * 32 + F.tid * 2;
            re[a0] = gx * 8 + i1; rw[a0] = gw * w1; re[a0 + 1] = gx * 8 + i2; rw[a0 + 1] = gw * w2; }
    }
    LDS_BAR();
    if (F.tid < 32) lc[F.tid] = 0;
    LDS_BAR();
    const int na = gi * 32;
    if (F.tid < na) rp[F.tid] = __hip_atomic_fetch_add(&lc[re[F.tid]], 1, __ATOMIC_RELAXED, __HIP_MEMORY_SCOPE_WORKGROUP);
    LDS_BAR();
    if (F.tid < 32) lb[F.tid] = lc[F.tid] > 0 ? (int)__hip_atomic_fetch_add(cnt + F.tid * 64, (unsigned)lc[F.tid], RLX_AGENT) : 0;
    LDS_BAR();
    if (F.tid < na) { const int a = F.tid, g = a >> 5, i = (a >> 1) & 15, slot = a & 1, e = re[a];
        const int tok = tokbase + (F.bid + g * F.G) * 16 + i, gidx = tok * 2 + slot;
        LIST[(size_t)e * NASG + lb[e] + rp[a]] = gidx; AW[gidx] = rw[a]; }
}

struct MoeSched {
    LAS int* cnt; LAS int* tstart; LAS unsigned* rowtab;
    const char* A; const char* B; char* O; int total, G, c, mode;
    __device__ __forceinline__ void locate(int Lq, int& e, int& mt, int& pn) const {
        const int L = pg8::xcd_remap(Lq, total);
        const int mtg = L >> 2; pn = L & 3; e = 0;
        for (int j = 1; j < 32; ++j) if (tstart[j] <= mtg) e = j;
        mt = mtg - tstart[e];
    }
    __device__ __forceinline__ bool next(int i, GUnit& u) const {
        const int L = i * G + c; if (L >= total) return false;
        int e, mt, pn; locate(L, e, mt, pn);
        u.g = e; u.aux = mt; u.pm = tstart[e] + mt; u.pn = pn; u.half = i;
        if (mode == 0) { u.a = A; u.lda = 1024; u.b = B + ((size_t)e * 1024 + pn * 128) * 1024 * 2; u.ldb = 1024; u.hsb = 512; u.o = O + ((size_t)u.pm * 256 * 512 + pn * 128) * 2; u.ldo = 512; }
        else { u.a = A + (size_t)u.pm * 256 * 512 * 2; u.lda = 512; u.b = B + ((size_t)e * 1024 + pn * 256) * 512 * 2; u.ldb = 512; u.hsb = 128; u.o = O; u.ldo = 1024; }
        return true;
    }
    __device__ __forceinline__ unsigned grow(int slot, int r) const { return rowtab[slot * 256 + r]; }
};
__device__ __forceinline__ void moe_tables(const Frame& F, int l, MoeSched& S, int mode) {
    S.cnt = (LAS int*)(F.lds + MOE_TAB); S.tstart = S.cnt + 32; S.rowtab = (LAS unsigned*)(F.lds + MOE_TAB + 512);
    const unsigned* cnt = (const unsigned*)(F.ws + WS_CTL) + CW_CNT + l * 32 * 64;
    __syncthreads();
    if (F.tid < 32) S.cnt[F.tid] = (int)__hip_atomic_load(cnt + F.tid * 64, RLX_AGENT);
    __syncthreads();
    if (F.tid == 0) { int a = 0; for (int e = 0; e < 32; ++e) { S.tstart[e] = a; a += (S.cnt[e] + 255) >> 8; } S.tstart[32] = a; }
    __syncthreads();
    S.total = S.tstart[32] * 4; S.G = F.G; S.c = F.bid; S.mode = mode;
    if (mode == 0 && F.tid < 256) {
        const int* LIST = (const int*)(F.ws + WS_LIST);
        for (int slot = 0; slot < MOE_MAXU; ++slot) { const int L = slot * S.G + S.c; if (L >= S.total) break;
            int e, mt, pn; S.locate(L, e, mt, pn);
            const int idx = mt * 256 + F.tid; const int tok = idx < S.cnt[e] ? (LIST[(size_t)e * NASG + idx] >> 1) : 0;
            S.rowtab[slot * 256 + F.tid] = (unsigned)tok * 2048u; }
    }
    if (mode == 1 && F.tid < 256) {
        const int* LIST = (const int*)(F.ws + WS_LIST); const float* AW = (const float*)(F.ws + WS_AW);
        LAS float* awtab = (LAS float*)(S.rowtab + MOE_MAXU * 256);
        for (int slot = 0; slot < MOE_MAXU; ++slot) { const int L = slot * S.G + S.c; if (L >= S.total) break;
            int e, mt, pn; S.locate(L, e, mt, pn);
            const int idx = mt * 256 + F.tid; const bool ok = idx < S.cnt[e]; const int a = ok ? LIST[(size_t)e * NASG + idx] : -1;
            S.rowtab[slot * 256 + F.tid] = (unsigned)a; awtab[slot * 256 + F.tid] = ok ? AW[a] : 0.f; }
    }
    __syncthreads();
}
struct EpiSwiGLU {
    static constexpr bool PERM = true;
    __device__ __forceinline__ void operator()(const f32x4 (&acc)[2][2][4][2], const GUnit& u, int wr, int wc, int fr, int fq) const {
        bf16_t* base = (bf16_t*)u.o;
#pragma unroll
        for (int ai = 0; ai < 2; ++ai)
#pragma unroll
            for (int m = 0; m < 4; ++m) { const int r = ai * 128 + wr * 64 + m * 16 + fr; float o[8];
#pragma unroll
                for (int n = 0; n < 2; ++n)
#pragma unroll
                    for (int j = 0; j < 4; ++j) o[n * 4 + j] = siluf(acc[ai][0][m][n][j]) * acc[ai][1][m][n][j];
                u32x4 w; w.x = pk2(o[0], o[1]); w.y = pk2(o[2], o[3]); w.z = pk2(o[4], o[5]); w.w = pk2(o[6], o[7]);
                *(u32x4*)(base + (size_t)r * 512 + wc * 32 + 8 * fq) = w; }
    }
};
struct EpiScatter {
    static constexpr bool PERM = true;
    LAS unsigned* rowtab; bf16_t* YB;
    __device__ __forceinline__ void operator()(const f32x4 (&acc)[2][2][4][2], const GUnit& u, int wr, int wc, int fr, int fq) const {
        const LAS unsigned* rt = rowtab + u.half * 256; const LAS float* wt = (const LAS float*)(rowtab + MOE_MAXU * 256) + u.half * 256;
#pragma unroll
        for (int ai = 0; ai < 2; ++ai)
#pragma unroll
            for (int m = 0; m < 4; ++m) { const int r = ai * 128 + wr * 64 + m * 16 + fr; const int a = (int)rt[r];
                if (a >= 0) { const float w = wt[r];
                    bf16_t* rowp = YB + (size_t)a * 1024 + u.pn * 256 + wc * 32 + 8 * fq;
#pragma unroll
                    for (int bj = 0; bj < 2; ++bj) { const f32x4 v0 = acc[ai][bj][m][0] * w, v1 = acc[ai][bj][m][1] * w;
                        u32x4 q; q.x = pk2(v0[0], v0[1]); q.y = pk2(v0[2], v0[3]); q.z = pk2(v1[0], v1[1]); q.w = pk2(v1[2], v1[3]);
                        *(u32x4*)(rowp + bj * 128) = q; } } }
    }
};
__device__ __forceinline__ void moe_e1(const Frame& F, int l) {
    MoeSched S; moe_tables(F, l, S, 0);
    S.A = (const char*)(F.ws + WS_VN); S.B = (const char*)(F.ws + WS_W13) + (size_t)l * 32 * 1024 * 1024 * 2; S.O = (char*)(F.ws + WS_H1);
    EpiSwiGLU E;
    pg8::gemm_phase<EpiSwiGLU, MoeSched, true>(F.lds, 1024, S, E, F.tid);
}
__device__ __forceinline__ void moe_e2(const Frame& F, int l) {
    MoeSched S; moe_tables(F, l, S, 1);
    S.A = (const char*)(F.ws + WS_H1); S.B = (const char*)(F.ws + WS_W2) + (size_t)l * 32 * 1024 * 512 * 2; S.O = nullptr;
    EpiScatter E{S.rowtab, (bf16_t*)(F.ws + WS_YBUF)};
    pg8::gemm_phase<EpiScatter, MoeSched, false>(F.lds, 512, S, E, F.tid);
}
#ifndef MK_LAYERS
#define MK_LAYERS 4
#endif
__global__ void __launch_bounds__(NT, 2) mk_fwd(Args args) {
    extern __shared__ __attribute__((aligned(16))) unsigned char lds_raw[];
    Frame F0;
    { Frame& F = F0;
    F.lds = (LAS unsigned char*)lds_raw; F.ws = args.ws; F.in = args.in; F.out = args.out;
    F.wave = __builtin_amdgcn_readfirstlane((int)threadIdx.x >> 6); F.lane = fresh_lane(); F.tid = F.wave * 64 + F.lane; F.G = gridDim.x; F.bid = blockIdx.x; }
    const Frame& F = F0;
    volatile LAS unsigned* xbw = (volatile LAS unsigned*)(F.lds + LDS_BYTES - 16);
    if (F.tid < 4) xbw[F.tid] = 0u;
    __syncthreads();
    unsigned* ctl = (unsigned*)(F.ws + WS_CTL);
    const int lo = args.ph_lo, hi = args.ph_hi;
    XcdBarrier bar; bar.bar = ctl + CW_BAR; bar.x = 0; bar.st = xbw;
    if (hi - lo > 1) bar = xcd_barrier_post(ctl + CW_BAR, xbw, F.tid);
    int ph = 0;
#ifdef MK_PROBE
    unsigned long long tacc = 0ull, tp0 = 0ull;
#define PROBE_T0(g) tp0 = __builtin_amdgcn_s_memrealtime();
#ifdef MK_PROBE_WG
#define PROBE_TMID(g) if (((MK_PROBE >> (g)) & 1) && F0.bid == MK_PROBE_WG) tacc += __builtin_amdgcn_s_memrealtime() - tp0;
#define PROBE_T1(g)
#elif defined(MK_PROBE_SEL)
#define PROBE_TMID(g) if (((MK_PROBE >> (g)) & 1) && (MK_PROBE_SEL)) tacc += __builtin_amdgcn_s_memrealtime() - tp0;
#define PROBE_T1(g)
#else
#define PROBE_TMID(g)
#define PROBE_T1(g) if ((MK_PROBE >> (g)) & 1) tacc += __builtin_amdgcn_s_memrealtime() - tp0;
#endif
#else
#define PROBE_T0(g)
#define PROBE_T1(g)
#define PROBE_TMID(g)
#endif
#define PHASE_BEGIN(g) if (lo <= ph && ph < hi) { PROBE_T0(g) Frame F = F0; { const int t_ = F0.wave * 64 + fresh_lane(); F.tid = t_; F.lane = t_ & 63; }
#define PHASE_END(g)   PROBE_TMID(g) if (ph + 1 < hi) xcd_barrier(bar, F0.wave * 64 + fresh_lane()); PROBE_T1(g) } ++ph;

    PHASE_BEGIN(0) p0_prologue(F); PHASE_END(0)
    int lprev = -1;
#define LAYER_PAIR(IT) { constexpr int it = IT; \
        const int lm = 2 * it, lh = 2 * it + 1; const bool colmajor = (it == 1), ctxl = (it == 0); \
        if (lm < MK_LAYERS) { \
         \
        PHASE_BEGIN(1) n1_phase(F, lm, it > 0, true, it > 0, it == 0, colmajor); hyena_filtergen(F, it, ctxl); PHASE_END(1) \
        PHASE_BEGIN(2) mlstm_inproj(F, it); PHASE_END(2) \
        PHASE_BEGIN(3) mlstm_conv_gates(F, it); PHASE_END(3) \
        PHASE_BEGIN(4) mlstm_qkv(F, it); PHASE_END(4) \
        PHASE_BEGIN(5) mlstm_scan(F, it); PHASE_END(5) \
        PHASE_BEGIN(6) mlstm_intra(F, it, ctxl ? 0 : 4); PHASE_END(6) \
        PHASE_BEGIN(7) mlstm_outproj(F, lm, it, ctxl, colmajor); PHASE_END(7) \
        PHASE_BEGIN(8) moe_route(F, lm, ctxl); PHASE_END(8) \
        PHASE_BEGIN(9) moe_e1(F, lm); PHASE_END(9) \
        PHASE_BEGIN(10) moe_e2(F, lm); PHASE_END(10) \
        lprev = lm; \
        if (lh < MK_LAYERS) { \
         \
        PHASE_BEGIN(1) n1_phase(F, lh, true, ctxl, ctxl, false, colmajor); PHASE_END(1) \
        PHASE_BEGIN(11) hyena_inproj(F, it, ctxl); PHASE_END(11) \
        PHASE_BEGIN(12) hyena_fft(F, it, ctxl); PHASE_END(12) \
        PHASE_BEGIN(13) hyena_transpose(F, ctxl); PHASE_END(13) \
        PHASE_BEGIN(14) hyena_outproj(F, lh, it, ctxl, colmajor); PHASE_END(14) \
        PHASE_BEGIN(8) moe_route(F, lh, ctxl); PHASE_END(8) \
        PHASE_BEGIN(9) moe_e1(F, lh); PHASE_END(9) \
        PHASE_BEGIN(10) moe_e2(F, lh); PHASE_END(10) \
        lprev = lh; \
        } } }
    LAYER_PAIR(0)
    LAYER_PAIR(1)
    PHASE_BEGIN(15) final_phase(F, lprev >= 0, lprev, lprev < 0); PHASE_END(15)
#ifdef MK_PROBE_WG
    { unsigned long long* slot = (unsigned long long*)(F0.ws + WS_CTL) + 16;
      if (F0.bid == MK_PROBE_WG && F0.tid == 0) __hip_atomic_store(slot, tacc, __ATOMIC_RELAXED, __HIP_MEMORY_SCOPE_AGENT);
      xcd_barrier(bar, F0.wave * 64 + fresh_lane());
      { const unsigned long long tv = __hip_atomic_load(slot, __ATOMIC_RELAXED, __HIP_MEMORY_SCOPE_AGENT); tacc = ((unsigned long long)(unsigned)__builtin_amdgcn_readfirstlane((int)(tv >> 32)) << 32) | (unsigned)__builtin_amdgcn_readfirstlane((int)tv); } }
#endif
#ifdef MK_PROBE
    { const unsigned long long te = __builtin_amdgcn_s_memrealtime() + tacc * MK_PROBE_MULT; while (__builtin_amdgcn_s_memrealtime() < te) __builtin_amdgcn_s_sleep(8); }
#endif
}

extern "C" void kernel_launch(void* const* d_in, const int* in_sizes, int n_in, void* d_out, int out_size, void* d_ws, size_t ws_size, hipStream_t stream) {
    static int grid = 0;
    if (grid == 0) {
        if (n_in != 40 || out_size != SEQ * D || ws_size < WS_END) { fprintf(stderr, "kernel_launch: unexpected shapes (n_in %d out %d ws %zu)\n", n_in, out_size, ws_size); grid = -1; return; }
        int dev = 0, cus = 0, per_cu = 0;
        if (hipGetDevice(&dev) != hipSuccess || hipDeviceGetAttribute(&cus, hipDeviceAttributeMultiprocessorCount, dev) != hipSuccess) { grid = -1; return; }
        if (hipFuncSetAttribute((const void*)mk_fwd, hipFuncAttributeMaxDynamicSharedMemorySize, LDS_BYTES) != hipSuccess) { fprintf(stderr, "kernel_launch: hipFuncSetAttribute failed\n"); grid = -1; return; }
        if (hipOccupancyMaxActiveBlocksPerMultiprocessor(&per_cu, (const void*)mk_fwd, NT, LDS_BYTES) != hipSuccess || per_cu < 1) { fprintf(stderr, "kernel_launch: occupancy query says %d\n", per_cu); }
        (void)hipGetLastError();
        grid = cus;
        if (grid > 256) grid = 256;
        if (grid < 128) { fprintf(stderr, "kernel_launch: needs >= 128 CUs (got %d)\n", grid); grid = -1; return; }
    }
    if (grid < 0) return;
    (void)hipMemsetAsync((char*)d_ws + WS_CTL, 0, CTL_BYTES, stream);
    Args a{};
    for (int i = 0; i < 40; ++i) a.in[i] = (const float*)d_in[i];
    a.out = (float*)d_out; a.ws = (unsigned char*)d_ws;
#ifdef MK_SPLIT
    for (int p = 0; p < MK_SPLIT; ++p) { a.ph_lo = p; a.ph_hi = p + 1; hipLaunchKernelGGL(mk_fwd, dim3(grid), dim3(NT), LDS_BYTES, stream, a); }
#else
    a.ph_lo = 0; a.ph_hi = 1000;
    hipLaunchKernelGGL(mk_fwd, dim3(grid), dim3(NT), LDS_BYTES, stream, a);
#endif
}
```
